# Optimizing an MI355X kernel written in HIP

```python
import math
import jax, jax.numpy as jnp
from jax import lax
import numpy as np

D_MODEL = 1024
BATCH = 4
SEQ = 8192
DEPTH = 2

HEAD_DIM = 64
BRANCH_W = D_MODEL // 4
N_HEADS_BR = BRANCH_W // HEAD_DIM
N_ATTN_HEADS = 2 * N_HEADS_BR
MOBA_BLOCK = 256
MOBA_TOPK = 3
MOBA_QCHUNK = 128
S5_GROUP = 16
S5_GROUPS = BRANCH_W // S5_GROUP
S5_STATE = 64
HGRN_CHUNK = 64
DIL_PAIRS = ((128, 1), (512, 4), (2048, 16))
DIL_BLOCK = 128
REL_BUCKETS = 32
REL_MAX_DIST = 2048
ALPHA = (2 * DEPTH) ** 0.25
BETA = (8 * DEPTH) ** -0.25
N_IN_SLOTS = 10
IN_COLS = N_IN_SLOTS * BRANCH_W + D_MODEL
LN_EPS = 1e-5
RMS_EPS = 1e-6
NEG = -1e30

kernel_name = 'hymba_moba_s5_hgrn2_dilated_deepnorm'


def rel_bucket(dist):
    max_exact = REL_BUCKETS // 2
    d = jnp.maximum(dist, 1).astype(jnp.float32)
    large = max_exact + (jnp.log(d / max_exact) / math.log(REL_MAX_DIST / max_exact)
                         * (REL_BUCKETS - max_exact)).astype(jnp.int32)
    return jnp.where(dist < max_exact, dist, jnp.minimum(large, REL_BUCKETS - 1))


def layer_norm(h, g, b):
    h = h.astype(jnp.float32)
    mu = h.mean(-1, keepdims=True)
    var = jnp.square(h - mu).mean(-1, keepdims=True)
    return (h - mu) * lax.rsqrt(var + LN_EPS) * g.astype(jnp.float32) + b.astype(jnp.float32)


def moba_attention(q, k, v, bias_table):
    Bt, H, S, Dh = q.shape
    scale = Dh ** -0.5
    Sp = -(-S // MOBA_BLOCK) * MOBA_BLOCK
    nkb = Sp // MOBA_BLOCK
    pad = ((0, 0), (0, 0), (0, Sp - S), (0, 0))
    kblk = jnp.pad(k, pad).reshape(Bt, H, nkb, MOBA_BLOCK, Dh)
    vblk = jnp.pad(v, pad).reshape(Bt, H, nkb, MOBA_BLOCK, Dh)
    kmean = kblk.astype(jnp.float32).mean(axis=3)
    topk = max(1, min(MOBA_TOPK, nkb - 1))
    nqc = S // MOBA_QCHUNK
    q_chunks = q.reshape(Bt, H, nqc, MOBA_QCHUNK, Dh).transpose(2, 0, 1, 3, 4)
    b_idx = jnp.arange(Bt)[:, None, None, None]
    h_idx = jnp.arange(H)[None, :, None, None]
    in_blk = jnp.arange(MOBA_BLOCK)
    blk_ids = jnp.arange(nkb)

    def one_chunk(args):
        qi, c = args
        qf = qi.astype(jnp.float32)
        pos = c * MOBA_QCHUNK + jnp.arange(MOBA_QCHUNK)
        own = (c * MOBA_QCHUNK) // MOBA_BLOCK
        gate = jnp.einsum('bhqd,bhnd->bhqn', qf, kmean)
        gate = jnp.where(blk_ids < own, gate, -jnp.inf)
        _, idx = lax.top_k(gate, topk)
        valid = idx < own
        ksel = kblk[b_idx, h_idx, idx].astype(jnp.float32)
        vsel = vblk[b_idx, h_idx, idx].astype(jnp.float32)
        l_sel = jnp.einsum('bhqd,bhqtkd->bhqtk', qf, ksel) * scale
        sel_pos = idx[..., None] * MOBA_BLOCK + in_blk
        sel_dist = jnp.maximum(pos[:, None, None] - sel_pos, 0)
        l_sel = l_sel + bias_table[rel_bucket(sel_dist), h_idx[..., None]].astype(jnp.float32)
        l_sel = jnp.where(valid[..., None], l_sel, NEG)
        kown = lax.dynamic_index_in_dim(kblk, own, axis=2, keepdims=False).astype(jnp.float32)
        vown = lax.dynamic_index_in_dim(vblk, own, axis=2, keepdims=False).astype(jnp.float32)
        own_dist = pos[:, None] - (own * MOBA_BLOCK + in_blk)[None, :]
        own_bias = bias_table[rel_bucket(jnp.maximum(own_dist, 0))].astype(jnp.float32).transpose(2, 0, 1)
        l_own = jnp.einsum('bhqd,bhkd->bhqk', qf, kown) * scale + own_bias
        l_own = jnp.where(own_dist >= 0, l_own, NEG)
        n_sel = topk * MOBA_BLOCK
        logits = jnp.concatenate([l_sel.reshape(Bt, H, MOBA_QCHUNK, n_sel), l_own], axis=-1)
        p = jax.nn.softmax(logits, axis=-1)
        p_sel = p[..., :n_sel].reshape(Bt, H, MOBA_QCHUNK, topk, MOBA_BLOCK)
        return (jnp.einsum('bhqtk,bhqtkd->bhqd', p_sel, vsel)
                + jnp.einsum('bhqk,bhkd->bhqd', p[..., n_sel:], vown))

    out = lax.map(one_chunk, (q_chunks, jnp.arange(nqc, dtype=jnp.int32)))
    return out.transpose(1, 2, 0, 3, 4).reshape(Bt, H, S, Dh)


def dilated_attention(q, k, v, bias_table):
    Bt, H, S, Dh = q.shape
    scale = Dh ** -0.5
    i = jnp.arange(DIL_BLOCK)[:, None]
    j = jnp.arange(2 * DIL_BLOCK)[None, :]
    dist_sub = DIL_BLOCK + i - j
    band = (dist_sub >= 0) & (dist_sub <= DIL_BLOCK)
    outs, lses = [], []
    for window, dil in DIL_PAIRS:
        L = S // dil
        nb = -(-L // DIL_BLOCK)
        Lp = nb * DIL_BLOCK

        def to_sub(t):
            t = t.reshape(Bt, H, L, dil, Dh).transpose(0, 1, 3, 2, 4)
            return jnp.pad(t, ((0, 0), (0, 0), (0, 0), (0, Lp - L), (0, 0)))

        def band_keys(t):
            t = jnp.pad(t, ((0, 0), (0, 0), (0, 0), (DIL_BLOCK, 0), (0, 0)))
            t = t.reshape(Bt, H, dil, nb + 1, DIL_BLOCK, Dh)
            return jnp.concatenate([t[:, :, :, :-1], t[:, :, :, 1:]], axis=4)

        qb = to_sub(q).reshape(Bt, H, dil, nb, DIL_BLOCK, Dh).astype(jnp.float32)
        kb = band_keys(to_sub(k)).astype(jnp.float32)
        vb = band_keys(to_sub(v)).astype(jnp.float32)
        logits = jnp.einsum('bhrnqd,bhrnkd->bhrnqk', qb, kb) * scale
        bias = bias_table[rel_bucket(jnp.maximum(dist_sub, 0) * dil)].astype(jnp.float32)
        logits = logits + bias.transpose(2, 0, 1)[None, :, None, None]
        key_pos = jnp.arange(nb)[:, None, None] * DIL_BLOCK + j[None] - DIL_BLOCK
        mask = band[None] & (key_pos >= 0)
        logits = jnp.where(mask, logits, NEG)
        m = logits.max(-1, keepdims=True)
        p = jnp.exp(logits - m)
        s = p.sum(-1, keepdims=True)
        o = jnp.einsum('bhrnqk,bhrnkd->bhrnqd', p, vb) / s
        lse = (m + jnp.log(s))[..., 0]
        o = o.reshape(Bt, H, dil, Lp, Dh)[:, :, :, :L].transpose(0, 1, 3, 2, 4).reshape(Bt, H, S, Dh)
        lse = lse.reshape(Bt, H, dil, Lp)[:, :, :, :L].transpose(0, 1, 3, 2).reshape(Bt, H, S)
        outs.append(o)
        lses.append(lse)
    w = jax.nn.softmax(jnp.stack(lses, 0), axis=0)
    return jnp.einsum('pbhs,pbhsd->bhsd', w, jnp.stack(outs, 0))


def s5_mixer(u, a_re, a_im, log_dt, b_re, b_im, c_re, c_im, d_skip, glu_w, glu_b):
    Bt, S, _ = u.shape
    uf = u.astype(jnp.float32)
    ug = uf.reshape(Bt, S, S5_GROUPS, S5_GROUP)
    ar = a_re.astype(jnp.float32)
    ai = a_im.astype(jnp.float32)
    dt = jnp.exp(log_dt.astype(jnp.float32))[:, None]
    mag = jnp.exp(dt * ar)
    abar_re = mag * jnp.cos(dt * ai)
    abar_im = mag * jnp.sin(dt * ai)
    nr, ni = abar_re - 1.0, abar_im
    den = ar * ar + ai * ai
    zr = (nr * ar + ni * ai) / den
    zi = (ni * ar - nr * ai) / den
    br = b_re.astype(jnp.float32)
    bi = b_im.astype(jnp.float32)
    bbar_re = zr[..., None] * br - zi[..., None] * bi
    bbar_im = zr[..., None] * bi + zi[..., None] * br
    xr = jnp.einsum('bsgc,gpc->bsgp', ug, bbar_re)
    xi = jnp.einsum('bsgc,gpc->bsgp', ug, bbar_im)
    at_re = jnp.broadcast_to(abar_re, xr.shape)
    at_im = jnp.broadcast_to(abar_im, xr.shape)

    def combine(e1, e2):
        a1r, a1i, b1r, b1i = e1
        a2r, a2i, b2r, b2i = e2
        return (a2r * a1r - a2i * a1i, a2r * a1i + a2i * a1r,
                a2r * b1r - a2i * b1i + b2r, a2r * b1i + a2i * b1r + b2i)

    _, _, hr, hi = lax.associative_scan(combine, (at_re, at_im, xr, xi), axis=1)
    y = (jnp.einsum('bsgp,gcp->bsgc', hr, c_re.astype(jnp.float32))
         - jnp.einsum('bsgp,gcp->bsgc', hi, c_im.astype(jnp.float32)))
    y = y.reshape(Bt, S, BRANCH_W) + d_skip.astype(jnp.float32) * uf
    y = jax.nn.gelu(y)
    return y * jax.nn.sigmoid(y @ glu_w.astype(jnp.float32) + glu_b.astype(jnp.float32))


def hgrn2_mixer(q, f_pre, i_in, lower_bound):
    Bt, S, _ = q.shape
    C = HGRN_CHUNK
    nc = S // C
    lb = lower_bound.astype(jnp.float32)
    f = lb + (1.0 - lb) * jax.nn.sigmoid(f_pre.astype(jnp.float32))
    log_f = jnp.log(f)
    k = 1.0 - f
    qf = jax.nn.silu(q.astype(jnp.float32)) * HEAD_DIM ** -0.5

    def chunks(t):
        return t.reshape(Bt, nc, C, N_HEADS_BR, HEAD_DIM).transpose(1, 0, 3, 2, 4)

    causal = jnp.tril(jnp.ones((C, C), dtype=bool))

    def step(state, inp):
        qc, kc, vc, gc = inp
        b = jnp.cumsum(gc, axis=2)
        diff = b[:, :, :, None, :] - b[:, :, None, :, :]
        decay = jnp.exp(jnp.where(causal[:, :, None], diff, NEG))
        scores = jnp.einsum('bhtd,bhsd,bhtsd->bhts', qc, kc, decay)
        o = (jnp.einsum('bhts,bhsv->bhtv', scores, vc)
             + jnp.einsum('bhtd,bhdv->bhtv', qc * jnp.exp(b), state))
        b_last = b[:, :, -1:]
        new_state = (jnp.exp(b_last[:, :, 0])[..., None] * state
                     + jnp.einsum('bhsd,bhsv->bhdv', kc * jnp.exp(b_last - b), vc))
        return new_state, o

    state0 = jnp.zeros((Bt, N_HEADS_BR, HEAD_DIM, HEAD_DIM), jnp.float32)
    _, o = lax.scan(step, state0, (chunks(qf), chunks(k), chunks(i_in.astype(jnp.float32)), chunks(log_f)))
    return o.transpose(1, 0, 3, 2, 4).reshape(Bt, S, BRANCH_W)


def setup_inputs(seed: int = 0) -> dict:
    key = jax.random.key(seed)
    ks = jax.random.split(key, 20)
    D, G, P, C = D_MODEL, S5_GROUPS, S5_STATE, S5_GROUP

    def nrm(k, shape, s):
        return jax.random.normal(k, shape, jnp.float32) * s

    n = jnp.arange(P, dtype=jnp.float32)
    return {
        'x': nrm(ks[0], (BATCH, SEQ, D), 1.0),
        'w_in': nrm(ks[1], (DEPTH, D, IN_COLS), D ** -0.5),
        'rel_bias': nrm(ks[2], (REL_BUCKETS, N_ATTN_HEADS), 0.2),
        's5_a_re': -0.5 + nrm(ks[3], (DEPTH, G, P), 0.01),
        's5_a_im': jnp.pi * n + nrm(ks[4], (DEPTH, G, P), 0.01),
        's5_log_dt': jax.random.uniform(ks[5], (DEPTH, G), jnp.float32, math.log(1e-3), math.log(1e-1)),
        's5_b_re': nrm(ks[6], (DEPTH, G, P, C), (2 * C) ** -0.5),
        's5_b_im': nrm(ks[7], (DEPTH, G, P, C), (2 * C) ** -0.5),
        's5_c_re': nrm(ks[8], (DEPTH, G, C, P), P ** -0.5),
        's5_c_im': nrm(ks[9], (DEPTH, G, C, P), P ** -0.5),
        's5_d': nrm(ks[10], (DEPTH, BRANCH_W), 0.5),
        's5_glu_w': nrm(ks[11], (DEPTH, BRANCH_W, BRANCH_W), BRANCH_W ** -0.5),
        's5_glu_b': nrm(ks[12], (DEPTH, BRANCH_W), 0.01),
        'hgrn_lower': nrm(ks[13], (DEPTH, BRANCH_W), 0.1),
        'branch_gain': 1.0 + nrm(ks[14], (DEPTH, D), 0.02),
        'w_out': nrm(ks[15], (DEPTH, D, D), D ** -0.5 * BETA),
        'ln_g': 1.0 + nrm(ks[16], (DEPTH, D), 0.02),
        'ln_b': nrm(ks[17], (DEPTH, D), 0.02),
    }


def reference(x, w_in, rel_bias, s5_a_re, s5_a_im, s5_log_dt, s5_b_re, s5_b_im, s5_c_re, s5_c_im,
              s5_d, s5_glu_w, s5_glu_b, hgrn_lower, branch_gain, w_out, ln_g, ln_b):
    Bt, S, D = x.shape
    W = BRANCH_W
    p_lb = jax.nn.softmax(hgrn_lower.astype(jnp.float32), axis=0)
    lb_all = jnp.cumsum(p_lb, axis=0) - p_lb[0]

    def heads(t):
        return t.reshape(Bt, S, N_HEADS_BR, HEAD_DIM).transpose(0, 2, 1, 3)

    def merge(t):
        return t.transpose(0, 2, 1, 3).reshape(Bt, S, W)

    for l in range(DEPTH):
        proj = x @ w_in[l]
        qa, ka, va, us, qc, fc, ic, qd, kd, vd = [proj[..., s * W:(s + 1) * W] for s in range(N_IN_SLOTS)]
        gates = proj[..., N_IN_SLOTS * W:]
        ya = merge(moba_attention(heads(qa), heads(ka), heads(va), rel_bias[:, :N_HEADS_BR]))
        yb = s5_mixer(us, s5_a_re[l], s5_a_im[l], s5_log_dt[l], s5_b_re[l], s5_b_im[l],
                      s5_c_re[l], s5_c_im[l], s5_d[l], s5_glu_w[l], s5_glu_b[l])
        yc = hgrn2_mixer(qc, fc, ic, lb_all[l])
        yd = merge(dilated_attention(heads(qd), heads(kd), heads(vd), rel_bias[:, N_HEADS_BR:]))
        y = jnp.concatenate([ya, yb, yc, yd], axis=-1).astype(jnp.float32)
        yg = y.reshape(Bt, S, D // HEAD_DIM, HEAD_DIM)
        yg = yg * lax.rsqrt(jnp.mean(yg * yg, axis=-1, keepdims=True) + RMS_EPS)
        y = (yg.reshape(Bt, S, D) * branch_gain[l].astype(jnp.float32)
             * jax.nn.silu(gates.astype(jnp.float32)))
        y = y.astype(x.dtype) @ w_out[l]
        x = layer_norm(ALPHA * x + y, ln_g[l], ln_b[l]).astype(x.dtype)
    return x
```

```cpp
#include <hip/hip_runtime.h>
#include <stdint.h>

typedef unsigned short bf16_t;
typedef unsigned u32x4 __attribute__((ext_vector_type(4)));

constexpr int BATCH = 4, SEQ = 8192, DM = 1024, M = BATCH * SEQ, BW = 256, NIN = 3584, HD = 64, DEPTH = 2;
constexpr int COL_QA = 0, COL_KA = 256, COL_VA = 512, COL_U = 768, COL_QC = 1024, COL_FC = 1280, COL_IC = 1536, COL_QD = 1792, COL_KD = 2048, COL_VD = 2304, COL_G = 2560;
constexpr float ALPHA = 1.4142135623730951f;
constexpr float LN_EPS = 1e-5f, RMS_EPS = 1e-6f, NEGF = -1e30f;

constexpr size_t MiB = 1u << 20;
constexpr size_t WS_CTL = 0;
constexpr size_t WS_SMALL = 1 * MiB;
constexpr size_t WS_WTIN = 2 * MiB;
constexpr size_t WS_WTOUT = 16 * MiB;
constexpr size_t WS_GLUWT = 20 * MiB;
constexpr size_t WS_KMEAN = 21 * MiB;
constexpr size_t WS_XB = 22 * MiB;
constexpr size_t WS_PROJ = 86 * MiB;
constexpr size_t WS_Y = 310 * MiB;
constexpr size_t WS_YBPRE = 374 * MiB;
constexpr size_t WS_END = 390 * MiB;
constexpr int SM_LB = 0;
constexpr int SM_ABAR = 512;
constexpr int SM_BBAR = SM_ABAR + 2 * 16 * 64 * 2;

__device__ __forceinline__ float bf2f(bf16_t v) { return __uint_as_float(((unsigned)v) << 16); }
__device__ __forceinline__ bf16_t f2bf(float f) { unsigned u = __float_as_uint(f); return (bf16_t)((u + 0x7fffu + ((u >> 16) & 1u)) >> 16); }
__device__ __forceinline__ float wave_max(float v) {
#pragma unroll
    for (int o = 1; o < 64; o <<= 1) v = fmaxf(v, __shfl_xor(v, o));
    return v;
}
__device__ __forceinline__ float wave_sum(float v) {
#pragma unroll
    for (int o = 1; o < 64; o <<= 1) v += __shfl_xor(v, o);
    return v;
}
__device__ __forceinline__ int t5_bucket(int d) {
    if (d < 16) return d;
    int b = 16;
    b += (d >= 22); b += (d >= 30); b += (d >= 40); b += (d >= 54); b += (d >= 73); b += (d >= 99); b += (d >= 134); b += (d >= 182);
    b += (d >= 246); b += (d >= 332); b += (d >= 450); b += (d >= 609); b += (d >= 825); b += (d >= 1117); b += (d >= 1513);
    return b;
}
__device__ __forceinline__ float sigmoidf_(float x) { return 1.0f / (1.0f + expf(-x)); }
__device__ __forceinline__ float siluf_(float x) { return x / (1.0f + expf(-x)); }
__device__ __forceinline__ float gelu_tanh(float x) { const float u = 0.7978845608028654f * (x + 0.044715f * x * x * x); return 0.5f * x * (1.0f + tanhf(u)); }

__global__ __launch_bounds__(256) void k_transpose_bf16(const float* __restrict__ W, bf16_t* __restrict__ WT, int K, int N) {
    __shared__ float t[32][33];
    const int n0 = blockIdx.x * 32, k0 = blockIdx.y * 32, tx = threadIdx.x & 31, ty = threadIdx.x >> 5;
#pragma unroll
    for (int i = 0; i < 4; ++i) t[ty + 8 * i][tx] = W[(size_t)(k0 + ty + 8 * i) * N + n0 + tx];
    __syncthreads();
#pragma unroll
    for (int i = 0; i < 4; ++i) WT[(size_t)(n0 + ty + 8 * i) * K + k0 + tx] = f2bf(t[tx][ty + 8 * i]);
}
__global__ __launch_bounds__(256) void k_cvt_bf16(const float* __restrict__ x, bf16_t* __restrict__ xb, size_t n4) {
    for (size_t i = (size_t)blockIdx.x * 256 + threadIdx.x; i < n4; i += (size_t)gridDim.x * 256) {
        const float4 v = ((const float4*)x)[i];
        ushort4 o; o.x = f2bf(v.x); o.y = f2bf(v.y); o.z = f2bf(v.z); o.w = f2bf(v.w);
        ((ushort4*)xb)[i] = o;
    }
}
__device__ __forceinline__ void sincos_d(double th, double& s, double& c) {
    const double k = rint(th * 0.63661977236758134308);
    double r = fma(-k, 1.57079632679489655800, th); r = fma(-k, 6.12323399573676603587e-17, r);
    const long q = ((long)k) & 3;
    const double r2 = r * r;
    const double sp = r * (1.0 + r2 * (-1.0 / 6 + r2 * (1.0 / 120 + r2 * (-1.0 / 5040 + r2 * (1.0 / 362880 + r2 * (-1.0 / 39916800 + r2 * (1.0 / 6227020800.0 + r2 * (-1.0 / 1307674368000.0))))))));
    const double cp = 1.0 + r2 * (-0.5 + r2 * (1.0 / 24 + r2 * (-1.0 / 720 + r2 * (1.0 / 40320 + r2 * (-1.0 / 3628800 + r2 * (1.0 / 479001600.0 + r2 * (-1.0 / 87178291200.0 + r2 * (1.0 / 20922789888000.0))))))));
    if (q == 0) { s = sp; c = cp; } else if (q == 1) { s = cp; c = -sp; } else if (q == 2) { s = -sp; c = -cp; } else { s = -cp; c = sp; }
}
__global__ __launch_bounds__(256) void k_prep_small(const float* __restrict__ a_re, const float* __restrict__ a_im, const float* __restrict__ log_dt,
                                                    const float* __restrict__ b_re, const float* __restrict__ b_im, const float* __restrict__ hl, float* __restrict__ sm) {
    const int id = blockIdx.x * 256 + threadIdx.x;
    if (id < DEPTH * 16 * 64) {
        const int lg = id >> 6;
        const double dt = exp((double)log_dt[lg]), ar = a_re[id], ai = a_im[id];
        const double mag = exp(dt * ar); double sn, cs; sincos_d(dt * ai, sn, cs);
        const double are = mag * cs, aim = mag * sn, nr = are - 1.0, ni = aim, den = ar * ar + ai * ai;
        const double zr = (nr * ar + ni * ai) / den, zi = (ni * ar - nr * ai) / den;
        sm[SM_ABAR + id * 2] = (float)are; sm[SM_ABAR + id * 2 + 1] = (float)aim;
        for (int c = 0; c < 16; ++c) {
            const double br = b_re[id * 16 + c], bi = b_im[id * 16 + c];
            sm[SM_BBAR + (id * 16 + c) * 2] = (float)(zr * br - zi * bi);
            sm[SM_BBAR + (id * 16 + c) * 2 + 1] = (float)(zr * bi + zi * br);
        }
    }
    if (id < 256) {
        const float h0 = hl[id], h1 = hl[256 + id], mx = fmaxf(h0, h1), e0 = expf(h0 - mx), e1 = expf(h1 - mx);
        sm[SM_LB + id] = 0.0f; sm[SM_LB + 256 + id] = e1 / (e0 + e1);
    }
}

struct GemmArgs { const bf16_t* A; int lda; const bf16_t* Bt; int ldb; int K; bf16_t* C; int ldc; const float* bias; float* zio; };
template <int EPI> __global__ __launch_bounds__(256) void k_gemm_simple(GemmArgs g) {
    __shared__ float As[32][68], Bs[32][68];
    const int tid = threadIdx.x, n0 = blockIdx.x * 64, m0 = blockIdx.y * 64, tx = tid & 15, ty = tid >> 4;
    const int lr = tid >> 2, lk = (tid & 3) * 8;
    float acc[4][4];
#pragma unroll
    for (int i = 0; i < 4; ++i)
#pragma unroll
        for (int j = 0; j < 4; ++j) acc[i][j] = 0.f;
    for (int k0 = 0; k0 < g.K; k0 += 32) {
        const u32x4 av = *(const u32x4*)(g.A + (size_t)(m0 + lr) * g.lda + k0 + lk);
        const u32x4 bv = *(const u32x4*)(g.Bt + (size_t)(n0 + lr) * g.ldb + k0 + lk);
        __syncthreads();
#pragma unroll
        for (int j = 0; j < 4; ++j) {
            As[lk + 2 * j][lr] = __uint_as_float(av[j] << 16); As[lk + 2 * j + 1][lr] = __uint_as_float(av[j] & 0xffff0000u);
            Bs[lk + 2 * j][lr] = __uint_as_float(bv[j] << 16); Bs[lk + 2 * j + 1][lr] = __uint_as_float(bv[j] & 0xffff0000u);
        }
        __syncthreads();
#pragma unroll 8
        for (int k = 0; k < 32; ++k) {
            const float4 a = *(const float4*)&As[k][ty * 4], b = *(const float4*)&Bs[k][tx * 4];
            const float aa[4] = {a.x, a.y, a.z, a.w}, bb[4] = {b.x, b.y, b.z, b.w};
#pragma unroll
            for (int i = 0; i < 4; ++i)
#pragma unroll
                for (int j = 0; j < 4; ++j) acc[i][j] = fmaf(aa[i], bb[j], acc[i][j]);
        }
    }
#pragma unroll
    for (int i = 0; i < 4; ++i) {
        const int m = m0 + ty * 4 + i;
#pragma unroll
        for (int j = 0; j < 4; ++j) {
            const int n = n0 + tx * 4 + j;
            if (EPI == 0) g.C[(size_t)m * g.ldc + n] = f2bf(acc[i][j]);
            else if (EPI == 1) { float* p = g.zio + (size_t)m * DM + n; *p = ALPHA * (*p) + acc[i][j]; }
            else { const float a = bf2f(g.A[(size_t)m * g.lda + n]); g.C[(size_t)m * g.ldc + n] = f2bf(a * sigmoidf_(acc[i][j] + g.bias[n])); }
        }
    }
}

__global__ __launch_bounds__(256) void k_kmean(const bf16_t* __restrict__ proj, float* __restrict__ kmean) {
    const int b = blockIdx.x >> 5, n = blockIdx.x & 31, c = threadIdx.x;
    const bf16_t* p = proj + (size_t)(b * SEQ + n * 256) * NIN + COL_KA + c;
    float s = 0.f;
    for (int r = 0; r < 256; ++r) s += bf2f(p[(size_t)r * NIN]);
    kmean[((b * 4 + (c >> 6)) * 32 + n) * 64 + (c & 63)] = s * (1.0f / 256.0f);
}
__device__ __forceinline__ float dot64(const float* qs, const bf16_t* krow) {
    float s = 0.f;
#pragma unroll
    for (int i = 0; i < 8; ++i) {
        const u32x4 v = *(const u32x4*)(krow + i * 8);
#pragma unroll
        for (int j = 0; j < 4; ++j) { s = fmaf(qs[i * 8 + 2 * j], __uint_as_float(v[j] << 16), s); s = fmaf(qs[i * 8 + 2 * j + 1], __uint_as_float(v[j] & 0xffff0000u), s); }
    }
    return s;
}
__global__ __launch_bounds__(256) void k_moba_simple(const bf16_t* __restrict__ proj, const float* __restrict__ kmean, const float* __restrict__ rel_bias, bf16_t* __restrict__ Y) {
    __shared__ float qs_[4][64];
    __shared__ float ps_[4][1024];
    const int w = threadIdx.x >> 6, lane = threadIdx.x & 63;
    const int gid = blockIdx.x * 4 + w, s = gid % SEQ, h = (gid / SEQ) & 3, b = gid / (SEQ * 4);
    float* qs = qs_[w]; float* ps = ps_[w];
    const size_t row = (size_t)b * SEQ + s;
    qs[lane] = bf2f(proj[row * NIN + COL_QA + h * 64 + lane]);
    __syncthreads();
    const int own = s >> 8;
    float g = -INFINITY;
    if (lane < own) { const float* km = kmean + ((b * 4 + h) * 32 + lane) * 64; float a = 0.f; for (int d = 0; d < 64; ++d) a = fmaf(qs[d], km[d], a); g = a; }
    int blk[4]; bool val[4];
#pragma unroll
    for (int t = 0; t < 3; ++t) {
        const float mx = wave_max(g);
        val[t] = mx > -INFINITY;
        const unsigned long long mk = __ballot(g == mx);
        const int idx = val[t] ? (__ffsll((long long)mk) - 1) : own;
        blk[t] = idx;
        if (val[t] && lane == idx) g = -INFINITY;
    }
    blk[3] = own; val[3] = true;
    float lmax = NEGF;
#pragma unroll
    for (int t = 0; t < 4; ++t) {
        for (int i = 0; i < 4; ++i) {
            const int kk = lane + 64 * i, kpos = blk[t] * 256 + kk;
            const bool ok = (t < 3) ? val[t] : (kpos <= s);
            float lg = NEGF;
            if (ok) {
                const int dist = s - kpos;
                lg = dot64(qs, proj + ((size_t)b * SEQ + kpos) * NIN + COL_KA + h * 64) * 0.125f + rel_bias[t5_bucket(dist) * 8 + h];
            }
            ps[t * 256 + kk] = lg; lmax = fmaxf(lmax, lg);
        }
    }
    const float mx = wave_max(lmax);
    float lsum = 0.f;
    for (int i = 0; i < 16; ++i) { const float p = expf(ps[lane + 64 * i] - mx); ps[lane + 64 * i] = p; lsum += p; }
    const float tot = wave_sum(lsum);
    __syncthreads();
    float acc = 0.f;
#pragma unroll
    for (int t = 0; t < 4; ++t) {
        if (!val[t]) continue;
        const bf16_t* vp = proj + ((size_t)b * SEQ + blk[t] * 256) * NIN + COL_VA + h * 64 + lane;
        const int nk = (t < 3) ? 256 : (s - own * 256 + 1);
        for (int kk = 0; kk < nk; ++kk) acc = fmaf(ps[t * 256 + kk], bf2f(vp[(size_t)kk * NIN]), acc);
    }
    Y[row * DM + h * 64 + lane] = f2bf(acc / tot);
}
__global__ __launch_bounds__(256) void k_dilated_simple(const bf16_t* __restrict__ proj, const float* __restrict__ rel_bias, bf16_t* __restrict__ Y) {
    __shared__ float qs_[4][64];
    __shared__ float ps_[4][3 * 192];
    const int w = threadIdx.x >> 6, lane = threadIdx.x & 63;
    const int gid = blockIdx.x * 4 + w, s = gid % SEQ, h = (gid / SEQ) & 3, b = gid / (SEQ * 4);
    float* qs = qs_[w]; float* ps = ps_[w];
    const size_t row = (size_t)b * SEQ + s;
    qs[lane] = bf2f(proj[row * NIN + COL_QD + h * 64 + lane]);
    __syncthreads();
    float lse[3], ssum[3];
#pragma unroll
    for (int pi = 0; pi < 3; ++pi) {
        const int dil = (pi == 0) ? 1 : (pi == 1) ? 4 : 16;
        float lmax = NEGF;
        for (int i = 0; i < 3; ++i) {
            const int j = lane + 64 * i, kpos = s - j * dil;
            float lg = NEGF;
            if (j <= 128 && kpos >= 0) lg = dot64(qs, proj + ((size_t)b * SEQ + kpos) * NIN + COL_KD + h * 64) * 0.125f + rel_bias[t5_bucket(j * dil) * 8 + 4 + h];
            ps[pi * 192 + j] = lg; lmax = fmaxf(lmax, lg);
        }
        const float mx = wave_max(lmax);
        float lsum = 0.f;
        for (int i = 0; i < 3; ++i) { const int j = lane + 64 * i; const float p = expf(ps[pi * 192 + j] - mx); ps[pi * 192 + j] = p; lsum += p; }
        ssum[pi] = wave_sum(lsum);
        lse[pi] = mx + logf(ssum[pi]);
    }
    __syncthreads();
    const float lm = fmaxf(lse[0], fmaxf(lse[1], lse[2]));
    const float w0 = expf(lse[0] - lm), w1 = expf(lse[1] - lm), w2 = expf(lse[2] - lm), wt = w0 + w1 + w2;
    const float wgt[3] = {w0 / wt, w1 / wt, w2 / wt};
    float out = 0.f;
#pragma unroll
    for (int pi = 0; pi < 3; ++pi) {
        const int dil = (pi == 0) ? 1 : (pi == 1) ? 4 : 16;
        float acc = 0.f;
        for (int j = 0; j <= 128; ++j) {
            const int kpos = s - j * dil; if (kpos < 0) break;
            acc = fmaf(ps[pi * 192 + j], bf2f(proj[((size_t)b * SEQ + kpos) * NIN + COL_VD + h * 64 + lane]), acc);
        }
        out += wgt[pi] * acc / ssum[pi];
    }
    Y[row * DM + 768 + h * 64 + lane] = f2bf(out);
}
__global__ __launch_bounds__(64) void k_s5_simple(const bf16_t* __restrict__ proj, const float* __restrict__ sm, const float* __restrict__ c_re, const float* __restrict__ c_im,
                                                  const float* __restrict__ dskip, bf16_t* __restrict__ ybpre, int layer) {
    __shared__ float hs[64][64][2];
    __shared__ float us[64][16];
    __shared__ float cs[16][65][2];
    const int b = blockIdx.x >> 4, g = blockIdx.x & 15, lane = threadIdx.x;
    const int pid = (layer * 16 + g) * 64 + lane;
    const float are = sm[SM_ABAR + pid * 2], aim = sm[SM_ABAR + pid * 2 + 1];
    float bbr[16], bbi[16];
#pragma unroll
    for (int c = 0; c < 16; ++c) { bbr[c] = sm[SM_BBAR + (pid * 16 + c) * 2]; bbi[c] = sm[SM_BBAR + (pid * 16 + c) * 2 + 1]; }
    for (int c = 0; c < 16; ++c) { cs[c][lane][0] = c_re[((layer * 16 + g) * 16 + c) * 64 + lane]; cs[c][lane][1] = c_im[((layer * 16 + g) * 16 + c) * 64 + lane]; }
    const int oc = lane & 15, otq = lane >> 4;
    const float dsk = dskip[layer * 256 + g * 16 + oc];
    float hr = 0.f, hi = 0.f;
    for (int t0 = 0; t0 < SEQ; t0 += 64) {
        __syncthreads();
        for (int e = lane; e < 1024; e += 64) { const int t = e >> 4, c = e & 15; us[t][c] = bf2f(proj[((size_t)b * SEQ + t0 + t) * NIN + COL_U + g * 16 + c]); }
        __syncthreads();
        for (int t = 0; t < 64; ++t) {
            float xr = 0.f, xi = 0.f;
#pragma unroll
            for (int c = 0; c < 16; ++c) { const float u = us[t][c]; xr = fmaf(bbr[c], u, xr); xi = fmaf(bbi[c], u, xi); }
            const float nr = are * hr - aim * hi + xr, ni = are * hi + aim * hr + xi;
            hr = nr; hi = ni;
            hs[t][lane][0] = hr; hs[t][lane][1] = hi;
        }
        __syncthreads();
        for (int i = 0; i < 16; ++i) {
            const int t = otq + 4 * i;
            float y = 0.f;
            for (int p = 0; p < 64; ++p) y += hs[t][p][0] * cs[oc][p][0] - hs[t][p][1] * cs[oc][p][1];
            y += dsk * us[t][oc];
            ybpre[((size_t)b * SEQ + t0 + t) * 256 + g * 16 + oc] = f2bf(gelu_tanh(y));
        }
    }
}
__global__ __launch_bounds__(64) void k_hgrn_simple(const bf16_t* __restrict__ proj, const float* __restrict__ sm, bf16_t* __restrict__ Y, int layer) {
    __shared__ float fs[64][64], qs[64][64], is[64][64];
    const int b = blockIdx.x >> 2, h = blockIdx.x & 3, lane = threadIdx.x;
    const float lb = sm[SM_LB + layer * 256 + h * 64 + lane];
    float S[64];
#pragma unroll
    for (int d = 0; d < 64; ++d) S[d] = 0.f;
    for (int t0 = 0; t0 < SEQ; t0 += 64) {
        __syncthreads();
        for (int t = 0; t < 64; ++t) {
            const bf16_t* r = proj + ((size_t)b * SEQ + t0 + t) * NIN + h * 64 + lane;
            const float qv = bf2f(r[COL_QC]), fv = bf2f(r[COL_FC]), iv = bf2f(r[COL_IC]);
            fs[t][lane] = lb + (1.0f - lb) * sigmoidf_(fv); qs[t][lane] = siluf_(qv) * 0.125f; is[t][lane] = iv;
        }
        __syncthreads();
        for (int t = 0; t < 64; ++t) {
            const float iv = is[t][lane];
            float o = 0.f;
#pragma unroll
            for (int d = 0; d < 64; ++d) { const float f = fs[t][d]; S[d] = fmaf(f, S[d] - iv, iv); o = fmaf(qs[t][d], S[d], o); }
            Y[((size_t)b * SEQ + t0 + t) * DM + 512 + h * 64 + lane] = f2bf(o);
        }
    }
}
__global__ __launch_bounds__(256) void k_combine(bf16_t* __restrict__ Y, const bf16_t* __restrict__ proj, const float* __restrict__ gain) {
    const int w = threadIdx.x >> 6, lane = threadIdx.x & 63;
    const size_t row = (size_t)blockIdx.x * 4 + w;
    bf16_t* yp = Y + row * DM + lane * 16; const bf16_t* gp = proj + row * NIN + COL_G + lane * 16;
    float v[16]; float ss = 0.f;
#pragma unroll
    for (int i = 0; i < 16; ++i) { v[i] = bf2f(yp[i]); ss = fmaf(v[i], v[i], ss); }
    ss += __shfl_xor(ss, 1); ss += __shfl_xor(ss, 2);
    const float r = rsqrtf(ss * (1.0f / 64.0f) + RMS_EPS);
#pragma unroll
    for (int i = 0; i < 16; ++i) yp[i] = f2bf(v[i] * r * gain[lane * 16 + i] * siluf_(bf2f(gp[i])));
}
__global__ __launch_bounds__(256) void k_layernorm(float* __restrict__ z, bf16_t* __restrict__ xb, const float* __restrict__ lg, const float* __restrict__ lbias) {
    const int w = threadIdx.x >> 6, lane = threadIdx.x & 63;
    const size_t row = (size_t)blockIdx.x * 4 + w;
    float4* zp = (float4*)(z + row * DM) + lane;
    float4 v[4]; float s = 0.f;
#pragma unroll
    for (int j = 0; j < 4; ++j) { v[j] = zp[64 * j]; s += (v[j].x + v[j].y) + (v[j].z + v[j].w); }
    const float mean = wave_sum(s) * (1.0f / DM); float q = 0.f;
#pragma unroll
    for (int j = 0; j < 4; ++j) { v[j].x -= mean; v[j].y -= mean; v[j].z -= mean; v[j].w -= mean; q += (v[j].x * v[j].x + v[j].y * v[j].y) + (v[j].z * v[j].z + v[j].w * v[j].w); }
    const float rstd = rsqrtf(wave_sum(q) * (1.0f / DM) + LN_EPS);
#pragma unroll
    for (int j = 0; j < 4; ++j) {
        const float4 gg = ((const float4*)lg)[lane + 64 * j], bb = ((const float4*)lbias)[lane + 64 * j];
        float4 o; o.x = v[j].x * rstd * gg.x + bb.x; o.y = v[j].y * rstd * gg.y + bb.y; o.z = v[j].z * rstd * gg.z + bb.z; o.w = v[j].w * rstd * gg.w + bb.w;
        zp[64 * j] = o;
        ushort4 ob; ob.x = f2bf(o.x); ob.y = f2bf(o.y); ob.z = f2bf(o.z); ob.w = f2bf(o.w);
        ((ushort4*)(xb + row * DM))[lane + 64 * j] = ob;
    }
}

extern "C" void kernel_launch(void* const* d_in, const int* in_sizes, int n_in, void* d_out, int out_size, void* d_ws, size_t ws_size, hipStream_t stream) {
    (void)in_sizes; (void)n_in; (void)out_size; (void)ws_size;
    const float* x = (const float*)d_in[0]; const float* w_in = (const float*)d_in[1]; const float* rel_bias = (const float*)d_in[2];
    const float* a_re = (const float*)d_in[3]; const float* a_im = (const float*)d_in[4]; const float* log_dt = (const float*)d_in[5];
    const float* b_re = (const float*)d_in[6]; const float* b_im = (const float*)d_in[7]; const float* c_re = (const float*)d_in[8]; const float* c_im = (const float*)d_in[9];
    const float* s5d = (const float*)d_in[10]; const float* glu_w = (const float*)d_in[11]; const float* glu_b = (const float*)d_in[12]; const float* hl = (const float*)d_in[13];
    const float* gain = (const float*)d_in[14]; const float* w_out = (const float*)d_in[15]; const float* ln_g = (const float*)d_in[16]; const float* ln_b = (const float*)d_in[17];
    unsigned char* ws = (unsigned char*)d_ws; float* out = (float*)d_out;
    float* sm = (float*)(ws + WS_SMALL); bf16_t* wtin = (bf16_t*)(ws + WS_WTIN); bf16_t* wtout = (bf16_t*)(ws + WS_WTOUT); bf16_t* gluwt = (bf16_t*)(ws + WS_GLUWT);
    float* kmean = (float*)(ws + WS_KMEAN); bf16_t* xb = (bf16_t*)(ws + WS_XB); bf16_t* proj = (bf16_t*)(ws + WS_PROJ); bf16_t* Y = (bf16_t*)(ws + WS_Y); bf16_t* ybpre = (bf16_t*)(ws + WS_YBPRE);

    for (int l = 0; l < DEPTH; ++l) {
        k_transpose_bf16<<<dim3(NIN / 32, DM / 32), 256, 0, stream>>>(w_in + (size_t)l * DM * NIN, wtin + (size_t)l * NIN * DM, DM, NIN);
        k_transpose_bf16<<<dim3(DM / 32, DM / 32), 256, 0, stream>>>(w_out + (size_t)l * DM * DM, wtout + (size_t)l * DM * DM, DM, DM);
        k_transpose_bf16<<<dim3(BW / 32, BW / 32), 256, 0, stream>>>(glu_w + (size_t)l * BW * BW, gluwt + (size_t)l * BW * BW, BW, BW);
    }
    k_prep_small<<<8, 256, 0, stream>>>(a_re, a_im, log_dt, b_re, b_im, hl, sm);
    k_cvt_bf16<<<2048, 256, 0, stream>>>(x, xb, (size_t)M * DM / 4);
    hipMemcpyAsync(out, x, (size_t)M * DM * 4, hipMemcpyDeviceToDevice, stream);
    for (int l = 0; l < DEPTH; ++l) {
        GemmArgs g0{xb, DM, wtin + (size_t)l * NIN * DM, DM, DM, proj, NIN, nullptr, nullptr};
        k_gemm_simple<0><<<dim3(NIN / 64, M / 64), 256, 0, stream>>>(g0);
        k_kmean<<<BATCH * 32, 256, 0, stream>>>(proj, kmean);
        k_moba_simple<<<M * 4 / 4, 256, 0, stream>>>(proj, kmean, rel_bias, Y);
        k_dilated_simple<<<M * 4 / 4, 256, 0, stream>>>(proj, rel_bias, Y);
        k_s5_simple<<<BATCH * 16, 64, 0, stream>>>(proj, sm, c_re, c_im, s5d, ybpre, l);
        GemmArgs g2{ybpre, BW, gluwt + (size_t)l * BW * BW, BW, BW, Y + 256, DM, glu_b + l * BW, nullptr};
        k_gemm_simple<2><<<dim3(BW / 64, M / 64), 256, 0, stream>>>(g2);
        k_hgrn_simple<<<BATCH * 4, 64, 0, stream>>>(proj, sm, Y, l);
        k_combine<<<M / 4, 256, 0, stream>>>(Y, proj, gain + l * DM);
        GemmArgs g1{Y, DM, wtout + (size_t)l * DM * DM, DM, DM, nullptr, 0, nullptr, out};
        k_gemm_simple<1><<<dim3(DM / 64, M / 64), 256, 0, stream>>>(g1);
        k_layernorm<<<M / 4, 256, 0, stream>>>(out, xb, ln_g + l * DM, ln_b + l * DM);
    }
}
```

```cpp
#include <hip/hip_runtime.h>
#include <stdint.h>
#include <cstdio>

typedef unsigned short bf16_t;
typedef unsigned u32x4 __attribute__((ext_vector_type(4)));
#define LAS __attribute__((address_space(3)))
#define GAS __attribute__((address_space(1)))

constexpr int BATCH = 4, SEQ = 8192, DM = 1024, M = BATCH * SEQ, BW = 256, NIN = 3584, HD = 64, DEPTH = 2;
constexpr int COL_QA = 0, COL_KA = 256, COL_VA = 512, COL_U = 768, COL_QC = 1024, COL_FC = 1280, COL_IC = 1536, COL_QD = 1792, COL_KD = 2048, COL_VD = 2304, COL_G = 2560;
constexpr float ALPHA = 1.4142135623730951f;
constexpr float LN_EPS = 1e-5f, RMS_EPS = 1e-6f, NEGF = -1e30f;

constexpr size_t MiB = 1u << 20;
constexpr size_t WS_CTL = 0, CTL_ZERO_BYTES = 1 * MiB;
constexpr size_t WS_SMALL = 1 * MiB;
constexpr size_t WS_WTIN = 2 * MiB;
constexpr size_t WS_WTOUT = 16 * MiB;
constexpr size_t WS_GLUWT = 20 * MiB;
constexpr size_t WS_KMEAN = 21 * MiB;
constexpr size_t WS_XB = 22 * MiB;
constexpr size_t WS_PROJ = 86 * MiB;
constexpr size_t WS_Y = 310 * MiB;
constexpr size_t WS_YBPRE = 374 * MiB;
constexpr size_t WS_END = 390 * MiB;
constexpr int SM_LB = 0;
constexpr int SM_ABAR = 512;
constexpr int SM_BBAR = SM_ABAR + 2 * 16 * 64 * 2;
constexpr int CW_BAR = 4096;

__device__ __forceinline__ float bf2f(bf16_t v) { return __uint_as_float(((unsigned)v) << 16); }
__device__ __forceinline__ bf16_t f2bf(float f) { unsigned u = __float_as_uint(f); return (bf16_t)((u + 0x7fffu + ((u >> 16) & 1u)) >> 16); }
__device__ __forceinline__ unsigned pk2(float lo, float hi) { return (unsigned)f2bf(lo) | ((unsigned)f2bf(hi) << 16); }
__device__ __forceinline__ float wave_max(float v) {
#pragma unroll
    for (int o = 1; o < 64; o <<= 1) v = fmaxf(v, __shfl_xor(v, o));
    return v;
}
__device__ __forceinline__ float wave_sum(float v) {
#pragma unroll
    for (int o = 1; o < 64; o <<= 1) v += __shfl_xor(v, o);
    return v;
}
__device__ __forceinline__ int t5_bucket(int d) {
    if (d < 16) return d;
    int b = 16;
    b += (d >= 22); b += (d >= 30); b += (d >= 40); b += (d >= 54); b += (d >= 73); b += (d >= 99); b += (d >= 134); b += (d >= 182);
    b += (d >= 246); b += (d >= 332); b += (d >= 450); b += (d >= 609); b += (d >= 825); b += (d >= 1117); b += (d >= 1513);
    return b;
}
__device__ __forceinline__ float sigmoidf_(float x) { return 1.0f / (1.0f + expf(-x)); }
__device__ __forceinline__ float siluf_(float x) { return x / (1.0f + expf(-x)); }
__device__ __forceinline__ float gelu_tanh(float x) { const float u = 0.7978845608028654f * (x + 0.044715f * x * x * x); return 0.5f * x * (1.0f + tanhf(u)); }
#define WSYNC() asm volatile("s_waitcnt lgkmcnt(0)" ::: "memory")

namespace pg8 {
#define PG8_LAS __attribute__((address_space(3)))
typedef unsigned short bf16_t;
typedef short bf16x8 __attribute__((ext_vector_type(8)));
typedef float f32x4 __attribute__((ext_vector_type(4)));
typedef unsigned u32x4 __attribute__((ext_vector_type(4)));
constexpr int BM = 256, BK = 64, HALF = 128, HTB = HALF * BK * 2  , STAGE_BYTES = 8 * HTB, NXCD = 8, WGM = 8;

__host__ __device__ __forceinline__ int lds_byte(int r, int c) { const int st = (r >> 4) * 2 + (c >> 5), rr = r & 15, cc = c & 31, ob = rr * 64 + cc * 2; return st * 1024 + (ob ^ (((ob >> 9) & 1) << 5)); }
__host__ __device__ __forceinline__ void stage_rc(int b, int& R, int& C) { const int st = b / 1024, sb = b % 1024, swz = sb ^ (((sb >> 9) & 1) << 5); R = (st >> 1) * 16 + swz / 64; C = (st & 1) * 32 + (swz % 64) / 2; }
__host__ __device__ __forceinline__ int perm32(int rho) { const int n = rho >> 4, i = rho & 15; return 8 * (i >> 2) + 4 * n + (i & 3); }

struct Unit { int pm, pn; };
struct Gemm { const bf16_t* A; const bf16_t* Bt; int M, N, K; };

struct StaticOrder {
    int nM, nN, nwg, G, c;
    __host__ __device__ void init(int M, int N, int G_, int c_) { nM = M / BM; nN = N / BM; nwg = nM * nN; G = G_; c = c_; }
    __host__ __device__ bool next(int i, Unit& u) const {
        const long L = (long)i * G + c; if (L >= nwg) return false;
        int wgid = (int)L; { const int q = nwg / NXCD, r = nwg % NXCD, xcd = wgid % NXCD, off = wgid / NXCD; wgid = (xcd < r ? xcd * (q + 1) : r * (q + 1) + (xcd - r) * q) + off; }
        const int nig = WGM * nN, gid = wgid / nig, fm = gid * WGM, gsz = (nM - fm) < WGM ? (nM - fm) : WGM;
        u.pm = fm + ((wgid % nig) % gsz); u.pn = (wgid % nig) / gsz; return true;
    }
    __device__ __forceinline__ void a_ready(const Unit&) const {}
    __device__ __forceinline__ void done(const Unit&) const {}
};

__device__ __forceinline__ unsigned cvt_pk_bf16(float lo, float hi) { unsigned r; asm volatile("v_cvt_pk_bf16_f32 %0, %1, %2" : "=v"(r) : "v"(lo), "v"(hi)); return r; }
struct EpiStoreBf16 {
    static constexpr bool PERM = true, AFTER_DRAIN = false;
    bf16_t* O; int ldc;
    __device__ __forceinline__ void operator()(const f32x4 (&acc)[2][2][4][2], const Unit& u, int wr, int wc, int fr, int fq) const {
        const int row0 = u.pm * BM + wr * 64 + fr, col0 = u.pn * BM + wc * 32 + 8 * fq;
#pragma unroll
        for (int ai = 0; ai < 2; ++ai)
#pragma unroll
            for (int m = 0; m < 4; ++m) { bf16_t* rowp = O + (size_t)(row0 + ai * HALF + m * 16) * ldc + col0;
#pragma unroll
                for (int bj = 0; bj < 2; ++bj) { const f32x4 v0 = acc[ai][bj][m][0], v1 = acc[ai][bj][m][1];
                    u32x4 w; w.x = cvt_pk_bf16(v0[0], v0[1]); w.y = cvt_pk_bf16(v0[2], v0[3]); w.z = cvt_pk_bf16(v1[0], v1[1]); w.w = cvt_pk_bf16(v1[2], v1[3]);
                    *(u32x4*)(rowp + bj * HALF) = w; } }
    }
};
struct EpiGlu {
    static constexpr bool PERM = true, AFTER_DRAIN = false;
    bf16_t* O; int ldc; const bf16_t* Ain; int lda; const float* bias;
    __device__ __forceinline__ void operator()(const f32x4 (&acc)[2][2][4][2], const Unit& u, int wr, int wc, int fr, int fq) const {
        const int row0 = u.pm * BM + wr * 64 + fr, col0 = u.pn * BM + wc * 32 + 8 * fq;
#pragma unroll
        for (int ai = 0; ai < 2; ++ai)
#pragma unroll
            for (int m = 0; m < 4; ++m) { const size_t r = (size_t)(row0 + ai * HALF + m * 16);
#pragma unroll
                for (int bj = 0; bj < 2; ++bj) { const int c = col0 + bj * HALF;
                    const u32x4 av = *(const u32x4*)(Ain + r * lda + c);
                    const f32x4 b0 = *(const f32x4*)(bias + c), b1 = *(const f32x4*)(bias + c + 4);
                    const f32x4 v0 = acc[ai][bj][m][0] + b0, v1 = acc[ai][bj][m][1] + b1;
                    float o[8];
#pragma unroll
                    for (int j = 0; j < 4; ++j) { const float alo = __uint_as_float(av[j] << 16), ahi = __uint_as_float(av[j] & 0xffff0000u);
                        const float s0 = (j < 2) ? v0[2 * j] : v1[2 * j - 4], s1 = (j < 2) ? v0[2 * j + 1] : v1[2 * j - 3];
                        o[2 * j] = alo / (1.0f + __expf(-s0)); o[2 * j + 1] = ahi / (1.0f + __expf(-s1)); }
                    u32x4 w; w.x = cvt_pk_bf16(o[0], o[1]); w.y = cvt_pk_bf16(o[2], o[3]); w.z = cvt_pk_bf16(o[4], o[5]); w.w = cvt_pk_bf16(o[6], o[7]);
                    *(u32x4*)(O + r * ldc + c) = w; } }
    }
};
struct EpiResF32 {
    static constexpr bool PERM = false, AFTER_DRAIN = false;
    const float* res; float* out;
    __device__ __forceinline__ void operator()(const f32x4 (&acc)[2][2][4][2], const Unit& u, int wr, int wc, int fr, int fq) const {
        const int col0 = u.pn * BM + wc * 32 + 4 * fq;
#pragma unroll
        for (int ai = 0; ai < 2; ++ai)
#pragma unroll
            for (int m = 0; m < 4; ++m) { const size_t off = (size_t)(u.pm * BM + ai * HALF + wr * 64 + m * 16 + fr) * 1024 + col0;
#pragma unroll
                for (int bj = 0; bj < 2; ++bj)
#pragma unroll
                    for (int n = 0; n < 2; ++n) { const f32x4 rv = *(const f32x4*)(res + off + bj * HALF + n * 16);
                        *(f32x4*)(out + off + bj * HALF + n * 16) = rv * 1.4142135623730951f + acc[ai][bj][m][n]; } }
    }
};

template <class Epi, class Sched, bool ALIGN_EPI = false, bool SP2 = false>
__device__ __forceinline__ void gemm_phase(PG8_LAS unsigned char* lds, const Gemm g, const Sched& S, const Epi& E, const int tid_in  ) {
    const int tid = tid_in, wid = __builtin_amdgcn_readfirstlane(tid >> 6), lane = tid & 63, wr = wid >> 2, wc = wid & 3, fr = lane & 15, fq = lane >> 4;
    const int K = g.K, nt = K / BK;
    unsigned voffA[2], voffB[2];
#pragma unroll
    for (int i = 0; i < 2; ++i) { int R, C; stage_rc(tid * 16 + i * 8192, R, C); const int Rb = Epi::PERM ? ((R & ~31) + perm32(R & 31)) : R;
        voffA[i] = (unsigned)(R * K + C) * 2u; voffB[i] = (unsigned)(Rb * K + C) * 2u; }
    const size_t kstep = (size_t)(BK * 2);
    const size_t hstep = (size_t)HALF * K * 2;
    const size_t tstep = 2 * hstep;
    const unsigned ldsw = (unsigned)wid * 1024u;
    const int aoff = lds_byte(wr * 64 + fr, fq * 8), boff = lds_byte(wc * 32 + fr, fq * 8);
#define PG8_SA(b, h) (((b) * 2 + (h)) * HTB)
#define PG8_SB(b, h) ((4 + (b) * 2 + (h)) * HTB)
#define PG8_STAGE(bufoff, gbase, voff) do { _Pragma("unroll") for (int _i = 0; _i < 2; ++_i) \
        __builtin_amdgcn_global_load_lds((const unsigned*)((const char*)(gbase) + (voff)[_i]), (PG8_LAS unsigned*)(lds + (bufoff) + ldsw + _i * 8192), 16, 0, 0); } while (0)
#define PG8_LDA(dst, b, h) do { _Pragma("unroll") for (int m = 0; m < 4; ++m) _Pragma("unroll") for (int k = 0; k < 2; ++k) dst[m][k] = *(const PG8_LAS bf16x8*)(lds + PG8_SA(b, h) + aoff + m * 2048 + k * 1024); } while (0)
#define PG8_LDB(dst, b, h) do { _Pragma("unroll") for (int n = 0; n < 2; ++n) _Pragma("unroll") for (int k = 0; k < 2; ++k) dst[n][k] = *(const PG8_LAS bf16x8*)(lds + PG8_SB(b, h) + boff + n * 2048 + k * 1024); } while (0)
#define PG8_MMA(ai, bj, At, Bt) do { __builtin_amdgcn_s_setprio(1); _Pragma("unroll") for (int m = 0; m < 4; ++m) _Pragma("unroll") for (int n = 0; n < 2; ++n) _Pragma("unroll") for (int k = 0; k < 2; ++k) \
        acc[ai][bj][m][n] = __builtin_amdgcn_mfma_f32_16x16x32_bf16(Bt[n][k], At[m][k], acc[ai][bj][m][n], 0, 0, 0); __builtin_amdgcn_s_setprio(0); } while (0)
#define PG8_WAIT_V(n) asm volatile("s_waitcnt vmcnt(" #n ")" ::: "memory")
#define PG8_WAIT_L(n) asm volatile("s_waitcnt lgkmcnt(" #n ")" ::: "memory")
#define PG8_BAR __builtin_amdgcn_s_barrier()
#define PG8_SCHED __builtin_amdgcn_sched_barrier(0)
    Unit cur, nxt; int ui = 0;
    if (!S.next(0, cur)) return;
    f32x4 acc[2][2][4][2];
#pragma unroll
    for (int a = 0; a < 2; ++a)
#pragma unroll
        for (int b = 0; b < 2; ++b)
#pragma unroll
            for (int m = 0; m < 4; ++m)
#pragma unroll
                for (int n = 0; n < 2; ++n) acc[a][b][m][n] = (f32x4){0.f, 0.f, 0.f, 0.f};
    bf16x8 At[4][2], B0[2][2], B1[2][2];
    const char* cA = (const char*)g.A + (size_t)cur.pm * tstep; const char* cB = (const char*)g.Bt + (size_t)cur.pn * tstep;
    S.a_ready(cur);
    if constexpr (SP2) {
        PG8_STAGE(PG8_SB(0, 0), cB, voffB); PG8_STAGE(PG8_SB(0, 1), cB + hstep, voffB); PG8_STAGE(PG8_SA(0, 0), cA, voffA); PG8_STAGE(PG8_SA(0, 1), cA + hstep, voffA);
        if (wr == 1) PG8_BAR;
        PG8_WAIT_V(2); PG8_BAR;
        PG8_STAGE(PG8_SB(1, 0), cB + kstep, voffB); PG8_STAGE(PG8_SA(1, 0), cA + kstep, voffA); PG8_STAGE(PG8_SB(1, 1), cB + hstep + kstep, voffB);
        PG8_WAIT_V(6); PG8_BAR;
    } else {
        PG8_STAGE(PG8_SB(0, 0), cB, voffB); PG8_STAGE(PG8_SA(0, 0), cA, voffA); PG8_STAGE(PG8_SB(0, 1), cB + hstep, voffB); PG8_STAGE(PG8_SA(0, 1), cA + hstep, voffA);
        if (wr == 1) PG8_BAR;
        PG8_WAIT_V(4); PG8_BAR;
        PG8_STAGE(PG8_SB(1, 0), cB + kstep, voffB); PG8_STAGE(PG8_SA(1, 0), cA + kstep, voffA); PG8_STAGE(PG8_SB(1, 1), cB + hstep + kstep, voffB);
        PG8_WAIT_V(6); PG8_BAR;
    }
    for (;;) {
        const bool has_next = S.next(ui + 1, nxt);
        const char* nA = has_next ? (const char*)g.A + (size_t)nxt.pm * tstep : cA; const char* nB = has_next ? (const char*)g.Bt + (size_t)nxt.pn * tstep : cB;
        for (int t = 0; t < nt; t += 2) {
            const bool last = (t == nt - 2);
            const char* a1 = cA + (size_t)(t + 1) * kstep;
            const char* a2 = last ? nA : cA + (size_t)(t + 2) * kstep; const char* b2 = last ? nB : cB + (size_t)(t + 2) * kstep;
            const char* a3 = a2 + kstep; const char* b3 = b2 + kstep;
            if (last && has_next) S.a_ready(nxt);
            if constexpr (SP2) {
            PG8_LDB(B0, 0, 0); PG8_LDB(B1, 0, 1); PG8_SCHED; PG8_LDA(At, 0, 0); PG8_STAGE(PG8_SA(1, 1), a1 + hstep, voffA);
            PG8_WAIT_V(8); PG8_WAIT_L(0); PG8_BAR; PG8_MMA(0, 0, At, B0); PG8_MMA(0, 1, At, B1); PG8_BAR; PG8_SCHED;
            PG8_LDA(At, 0, 1); PG8_STAGE(PG8_SB(0, 0), b2, voffB); PG8_STAGE(PG8_SB(0, 1), b2 + hstep, voffB); PG8_STAGE(PG8_SA(0, 0), a2, voffA);
            PG8_WAIT_V(8); PG8_WAIT_L(0); PG8_BAR; PG8_MMA(1, 0, At, B0); PG8_MMA(1, 1, At, B1); PG8_BAR; PG8_SCHED;
            PG8_LDB(B0, 1, 0); PG8_LDB(B1, 1, 1); PG8_SCHED; PG8_LDA(At, 1, 0); PG8_STAGE(PG8_SA(0, 1), a2 + hstep, voffA);
            PG8_WAIT_V(8); PG8_WAIT_L(0); PG8_BAR; PG8_MMA(0, 0, At, B0); PG8_MMA(0, 1, At, B1); PG8_BAR; PG8_SCHED;
            PG8_LDA(At, 1, 1); PG8_STAGE(PG8_SB(1, 0), b3, voffB); PG8_STAGE(PG8_SB(1, 1), b3 + hstep, voffB); PG8_STAGE(PG8_SA(1, 0), a3, voffA);
            PG8_WAIT_V(8); PG8_WAIT_L(0); PG8_BAR; PG8_MMA(1, 0, At, B0); PG8_MMA(1, 1, At, B1); PG8_BAR; PG8_SCHED;
            } else {
            PG8_LDB(B0, 0, 0); PG8_SCHED; PG8_LDA(At, 0, 0); PG8_STAGE(PG8_SA(1, 1), a1 + hstep, voffA);
            PG8_WAIT_L(8); PG8_BAR; PG8_WAIT_L(0); PG8_MMA(0, 0, At, B0); PG8_BAR; PG8_SCHED;
            PG8_LDB(B1, 0, 1); PG8_STAGE(PG8_SB(0, 0), b2, voffB);
            PG8_BAR; PG8_WAIT_L(0); PG8_MMA(0, 1, At, B1); PG8_BAR;
            PG8_LDA(At, 0, 1); PG8_STAGE(PG8_SA(0, 0), a2, voffA);
            PG8_BAR; PG8_WAIT_L(0); PG8_MMA(1, 0, At, B0); PG8_BAR; PG8_SCHED;
            PG8_STAGE(PG8_SB(0, 1), b2 + hstep, voffB);
            PG8_WAIT_V(6); PG8_BAR; PG8_MMA(1, 1, At, B1); PG8_BAR;
            PG8_LDB(B0, 1, 0); PG8_SCHED; PG8_LDA(At, 1, 0); PG8_STAGE(PG8_SA(0, 1), a2 + hstep, voffA);
            PG8_WAIT_L(8); PG8_BAR; PG8_WAIT_L(0); PG8_MMA(0, 0, At, B0); PG8_BAR; PG8_SCHED;
            PG8_LDB(B1, 1, 1); PG8_STAGE(PG8_SB(1, 0), b3, voffB);
            PG8_BAR; PG8_WAIT_L(0); PG8_MMA(0, 1, At, B1); PG8_BAR;
            PG8_LDA(At, 1, 1); PG8_STAGE(PG8_SA(1, 0), a3, voffA);
            PG8_BAR; PG8_WAIT_L(0); PG8_MMA(1, 0, At, B0); PG8_BAR; PG8_SCHED;
            PG8_STAGE(PG8_SB(1, 1), b3 + hstep, voffB);
            PG8_WAIT_V(6); PG8_BAR; PG8_MMA(1, 1, At, B1); PG8_BAR;
            }
        }
        if constexpr (ALIGN_EPI) { if (wr == 0) PG8_BAR; }
        if constexpr (!Epi::AFTER_DRAIN) { E(acc, cur, wr, wc, fr, fq); S.done(cur); }
        if (!has_next) break;
#pragma unroll
        for (int a = 0; a < 2; ++a)
#pragma unroll
            for (int b = 0; b < 2; ++b)
#pragma unroll
                for (int m = 0; m < 4; ++m)
#pragma unroll
                    for (int n = 0; n < 2; ++n) acc[a][b][m][n] = (f32x4){0.f, 0.f, 0.f, 0.f};
        cur = nxt; cA = nA; cB = nB; ++ui;
        if constexpr (ALIGN_EPI) { if (wr == 1) PG8_BAR; }
    }
    PG8_WAIT_V(0);
    if constexpr (!ALIGN_EPI) { if (wr == 0) PG8_BAR; }
    PG8_BAR;
    if constexpr (Epi::AFTER_DRAIN) { E.fused(acc, cur, wr, wc, fr, fq, lds, wid, lane); S.done(cur); }
#undef PG8_SA
#undef PG8_SB
#undef PG8_STAGE
#undef PG8_LDA
#undef PG8_LDB
#undef PG8_MMA
#undef PG8_WAIT_V
#undef PG8_WAIT_L
#undef PG8_BAR
#undef PG8_SCHED
}
}
#define XB_TMO      128
#define XB_XCNT(j)  (256  + 64 * (j))
#define XB_XSUB(j)  (1280 + 64 * (j))
#define XB_XGEN(j)  (2304 + 64 * (j))
#define XB_TOP      3328
#define XB_TOPGEN   3392
#define XCD_BAR_WORDS 3456
#define XB_SPIN_CAP (1u << 18)

__device__ __forceinline__ unsigned xb_ld(unsigned* p)              { return __hip_atomic_load(p, __ATOMIC_RELAXED, __HIP_MEMORY_SCOPE_AGENT); }
__device__ __forceinline__ unsigned xb_add(unsigned* p, unsigned v) { return __hip_atomic_fetch_add(p, v, __ATOMIC_RELAXED, __HIP_MEMORY_SCOPE_AGENT); }
__device__ __forceinline__ unsigned xb_xcc_id() { return (unsigned)__builtin_amdgcn_s_getreg((3 << 11) | 20) & 0xFu; }
#define XB_SPIN(cond, bar) do { unsigned _sp = 0; while (cond) { __builtin_amdgcn_s_sleep(1); \
    if ((++_sp & 255u) == 0u) { if (xb_ld(&(bar)[XB_TMO])) break; if (_sp > XB_SPIN_CAP) { atomicAdd(&(bar)[XB_TMO], 1u); break; } } } } while (0)

struct XcdBarrier {
    unsigned* bar; unsigned x;
    volatile LAS unsigned* st;
};

__device__ __forceinline__ XcdBarrier xcd_barrier_post(unsigned* bar, volatile LAS unsigned* st) {
    XcdBarrier b; b.bar = bar; b.x = xb_xcc_id(); b.st = st;
    if (threadIdx.x == 0) (void)xb_add(&bar[XB_XCNT(b.x)], 1u);
    return b;
}
__device__ __forceinline__ void xcd_barrier_complete(unsigned* bar, unsigned x, unsigned& nloc, unsigned& nx) {
    const unsigned G = gridDim.x * gridDim.y * gridDim.z;
    unsigned sum, cnt, mine, sp = 0u;
    for (;;) {
        sum = 0u; cnt = 0u; mine = 0u;
#pragma unroll
        for (unsigned j = 0; j < 16; ++j) { const unsigned c = xb_ld(&bar[XB_XCNT(j)]); sum += c; cnt += (c > 0u) ? 1u : 0u; mine = (j == x) ? c : mine; }
        if (sum == G) break;
        __builtin_amdgcn_s_sleep(1);
        if ((++sp & 255u) == 0u) { if (xb_ld(&bar[XB_TMO])) break; if (sp > XB_SPIN_CAP) { atomicAdd(&bar[XB_TMO], 1u); break; } }
    }
    nloc = mine > 0u ? mine : 1u; nx = cnt > 0u ? cnt : 1u;
}

__device__ __forceinline__ void xcd_barrier(const XcdBarrier& b) {
    asm volatile("s_waitcnt vmcnt(0)" ::: "memory");
    __syncthreads();
    if (threadIdx.x == 0) {
        unsigned* bar = b.bar;
        __builtin_amdgcn_s_waitcnt(0);
        unsigned nloc = b.st[0], nx = b.st[1];
        if (nloc == 0u) { xcd_barrier_complete(bar, b.x, nloc, nx); b.st[0] = nloc; b.st[1] = nx; }
        const unsigned old = xb_add(&bar[XB_XSUB(b.x)], 1u);
        const unsigned gen = old / nloc;
        if (old + 1u == (gen + 1u) * nloc) {
            __builtin_amdgcn_fence(__ATOMIC_RELEASE, "agent");
            asm volatile("s_waitcnt vmcnt(0)" ::: "memory");
            const unsigned og = xb_add(&bar[XB_TOP], 1u);
            const unsigned tg = og / nx;
            if (og + 1u == (tg + 1u) * nx) xb_add(&bar[XB_TOPGEN], 1u);
            else XB_SPIN(xb_ld(&bar[XB_TOPGEN]) == tg, bar);
            __builtin_amdgcn_fence(__ATOMIC_ACQUIRE, "agent");
            xb_add(&bar[XB_XGEN(b.x)], 1u);
            asm volatile("s_waitcnt vmcnt(0)" ::: "memory");
        } else {
            XB_SPIN(xb_ld(&bar[XB_XGEN(b.x)]) == gen, bar);
            __builtin_amdgcn_fence(__ATOMIC_ACQUIRE, "agent");
            asm volatile("s_waitcnt vmcnt(0)" ::: "memory");
        }
    }
    __syncthreads();
}
constexpr int NWAVES = 8;
constexpr int RING_BYTES = 131072, MISC_OFF = RING_BYTES + 320, LDS_BYTES = 147456;
typedef unsigned v4u __attribute__((ext_vector_type(4)));
#define LDS_WAIT() asm volatile("s_waitcnt lgkmcnt(0)" ::: "memory")

struct Args { const float* in[18]; float* out; unsigned char* ws; };

__device__ __forceinline__ void p0_transpose_item(const float* W, int K, int N, bf16_t* WT, LAS float* scr, int item, int lane) {
    const int nblk = N / 32, kb = item / nblk, nb = item % nblk, k0 = 64 * kb, n0 = 32 * nb;
#pragma unroll 8
    for (int i = 0; i < 32; ++i) { const int kk = 2 * i + (lane >> 5); scr[kk * 33 + (lane & 31)] = W[(size_t)(k0 + kk) * N + n0 + (lane & 31)]; }
    LDS_WAIT();
    const int c = lane & 7;
#pragma unroll
    for (int j = 0; j < 4; ++j) { const int n = (lane >> 3) + 8 * j; const LAS float* s = scr + (8 * c) * 33 + n;
        v4u o; o.x = pk2(s[0 * 33], s[1 * 33]); o.y = pk2(s[2 * 33], s[3 * 33]); o.z = pk2(s[4 * 33], s[5 * 33]); o.w = pk2(s[6 * 33], s[7 * 33]);
        *(v4u*)(WT + (size_t)(n0 + n) * K + k0 + 8 * c) = o; }
    LDS_WAIT();
}
__device__ __forceinline__ void sincos_d(double th, double& s, double& c) {
    const double k = rint(th * 0.63661977236758134308);
    double r = fma(-k, 1.57079632679489655800, th); r = fma(-k, 6.12323399573676603587e-17, r);
    const long q = ((long)k) & 3;
    const double r2 = r * r;
    const double sp = r * (1.0 + r2 * (-1.0 / 6 + r2 * (1.0 / 120 + r2 * (-1.0 / 5040 + r2 * (1.0 / 362880 + r2 * (-1.0 / 39916800 + r2 * (1.0 / 6227020800.0 + r2 * (-1.0 / 1307674368000.0))))))));
    const double cp = 1.0 + r2 * (-0.5 + r2 * (1.0 / 24 + r2 * (-1.0 / 720 + r2 * (1.0 / 40320 + r2 * (-1.0 / 3628800 + r2 * (1.0 / 479001600.0 + r2 * (-1.0 / 87178291200.0 + r2 * (1.0 / 20922789888000.0))))))));
    if (q == 0) { s = sp; c = cp; } else if (q == 1) { s = cp; c = -sp; } else if (q == 2) { s = -sp; c = -cp; } else { s = -cp; c = sp; }
}
__device__ __forceinline__ void prep_small(int id, const float* a_re, const float* a_im, const float* log_dt, const float* b_re, const float* b_im, const float* hl, float* sm) {
    if (id < DEPTH * 16 * 64) {
        const int lg = id >> 6;
        const double dt = exp((double)log_dt[lg]), ar = a_re[id], ai = a_im[id];
        const double mag = exp(dt * ar); double sn, cs; sincos_d(dt * ai, sn, cs);
        const double are = mag * cs, aim = mag * sn, nr = are - 1.0, ni = aim, den = ar * ar + ai * ai;
        const double zr = (nr * ar + ni * ai) / den, zi = (ni * ar - nr * ai) / den;
        sm[SM_ABAR + id * 2] = (float)are; sm[SM_ABAR + id * 2 + 1] = (float)aim;
        for (int c = 0; c < 16; ++c) {
            const double br = b_re[id * 16 + c], bi = b_im[id * 16 + c];
            sm[SM_BBAR + (id * 16 + c) * 2] = (float)(zr * br - zi * bi);
            sm[SM_BBAR + (id * 16 + c) * 2 + 1] = (float)(zr * bi + zi * br);
        }
    }
    if (id < 256) {
        const float h0 = hl[id], h1 = hl[256 + id], mx = fmaxf(h0, h1), e0 = expf(h0 - mx), e1 = expf(h1 - mx);
        sm[SM_LB + id] = 0.0f; sm[SM_LB + 256 + id] = e1 / (e0 + e1);
    }
}

__device__ __forceinline__ float dot64(const float* qs, const bf16_t* krow) {
    float s = 0.f;
#pragma unroll
    for (int i = 0; i < 8; ++i) {
        const u32x4 v = *(const u32x4*)(krow + i * 8);
#pragma unroll
        for (int j = 0; j < 4; ++j) { s = fmaf(qs[i * 8 + 2 * j], __uint_as_float(v[j] << 16), s); s = fmaf(qs[i * 8 + 2 * j + 1], __uint_as_float(v[j] & 0xffff0000u), s); }
    }
    return s;
}
__device__ __forceinline__ void moba_simple(int gid, int lane, float* scr, const bf16_t* __restrict__ proj, const float* __restrict__ kmean, const float* __restrict__ rel_bias, bf16_t* __restrict__ Y) {
    const int s = gid % SEQ, h = (gid / SEQ) & 3, b = gid / (SEQ * 4);
    float* qs = scr; float* ps = scr + 64;
    const size_t row = (size_t)b * SEQ + s;
    WSYNC();
    qs[lane] = bf2f(proj[row * NIN + COL_QA + h * 64 + lane]);
    WSYNC();
    const int own = s >> 8;
    float g = -INFINITY;
    if (lane < own) { const float* km = kmean + ((b * 4 + h) * 32 + lane) * 64; float a = 0.f; for (int d = 0; d < 64; ++d) a = fmaf(qs[d], km[d], a); g = a; }
    int blk[4]; bool val[4];
#pragma unroll
    for (int t = 0; t < 3; ++t) {
        const float mx = wave_max(g);
        val[t] = mx > -INFINITY;
        const unsigned long long mk = __ballot(g == mx);
        const int idx = val[t] ? (__ffsll((long long)mk) - 1) : own;
        blk[t] = idx;
        if (val[t] && lane == idx) g = -INFINITY;
    }
    blk[3] = own; val[3] = true;
    float lmax = NEGF;
#pragma unroll
    for (int t = 0; t < 4; ++t) {
        for (int i = 0; i < 4; ++i) {
            const int kk = lane + 64 * i, kpos = blk[t] * 256 + kk;
            const bool ok = (t < 3) ? val[t] : (kpos <= s);
            float lg = NEGF;
            if (ok) lg = dot64(qs, proj + ((size_t)b * SEQ + kpos) * NIN + COL_KA + h * 64) * 0.125f + rel_bias[t5_bucket(s - kpos) * 8 + h];
            ps[t * 256 + kk] = lg; lmax = fmaxf(lmax, lg);
        }
    }
    const float mx = wave_max(lmax);
    float lsum = 0.f;
    for (int i = 0; i < 16; ++i) { const float p = expf(ps[lane + 64 * i] - mx); ps[lane + 64 * i] = p; lsum += p; }
    const float tot = wave_sum(lsum);
    WSYNC();
    float acc = 0.f;
#pragma unroll
    for (int t = 0; t < 4; ++t) {
        if (!val[t]) continue;
        const bf16_t* vp = proj + ((size_t)b * SEQ + blk[t] * 256) * NIN + COL_VA + h * 64 + lane;
        const int nk = (t < 3) ? 256 : (s - own * 256 + 1);
        for (int kk = 0; kk < nk; ++kk) acc = fmaf(ps[t * 256 + kk], bf2f(vp[(size_t)kk * NIN]), acc);
    }
    Y[row * DM + h * 64 + lane] = f2bf(acc / tot);
}
__device__ __forceinline__ void dilated_simple(int gid, int lane, float* scr, const bf16_t* __restrict__ proj, const float* __restrict__ rel_bias, bf16_t* __restrict__ Y) {
    const int s = gid % SEQ, h = (gid / SEQ) & 3, b = gid / (SEQ * 4);
    float* qs = scr; float* ps = scr + 64;
    const size_t row = (size_t)b * SEQ + s;
    WSYNC();
    qs[lane] = bf2f(proj[row * NIN + COL_QD + h * 64 + lane]);
    WSYNC();
    float lse[3], ssum[3];
#pragma unroll
    for (int pi = 0; pi < 3; ++pi) {
        const int dil = (pi == 0) ? 1 : (pi == 1) ? 4 : 16;
        float lmax = NEGF;
        for (int i = 0; i < 3; ++i) {
            const int j = lane + 64 * i, kpos = s - j * dil;
            float lg = NEGF;
            if (j <= 128 && kpos >= 0) lg = dot64(qs, proj + ((size_t)b * SEQ + kpos) * NIN + COL_KD + h * 64) * 0.125f + rel_bias[t5_bucket(j * dil) * 8 + 4 + h];
            ps[pi * 192 + j] = lg; lmax = fmaxf(lmax, lg);
        }
        const float mx = wave_max(lmax);
        float lsum = 0.f;
        for (int i = 0; i < 3; ++i) { const int j = lane + 64 * i; const float p = expf(ps[pi * 192 + j] - mx); ps[pi * 192 + j] = p; lsum += p; }
        ssum[pi] = wave_sum(lsum);
        lse[pi] = mx + logf(ssum[pi]);
    }
    WSYNC();
    const float lm = fmaxf(lse[0], fmaxf(lse[1], lse[2]));
    const float w0 = expf(lse[0] - lm), w1 = expf(lse[1] - lm), w2 = expf(lse[2] - lm), wt = w0 + w1 + w2;
    const float wgt[3] = {w0 / wt, w1 / wt, w2 / wt};
    float out = 0.f;
#pragma unroll
    for (int pi = 0; pi < 3; ++pi) {
        const int dil = (pi == 0) ? 1 : (pi == 1) ? 4 : 16;
        float acc = 0.f;
        for (int j = 0; j <= 128; ++j) {
            const int kpos = s - j * dil; if (kpos < 0) break;
            acc = fmaf(ps[pi * 192 + j], bf2f(proj[((size_t)b * SEQ + kpos) * NIN + COL_VD + h * 64 + lane]), acc);
        }
        out += wgt[pi] * acc / ssum[pi];
    }
    Y[row * DM + 768 + h * 64 + lane] = f2bf(out);
}
__device__ __forceinline__ void s5_simple(int b, int g, int lane, float* scr, const bf16_t* __restrict__ proj, const float* __restrict__ sm, const float* __restrict__ c_re, const float* __restrict__ c_im,
                                          const float* __restrict__ dskip, bf16_t* __restrict__ ybpre, int layer) {
    float* hs = scr; float* us = scr + 8192; float* cs = scr + 8192 + 1024;
    const int pid = (layer * 16 + g) * 64 + lane;
    const float are = sm[SM_ABAR + pid * 2], aim = sm[SM_ABAR + pid * 2 + 1];
    float bbr[16], bbi[16];
#pragma unroll
    for (int c = 0; c < 16; ++c) { bbr[c] = sm[SM_BBAR + (pid * 16 + c) * 2]; bbi[c] = sm[SM_BBAR + (pid * 16 + c) * 2 + 1]; }
    for (int c = 0; c < 16; ++c) { cs[(c * 65 + lane) * 2] = c_re[((layer * 16 + g) * 16 + c) * 64 + lane]; cs[(c * 65 + lane) * 2 + 1] = c_im[((layer * 16 + g) * 16 + c) * 64 + lane]; }
    const int oc = lane & 15, otq = lane >> 4;
    const float dsk = dskip[layer * 256 + g * 16 + oc];
    float hr = 0.f, hi = 0.f;
#pragma unroll 1
    for (int t0 = 0; t0 < SEQ; t0 += 64) {
        WSYNC();
#pragma unroll 1
        for (int e = lane; e < 1024; e += 64) { const int t = e >> 4, c = e & 15; us[t * 16 + c] = bf2f(proj[((size_t)b * SEQ + t0 + t) * NIN + COL_U + g * 16 + c]); }
        WSYNC();
#pragma unroll 1
        for (int t = 0; t < 64; ++t) {
            float xr = 0.f, xi = 0.f;
#pragma unroll
            for (int c = 0; c < 16; ++c) { const float u = us[t * 16 + c]; xr = fmaf(bbr[c], u, xr); xi = fmaf(bbi[c], u, xi); }
            const float nr = are * hr - aim * hi + xr, ni = are * hi + aim * hr + xi;
            hr = nr; hi = ni;
            hs[(t * 64 + lane) * 2] = hr; hs[(t * 64 + lane) * 2 + 1] = hi;
        }
        WSYNC();
#pragma unroll 1
        for (int i = 0; i < 16; ++i) {
            const int t = otq + 4 * i;
            float y = 0.f;
#pragma unroll 4
            for (int p = 0; p < 64; ++p) y += hs[(t * 64 + p) * 2] * cs[(oc * 65 + p) * 2] - hs[(t * 64 + p) * 2 + 1] * cs[(oc * 65 + p) * 2 + 1];
            y += dsk * us[t * 16 + oc];
            ybpre[((size_t)b * SEQ + t0 + t) * 256 + g * 16 + oc] = f2bf(gelu_tanh(y));
        }
    }
}
__device__ __forceinline__ void hgrn_simple(int b, int h, int lane, float* scr, const bf16_t* __restrict__ proj, const float* __restrict__ sm, bf16_t* __restrict__ Y, int layer) {
    float* fs = scr; float* qs = scr + 4096; float* is = scr + 8192;
    const float lb = sm[SM_LB + layer * 256 + h * 64 + lane];
    float S[64];
#pragma unroll
    for (int d = 0; d < 64; ++d) S[d] = 0.f;
    for (int t0 = 0; t0 < SEQ; t0 += 64) {
        WSYNC();
        for (int t = 0; t < 64; ++t) {
            const bf16_t* r = proj + ((size_t)b * SEQ + t0 + t) * NIN + h * 64 + lane;
            const float qv = bf2f(r[COL_QC]), fv = bf2f(r[COL_FC]), iv = bf2f(r[COL_IC]);
            fs[t * 64 + lane] = lb + (1.0f - lb) * sigmoidf_(fv); qs[t * 64 + lane] = siluf_(qv) * 0.125f; is[t * 64 + lane] = iv;
        }
        WSYNC();
        for (int t = 0; t < 64; ++t) {
            const float iv = is[t * 64 + lane];
            float o = 0.f;
#pragma unroll
            for (int d = 0; d < 64; ++d) { const float f = fs[t * 64 + d]; S[d] = fmaf(f, S[d] - iv, iv); o = fmaf(qs[t * 64 + d], S[d], o); }
            Y[((size_t)b * SEQ + t0 + t) * DM + 512 + h * 64 + lane] = f2bf(o);
        }
    }
}
__device__ __forceinline__ void combine_row(size_t row, int lane, bf16_t* __restrict__ Y, const bf16_t* __restrict__ proj, const float* __restrict__ gain) {
    bf16_t* yp = Y + row * DM + lane * 16; const bf16_t* gp = proj + row * NIN + COL_G + lane * 16;
    const u32x4 y0 = *(const u32x4*)yp, y1 = *(const u32x4*)(yp + 8), g0 = *(const u32x4*)gp, g1 = *(const u32x4*)(gp + 8);
    float v[16], gt[16]; float ss = 0.f;
#pragma unroll
    for (int j = 0; j < 4; ++j) { v[2 * j] = __uint_as_float(y0[j] << 16); v[2 * j + 1] = __uint_as_float(y0[j] & 0xffff0000u); v[8 + 2 * j] = __uint_as_float(y1[j] << 16); v[8 + 2 * j + 1] = __uint_as_float(y1[j] & 0xffff0000u);
        gt[2 * j] = __uint_as_float(g0[j] << 16); gt[2 * j + 1] = __uint_as_float(g0[j] & 0xffff0000u); gt[8 + 2 * j] = __uint_as_float(g1[j] << 16); gt[8 + 2 * j + 1] = __uint_as_float(g1[j] & 0xffff0000u); }
#pragma unroll
    for (int i = 0; i < 16; ++i) ss = fmaf(v[i], v[i], ss);
    ss += __shfl_xor(ss, 1); ss += __shfl_xor(ss, 2);
    const float r = rsqrtf(ss * (1.0f / 64.0f) + RMS_EPS);
    float o[16];
#pragma unroll
    for (int i = 0; i < 16; ++i) o[i] = v[i] * r * gain[lane * 16 + i] * siluf_(gt[i]);
    u32x4 w0, w1;
    w0.x = pk2(o[0], o[1]); w0.y = pk2(o[2], o[3]); w0.z = pk2(o[4], o[5]); w0.w = pk2(o[6], o[7]);
    w1.x = pk2(o[8], o[9]); w1.y = pk2(o[10], o[11]); w1.z = pk2(o[12], o[13]); w1.w = pk2(o[14], o[15]);
    *(u32x4*)yp = w0; *(u32x4*)(yp + 8) = w1;
}
__device__ __forceinline__ void layernorm_row(size_t row, int lane, float* __restrict__ z, bf16_t* __restrict__ xb, const float* __restrict__ lg, const float* __restrict__ lbias) {
    float4* zp = (float4*)(z + row * DM) + lane;
    float4 v[4]; float s = 0.f;
#pragma unroll
    for (int j = 0; j < 4; ++j) { v[j] = zp[64 * j]; s += (v[j].x + v[j].y) + (v[j].z + v[j].w); }
    const float mean = wave_sum(s) * (1.0f / DM); float q = 0.f;
#pragma unroll
    for (int j = 0; j < 4; ++j) { v[j].x -= mean; v[j].y -= mean; v[j].z -= mean; v[j].w -= mean; q += (v[j].x * v[j].x + v[j].y * v[j].y) + (v[j].z * v[j].z + v[j].w * v[j].w); }
    const float rstd = rsqrtf(wave_sum(q) * (1.0f / DM) + LN_EPS);
#pragma unroll
    for (int j = 0; j < 4; ++j) {
        const float4 gg = ((const float4*)lg)[lane + 64 * j], bb = ((const float4*)lbias)[lane + 64 * j];
        float4 o; o.x = v[j].x * rstd * gg.x + bb.x; o.y = v[j].y * rstd * gg.y + bb.y; o.z = v[j].z * rstd * gg.z + bb.z; o.w = v[j].w * rstd * gg.w + bb.w;
        zp[64 * j] = o;
        uint2 ob; ob.x = pk2(o.x, o.y); ob.y = pk2(o.z, o.w);
        ((uint2*)(xb + row * DM))[lane + 64 * j] = ob;
    }
}


#define OPQS(x) asm volatile("" : "+s"(x))
#define OPQ(x) asm volatile("" : "+v"(x))
__global__ void __launch_bounds__(NWAVES * 64, 2) mega_fwd(Args args) {
    extern __shared__ __attribute__((aligned(16))) unsigned char lds[];
    const int tid_ = threadIdx.x, lane_ = tid_ & 63, wave = __builtin_amdgcn_readfirstlane(tid_ >> 6);
    const int G = gridDim.x, bx = blockIdx.x, bx_ = bx;
    LAS unsigned char* ldsl = (LAS unsigned char*)lds;
    volatile LAS unsigned* MISC = (volatile LAS unsigned*)(ldsl + MISC_OFF);
    for (int u = tid_; u < (LDS_BYTES - RING_BYTES) / 4; u += NWAVES * 64) ((LAS unsigned*)(ldsl + RING_BYTES))[u] = 0u;
    __syncthreads();
    const XcdBarrier bar = xcd_barrier_post((unsigned*)(args.ws + WS_CTL) + CW_BAR, MISC + 8);
    const int gw = bx * NWAVES + wave, NGW = G * NWAVES;
#define GRID_BAR() do { XcdBarrier b_ = bar; unsigned x_ = b_.x; asm volatile("" : "+s"(x_)); b_.x = x_; xcd_barrier(b_); } while (0)

    {
        const Args* A = &args; unsigned char* ws = A->ws;
        int lane = lane_, tid = tid_; OPQ(lane); OPQ(tid);
        const float* x = A->in[0]; const float* w_in = A->in[1]; const float* glu_w = A->in[11]; const float* w_out = A->in[15];
        bf16_t* wtin = (bf16_t*)(ws + WS_WTIN); bf16_t* wtout = (bf16_t*)(ws + WS_WTOUT); bf16_t* gluwt = (bf16_t*)(ws + WS_GLUWT); bf16_t* xb = (bf16_t*)(ws + WS_XB);
        LAS float* scr = (LAS float*)(ldsl + wave * 16384);
        constexpr int I_IN = (DM / 64) * (NIN / 32), I_OUT = (DM / 64) * (DM / 32), I_GLU = (BW / 64) * (BW / 32), I_L = I_IN + I_OUT + I_GLU;
        for (int it = gw; it < DEPTH * I_L; it += NGW) {
            const int l = it / I_L; int r = it % I_L;
            if (r < I_IN) { p0_transpose_item(w_in + (size_t)l * DM * NIN, DM, NIN, wtin + (size_t)l * NIN * DM, scr, r, lane); continue; } r -= I_IN;
            if (r < I_OUT) { p0_transpose_item(w_out + (size_t)l * DM * DM, DM, DM, wtout + (size_t)l * DM * DM, scr, r, lane); continue; } r -= I_OUT;
            p0_transpose_item(glu_w + (size_t)l * BW * BW, BW, BW, gluwt + (size_t)l * BW * BW, scr, r, lane);
        }
        for (size_t i = (size_t)bx * 512 + tid; i < (size_t)M * DM / 4; i += (size_t)G * 512) {
            const float4 v = ((const float4*)x)[i]; uint2 o; o.x = pk2(v.x, v.y); o.y = pk2(v.z, v.w); ((uint2*)xb)[i] = o;
        }
        if (bx < 8 && tid < 256) prep_small(bx * 256 + tid, A->in[3], A->in[4], A->in[5], A->in[6], A->in[7], A->in[13], (float*)(ws + WS_SMALL));
    }
    GRID_BAR();

#pragma unroll 1
    for (int l = 0; l < DEPTH; ++l) {
        {
            const Args* A = &args; unsigned char* ws = A->ws;
            pg8::Gemm g{(const bf16_t*)(ws + WS_XB), (const bf16_t*)(ws + WS_WTIN) + (size_t)l * NIN * DM, M, NIN, DM}; int tidg = tid_, bxg = bx; OPQ(tidg); OPQS(bxg); pg8::StaticOrder S; S.init(M, NIN, G, bxg);
            pg8::EpiStoreBf16 E{(bf16_t*)(ws + WS_PROJ), NIN};
            pg8::gemm_phase<pg8::EpiStoreBf16, pg8::StaticOrder, true, true>(ldsl, g, S, E, tidg);
        }
        GRID_BAR();
        {
            const Args* A = &args; unsigned char* ws = A->ws;
            const bf16_t* proj = (const bf16_t*)(ws + WS_PROJ); float* kmean = (float*)(ws + WS_KMEAN);
            int tid = tid_; OPQ(tid);
            for (int it = bx; it < BATCH * 32; it += G) {
                if (tid < 256) {
                    const int b = it >> 5, n = it & 31, c = tid;
                    const bf16_t* p = proj + (size_t)(b * SEQ + n * 256) * NIN + COL_KA + c;
                    float s = 0.f;
                    for (int r = 0; r < 256; ++r) s += bf2f(p[(size_t)r * NIN]);
                    kmean[((b * 4 + (c >> 6)) * 32 + n) * 64 + (c & 63)] = s * (1.0f / 256.0f);
                }
            }
        }
        GRID_BAR();
        {
            const Args* A = &args; unsigned char* ws = A->ws;
            const bf16_t* proj = (const bf16_t*)(ws + WS_PROJ); bf16_t* Y = (bf16_t*)(ws + WS_Y); const float* sm = (const float*)(ws + WS_SMALL);
            int lane = lane_; OPQ(lane);
            int bx = bx_; OPQS(bx);
            if (wave == 0 && bx < 64) s5_simple(bx >> 4, bx & 15, lane, (float*)lds, proj, sm, A->in[8], A->in[9], A->in[10], (bf16_t*)(ws + WS_YBPRE), l);
            else if (wave == 0 && bx < 80) hgrn_simple((bx - 64) >> 2, (bx - 64) & 3, lane, (float*)lds, proj, sm, Y, l);
            else {
                const float* kmean = (const float*)(ws + WS_KMEAN); const float* rel_bias = A->in[2];
                const int aw = (bx < 80) ? bx * 7 + (wave - 1) : 80 * 7 + (bx - 80) * 8 + wave, NAW = 80 * 7 + (G - 80) * 8;
                float* scr = (float*)(lds + 65536 + wave * 8192);
                for (int it = aw; it < 2 * M * 4; it += NAW) {
                    if (it < M * 4) moba_simple(it, lane, scr, proj, kmean, rel_bias, Y);
                    else dilated_simple(it - M * 4, lane, scr, proj, rel_bias, Y);
                }
            }
        }
        GRID_BAR();
        {
            const Args* A = &args; unsigned char* ws = A->ws;
            const bf16_t* ybpre = (const bf16_t*)(ws + WS_YBPRE);
            pg8::Gemm g{ybpre, (const bf16_t*)(ws + WS_GLUWT) + (size_t)l * BW * BW, M, BW, BW}; int tidg = tid_, bxg = bx; OPQ(tidg); OPQS(bxg); pg8::StaticOrder S; S.init(M, BW, G, bxg);
            pg8::EpiGlu E{(bf16_t*)(ws + WS_Y) + 256, DM, ybpre, BW, A->in[12] + l * BW};
            pg8::gemm_phase<pg8::EpiGlu, pg8::StaticOrder, true, true>(ldsl, g, S, E, tidg);
        }
        GRID_BAR();
        {
            const Args* A = &args; unsigned char* ws = A->ws;
            int lane = lane_; OPQ(lane);
            for (int r = gw; r < M; r += NGW) combine_row((size_t)r, lane, (bf16_t*)(ws + WS_Y), (const bf16_t*)(ws + WS_PROJ), A->in[14] + l * DM);
        }
        GRID_BAR();
        {
            const Args* A = &args; unsigned char* ws = A->ws;
            pg8::Gemm g{(const bf16_t*)(ws + WS_Y), (const bf16_t*)(ws + WS_WTOUT) + (size_t)l * DM * DM, M, DM, DM}; int tidg = tid_, bxg = bx; OPQ(tidg); OPQS(bxg); pg8::StaticOrder S; S.init(M, DM, G, bxg);
            pg8::EpiResF32 E{l == 0 ? A->in[0] : A->out, A->out};
            pg8::gemm_phase<pg8::EpiResF32, pg8::StaticOrder, true, true>(ldsl, g, S, E, tidg);
        }
        GRID_BAR();
        {
            const Args* A = &args; unsigned char* ws = A->ws;
            int lane = lane_; OPQ(lane);
            for (int r = gw; r < M; r += NGW) layernorm_row((size_t)r, lane, A->out, (bf16_t*)(ws + WS_XB), A->in[16] + l * DM, A->in[17] + l * DM);
        }
        if (l + 1 < DEPTH) GRID_BAR();
    }
}

extern "C" void kernel_launch(void* const* d_in, const int* in_sizes, int n_in, void* d_out, int out_size, void* d_ws, size_t ws_size, hipStream_t stream) {
    static int grid = 0;
    if (grid == 0) {
        if (n_in != 18 || in_sizes[0] != M * DM || out_size != M * DM || ws_size < WS_END) { fprintf(stderr, "kernel_launch: unexpected shapes (n_in %d, in0 %d, out %d, ws %zu)\n", n_in, n_in > 0 ? in_sizes[0] : -1, out_size, ws_size); grid = -1; return; }
        int dev = 0, cus = 0, per_cu = 0;
        if (hipGetDevice(&dev) != hipSuccess || hipDeviceGetAttribute(&cus, hipDeviceAttributeMultiprocessorCount, dev) != hipSuccess) { grid = -1; return; }
        if (hipFuncSetAttribute((const void*)mega_fwd, hipFuncAttributeMaxDynamicSharedMemorySize, LDS_BYTES) != hipSuccess) { fprintf(stderr, "kernel_launch: hipFuncSetAttribute failed\n"); grid = -1; return; }
        if (hipOccupancyMaxActiveBlocksPerMultiprocessor(&per_cu, (const void*)mega_fwd, NWAVES * 64, LDS_BYTES) != hipSuccess || per_cu < 1) { fprintf(stderr, "kernel_launch: occupancy query says %d\n", per_cu); }
        (void)hipGetLastError();
        grid = cus;
    }
    if (grid < 0) return;
    if (hipMemsetAsync((char*)d_ws + WS_CTL, 0, CTL_ZERO_BYTES, stream) != hipSuccess) return;
    Args a{};
    for (int i = 0; i < 18; ++i) a.in[i] = (const float*)d_in[i];
    a.out = (float*)d_out; a.ws = (unsigned char*)d_ws;
    hipLaunchKernelGGL(mega_fwd, dim3(grid), dim3(NWAVES * 64), LDS_BYTES, stream, a);
}
```

```cpp
#include <hip/hip_runtime.h>
#include <stdint.h>
#include <cstdio>

typedef unsigned short bf16_t;
typedef unsigned u32x4 __attribute__((ext_vector_type(4)));
#define LAS __attribute__((address_space(3)))
#define GAS __attribute__((address_space(1)))

constexpr int BATCH = 4, SEQ = 8192, DM = 1024, M = BATCH * SEQ, BW = 256, NIN = 3584, HD = 64, DEPTH = 2;
constexpr int COL_QA = 0, COL_KA = 256, COL_VA = 512, COL_U = 768, COL_QC = 1024, COL_FC = 1280, COL_IC = 1536, COL_QD = 1792, COL_KD = 2048, COL_VD = 2304, COL_G = 2560;
constexpr float ALPHA = 1.4142135623730951f;
constexpr float LN_EPS = 1e-5f, RMS_EPS = 1e-6f, NEGF = -1e30f;

constexpr size_t MiB = 1u << 20;
constexpr size_t WS_CTL = 0, CTL_ZERO_BYTES = 1 * MiB;
constexpr size_t WS_SMALL = 1 * MiB;
constexpr size_t WS_WTIN = 2 * MiB;
constexpr size_t WS_WTOUT = 16 * MiB;
constexpr size_t WS_GLUWT = 20 * MiB;
constexpr size_t WS_KMEAN = 21 * MiB;
constexpr size_t WS_XB = 22 * MiB;
constexpr size_t WS_PROJ = 86 * MiB;
constexpr size_t WS_Y = 310 * MiB;
constexpr size_t WS_YBPRE = 374 * MiB;
constexpr size_t WS_PO = 390 * MiB;
constexpr size_t WS_PL = 438 * MiB;
constexpr size_t WS_DS = 440 * MiB;
constexpr size_t WS_ST = 472 * MiB;
constexpr size_t WS_DEC = 488 * MiB;
constexpr size_t WS_KM = 489 * MiB;
constexpr size_t WS_W1 = 490 * MiB;
constexpr size_t WS_W3 = 498 * MiB;
constexpr size_t WS_HEND = 506 * MiB;
constexpr size_t WS_HST = 510 * MiB;
constexpr size_t WS_END = 512 * MiB;
constexpr int SM_LB = 0;
constexpr int SM_ABAR = 512;
constexpr int SM_BBAR = SM_ABAR + 2 * 16 * 64 * 2;
constexpr int SM_A64 = SM_BBAR + 2 * 16 * 64 * 16 * 2;
constexpr int CW_BAR = 4096;

__device__ __forceinline__ float bf2f(bf16_t v) { return __uint_as_float(((unsigned)v) << 16); }
__device__ __forceinline__ bf16_t f2bf(float f) { unsigned u = __float_as_uint(f); return (bf16_t)((u + 0x7fffu + ((u >> 16) & 1u)) >> 16); }
__device__ __forceinline__ unsigned pk2(float lo, float hi) { return (unsigned)f2bf(lo) | ((unsigned)f2bf(hi) << 16); }
__device__ __forceinline__ float wave_max(float v) {
#pragma unroll
    for (int o = 1; o < 64; o <<= 1) v = fmaxf(v, __shfl_xor(v, o));
    return v;
}
__device__ __forceinline__ float wave_sum(float v) {
#pragma unroll
    for (int o = 1; o < 64; o <<= 1) v += __shfl_xor(v, o);
    return v;
}
__device__ __forceinline__ int t5_bucket(int d) {
    if (d < 16) return d;
    int b = 16;
    b += (d >= 22); b += (d >= 30); b += (d >= 40); b += (d >= 54); b += (d >= 73); b += (d >= 99); b += (d >= 134); b += (d >= 182);
    b += (d >= 246); b += (d >= 332); b += (d >= 450); b += (d >= 609); b += (d >= 825); b += (d >= 1117); b += (d >= 1513);
    return b;
}
__device__ __forceinline__ float sigmoidf_(float x) { return 1.0f / (1.0f + expf(-x)); }
__device__ __forceinline__ float siluf_(float x) { return x / (1.0f + expf(-x)); }
__device__ __forceinline__ float gelu_tanh(float x) { const float u = 0.7978845608028654f * (x + 0.044715f * x * x * x); return 0.5f * x * (1.0f + tanhf(u)); }
typedef float f32x2_t __attribute__((ext_vector_type(2))); typedef __bf16 bf16x2_t __attribute__((ext_vector_type(2)));
__device__ __forceinline__ unsigned cvtpk_s(float lo, float hi) { f32x2_t v = {lo, hi}; bf16x2_t b = __builtin_convertvector(v, bf16x2_t); return __builtin_bit_cast(unsigned, b); }
__device__ __forceinline__ int lane_id_opaque() { unsigned z = 0u; asm volatile("" : "+v"(z)); return (int)__builtin_amdgcn_mbcnt_hi(~0u, __builtin_amdgcn_mbcnt_lo(~0u, z)); }
#define WSYNC() asm volatile("s_waitcnt lgkmcnt(0)" ::: "memory")

__device__ __forceinline__ void sincos_d(double th, double& s, double& c) {
    const double k = rint(th * 0.63661977236758134308);
    double r = fma(-k, 1.57079632679489655800, th); r = fma(-k, 6.12323399573676603587e-17, r);
    const long q = ((long)k) & 3;
    const double r2 = r * r;
    const double sp = r * (1.0 + r2 * (-1.0 / 6 + r2 * (1.0 / 120 + r2 * (-1.0 / 5040 + r2 * (1.0 / 362880 + r2 * (-1.0 / 39916800 + r2 * (1.0 / 6227020800.0 + r2 * (-1.0 / 1307674368000.0))))))));
    const double cp = 1.0 + r2 * (-0.5 + r2 * (1.0 / 24 + r2 * (-1.0 / 720 + r2 * (1.0 / 40320 + r2 * (-1.0 / 3628800 + r2 * (1.0 / 479001600.0 + r2 * (-1.0 / 87178291200.0 + r2 * (1.0 / 20922789888000.0))))))));
    if (q == 0) { s = sp; c = cp; } else if (q == 1) { s = cp; c = -sp; } else if (q == 2) { s = -sp; c = -cp; } else { s = -cp; c = sp; }
}

namespace pg8 {
#define PG8_LAS __attribute__((address_space(3)))
typedef unsigned short bf16_t;
typedef short bf16x8 __attribute__((ext_vector_type(8)));
typedef float f32x4 __attribute__((ext_vector_type(4)));
typedef unsigned u32x4 __attribute__((ext_vector_type(4)));
constexpr int BM = 256, BK = 64, HALF = 128, HTB = HALF * BK * 2  , STAGE_BYTES = 8 * HTB, NXCD = 8, WGM = 8;

__host__ __device__ __forceinline__ int lds_byte(int r, int c) { const int st = (r >> 4) * 2 + (c >> 5), rr = r & 15, cc = c & 31, ob = rr * 64 + cc * 2; return st * 1024 + (ob ^ (((ob >> 9) & 1) << 5)); }
__host__ __device__ __forceinline__ void stage_rc(int b, int& R, int& C) { const int st = b / 1024, sb = b % 1024, swz = sb ^ (((sb >> 9) & 1) << 5); R = (st >> 1) * 16 + swz / 64; C = (st & 1) * 32 + (swz % 64) / 2; }
__host__ __device__ __forceinline__ int perm32(int rho) { const int n = rho >> 4, i = rho & 15; return 8 * (i >> 2) + 4 * n + (i & 3); }

struct Unit { int pm, pn; };
struct Gemm { const bf16_t* A; const bf16_t* Bt; int M, N, K; };

struct StaticOrder {
    int nM, nN, nwg, G, c;
    __host__ __device__ void init(int M, int N, int G_, int c_) { nM = M / BM; nN = N / BM; nwg = nM * nN; G = G_; c = c_; }
    __host__ __device__ bool next(int i, Unit& u) const {
        const long L = (long)i * G + c; if (L >= nwg) return false;
        int wgid = (int)L; { const int q = nwg / NXCD, r = nwg % NXCD, xcd = wgid % NXCD, off = wgid / NXCD; wgid = (xcd < r ? xcd * (q + 1) : r * (q + 1) + (xcd - r) * q) + off; }
        const int nig = WGM * nN, gid = wgid / nig, fm = gid * WGM, gsz = (nM - fm) < WGM ? (nM - fm) : WGM;
        u.pm = fm + ((wgid % nig) % gsz); u.pn = (wgid % nig) / gsz; return true;
    }
    __device__ __forceinline__ void a_ready(const Unit&) const {}
    __device__ __forceinline__ void done(const Unit&) const {}
};

__device__ __forceinline__ unsigned cvt_pk_bf16(float lo, float hi) { unsigned r; asm volatile("v_cvt_pk_bf16_f32 %0, %1, %2" : "=v"(r) : "v"(lo), "v"(hi)); return r; }
struct EpiStoreBf16 {
    static constexpr bool PERM = true, AFTER_DRAIN = false;
    bf16_t* O; int ldc;
    __device__ __forceinline__ void operator()(const f32x4 (&acc)[2][2][4][2], const Unit& u, int wr, int wc, int fr_, int fq_) const {
        const int ln_ = lane_id_opaque(), fr = ln_ & 15, fq = ln_ >> 4; (void)fr_; (void)fq_;
        const int row0 = u.pm * BM + wr * 64 + fr, col0 = u.pn * BM + wc * 32 + 8 * fq;
#pragma unroll
        for (int ai = 0; ai < 2; ++ai)
#pragma unroll
            for (int m = 0; m < 4; ++m) { bf16_t* rowp = O + (size_t)(row0 + ai * HALF + m * 16) * ldc + col0;
#pragma unroll
                for (int bj = 0; bj < 2; ++bj) { const f32x4 v0 = acc[ai][bj][m][0], v1 = acc[ai][bj][m][1];
                    u32x4 w; w.x = cvtpk_s(v0[0], v0[1]); w.y = cvtpk_s(v0[2], v0[3]); w.z = cvtpk_s(v1[0], v1[1]); w.w = cvtpk_s(v1[2], v1[3]);
                    *(u32x4*)(rowp + bj * HALF) = w; } }
    }
};
struct EpiGlu {
    static constexpr bool PERM = true, AFTER_DRAIN = false;
    bf16_t* O; int ldc; const bf16_t* Ain; int lda; const float* bias;
    __device__ __forceinline__ void operator()(const f32x4 (&acc)[2][2][4][2], const Unit& u, int wr, int wc, int fr_, int fq_) const {
        const int ln_ = lane_id_opaque(), fr = ln_ & 15, fq = ln_ >> 4; (void)fr_; (void)fq_;
        const int row0 = u.pm * BM + wr * 64 + fr, col0 = u.pn * BM + wc * 32 + 8 * fq;
#pragma unroll
        for (int ai = 0; ai < 2; ++ai)
#pragma unroll
            for (int m = 0; m < 4; ++m) { const size_t r = (size_t)(row0 + ai * HALF + m * 16);
#pragma unroll
                for (int bj = 0; bj < 2; ++bj) { const int c = col0 + bj * HALF;
                    const u32x4 av = *(const u32x4*)(Ain + r * lda + c);
                    const f32x4 b0 = *(const f32x4*)(bias + c), b1 = *(const f32x4*)(bias + c + 4);
                    const f32x4 v0 = acc[ai][bj][m][0] + b0, v1 = acc[ai][bj][m][1] + b1;
                    float o[8];
#pragma unroll
                    for (int j = 0; j < 4; ++j) { const float alo = __uint_as_float(av[j] << 16), ahi = __uint_as_float(av[j] & 0xffff0000u);
                        const float s0 = (j < 2) ? v0[2 * j] : v1[2 * j - 4], s1 = (j < 2) ? v0[2 * j + 1] : v1[2 * j - 3];
                        o[2 * j] = alo / (1.0f + __expf(-s0)); o[2 * j + 1] = ahi / (1.0f + __expf(-s1)); }
                    u32x4 w; w.x = cvtpk_s(o[0], o[1]); w.y = cvtpk_s(o[2], o[3]); w.z = cvtpk_s(o[4], o[5]); w.w = cvtpk_s(o[6], o[7]);
                    *(u32x4*)(O + r * ldc + c) = w; } }
    }
};
struct EpiResF32 {
    static constexpr bool PERM = false, AFTER_DRAIN = false;
    const float* res; float* out;
    __device__ __forceinline__ void operator()(const f32x4 (&acc)[2][2][4][2], const Unit& u, int wr, int wc, int fr_, int fq_) const {
        const int ln_ = lane_id_opaque(), fr = ln_ & 15, fq = ln_ >> 4; (void)fr_; (void)fq_;
        const int col0 = u.pn * BM + wc * 32 + 4 * fq;
#pragma unroll
        for (int ai = 0; ai < 2; ++ai)
#pragma unroll
            for (int m = 0; m < 4; ++m) { const size_t off = (size_t)(u.pm * BM + ai * HALF + wr * 64 + m * 16 + fr) * 1024 + col0;
#pragma unroll
                for (int bj = 0; bj < 2; ++bj)
#pragma unroll
                    for (int n = 0; n < 2; ++n) { const f32x4 rv = *(const f32x4*)(res + off + bj * HALF + n * 16);
                        *(f32x4*)(out + off + bj * HALF + n * 16) = rv * 1.4142135623730951f + acc[ai][bj][m][n]; } }
    }
};

template <class Epi, class Sched, bool ALIGN_EPI = false, bool SP2 = false>
__device__ __forceinline__ void gemm_phase(PG8_LAS unsigned char* lds, const Gemm g, const Sched& S, const Epi& E, const int tid_in  ) {
    const int tid = tid_in, wid = __builtin_amdgcn_readfirstlane(tid >> 6), lane = tid & 63, wr = wid >> 2, wc = wid & 3, fr = lane & 15, fq = lane >> 4;
    const int K = g.K, nt = K / BK;
    unsigned voffA[2], voffB[2];
#pragma unroll
    for (int i = 0; i < 2; ++i) { int R, C; stage_rc(tid * 16 + i * 8192, R, C); const int Rb = Epi::PERM ? ((R & ~31) + perm32(R & 31)) : R;
        voffA[i] = (unsigned)(R * K + C) * 2u; voffB[i] = (unsigned)(Rb * K + C) * 2u; }
    const size_t kstep = (size_t)(BK * 2);
    const size_t hstep = (size_t)HALF * K * 2;
    const size_t tstep = 2 * hstep;
    const unsigned ldsw = (unsigned)wid * 1024u;
    const int aoff = lds_byte(wr * 64 + fr, fq * 8), boff = lds_byte(wc * 32 + fr, fq * 8);
#define PG8_SA(b, h) (((b) * 2 + (h)) * HTB)
#define PG8_SB(b, h) ((4 + (b) * 2 + (h)) * HTB)
#define PG8_STAGE(bufoff, gbase, voff) do { _Pragma("unroll") for (int _i = 0; _i < 2; ++_i) \
        __builtin_amdgcn_global_load_lds((const unsigned*)((const char*)(gbase) + (voff)[_i]), (PG8_LAS unsigned*)(lds + (bufoff) + ldsw + _i * 8192), 16, 0, 0); } while (0)
#define PG8_LDA(dst, b, h) do { _Pragma("unroll") for (int m = 0; m < 4; ++m) _Pragma("unroll") for (int k = 0; k < 2; ++k) dst[m][k] = *(const PG8_LAS bf16x8*)(lds + PG8_SA(b, h) + aoff + m * 2048 + k * 1024); } while (0)
#define PG8_LDB(dst, b, h) do { _Pragma("unroll") for (int n = 0; n < 2; ++n) _Pragma("unroll") for (int k = 0; k < 2; ++k) dst[n][k] = *(const PG8_LAS bf16x8*)(lds + PG8_SB(b, h) + boff + n * 2048 + k * 1024); } while (0)
#define PG8_MMA(ai, bj, At, Bt) do { __builtin_amdgcn_s_setprio(1); _Pragma("unroll") for (int m = 0; m < 4; ++m) _Pragma("unroll") for (int n = 0; n < 2; ++n) _Pragma("unroll") for (int k = 0; k < 2; ++k) \
        acc[ai][bj][m][n] = __builtin_amdgcn_mfma_f32_16x16x32_bf16(Bt[n][k], At[m][k], acc[ai][bj][m][n], 0, 0, 0); __builtin_amdgcn_s_setprio(0); } while (0)
#define PG8_WAIT_V(n) asm volatile("s_waitcnt vmcnt(" #n ")" ::: "memory")
#define PG8_WAIT_L(n) asm volatile("s_waitcnt lgkmcnt(" #n ")" ::: "memory")
#define PG8_BAR __builtin_amdgcn_s_barrier()
#define PG8_SCHED __builtin_amdgcn_sched_barrier(0)
    Unit cur, nxt; int ui = 0;
    if (!S.next(0, cur)) return;
    f32x4 acc[2][2][4][2];
#pragma unroll
    for (int a = 0; a < 2; ++a)
#pragma unroll
        for (int b = 0; b < 2; ++b)
#pragma unroll
            for (int m = 0; m < 4; ++m)
#pragma unroll
                for (int n = 0; n < 2; ++n) acc[a][b][m][n] = (f32x4){0.f, 0.f, 0.f, 0.f};
    bf16x8 At[4][2], B0[2][2], B1[2][2];
    const char* cA = (const char*)g.A + (size_t)cur.pm * tstep; const char* cB = (const char*)g.Bt + (size_t)cur.pn * tstep;
    S.a_ready(cur);
    if constexpr (SP2) {
        PG8_STAGE(PG8_SB(0, 0), cB, voffB); PG8_STAGE(PG8_SB(0, 1), cB + hstep, voffB); PG8_STAGE(PG8_SA(0, 0), cA, voffA); PG8_STAGE(PG8_SA(0, 1), cA + hstep, voffA);
        if (wr == 1) PG8_BAR;
        PG8_WAIT_V(2); PG8_BAR;
        PG8_STAGE(PG8_SB(1, 0), cB + kstep, voffB); PG8_STAGE(PG8_SA(1, 0), cA + kstep, voffA); PG8_STAGE(PG8_SB(1, 1), cB + hstep + kstep, voffB);
        PG8_WAIT_V(6); PG8_BAR;
    } else {
        PG8_STAGE(PG8_SB(0, 0), cB, voffB); PG8_STAGE(PG8_SA(0, 0), cA, voffA); PG8_STAGE(PG8_SB(0, 1), cB + hstep, voffB); PG8_STAGE(PG8_SA(0, 1), cA + hstep, voffA);
        if (wr == 1) PG8_BAR;
        PG8_WAIT_V(4); PG8_BAR;
        PG8_STAGE(PG8_SB(1, 0), cB + kstep, voffB); PG8_STAGE(PG8_SA(1, 0), cA + kstep, voffA); PG8_STAGE(PG8_SB(1, 1), cB + hstep + kstep, voffB);
        PG8_WAIT_V(6); PG8_BAR;
    }
    for (;;) {
        const bool has_next = S.next(ui + 1, nxt);
        const char* nA = has_next ? (const char*)g.A + (size_t)nxt.pm * tstep : cA; const char* nB = has_next ? (const char*)g.Bt + (size_t)nxt.pn * tstep : cB;
        for (int t = 0; t < nt; t += 2) {
            const bool last = (t == nt - 2);
            const char* a1 = cA + (size_t)(t + 1) * kstep;
            const char* a2 = last ? nA : cA + (size_t)(t + 2) * kstep; const char* b2 = last ? nB : cB + (size_t)(t + 2) * kstep;
            const char* a3 = a2 + kstep; const char* b3 = b2 + kstep;
            if (last && has_next) S.a_ready(nxt);
            if constexpr (SP2) {
            PG8_LDB(B0, 0, 0); PG8_LDB(B1, 0, 1); PG8_SCHED; PG8_LDA(At, 0, 0); PG8_STAGE(PG8_SA(1, 1), a1 + hstep, voffA);
            PG8_WAIT_V(8); PG8_WAIT_L(0); PG8_BAR; PG8_MMA(0, 0, At, B0); PG8_MMA(0, 1, At, B1); PG8_BAR; PG8_SCHED;
            PG8_LDA(At, 0, 1); PG8_STAGE(PG8_SB(0, 0), b2, voffB); PG8_STAGE(PG8_SB(0, 1), b2 + hstep, voffB); PG8_STAGE(PG8_SA(0, 0), a2, voffA);
            PG8_WAIT_V(8); PG8_WAIT_L(0); PG8_BAR; PG8_MMA(1, 0, At, B0); PG8_MMA(1, 1, At, B1); PG8_BAR; PG8_SCHED;
            PG8_LDB(B0, 1, 0); PG8_LDB(B1, 1, 1); PG8_SCHED; PG8_LDA(At, 1, 0); PG8_STAGE(PG8_SA(0, 1), a2 + hstep, voffA);
            PG8_WAIT_V(8); PG8_WAIT_L(0); PG8_BAR; PG8_MMA(0, 0, At, B0); PG8_MMA(0, 1, At, B1); PG8_BAR; PG8_SCHED;
            PG8_LDA(At, 1, 1); PG8_STAGE(PG8_SB(1, 0), b3, voffB); PG8_STAGE(PG8_SB(1, 1), b3 + hstep, voffB); PG8_STAGE(PG8_SA(1, 0), a3, voffA);
            PG8_WAIT_V(8); PG8_WAIT_L(0); PG8_BAR; PG8_MMA(1, 0, At, B0); PG8_MMA(1, 1, At, B1); PG8_BAR; PG8_SCHED;
            } else {
            PG8_LDB(B0, 0, 0); PG8_SCHED; PG8_LDA(At, 0, 0); PG8_STAGE(PG8_SA(1, 1), a1 + hstep, voffA);
            PG8_WAIT_L(8); PG8_BAR; PG8_WAIT_L(0); PG8_MMA(0, 0, At, B0); PG8_BAR; PG8_SCHED;
            PG8_LDB(B1, 0, 1); PG8_STAGE(PG8_SB(0, 0), b2, voffB);
            PG8_BAR; PG8_WAIT_L(0); PG8_MMA(0, 1, At, B1); PG8_BAR;
            PG8_LDA(At, 0, 1); PG8_STAGE(PG8_SA(0, 0), a2, voffA);
            PG8_BAR; PG8_WAIT_L(0); PG8_MMA(1, 0, At, B0); PG8_BAR; PG8_SCHED;
            PG8_STAGE(PG8_SB(0, 1), b2 + hstep, voffB);
            PG8_WAIT_V(6); PG8_BAR; PG8_MMA(1, 1, At, B1); PG8_BAR;
            PG8_LDB(B0, 1, 0); PG8_SCHED; PG8_LDA(At, 1, 0); PG8_STAGE(PG8_SA(0, 1), a2 + hstep, voffA);
            PG8_WAIT_L(8); PG8_BAR; PG8_WAIT_L(0); PG8_MMA(0, 0, At, B0); PG8_BAR; PG8_SCHED;
            PG8_LDB(B1, 1, 1); PG8_STAGE(PG8_SB(1, 0), b3, voffB);
            PG8_BAR; PG8_WAIT_L(0); PG8_MMA(0, 1, At, B1); PG8_BAR;
            PG8_LDA(At, 1, 1); PG8_STAGE(PG8_SA(1, 0), a3, voffA);
            PG8_BAR; PG8_WAIT_L(0); PG8_MMA(1, 0, At, B0); PG8_BAR; PG8_SCHED;
            PG8_STAGE(PG8_SB(1, 1), b3 + hstep, voffB);
            PG8_WAIT_V(6); PG8_BAR; PG8_MMA(1, 1, At, B1); PG8_BAR;
            }
        }
        if constexpr (ALIGN_EPI) { if (wr == 0) PG8_BAR; }
        if constexpr (!Epi::AFTER_DRAIN) { E(acc, cur, wr, wc, fr, fq); S.done(cur); }
        if (!has_next) break;
#pragma unroll
        for (int a = 0; a < 2; ++a)
#pragma unroll
            for (int b = 0; b < 2; ++b)
#pragma unroll
                for (int m = 0; m < 4; ++m)
#pragma unroll
                    for (int n = 0; n < 2; ++n) acc[a][b][m][n] = (f32x4){0.f, 0.f, 0.f, 0.f};
        cur = nxt; cA = nA; cB = nB; ++ui;
        if constexpr (ALIGN_EPI) { if (wr == 1) PG8_BAR; }
    }
    PG8_WAIT_V(0);
    if constexpr (!ALIGN_EPI) { if (wr == 0) PG8_BAR; }
    PG8_BAR;
    if constexpr (Epi::AFTER_DRAIN) { E.fused(acc, cur, wr, wc, fr, fq, lds, wid, lane); S.done(cur); }
#undef PG8_SA
#undef PG8_SB
#undef PG8_STAGE
#undef PG8_LDA
#undef PG8_LDB
#undef PG8_MMA
#undef PG8_WAIT_V
#undef PG8_WAIT_L
#undef PG8_BAR
#undef PG8_SCHED
}
}
#define XB_TMO      128
#define XB_XCNT(j)  (256  + 64 * (j))
#define XB_XSUB(j)  (1280 + 64 * (j))
#define XB_XGEN(j)  (2304 + 64 * (j))
#define XB_TOP      3328
#define XB_TOPGEN   3392
#define XCD_BAR_WORDS 3456
#define XB_SPIN_CAP (1u << 18)

__device__ __forceinline__ unsigned xb_ld(unsigned* p)              { return __hip_atomic_load(p, __ATOMIC_RELAXED, __HIP_MEMORY_SCOPE_AGENT); }
__device__ __forceinline__ unsigned xb_add(unsigned* p, unsigned v) { return __hip_atomic_fetch_add(p, v, __ATOMIC_RELAXED, __HIP_MEMORY_SCOPE_AGENT); }
__device__ __forceinline__ unsigned xb_xcc_id() { return (unsigned)__builtin_amdgcn_s_getreg((3 << 11) | 20) & 0xFu; }
#define XB_SPIN(cond, bar) do { unsigned _sp = 0; while (cond) { __builtin_amdgcn_s_sleep(1); \
    if ((++_sp & 255u) == 0u) { if (xb_ld(&(bar)[XB_TMO])) break; if (_sp > XB_SPIN_CAP) { atomicAdd(&(bar)[XB_TMO], 1u); break; } } } } while (0)

struct XcdBarrier {
    unsigned* bar; unsigned x;
    volatile LAS unsigned* st;
};

__device__ __forceinline__ XcdBarrier xcd_barrier_post(unsigned* bar, volatile LAS unsigned* st) {
    XcdBarrier b; b.bar = bar; b.x = xb_xcc_id(); b.st = st;
    if (threadIdx.x == 0) (void)xb_add(&bar[XB_XCNT(b.x)], 1u);
    return b;
}
__device__ __forceinline__ void xcd_barrier_complete(unsigned* bar, unsigned x, unsigned& nloc, unsigned& nx) {
    const unsigned G = gridDim.x * gridDim.y * gridDim.z;
    unsigned sum, cnt, mine, sp = 0u;
    for (;;) {
        sum = 0u; cnt = 0u; mine = 0u;
#pragma unroll
        for (unsigned j = 0; j < 16; ++j) { const unsigned c = xb_ld(&bar[XB_XCNT(j)]); sum += c; cnt += (c > 0u) ? 1u : 0u; mine = (j == x) ? c : mine; }
        if (sum == G) break;
        __builtin_amdgcn_s_sleep(1);
        if ((++sp & 255u) == 0u) { if (xb_ld(&bar[XB_TMO])) break; if (sp > XB_SPIN_CAP) { atomicAdd(&bar[XB_TMO], 1u); break; } }
    }
    nloc = mine > 0u ? mine : 1u; nx = cnt > 0u ? cnt : 1u;
}

__device__ __forceinline__ void xcd_barrier(const XcdBarrier& b) {
    asm volatile("s_waitcnt vmcnt(0)" ::: "memory");
    __syncthreads();
    if (threadIdx.x == 0) {
        unsigned* bar = b.bar;
        __builtin_amdgcn_s_waitcnt(0);
        unsigned nloc = b.st[0], nx = b.st[1];
        if (nloc == 0u) { xcd_barrier_complete(bar, b.x, nloc, nx); b.st[0] = nloc; b.st[1] = nx; }
        const unsigned old = xb_add(&bar[XB_XSUB(b.x)], 1u);
        const unsigned gen = old / nloc;
        if (old + 1u == (gen + 1u) * nloc) {
            __builtin_amdgcn_fence(__ATOMIC_RELEASE, "agent");
            asm volatile("s_waitcnt vmcnt(0)" ::: "memory");
            const unsigned og = xb_add(&bar[XB_TOP], 1u);
            const unsigned tg = og / nx;
            if (og + 1u == (tg + 1u) * nx) xb_add(&bar[XB_TOPGEN], 1u);
            else XB_SPIN(xb_ld(&bar[XB_TOPGEN]) == tg, bar);
            __builtin_amdgcn_fence(__ATOMIC_ACQUIRE, "agent");
            xb_add(&bar[XB_XGEN(b.x)], 1u);
            asm volatile("s_waitcnt vmcnt(0)" ::: "memory");
        } else {
            XB_SPIN(xb_ld(&bar[XB_XGEN(b.x)]) == gen, bar);
            __builtin_amdgcn_fence(__ATOMIC_ACQUIRE, "agent");
            asm volatile("s_waitcnt vmcnt(0)" ::: "memory");
        }
    }
    __syncthreads();
}
namespace fa {
typedef short bf16x8 __attribute__((ext_vector_type(8)));
typedef float f32x16 __attribute__((ext_vector_type(16)));
typedef short v4i16_t __attribute__((ext_vector_type(4)));
constexpr int KT_OFF = 0, VT_OFF = 8192, LUT_OFF = 16384, OST_OFF = 24576, FA_LDS = OST_OFF + 8 * 4096;
__device__ __forceinline__ int crow(int r, int hi) { return (r & 3) + 8 * (r >> 2) + 4 * hi; }
__device__ __forceinline__ unsigned cvtpk(float lo, float hi) { return cvtpk_s(lo, hi); }
template <int B> __device__ __forceinline__ bf16x8 pack8(const f32x16& p) {
    u32x4 w; w.x = cvtpk(p[B], p[B + 1]); w.y = cvtpk(p[B + 2], p[B + 3]); w.z = cvtpk(p[B + 4], p[B + 5]); w.w = cvtpk(p[B + 6], p[B + 7]);
    return __builtin_bit_cast(bf16x8, w);
}
__device__ __forceinline__ v4i16_t trd(LAS const unsigned char* p) { return __builtin_amdgcn_ds_read_tr16_b64_v4i16((LAS v4i16_t*)p); }
__device__ __forceinline__ void stage_tile(LAS unsigned char* lds, int tid, const bf16_t* krow, const bf16_t* vrow) {
    const int row = tid >> 3, ch = tid & 7;
    u32x4 kv = {0u, 0u, 0u, 0u}, vv = {0u, 0u, 0u, 0u};
    if (krow) { kv = *(const u32x4*)(krow + ch * 8); vv = *(const u32x4*)(vrow + ch * 8); }
    *(LAS u32x4*)(lds + KT_OFF + row * 128 + ((ch ^ (row & 7)) * 16)) = kv;
    *(LAS u32x4*)(lds + VT_OFF + row * 128 + ch * 16) = vv;
}
template <class Fn> __device__ __forceinline__ void tile_step(LAS const unsigned char* lds, const bf16x8 (&qf)[4], f32x16& o0, f32x16& o1, float& m, float& l, int lane, const Fn& fn) {
    const int r32 = lane & 31, hi = lane >> 5;
    f32x16 p0, p1;
#pragma unroll
    for (int r = 0; r < 16; ++r) { p0[r] = 0.f; p1[r] = 0.f; }
#pragma unroll
    for (int s = 0; s < 4; ++s) {
        const int ch = ((2 * s + hi) ^ (r32 & 7)) * 16;
        const bf16x8 k0 = *(const LAS bf16x8*)(lds + KT_OFF + r32 * 128 + ch);
        const bf16x8 k1 = *(const LAS bf16x8*)(lds + KT_OFF + (32 + r32) * 128 + ch);
        p0 = __builtin_amdgcn_mfma_f32_32x32x16_bf16(k0, qf[s], p0, 0, 0, 0);
        p1 = __builtin_amdgcn_mfma_f32_32x32x16_bf16(k1, qf[s], p1, 0, 0, 0);
    }
    float mx = NEGF;
#pragma unroll
    for (int r = 0; r < 16; ++r) { p0[r] = fn(crow(r, hi), p0[r]); p1[r] = fn(32 + crow(r, hi), p1[r]); mx = fmaxf(mx, fmaxf(p0[r], p1[r])); }
    mx = fmaxf(mx, __shfl_xor(mx, 32));
    const float mn = fmaxf(m, mx), alpha = __expf(m - mn);
    m = mn;
    float ps = 0.f;
#pragma unroll
    for (int r = 0; r < 16; ++r) { p0[r] = __expf(p0[r] - mn); p1[r] = __expf(p1[r] - mn); ps += p0[r] + p1[r]; }
    l = l * alpha + ps;
#pragma unroll
    for (int r = 0; r < 16; ++r) { o0[r] *= alpha; o1[r] *= alpha; }
    const int q4 = (lane & 15) >> 2, p4 = lane & 3, dgrp = (lane >> 4) & 1;
    const int vb = VT_OFF + (4 * hi + q4) * 128 + (16 * dgrp + 4 * p4) * 2;
#define FA_PV(P, KH, S2) do { const bf16x8 pb = pack8<8 * (S2)>(P); \
        _Pragma("unroll") for (int blk = 0; blk < 2; ++blk) { const int a = vb + (32 * (KH) + 16 * (S2)) * 128 + blk * 64; \
            const v4i16_t lo = trd(lds + a), hh = trd(lds + a + 8 * 128); \
            const bf16x8 va = {lo[0], lo[1], lo[2], lo[3], hh[0], hh[1], hh[2], hh[3]}; \
            if (blk == 0) o0 = __builtin_amdgcn_mfma_f32_32x32x16_bf16(va, pb, o0, 0, 0, 0); else o1 = __builtin_amdgcn_mfma_f32_32x32x16_bf16(va, pb, o1, 0, 0, 0); } } while (0)
    FA_PV(p0, 0, 0); FA_PV(p0, 0, 1); FA_PV(p1, 1, 0); FA_PV(p1, 1, 1);
#undef FA_PV
}
template <class RowFn> __device__ __forceinline__ float store_o(LAS unsigned char* lds, int wave, int lane, const f32x16& o0, const f32x16& o1, float l, const RowFn& orow) {
    const int r32 = lane & 31, hi = lane >> 5;
    l += __shfl_xor(l, 32);
    const float inv = 1.0f / l;
    LAS bf16_t* stg = (LAS bf16_t*)(lds + OST_OFF + wave * 4096);
#pragma unroll
    for (int r = 0; r < 16; ++r) { const int d = crow(r, hi); stg[r32 * 64 + d] = f2bf(o0[r] * inv); stg[r32 * 64 + 32 + d] = f2bf(o1[r] * inv); }
    asm volatile("s_waitcnt lgkmcnt(0)" ::: "memory");
#pragma unroll
    for (int i = 0; i < 4; ++i) { const int row = i * 8 + (lane >> 3), ch = lane & 7; const u32x4 v = *(const LAS u32x4*)(stg + row * 64 + ch * 8); *(u32x4*)(orow(row) + ch * 8) = v; }
    asm volatile("s_waitcnt lgkmcnt(0)" ::: "memory");
    return l;
}
struct DilFn {
    int qrel; LAS const float* lut;
    int ksub0;
    __device__ __forceinline__ float operator()(int key, float s) const {
        const int d = qrel - key; const bool ok = (d >= 0) && (d <= 128) && (ksub0 + key >= 0);
        const float b = lut[min(max(d, 0), 128)];
        return ok ? fmaf(s, 0.125f, b) : NEGF;
    }
};
struct MobaFn {
    int qrel; LAS const float* lut; bool allowed; bool causal;
    __device__ __forceinline__ float operator()(int key, float s) const {
        const int d = qrel - key; const bool ok = causal ? (d >= 0) : allowed;
        const float b = lut[min(max(d, 0), 1535)];
        return ok ? fmaf(s, 0.125f, b) : NEGF;
    }
};
__device__ __forceinline__ void dilated_unit(LAS unsigned char* lds, int tid, int pi, int bh, int u, const bf16_t* __restrict__ proj, const float* __restrict__ rel_bias, bf16_t* __restrict__ PO, float* __restrict__ PL) {
    const int lane = tid & 63, wave = __builtin_amdgcn_readfirstlane(tid >> 6), r32 = lane & 31, hi = lane >> 5;
    const int dil = (pi == 0) ? 1 : (pi == 1) ? 4 : 16, b = bh >> 2, h = bh & 3;
    const int r = u % dil, sb = u / dil;
    __syncthreads();
    LAS float* lut = (LAS float*)(lds + LUT_OFF);
    if (tid <= 128) lut[tid] = rel_bias[t5_bucket(tid * dil) * 8 + 4 + h];
    const int qsub = 256 * sb + 32 * wave + r32;
    const size_t qrow = (size_t)b * SEQ + (size_t)qsub * dil + r;
    bf16x8 qf[4];
#pragma unroll
    for (int s = 0; s < 4; ++s) qf[s] = *(const bf16x8*)(proj + qrow * NIN + COL_QD + h * 64 + 16 * s + 8 * hi);
    f32x16 o0, o1;
#pragma unroll
    for (int i = 0; i < 16; ++i) { o0[i] = 0.f; o1[i] = 0.f; }
    float m = NEGF, l = 0.f;
    for (int j = (sb == 0 ? 2 : 0); j < 6; ++j) {
        const int ksub0 = 256 * sb - 128 + 64 * j;
        { const int ksub = ksub0 + (tid >> 3);
          const bf16_t* base = (ksub >= 0) ? proj + ((size_t)b * SEQ + (size_t)ksub * dil + r) * NIN + h * 64 : nullptr;
          __syncthreads();
          stage_tile(lds, tid, base ? base + COL_KD : nullptr, base ? base + COL_VD : nullptr); }
        __syncthreads();
        if (64 * j + 63 >= 32 * wave && 64 * j <= 32 * wave + 159) {
            DilFn fn{qsub - ksub0, lut, ksub0};
            tile_step(lds, qf, o0, o1, m, l, lane, fn);
        }
    }
    const size_t rbase = (size_t)b * SEQ + (size_t)(256 * sb + 32 * wave) * dil + r;
    bf16_t* po = PO + (size_t)pi * M * 256 + h * 64;
    const float lt = store_o(lds, wave, lane, o0, o1, l, [&](int q) { return po + (rbase + (size_t)q * dil) * 256; });
    if (hi == 0) PL[((size_t)pi * M + qrow) * 4 + h] = m + __logf(lt);
}
__device__ __forceinline__ void moba_unit(LAS unsigned char* lds, int tid, int bh, int own, const bf16_t* __restrict__ proj, const float* __restrict__ kmean, const float* __restrict__ rel_bias, bf16_t* __restrict__ Y) {
    const int lane = tid & 63, wave = __builtin_amdgcn_readfirstlane(tid >> 6), r32 = lane & 31, hi = lane >> 5;
    const int b = bh >> 2, h = bh & 3;
    __syncthreads();
    LAS float* lut = (LAS float*)(lds + LUT_OFF);
    for (int d = tid; d < 1536; d += 512) lut[d] = rel_bias[t5_bucket(d) * 8 + h];
    const int qpos = 256 * own + 32 * wave + r32;
    const size_t qrow = (size_t)b * SEQ + qpos;
    bf16x8 qf[4];
#pragma unroll
    for (int s = 0; s < 4; ++s) qf[s] = *(const bf16x8*)(proj + qrow * NIN + COL_QA + h * 64 + 16 * s + 8 * hi);
    unsigned selbits = 0u;
    {
        f32x16 g;
#pragma unroll
        for (int i = 0; i < 16; ++i) g[i] = 0.f;
        const float* km = kmean + ((size_t)bh * 32 + r32) * 64;
#pragma unroll
        for (int s = 0; s < 4; ++s) {
            float kv[8];
            *(float4*)&kv[0] = *(const float4*)(km + 16 * s + 8 * hi); *(float4*)&kv[4] = *(const float4*)(km + 16 * s + 8 * hi + 4);
            u32x4 wh, wl;
#pragma unroll
            for (int j = 0; j < 4; ++j) {
                const bf16_t h0 = f2bf(kv[2 * j]), h1 = f2bf(kv[2 * j + 1]);
                const bf16_t l0 = f2bf(kv[2 * j] - bf2f(h0)), l1 = f2bf(kv[2 * j + 1] - bf2f(h1));
                wh[j] = (unsigned)h0 | ((unsigned)h1 << 16); wl[j] = (unsigned)l0 | ((unsigned)l1 << 16);
            }
            g = __builtin_amdgcn_mfma_f32_32x32x16_bf16(__builtin_bit_cast(bf16x8, wh), qf[s], g, 0, 0, 0);
            g = __builtin_amdgcn_mfma_f32_32x32x16_bf16(__builtin_bit_cast(bf16x8, wl), qf[s], g, 0, 0, 0);
        }
#pragma unroll
        for (int i = 0; i < 16; ++i) if (crow(i, hi) >= own) g[i] = -INFINITY;
#pragma unroll
        for (int t = 0; t < 3; ++t) {
            float lm = -INFINITY;
#pragma unroll
            for (int i = 0; i < 16; ++i) lm = fmaxf(lm, g[i]);
            const float gm = fmaxf(lm, __shfl_xor(lm, 32));
            int cand = 99;
#pragma unroll
            for (int i = 15; i >= 0; --i) if (g[i] == gm) cand = crow(i, hi);
            cand = min(cand, __shfl_xor(cand, 32));
            if (gm > -INFINITY) {
                selbits |= 1u << cand;
#pragma unroll
                for (int i = 0; i < 16; ++i) if (crow(i, hi) == cand) g[i] = -INFINITY;
            }
        }
    }
    f32x16 o0, o1;
#pragma unroll
    for (int i = 0; i < 16; ++i) { o0[i] = 0.f; o1[i] = 0.f; }
    float m = NEGF, l = 0.f;
    for (int n = 0; n <= own; ++n) {
        const bool allowed = (selbits >> n) & 1u;
        const bool need = (n == own) || (__ballot(allowed) != 0ull);
        for (int kt = 0; kt < 4; ++kt) {
            const int kpos0 = 256 * n + 64 * kt;
            { const bf16_t* base = proj + ((size_t)b * SEQ + kpos0 + (tid >> 3)) * NIN + h * 64;
              __syncthreads();
              stage_tile(lds, tid, base + COL_KA, base + COL_VA); }
            __syncthreads();
            if (need && (n < own || 64 * kt <= 32 * wave + 31)) {
                MobaFn fn{qpos - kpos0, lut, allowed, n == own};
                tile_step(lds, qf, o0, o1, m, l, lane, fn);
            }
        }
    }
    bf16_t* yo = Y + ((size_t)b * SEQ + 256 * own + 32 * wave) * DM + h * 64;
    store_o(lds, wave, lane, o0, o1, l, [&](int q) { return yo + (size_t)q * DM; });
}
}

namespace hg {
typedef short bf16x8 __attribute__((ext_vector_type(8)));
typedef float f32x4 __attribute__((ext_vector_type(4)));
typedef unsigned u32x2 __attribute__((ext_vector_type(2)));
constexpr int SEG_OFF = 0, BT_OFF = 2048, VT_OFF = 18432, KT_OFF = 26624;
constexpr int QS_OFF = 26624, QD_OFF = 34816, QO_OFF = 43008, KD_OFF = 51200, KO_OFF = 59392;
__device__ __forceinline__ void img_put(LAS unsigned char* lds, int off, int row, int d, float v) { *(LAS bf16_t*)(lds + off + row * 128 + ((((d >> 3) ^ (row & 7))) << 4) + (d & 7) * 2) = f2bf(v); }
__device__ __forceinline__ bf16x8 img_frag(LAS const unsigned char* lds, int off, int row, int chunk) { return *(const LAS bf16x8*)(lds + off + row * 128 + ((chunk ^ (row & 7)) << 4)); }
__device__ __forceinline__ unsigned cvtpk(float lo, float hi) { return cvtpk_s(lo, hi); }
struct Ch { float f[8], b[8], qv[8], iv[8], blast; };
template <bool NEEDQ> __device__ __forceinline__ void stage(LAS unsigned char* lds, int wave, int lane, const bf16_t* __restrict__ rowp  , float lb, Ch& c) {
    float cs = 0.f;
#pragma unroll
    for (int i = 0; i < 8; ++i) {
        const bf16_t* r = rowp + (size_t)(8 * wave + i) * NIN + lane;
        const float fp = bf2f(r[COL_FC]); c.iv[i] = bf2f(r[COL_IC]);
        if (NEEDQ) { const float q = bf2f(r[COL_QC]); c.qv[i] = q / (1.0f + __expf(-q)) * 0.125f; }
        c.f[i] = lb + (1.0f - lb) / (1.0f + __expf(-fp));
        cs += __logf(c.f[i]); c.b[i] = cs;
    }
    LAS float* seg = (LAS float*)(lds + SEG_OFF);
    seg[wave * 64 + lane] = cs;
    __syncthreads();
    float off = 0.f, tot = 0.f;
#pragma unroll
    for (int w = 0; w < 8; ++w) { const float s = seg[w * 64 + lane]; tot += s; if (w < wave) off += s; }
#pragma unroll
    for (int i = 0; i < 8; ++i) c.b[i] += off;
    c.blast = tot;
}
__device__ __forceinline__ void x1_item(LAS unsigned char* lds, int wave, int lane, int item, const bf16_t* __restrict__ proj, const float* __restrict__ lbp, float* __restrict__ DS, float* __restrict__ DEC) {
    const int bh = item >> 7, ch = item & 127, b = bh >> 2, h = bh & 3;
    __syncthreads();
    Ch c; stage<false>(lds, wave, lane, proj + ((size_t)b * SEQ + ch * 64) * NIN + h * 64, lbp[h * 64 + lane], c);
    u32x4 kw, vw;
#pragma unroll
    for (int j = 0; j < 4; ++j) {
        kw[j] = cvtpk((1.0f - c.f[2 * j]) * __expf(c.blast - c.b[2 * j]), (1.0f - c.f[2 * j + 1]) * __expf(c.blast - c.b[2 * j + 1]));
        vw[j] = cvtpk(c.iv[2 * j], c.iv[2 * j + 1]);
    }
    *(LAS u32x4*)(lds + KT_OFF + lane * 128 + ((wave ^ (lane & 7)) << 4)) = kw;
    *(LAS u32x4*)(lds + VT_OFF + lane * 128 + ((wave ^ (lane & 7)) << 4)) = vw;
    if (wave == 0) DEC[(size_t)item * 64 + lane] = __expf(c.blast);
    __syncthreads();
    const int fr = lane & 15, quad = lane >> 4, mt = wave >> 1;
#pragma unroll
    for (int n2 = 0; n2 < 2; ++n2) {
        const int nt = 2 * (wave & 1) + n2;
        f32x4 acc = {0.f, 0.f, 0.f, 0.f};
#pragma unroll
        for (int kk = 0; kk < 2; ++kk)
            acc = __builtin_amdgcn_mfma_f32_16x16x32_bf16(img_frag(lds, VT_OFF, 16 * mt + fr, quad + 4 * kk), img_frag(lds, KT_OFF, 16 * nt + fr, quad + 4 * kk), acc, 0, 0, 0);
        float* o = DS + (size_t)item * 4096 + (16 * mt + 4 * quad) * 64 + 16 * nt + fr;
#pragma unroll
        for (int r = 0; r < 4; ++r) o[r * 64] = acc[r];
    }
}
__device__ __forceinline__ void x2_scan(int gtid, int nthreads, const float* __restrict__ DS, const float* __restrict__ DEC, bf16_t* __restrict__ ST) {
    for (int e = gtid; e < 16 * 1024; e += nthreads) {
        const int bh = e >> 10, q = e & 1023;
        const int d4 = q & 15;
        f32x4 s = {0.f, 0.f, 0.f, 0.f};
#pragma unroll 1
        for (int c0 = 0; c0 < 128; c0 += 8) {
            f32x4 ds[8], de[8];
#pragma unroll
            for (int i = 0; i < 8; ++i) { const size_t it = (size_t)bh * 128 + c0 + i; ds[i] = *(const f32x4*)(DS + it * 4096 + q * 4); de[i] = *(const f32x4*)(DEC + it * 64 + d4 * 4); }
#pragma unroll
            for (int i = 0; i < 8; ++i) { const size_t it = (size_t)bh * 128 + c0 + i;
                uint2 w; w.x = cvtpk(s[0], s[1]); w.y = cvtpk(s[2], s[3]); *(uint2*)(ST + it * 4096 + q * 4) = w;
                s = s * de[i] + ds[i]; }
        }
    }
}
__device__ __forceinline__ void x3_item(LAS unsigned char* lds, int wave, int lane, int item, const bf16_t* __restrict__ proj, const float* __restrict__ lbp, const bf16_t* __restrict__ ST, bf16_t* __restrict__ Y) {
    const int bh = item >> 7, ch = item & 127, b = bh >> 2, h = bh & 3;
    __syncthreads();
    Ch c; stage<true>(lds, wave, lane, proj + ((size_t)b * SEQ + ch * 64) * NIN + h * 64, lbp[h * 64 + lane], c);
    LAS float* bt = (LAS float*)(lds + BT_OFF);
#pragma unroll
    for (int i = 0; i < 8; ++i) bt[(8 * wave + i) * 64 + lane] = c.b[i];
    { u32x4 vw;
#pragma unroll
      for (int j = 0; j < 4; ++j) vw[j] = cvtpk(c.iv[2 * j], c.iv[2 * j + 1]);
      *(LAS u32x4*)(lds + VT_OFF + lane * 128 + ((wave ^ (lane & 7)) << 4)) = vw; }
    __syncthreads();
    {
        const int I = wave >> 1;
        const float cI = bt[(16 * I + 7) * 64 + lane];
        const float rI = (I > 0) ? bt[(16 * I - 1) * 64 + lane] : 0.f;
        float rN[3];
#pragma unroll
        for (int ip = 1; ip < 4; ++ip) rN[ip - 1] = bt[(16 * ip - 1) * 64 + lane];
#pragma unroll
        for (int i = 0; i < 8; ++i) {
            const int t = 8 * wave + i; const float bb = c.b[i], q = c.qv[i], k = 1.0f - c.f[i];
            img_put(lds, QS_OFF, t, lane, q * __expf(bb));
            img_put(lds, QD_OFF, t, lane, q * __expf(bb - cI));
            img_put(lds, QO_OFF, t, lane, q * __expf(bb - rI));
            img_put(lds, KD_OFF, t, lane, k * __expf(cI - bb));
#pragma unroll
            for (int ip = 1; ip < 4; ++ip) if (ip > I) img_put(lds, KO_OFF + (ip - 1) * 8192, t, lane, k * __expf(rN[ip - 1] - bb));
        }
    }
    __syncthreads();
    const int fr = lane & 15, quad = lane >> 4, I = wave >> 1, vh = wave & 1;
    unsigned sc[4][2];
#pragma unroll
    for (int J = 0; J < 4; ++J) {
        sc[J][0] = 0u; sc[J][1] = 0u;
        if (J <= I) {
            f32x4 acc = {0.f, 0.f, 0.f, 0.f};
            const int ko = (J < I) ? KO_OFF + (I - 1) * 8192 : KD_OFF, qo = (J < I) ? QO_OFF : QD_OFF;
#pragma unroll
            for (int kk = 0; kk < 2; ++kk)
                acc = __builtin_amdgcn_mfma_f32_16x16x32_bf16(img_frag(lds, ko, 16 * J + fr, quad + 4 * kk), img_frag(lds, qo, 16 * I + fr, quad + 4 * kk), acc, 0, 0, 0);
            if (J == I) {
#pragma unroll
                for (int r = 0; r < 4; ++r) if (4 * quad + r > fr) acc[r] = 0.f;
            }
            sc[J][0] = cvtpk(acc[0], acc[1]); sc[J][1] = cvtpk(acc[2], acc[3]);
        }
    }
    const bf16_t* stp = ST + (size_t)item * 4096;
    const size_t orow = (size_t)b * SEQ + ch * 64 + 16 * I + fr;
#pragma unroll
    for (int m2 = 0; m2 < 2; ++m2) {
        const int mt = 2 * vh + m2, v = 16 * mt + fr;
        f32x4 acc = {0.f, 0.f, 0.f, 0.f};
#pragma unroll
        for (int ks = 0; ks < 2; ++ks) {
            if (2 * ks <= I) {
                u32x4 bw, aw;
                bw[0] = sc[2 * ks][0]; bw[1] = sc[2 * ks][1]; bw[2] = sc[2 * ks + 1][0]; bw[3] = sc[2 * ks + 1][1];
                const LAS unsigned char* vr = lds + VT_OFF + v * 128;
                const u32x2 a0 = *(const LAS u32x2*)(vr + (((4 * ks + (quad >> 1)) ^ (v & 7)) << 4) + (quad & 1) * 8);
                u32x2 a1 = {0u, 0u};
                if (2 * ks + 1 <= I) a1 = *(const LAS u32x2*)(vr + (((4 * ks + 2 + (quad >> 1)) ^ (v & 7)) << 4) + (quad & 1) * 8);
                aw[0] = a0.x; aw[1] = a0.y; aw[2] = a1.x; aw[3] = a1.y;
                acc = __builtin_amdgcn_mfma_f32_16x16x32_bf16(__builtin_bit_cast(bf16x8, aw), __builtin_bit_cast(bf16x8, bw), acc, 0, 0, 0);
            }
        }
#pragma unroll
        for (int kk = 0; kk < 2; ++kk) {
            const bf16x8 sa = *(const bf16x8*)(stp + v * 64 + 8 * quad + 32 * kk);
            acc = __builtin_amdgcn_mfma_f32_16x16x32_bf16(sa, img_frag(lds, QS_OFF, 16 * I + fr, quad + 4 * kk), acc, 0, 0, 0);
        }
        uint2 w; w.x = cvtpk(acc[0], acc[1]); w.y = cvtpk(acc[2], acc[3]);
        *(uint2*)(Y + orow * DM + 512 + h * 64 + 16 * mt + 4 * quad) = w;
    }
}
}

namespace s5 {
typedef short bf16x8 __attribute__((ext_vector_type(8)));
typedef float f32x4 __attribute__((ext_vector_type(4)));
__device__ __forceinline__ void cpow(double dt, double ar, double ai, int n, double& pr, double& pi) { const double mg = exp(n * dt * ar); double sn, cs; sincos_d(n * dt * ai, sn, cs); pr = mg * cs; pi = mg * sn; }
__device__ __forceinline__ void zfac(double dt, double ar, double ai, double& zr, double& zi) {
    double are, aim; cpow(dt, ar, ai, 1, are, aim);
    const double nr = are - 1.0, ni = aim, den = ar * ar + ai * ai; zr = (nr * ar + ni * ai) / den; zi = (ni * ar - nr * ai) / den;
}
__device__ __forceinline__ void tables_thread(int e, const float* a_re, const float* a_im, const float* log_dt, const float* b_re, const float* b_im, const float* c_re, const float* c_im,
                                              bf16_t* W1, bf16_t* W3, float* a64) {
    const int st = e & 63, p = (e >> 6) & 63, lg = e >> 12;
    const int id = lg * 64 + p;
    const double dt = exp((double)log_dt[lg]), ar = a_re[id], ai = a_im[id];
    double zr, zi; zfac(dt, ar, ai, zr, zi);
    { double pr, pi; cpow(dt, ar, ai, 63 - st, pr, pi);
      unsigned wr[8], wi[8];
#pragma unroll
      for (int c2 = 0; c2 < 8; ++c2) {
          float vr[2], vi[2];
#pragma unroll
          for (int q = 0; q < 2; ++q) { const int c = 2 * c2 + q; const double br = b_re[id * 16 + c], bi = b_im[id * 16 + c];
              const double bbr = zr * br - zi * bi, bbi = zr * bi + zi * br; vr[q] = (float)(pr * bbr - pi * bbi); vi[q] = (float)(pr * bbi + pi * bbr); }
          wr[c2] = pk2(vr[0], vr[1]); wi[c2] = pk2(vi[0], vi[1]);
      }
      u32x4* o0 = (u32x4*)(W1 + ((size_t)(lg * 128 + 2 * p) * 1024 + st * 16)); u32x4* o1 = (u32x4*)(W1 + ((size_t)(lg * 128 + 2 * p + 1) * 1024 + st * 16));
      o0[0] = (u32x4){wr[0], wr[1], wr[2], wr[3]}; o0[1] = (u32x4){wr[4], wr[5], wr[6], wr[7]};
      o1[0] = (u32x4){wi[0], wi[1], wi[2], wi[3]}; o1[1] = (u32x4){wi[4], wi[5], wi[6], wi[7]}; }
    { double pr, pi; cpow(dt, ar, ai, st + 1, pr, pi);
      for (int c = 0; c < 16; ++c) { const double cr = c_re[(lg * 16 + c) * 64 + p], ci = c_im[(lg * 16 + c) * 64 + p];
          *(unsigned*)(W3 + ((size_t)(lg * 1024 + st * 16 + c) * 128 + 2 * p)) = pk2((float)(cr * pr - ci * pi), -(float)(cr * pi + ci * pr)); }
      if (st == 63) { a64[id * 2] = (float)pr; a64[id * 2 + 1] = (float)pi; } }
}
__device__ __forceinline__ void kmat_item(LAS float* scr, int tid, int item, const float* a_re, const float* a_im, const float* log_dt, const float* b_re, const float* b_im, const float* c_re, const float* c_im, bf16_t* KM) {
    const int tau = item & 63, lg = item >> 6;
    __syncthreads();
    { const int p = tid >> 3, c0 = (tid & 7) * 2, id = lg * 64 + p;
      const double dt = exp((double)log_dt[lg]), ar = a_re[id], ai = a_im[id];
      double zr, zi, pr, pi; zfac(dt, ar, ai, zr, zi); cpow(dt, ar, ai, tau, pr, pi);
#pragma unroll
      for (int q = 0; q < 2; ++q) { const int c = c0 + q; const double br = b_re[id * 16 + c], bi = b_im[id * 16 + c];
          const double bbr = zr * br - zi * bi, bbi = zr * bi + zi * br;
          scr[(p * 16 + c) * 2] = (float)(pr * bbr - pi * bbi); scr[(p * 16 + c) * 2 + 1] = (float)(pr * bbi + pi * bbr); } }
    __syncthreads();
    if (tid < 256) { const int c = tid >> 4, cp = tid & 15; float s = 0.f;
        for (int p = 0; p < 64; ++p) s += c_re[(lg * 16 + c) * 64 + p] * scr[(p * 16 + cp) * 2] - c_im[(lg * 16 + c) * 64 + p] * scr[(p * 16 + cp) * 2 + 1];
        KM[((size_t)(lg * 64 + tau) * 16 + c) * 16 + cp] = f2bf(s); }
}
__device__ __forceinline__ size_t chunk_row(int cid) { return (size_t)(cid >> 7) * SEQ + (size_t)(cid & 127) * 64; }
__device__ __forceinline__ void x1_wave(int lane, int g, int mt, int lg, const bf16_t* __restrict__ proj, const bf16_t* __restrict__ W1, float* __restrict__ HEND) {
    const int fr = lane & 15, quad = lane >> 4;
    const bf16_t* ap = proj + (chunk_row(mt * 16 + fr) + (quad >> 1)) * NIN + COL_U + g * 16 + 8 * (quad & 1);
    const bf16_t* bp = W1 + ((size_t)(lg * 128 + fr) * 1024 + 8 * quad);
    f32x4 acc[8];
#pragma unroll
    for (int n = 0; n < 8; ++n) acc[n] = (f32x4){0.f, 0.f, 0.f, 0.f};
#pragma unroll 2
    for (int kk = 0; kk < 32; ++kk) {
        const bf16x8 a = *(const bf16x8*)(ap + (size_t)(2 * kk) * NIN);
#pragma unroll
        for (int n = 0; n < 8; ++n) acc[n] = __builtin_amdgcn_mfma_f32_16x16x32_bf16(a, *(const bf16x8*)(bp + (size_t)n * 16 * 1024 + 32 * kk), acc[n], 0, 0, 0);
    }
#pragma unroll
    for (int n = 0; n < 8; ++n)
#pragma unroll
        for (int r = 0; r < 4; ++r) HEND[((size_t)(mt * 16 + 4 * quad + r) * 16 + g) * 128 + 16 * n + fr] = acc[n][r];
}
__device__ __forceinline__ void x2_scan(int e, const float* __restrict__ HEND, const float* __restrict__ a64, bf16_t* __restrict__ HST, int layer) {
    const int p = e & 63, g = (e >> 6) & 15, b = e >> 10;
    const float ar = a64[((layer * 16 + g) * 64 + p) * 2], ai = a64[((layer * 16 + g) * 64 + p) * 2 + 1];
    float hr = 0.f, hi = 0.f;
#pragma unroll 1
    for (int c0 = 0; c0 < 128; c0 += 16) {
        float2 he[16];
#pragma unroll
        for (int i = 0; i < 16; ++i) he[i] = *(const float2*)(HEND + ((size_t)(b * 128 + c0 + i) * 16 + g) * 128 + 2 * p);
#pragma unroll
        for (int i = 0; i < 16; ++i) {
            *(unsigned*)(HST + ((size_t)(b * 128 + c0 + i) * 16 + g) * 128 + 2 * p) = cvtpk_s(hr, hi);
            const float nr = ar * hr - ai * hi + he[i].x, ni = ar * hi + ai * hr + he[i].y; hr = nr; hi = ni;
        }
    }
}
__device__ __forceinline__ void x3_item(LAS unsigned char* lds, int wave, int lane, int item, int layer, const bf16_t* __restrict__ proj, const bf16_t* __restrict__ KM, const bf16_t* __restrict__ W3,
                                        const bf16_t* __restrict__ HST, const float* __restrict__ dskip, bf16_t* __restrict__ ybpre) {
    const int g = item & 15, mtp = item >> 4, lg = layer * 16 + g;
    const int tid = wave * 64 + lane;
    __syncthreads();
    { const u32x4* src = (const u32x4*)(KM + (size_t)lg * 64 * 256);
#pragma unroll
      for (int i = 0; i < 4; ++i) ((LAS u32x4*)lds)[tid + 512 * i] = src[tid + 512 * i]; }
    __syncthreads();
    const int fr = lane & 15, quad = lane >> 4, mt = 2 * mtp + (wave >> 2), tr = wave & 3;
    const size_t crow = chunk_row(mt * 16 + fr);
    const bf16_t* ap = proj + (crow + (quad >> 1)) * NIN + COL_U + g * 16 + 8 * (quad & 1);
    f32x4 acc[16];
#pragma unroll
    for (int i = 0; i < 16; ++i) acc[i] = (f32x4){0.f, 0.f, 0.f, 0.f};
    const int kkmax = 8 * tr + 7;
    const int lbase = (fr * 16 + 8 * (quad & 1)) * 2;
#pragma unroll 1
    for (int kk = 0; kk <= kkmax; ++kk) {
        const bf16x8 a = *(const bf16x8*)(ap + (size_t)(2 * kk) * NIN);
#pragma unroll
        for (int ti = 0; ti < 16; ++ti) {
            const int t = 16 * tr + ti;
            if (2 * kk <= t) {
                const int tau = t - 2 * kk - (quad >> 1);
                bf16x8 bq = *(const LAS bf16x8*)(lds + max(tau, 0) * 512 + lbase);
                if (tau < 0) bq = (bf16x8){0, 0, 0, 0, 0, 0, 0, 0};
                acc[ti] = __builtin_amdgcn_mfma_f32_16x16x32_bf16(a, bq, acc[ti], 0, 0, 0);
            }
        }
    }
    {
        const bf16_t* hp = HST + ((size_t)(mt * 16 + fr) * 16 + g) * 128 + 8 * quad;
        const bf16_t* wp = W3 + ((size_t)(lg * 1024 + 16 * tr * 16 + fr) * 128 + 8 * quad);
#pragma unroll
        for (int kk = 0; kk < 4; ++kk) {
            const bf16x8 a = *(const bf16x8*)(hp + 32 * kk);
#pragma unroll
            for (int ti = 0; ti < 16; ++ti) acc[ti] = __builtin_amdgcn_mfma_f32_16x16x32_bf16(a, *(const bf16x8*)(wp + (size_t)ti * 16 * 128 + 32 * kk), acc[ti], 0, 0, 0);
        }
    }
    const float dsk = dskip[layer * 256 + g * 16 + fr];
#pragma unroll
    for (int ti = 0; ti < 16; ++ti)
#pragma unroll
        for (int r = 0; r < 4; ++r) {
            const size_t row = chunk_row(mt * 16 + 4 * quad + r) + 16 * tr + ti;
            const float u = bf2f(proj[row * NIN + COL_U + g * 16 + fr]);
            const float y = acc[ti][r] + dsk * u;
            const float uu = 1.5957691216057308f * (y + 0.044715f * y * y * y);
            ybpre[row * 256 + g * 16 + fr] = f2bf(y / (1.0f + __expf(-uu)));
        }
}
}

constexpr int NWAVES = 8;
constexpr int RING_BYTES = 131072, MISC_OFF = RING_BYTES + 320, LDS_BYTES = 147456;
typedef unsigned v4u __attribute__((ext_vector_type(4)));
#define LDS_WAIT() asm volatile("s_waitcnt lgkmcnt(0)" ::: "memory")

struct Args { const float* in[18]; float* out; unsigned char* ws; };

__device__ __forceinline__ void p0_transpose_item(const float* W, int K, int N, bf16_t* WT, LAS float* scr, int item, int lane) {
    const int nblk = N / 32, kb = item / nblk, nb = item % nblk, k0 = 64 * kb, n0 = 32 * nb;
#pragma unroll 8
    for (int i = 0; i < 32; ++i) { const int kk = 2 * i + (lane >> 5); scr[kk * 33 + (lane & 31)] = W[(size_t)(k0 + kk) * N + n0 + (lane & 31)]; }
    LDS_WAIT();
    const int c = lane & 7;
#pragma unroll
    for (int j = 0; j < 4; ++j) { const int n = (lane >> 3) + 8 * j; const LAS float* s = scr + (8 * c) * 33 + n;
        v4u o; o.x = pk2(s[0 * 33], s[1 * 33]); o.y = pk2(s[2 * 33], s[3 * 33]); o.z = pk2(s[4 * 33], s[5 * 33]); o.w = pk2(s[6 * 33], s[7 * 33]);
        *(v4u*)(WT + (size_t)(n0 + n) * K + k0 + 8 * c) = o; }
    LDS_WAIT();
}
__device__ __forceinline__ void prep_small(int id, const float* a_re, const float* a_im, const float* log_dt, const float* b_re, const float* b_im, const float* hl, float* sm) {
    if (id < DEPTH * 16 * 64) {
        const int lg = id >> 6;
        const double dt = exp((double)log_dt[lg]), ar = a_re[id], ai = a_im[id];
        const double mag = exp(dt * ar); double sn, cs; sincos_d(dt * ai, sn, cs);
        const double are = mag * cs, aim = mag * sn, nr = are - 1.0, ni = aim, den = ar * ar + ai * ai;
        const double zr = (nr * ar + ni * ai) / den, zi = (ni * ar - nr * ai) / den;
        sm[SM_ABAR + id * 2] = (float)are; sm[SM_ABAR + id * 2 + 1] = (float)aim;
        for (int c = 0; c < 16; ++c) {
            const double br = b_re[id * 16 + c], bi = b_im[id * 16 + c];
            sm[SM_BBAR + (id * 16 + c) * 2] = (float)(zr * br - zi * bi);
            sm[SM_BBAR + (id * 16 + c) * 2 + 1] = (float)(zr * bi + zi * br);
        }
    }
    if (id < 256) {
        const float h0 = hl[id], h1 = hl[256 + id], mx = fmaxf(h0, h1), e0 = expf(h0 - mx), e1 = expf(h1 - mx);
        sm[SM_LB + id] = 0.0f; sm[SM_LB + 256 + id] = e1 / (e0 + e1);
    }
}

__device__ __forceinline__ float dot64(const float* qs, const bf16_t* krow) {
    float s = 0.f;
#pragma unroll
    for (int i = 0; i < 8; ++i) {
        const u32x4 v = *(const u32x4*)(krow + i * 8);
#pragma unroll
        for (int j = 0; j < 4; ++j) { s = fmaf(qs[i * 8 + 2 * j], __uint_as_float(v[j] << 16), s); s = fmaf(qs[i * 8 + 2 * j + 1], __uint_as_float(v[j] & 0xffff0000u), s); }
    }
    return s;
}
__device__ __forceinline__ void moba_simple(int gid, int lane, float* scr, const bf16_t* __restrict__ proj, const float* __restrict__ kmean, const float* __restrict__ rel_bias, bf16_t* __restrict__ Y) {
    const int s = gid % SEQ, h = (gid / SEQ) & 3, b = gid / (SEQ * 4);
    float* qs = scr; float* ps = scr + 64;
    const size_t row = (size_t)b * SEQ + s;
    WSYNC();
    qs[lane] = bf2f(proj[row * NIN + COL_QA + h * 64 + lane]);
    WSYNC();
    const int own = s >> 8;
    float g = -INFINITY;
    if (lane < own) { const float* km = kmean + ((b * 4 + h) * 32 + lane) * 64; float a = 0.f; for (int d = 0; d < 64; ++d) a = fmaf(qs[d], km[d], a); g = a; }
    int blk[4]; bool val[4];
#pragma unroll
    for (int t = 0; t < 3; ++t) {
        const float mx = wave_max(g);
        val[t] = mx > -INFINITY;
        const unsigned long long mk = __ballot(g == mx);
        const int idx = val[t] ? (__ffsll((long long)mk) - 1) : own;
        blk[t] = idx;
        if (val[t] && lane == idx) g = -INFINITY;
    }
    blk[3] = own; val[3] = true;
    float lmax = NEGF;
#pragma unroll
    for (int t = 0; t < 4; ++t) {
        for (int i = 0; i < 4; ++i) {
            const int kk = lane + 64 * i, kpos = blk[t] * 256 + kk;
            const bool ok = (t < 3) ? val[t] : (kpos <= s);
            float lg = NEGF;
            if (ok) lg = dot64(qs, proj + ((size_t)b * SEQ + kpos) * NIN + COL_KA + h * 64) * 0.125f + rel_bias[t5_bucket(s - kpos) * 8 + h];
            ps[t * 256 + kk] = lg; lmax = fmaxf(lmax, lg);
        }
    }
    const float mx = wave_max(lmax);
    float lsum = 0.f;
    for (int i = 0; i < 16; ++i) { const float p = expf(ps[lane + 64 * i] - mx); ps[lane + 64 * i] = p; lsum += p; }
    const float tot = wave_sum(lsum);
    WSYNC();
    float acc = 0.f;
#pragma unroll
    for (int t = 0; t < 4; ++t) {
        if (!val[t]) continue;
        const bf16_t* vp = proj + ((size_t)b * SEQ + blk[t] * 256) * NIN + COL_VA + h * 64 + lane;
        const int nk = (t < 3) ? 256 : (s - own * 256 + 1);
        for (int kk = 0; kk < nk; ++kk) acc = fmaf(ps[t * 256 + kk], bf2f(vp[(size_t)kk * NIN]), acc);
    }
    Y[row * DM + h * 64 + lane] = f2bf(acc / tot);
}
__device__ __forceinline__ void dilated_simple(int gid, int lane, float* scr, const bf16_t* __restrict__ proj, const float* __restrict__ rel_bias, bf16_t* __restrict__ Y) {
    const int s = gid % SEQ, h = (gid / SEQ) & 3, b = gid / (SEQ * 4);
    float* qs = scr; float* ps = scr + 64;
    const size_t row = (size_t)b * SEQ + s;
    WSYNC();
    qs[lane] = bf2f(proj[row * NIN + COL_QD + h * 64 + lane]);
    WSYNC();
    float lse[3], ssum[3];
#pragma unroll
    for (int pi = 0; pi < 3; ++pi) {
        const int dil = (pi == 0) ? 1 : (pi == 1) ? 4 : 16;
        float lmax = NEGF;
        for (int i = 0; i < 3; ++i) {
            const int j = lane + 64 * i, kpos = s - j * dil;
            float lg = NEGF;
            if (j <= 128 && kpos >= 0) lg = dot64(qs, proj + ((size_t)b * SEQ + kpos) * NIN + COL_KD + h * 64) * 0.125f + rel_bias[t5_bucket(j * dil) * 8 + 4 + h];
            ps[pi * 192 + j] = lg; lmax = fmaxf(lmax, lg);
        }
        const float mx = wave_max(lmax);
        float lsum = 0.f;
        for (int i = 0; i < 3; ++i) { const int j = lane + 64 * i; const float p = expf(ps[pi * 192 + j] - mx); ps[pi * 192 + j] = p; lsum += p; }
        ssum[pi] = wave_sum(lsum);
        lse[pi] = mx + logf(ssum[pi]);
    }
    WSYNC();
    const float lm = fmaxf(lse[0], fmaxf(lse[1], lse[2]));
    const float w0 = expf(lse[0] - lm), w1 = expf(lse[1] - lm), w2 = expf(lse[2] - lm), wt = w0 + w1 + w2;
    const float wgt[3] = {w0 / wt, w1 / wt, w2 / wt};
    float out = 0.f;
#pragma unroll
    for (int pi = 0; pi < 3; ++pi) {
        const int dil = (pi == 0) ? 1 : (pi == 1) ? 4 : 16;
        float acc = 0.f;
        for (int j = 0; j <= 128; ++j) {
            const int kpos = s - j * dil; if (kpos < 0) break;
            acc = fmaf(ps[pi * 192 + j], bf2f(proj[((size_t)b * SEQ + kpos) * NIN + COL_VD + h * 64 + lane]), acc);
        }
        out += wgt[pi] * acc / ssum[pi];
    }
    Y[row * DM + 768 + h * 64 + lane] = f2bf(out);
}
__device__ __forceinline__ void s5_simple(int b, int g, int lane, float* scr, const bf16_t* __restrict__ proj, const float* __restrict__ sm, const float* __restrict__ c_re, const float* __restrict__ c_im,
                                          const float* __restrict__ dskip, bf16_t* __restrict__ ybpre, int layer) {
    float* hs = scr; float* us = scr + 8192; float* cs = scr + 8192 + 1024;
    const int pid = (layer * 16 + g) * 64 + lane;
    const float are = sm[SM_ABAR + pid * 2], aim = sm[SM_ABAR + pid * 2 + 1];
    float bbr[16], bbi[16];
#pragma unroll
    for (int c = 0; c < 16; ++c) { bbr[c] = sm[SM_BBAR + (pid * 16 + c) * 2]; bbi[c] = sm[SM_BBAR + (pid * 16 + c) * 2 + 1]; }
    for (int c = 0; c < 16; ++c) { cs[(c * 65 + lane) * 2] = c_re[((layer * 16 + g) * 16 + c) * 64 + lane]; cs[(c * 65 + lane) * 2 + 1] = c_im[((layer * 16 + g) * 16 + c) * 64 + lane]; }
    const int oc = lane & 15, otq = lane >> 4;
    const float dsk = dskip[layer * 256 + g * 16 + oc];
    float hr = 0.f, hi = 0.f;
#pragma unroll 1
    for (int t0 = 0; t0 < SEQ; t0 += 64) {
        WSYNC();
#pragma unroll 1
        for (int e = lane; e < 1024; e += 64) { const int t = e >> 4, c = e & 15; us[t * 16 + c] = bf2f(proj[((size_t)b * SEQ + t0 + t) * NIN + COL_U + g * 16 + c]); }
        WSYNC();
#pragma unroll 1
        for (int t = 0; t < 64; ++t) {
            float xr = 0.f, xi = 0.f;
#pragma unroll
            for (int c = 0; c < 16; ++c) { const float u = us[t * 16 + c]; xr = fmaf(bbr[c], u, xr); xi = fmaf(bbi[c], u, xi); }
            const float nr = are * hr - aim * hi + xr, ni = are * hi + aim * hr + xi;
            hr = nr; hi = ni;
            hs[(t * 64 + lane) * 2] = hr; hs[(t * 64 + lane) * 2 + 1] = hi;
        }
        WSYNC();
#pragma unroll 1
        for (int i = 0; i < 16; ++i) {
            const int t = otq + 4 * i;
            float y = 0.f;
#pragma unroll 4
            for (int p = 0; p < 64; ++p) y += hs[(t * 64 + p) * 2] * cs[(oc * 65 + p) * 2] - hs[(t * 64 + p) * 2 + 1] * cs[(oc * 65 + p) * 2 + 1];
            y += dsk * us[t * 16 + oc];
            ybpre[((size_t)b * SEQ + t0 + t) * 256 + g * 16 + oc] = f2bf(gelu_tanh(y));
        }
    }
}
__device__ __forceinline__ void hgrn_simple(int b, int h, int lane, float* scr, const bf16_t* __restrict__ proj, const float* __restrict__ sm, bf16_t* __restrict__ Y, int layer) {
    float* fs = scr; float* qs = scr + 4096; float* is = scr + 8192;
    const float lb = sm[SM_LB + layer * 256 + h * 64 + lane];
    float S[64];
#pragma unroll
    for (int d = 0; d < 64; ++d) S[d] = 0.f;
    for (int t0 = 0; t0 < SEQ; t0 += 64) {
        WSYNC();
        for (int t = 0; t < 64; ++t) {
            const bf16_t* r = proj + ((size_t)b * SEQ + t0 + t) * NIN + h * 64 + lane;
            const float qv = bf2f(r[COL_QC]), fv = bf2f(r[COL_FC]), iv = bf2f(r[COL_IC]);
            fs[t * 64 + lane] = lb + (1.0f - lb) * sigmoidf_(fv); qs[t * 64 + lane] = siluf_(qv) * 0.125f; is[t * 64 + lane] = iv;
        }
        WSYNC();
        for (int t = 0; t < 64; ++t) {
            const float iv = is[t * 64 + lane];
            float o = 0.f;
#pragma unroll
            for (int d = 0; d < 64; ++d) { const float f = fs[t * 64 + d]; S[d] = fmaf(f, S[d] - iv, iv); o = fmaf(qs[t * 64 + d], S[d], o); }
            Y[((size_t)b * SEQ + t0 + t) * DM + 512 + h * 64 + lane] = f2bf(o);
        }
    }
}
__device__ __forceinline__ void unpack16(const bf16_t* p, float* v) {
    const u32x4 y0 = *(const u32x4*)p, y1 = *(const u32x4*)(p + 8);
#pragma unroll
    for (int j = 0; j < 4; ++j) { v[2 * j] = __uint_as_float(y0[j] << 16); v[2 * j + 1] = __uint_as_float(y0[j] & 0xffff0000u); v[8 + 2 * j] = __uint_as_float(y1[j] << 16); v[8 + 2 * j + 1] = __uint_as_float(y1[j] & 0xffff0000u); }
}
__device__ __forceinline__ void combine_row(size_t row, int lane, bf16_t* __restrict__ Y, const bf16_t* __restrict__ proj, const float* __restrict__ gain, const bf16_t* __restrict__ PO, const float* __restrict__ PL) {
    bf16_t* yp = Y + row * DM + lane * 16; const bf16_t* gp = proj + row * NIN + COL_G + lane * 16;
    float v[16], gt[16]; float ss = 0.f;
    unpack16(gp, gt);
    if (lane < 48) unpack16(yp, v);
    else {
        const int h = (lane - 48) >> 2;
        const float l0 = PL[(0 * (size_t)M + row) * 4 + h], l1 = PL[(1 * (size_t)M + row) * 4 + h], l2 = PL[(2 * (size_t)M + row) * 4 + h];
        const float lm = fmaxf(l0, fmaxf(l1, l2)), w0 = __expf(l0 - lm), w1 = __expf(l1 - lm), w2 = __expf(l2 - lm), wi = 1.0f / (w0 + w1 + w2);
        float a0[16], a1[16], a2[16];
        unpack16(PO + (0 * (size_t)M + row) * 256 + (lane - 48) * 16, a0); unpack16(PO + (1 * (size_t)M + row) * 256 + (lane - 48) * 16, a1); unpack16(PO + (2 * (size_t)M + row) * 256 + (lane - 48) * 16, a2);
#pragma unroll
        for (int i = 0; i < 16; ++i) v[i] = (w0 * a0[i] + w1 * a1[i] + w2 * a2[i]) * wi;
    }
#pragma unroll
    for (int i = 0; i < 16; ++i) ss = fmaf(v[i], v[i], ss);
    ss += __shfl_xor(ss, 1); ss += __shfl_xor(ss, 2);
    const float r = rsqrtf(ss * (1.0f / 64.0f) + RMS_EPS);
    float o[16];
#pragma unroll
    for (int i = 0; i < 16; ++i) o[i] = v[i] * r * gain[lane * 16 + i] * siluf_(gt[i]);
    u32x4 w0, w1;
    w0.x = pk2(o[0], o[1]); w0.y = pk2(o[2], o[3]); w0.z = pk2(o[4], o[5]); w0.w = pk2(o[6], o[7]);
    w1.x = pk2(o[8], o[9]); w1.y = pk2(o[10], o[11]); w1.z = pk2(o[12], o[13]); w1.w = pk2(o[14], o[15]);
    *(u32x4*)yp = w0; *(u32x4*)(yp + 8) = w1;
}
__device__ __forceinline__ void layernorm_row(size_t row, int lane, float* __restrict__ z, bf16_t* __restrict__ xb, const float* __restrict__ lg, const float* __restrict__ lbias) {
    float4* zp = (float4*)(z + row * DM) + lane;
    float4 v[4]; float s = 0.f;
#pragma unroll
    for (int j = 0; j < 4; ++j) { v[j] = zp[64 * j]; s += (v[j].x + v[j].y) + (v[j].z + v[j].w); }
    const float mean = wave_sum(s) * (1.0f / DM); float q = 0.f;
#pragma unroll
    for (int j = 0; j < 4; ++j) { v[j].x -= mean; v[j].y -= mean; v[j].z -= mean; v[j].w -= mean; q += (v[j].x * v[j].x + v[j].y * v[j].y) + (v[j].z * v[j].z + v[j].w * v[j].w); }
    const float rstd = rsqrtf(wave_sum(q) * (1.0f / DM) + LN_EPS);
#pragma unroll
    for (int j = 0; j < 4; ++j) {
        const float4 gg = ((const float4*)lg)[lane + 64 * j], bb = ((const float4*)lbias)[lane + 64 * j];
        float4 o; o.x = v[j].x * rstd * gg.x + bb.x; o.y = v[j].y * rstd * gg.y + bb.y; o.z = v[j].z * rstd * gg.z + bb.z; o.w = v[j].w * rstd * gg.w + bb.w;
        zp[64 * j] = o;
        uint2 ob; ob.x = pk2(o.x, o.y); ob.y = pk2(o.z, o.w);
        ((uint2*)(xb + row * DM))[lane + 64 * j] = ob;
    }
}


#define OPQS(x) asm volatile("" : "+s"(x))
#define OPQ(x) asm volatile("" : "+v"(x))
__global__ void __launch_bounds__(NWAVES * 64, 2) mega_fwd(Args args) {
    extern __shared__ __attribute__((aligned(16))) unsigned char lds[];
#define LANE_ID() ({ unsigned z_ = 0u; asm volatile("" : "+v"(z_)); (int)__builtin_amdgcn_mbcnt_hi(~0u, __builtin_amdgcn_mbcnt_lo(~0u, z_)); })
#define TID_() (wave * 64 + LANE_ID())
#define tid_ TID_()
#define lane_ LANE_ID()
    const int wave = __builtin_amdgcn_readfirstlane((int)threadIdx.x >> 6);
    const int G = gridDim.x, bx = blockIdx.x, bx_ = bx;
    LAS unsigned char* ldsl = (LAS unsigned char*)lds;
    volatile LAS unsigned* MISC = (volatile LAS unsigned*)(ldsl + MISC_OFF);
    for (int u = tid_; u < (LDS_BYTES - RING_BYTES) / 4; u += NWAVES * 64) ((LAS unsigned*)(ldsl + RING_BYTES))[u] = 0u;
    __syncthreads();
    const XcdBarrier bar = xcd_barrier_post((unsigned*)(args.ws + WS_CTL) + CW_BAR, MISC + 8);
    const int gw = bx * NWAVES + wave, NGW = G * NWAVES;
#define GRID_BAR() do { XcdBarrier b_ = bar; unsigned x_ = b_.x; asm volatile("" : "+s"(x_)); b_.x = x_; xcd_barrier(b_); } while (0)

    {
        const Args* A = &args; unsigned char* ws = A->ws;
        int lane = lane_, tid = tid_; OPQ(lane); OPQ(tid);
        const float* x = A->in[0]; const float* w_in = A->in[1]; const float* glu_w = A->in[11]; const float* w_out = A->in[15];
        bf16_t* wtin = (bf16_t*)(ws + WS_WTIN); bf16_t* wtout = (bf16_t*)(ws + WS_WTOUT); bf16_t* gluwt = (bf16_t*)(ws + WS_GLUWT); bf16_t* xb = (bf16_t*)(ws + WS_XB);
        LAS float* scr = (LAS float*)(ldsl + wave * 16384);
        constexpr int I_IN = (DM / 64) * (NIN / 32), I_OUT = (DM / 64) * (DM / 32), I_GLU = (BW / 64) * (BW / 32), I_L = I_IN + I_OUT + I_GLU;
        for (int it = gw; it < DEPTH * I_L; it += NGW) {
            const int l = it / I_L; int r = it % I_L;
            if (r < I_IN) { p0_transpose_item(w_in + (size_t)l * DM * NIN, DM, NIN, wtin + (size_t)l * NIN * DM, scr, r, lane); continue; } r -= I_IN;
            if (r < I_OUT) { p0_transpose_item(w_out + (size_t)l * DM * DM, DM, DM, wtout + (size_t)l * DM * DM, scr, r, lane); continue; } r -= I_OUT;
            p0_transpose_item(glu_w + (size_t)l * BW * BW, BW, BW, gluwt + (size_t)l * BW * BW, scr, r, lane);
        }
        for (size_t i = (size_t)bx * 512 + tid; i < (size_t)M * DM / 4; i += (size_t)G * 512) {
            const float4 v = ((const float4*)x)[i]; uint2 o; o.x = pk2(v.x, v.y); o.y = pk2(v.z, v.w); ((uint2*)xb)[i] = o;
        }
        if (bx < 8 && tid < 256) prep_small(bx * 256 + tid, A->in[3], A->in[4], A->in[5], A->in[6], A->in[7], A->in[13], (float*)(ws + WS_SMALL));
        for (int e = bx * 512 + tid; e < 2 * 16 * 64 * 64; e += G * 512)
            s5::tables_thread(e, A->in[3], A->in[4], A->in[5], A->in[6], A->in[7], A->in[8], A->in[9], (bf16_t*)(ws + WS_W1), (bf16_t*)(ws + WS_W3), (float*)(ws + WS_SMALL) + SM_A64);
        for (int it = bx; it < 2 * 16 * 64; it += G)
            s5::kmat_item((LAS float*)ldsl, tid, it, A->in[3], A->in[4], A->in[5], A->in[6], A->in[7], A->in[8], A->in[9], (bf16_t*)(ws + WS_KM));
    }
    GRID_BAR();

#pragma unroll 1
    for (int l = 0; l < DEPTH; ++l) {
        {
            const Args* A = &args; unsigned char* ws = A->ws;
            pg8::Gemm g{(const bf16_t*)(ws + WS_XB), (const bf16_t*)(ws + WS_WTIN) + (size_t)l * NIN * DM, M, NIN, DM}; int tidg = tid_, bxg = bx; OPQ(tidg); OPQS(bxg); pg8::StaticOrder S; S.init(M, NIN, G, bxg);
            pg8::EpiStoreBf16 E{(bf16_t*)(ws + WS_PROJ), NIN};
            pg8::gemm_phase<pg8::EpiStoreBf16, pg8::StaticOrder, true, true>(ldsl, g, S, E, tidg);
        }
        GRID_BAR();
        {
            const Args* A = &args; unsigned char* ws = A->ws;
            const bf16_t* proj = (const bf16_t*)(ws + WS_PROJ); float* kmean = (float*)(ws + WS_KMEAN);
            int lane = lane_; OPQ(lane); const int tid = wave * 64 + lane;
            const float* lbp = (const float*)(ws + WS_SMALL) + SM_LB + l * 256;
            if (bx < 64) { const int wi = bx * 8 + wave; s5::x1_wave(lane, wi & 15, wi >> 4, l * 16 + (wi & 15), proj, (const bf16_t*)(ws + WS_W1), (float*)(ws + WS_HEND)); }
            for (int it = bx; it < 2048 + BATCH * 32; it += G) {
                if (it < 2048) { hg::x1_item(ldsl, wave, lane, it, proj, lbp, (float*)(ws + WS_DS), (float*)(ws + WS_DEC)); continue; }
                const int kt = it - 2048;
                if (tid < 256) {
                    const int b = kt >> 5, n = kt & 31, c = tid;
                    const bf16_t* p = proj + (size_t)(b * SEQ + n * 256) * NIN + COL_KA + c;
                    float s = 0.f;
                    for (int r = 0; r < 256; ++r) s += bf2f(p[(size_t)r * NIN]);
                    kmean[((b * 4 + (c >> 6)) * 32 + n) * 64 + (c & 63)] = s * (1.0f / 256.0f);
                }
            }
        }
        GRID_BAR();
        {
            const Args* A = &args; unsigned char* ws = A->ws;
            const bf16_t* proj = (const bf16_t*)(ws + WS_PROJ); bf16_t* Y = (bf16_t*)(ws + WS_Y); const float* sm = (const float*)(ws + WS_SMALL);
            int lane = lane_; OPQ(lane);
            int bx = bx_; OPQS(bx);
            {
                const int tid = wave * 64 + lane;
                if (bx < 32) hg::x2_scan(bx * 512 + tid, 32 * 512, (const float*)(ws + WS_DS), (const float*)(ws + WS_DEC), (bf16_t*)(ws + WS_ST));
                else if (bx < 40) s5::x2_scan((bx - 32) * 512 + tid, (const float*)(ws + WS_HEND), sm + SM_A64, (bf16_t*)(ws + WS_HST), l);
                const float* kmean = (const float*)(ws + WS_KMEAN); const float* rel_bias = A->in[2];
                const int nb = G;
                for (int it = bx; it < 512 + 1536; it += nb) {
                    if (it < 512) { const int own = 31 - (it >> 4), bh = it & 15; fa::moba_unit(ldsl, tid, bh, own, proj, kmean, rel_bias, Y); }
                    else { const int j = it - 512, pi = j / 512, bh = (j >> 5) & 15, u = j & 31; fa::dilated_unit(ldsl, tid, pi, bh, u, proj, rel_bias, (bf16_t*)(ws + WS_PO), (float*)(ws + WS_PL)); }
                }
            }
        }
        GRID_BAR();
        {
            const Args* A = &args; unsigned char* ws = A->ws;
            int lane = lane_; OPQ(lane);
            const float* lbp = (const float*)(ws + WS_SMALL) + SM_LB + l * 256;
            for (int it = bx; it < 256; it += G) s5::x3_item(ldsl, wave, lane, it, l, (const bf16_t*)(ws + WS_PROJ), (const bf16_t*)(ws + WS_KM), (const bf16_t*)(ws + WS_W3), (const bf16_t*)(ws + WS_HST), A->in[10], (bf16_t*)(ws + WS_YBPRE));
            for (int it = bx; it < 2048; it += G) hg::x3_item(ldsl, wave, lane, it, (const bf16_t*)(ws + WS_PROJ), lbp, (const bf16_t*)(ws + WS_ST), (bf16_t*)(ws + WS_Y));
        }
        GRID_BAR();
        {
            const Args* A = &args; unsigned char* ws = A->ws;
            const bf16_t* ybpre = (const bf16_t*)(ws + WS_YBPRE);
            pg8::Gemm g{ybpre, (const bf16_t*)(ws + WS_GLUWT) + (size_t)l * BW * BW, M, BW, BW}; int tidg = tid_, bxg = bx; OPQ(tidg); OPQS(bxg); pg8::StaticOrder S; S.init(M, BW, G, bxg);
            pg8::EpiGlu E{(bf16_t*)(ws + WS_Y) + 256, DM, ybpre, BW, A->in[12] + l * BW};
            pg8::gemm_phase<pg8::EpiGlu, pg8::StaticOrder, true, true>(ldsl, g, S, E, tidg);
        }
        GRID_BAR();
        {
            const Args* A = &args; unsigned char* ws = A->ws;
            int lane = lane_; OPQ(lane);
            for (int r = gw; r < M; r += NGW) combine_row((size_t)r, lane, (bf16_t*)(ws + WS_Y), (const bf16_t*)(ws + WS_PROJ), A->in[14] + l * DM, (const bf16_t*)(ws + WS_PO), (const float*)(ws + WS_PL));
        }
        GRID_BAR();
        {
            const Args* A = &args; unsigned char* ws = A->ws;
            pg8::Gemm g{(const bf16_t*)(ws + WS_Y), (const bf16_t*)(ws + WS_WTOUT) + (size_t)l * DM * DM, M, DM, DM}; int tidg = tid_, bxg = bx; OPQ(tidg); OPQS(bxg); pg8::StaticOrder S; S.init(M, DM, G, bxg);
            pg8::EpiResF32 E{l == 0 ? A->in[0] : A->out, A->out};
            pg8::gemm_phase<pg8::EpiResF32, pg8::StaticOrder, true, true>(ldsl, g, S, E, tidg);
        }
        GRID_BAR();
        {
            const Args* A = &args; unsigned char* ws = A->ws;
            int lane = lane_; OPQ(lane);
            for (int r = gw; r < M; r += NGW) layernorm_row((size_t)r, lane, A->out, (bf16_t*)(ws + WS_XB), A->in[16] + l * DM, A->in[17] + l * DM);
        }
        if (l + 1 < DEPTH) GRID_BAR();
    }
}

extern "C" void kernel_launch(void* const* d_in, const int* in_sizes, int n_in, void* d_out, int out_size, void* d_ws, size_t ws_size, hipStream_t stream) {
    static int grid = 0;
    if (grid == 0) {
        if (n_in != 18 || in_sizes[0] != M * DM || out_size != M * DM || ws_size < WS_END) { fprintf(stderr, "kernel_launch: unexpected shapes (n_in %d, in0 %d, out %d, ws %zu)\n", n_in, n_in > 0 ? in_sizes[0] : -1, out_size, ws_size); grid = -1; return; }
        int dev = 0, cus = 0, per_cu = 0;
        if (hipGetDevice(&dev) != hipSuccess || hipDeviceGetAttribute(&cus, hipDeviceAttributeMultiprocessorCount, dev) != hipSuccess) { grid = -1; return; }
        if (hipFuncSetAttribute((const void*)mega_fwd, hipFuncAttributeMaxDynamicSharedMemorySize, LDS_BYTES) != hipSuccess) { fprintf(stderr, "kernel_launch: hipFuncSetAttribute failed\n"); grid = -1; return; }
        if (hipOccupancyMaxActiveBlocksPerMultiprocessor(&per_cu, (const void*)mega_fwd, NWAVES * 64, LDS_BYTES) != hipSuccess || per_cu < 1) { fprintf(stderr, "kernel_launch: occupancy query says %d\n", per_cu); }
        (void)hipGetLastError();
        grid = cus;
    }
    if (grid < 0) return;
    if (hipMemsetAsync((char*)d_ws + WS_CTL, 0, CTL_ZERO_BYTES, stream) != hipSuccess) return;
    Args a{};
    for (int i = 0; i < 18; ++i) a.in[i] = (const float*)d_in[i];
    a.out = (float*)d_out; a.ws = (unsigned char*)d_ws;
    hipLaunchKernelGGL(mega_fwd, dim3(grid), dim3(NWAVES * 64), LDS_BYTES, stream, a);
}
```

```cpp
#include <hip/hip_runtime.h>
#include <stdint.h>
#include <cstdio>

typedef unsigned short bf16_t;
typedef unsigned u32x4 __attribute__((ext_vector_type(4)));
#define LAS __attribute__((address_space(3)))
#define GAS __attribute__((address_space(1)))

constexpr int BATCH = 4, SEQ = 8192, DM = 1024, M = BATCH * SEQ, BW = 256, NIN = 3584, HD = 64, DEPTH = 2;
constexpr int COL_QA = 0, COL_KA = 256, COL_VA = 512, COL_U = 768, COL_QC = 1024, COL_FC = 1280, COL_IC = 1536, COL_QD = 1792, COL_KD = 2048, COL_VD = 2304, COL_G = 2560;
constexpr float ALPHA = 1.4142135623730951f;
constexpr float LN_EPS = 1e-5f, RMS_EPS = 1e-6f, NEGF = -1e30f;

constexpr size_t MiB = 1u << 20;
constexpr size_t WS_CTL = 0, CTL_ZERO_BYTES = 1 * MiB;
constexpr size_t WS_SMALL = 1 * MiB;
constexpr size_t WS_WTIN = 2 * MiB;
constexpr size_t WS_WTOUT = 16 * MiB;
constexpr size_t WS_GLUWT = 20 * MiB;
constexpr size_t WS_KP = 21 * MiB;
constexpr size_t WS_XB = 22 * MiB;
constexpr size_t WS_PARTO = WS_XB;
constexpr size_t WS_PARTML = WS_XB + 48 * MiB;
constexpr size_t WS_LIST = WS_XB + 52 * MiB;
constexpr size_t WS_CNT = WS_XB + 60 * MiB;
constexpr size_t WS_PROJ = 86 * MiB;
constexpr size_t WS_Y = 310 * MiB;
constexpr size_t WS_YBPRE = 374 * MiB;
constexpr size_t WS_PO = 390 * MiB;
constexpr size_t WS_PL = 438 * MiB;
constexpr size_t WS_DS = 440 * MiB;
constexpr size_t WS_ST = 472 * MiB;
constexpr size_t WS_DEC = 488 * MiB;
constexpr size_t WS_KM = 489 * MiB;
constexpr size_t WS_W1 = 490 * MiB;
constexpr size_t WS_W3 = 498 * MiB;
constexpr size_t WS_HEND = 506 * MiB;
constexpr size_t WS_HST = 510 * MiB;
constexpr size_t WS_END = 512 * MiB;
constexpr int SM_LB = 0;
constexpr int SM_ABAR = 512;
constexpr int SM_BBAR = SM_ABAR + 2 * 16 * 64 * 2;
constexpr int SM_A64 = SM_BBAR + 2 * 16 * 64 * 16 * 2;
constexpr int SM_RELB = SM_A64 + 2 * 16 * 64 * 2, SM_GLUB = SM_RELB + 256, SM_GAIN = SM_GLUB + 512, SM_LNG = SM_GAIN + 2048, SM_LNB = SM_LNG + 2048, SM_END = SM_LNB + 2048;
constexpr int CW_BAR = 4096;
constexpr int CW_WQ = 16384;

__device__ __forceinline__ float bf2f(bf16_t v) { return __uint_as_float(((unsigned)v) << 16); }
__device__ __forceinline__ bf16_t f2bf(float f) { unsigned u = __float_as_uint(f); return (bf16_t)((u + 0x7fffu + ((u >> 16) & 1u)) >> 16); }
__device__ __forceinline__ unsigned pk2(float lo, float hi) { return (unsigned)f2bf(lo) | ((unsigned)f2bf(hi) << 16); }
__device__ __forceinline__ float wave_max(float v) {
#pragma unroll
    for (int o = 1; o < 64; o <<= 1) v = fmaxf(v, __shfl_xor(v, o));
    return v;
}
__device__ __forceinline__ float wave_sum(float v) {
#pragma unroll
    for (int o = 1; o < 64; o <<= 1) v += __shfl_xor(v, o);
    return v;
}
__device__ __forceinline__ int t5_bucket(int d) {
    if (d < 16) return d;
    int b = 16;
    b += (d >= 22); b += (d >= 30); b += (d >= 40); b += (d >= 54); b += (d >= 73); b += (d >= 99); b += (d >= 134); b += (d >= 182);
    b += (d >= 246); b += (d >= 332); b += (d >= 450); b += (d >= 609); b += (d >= 825); b += (d >= 1117); b += (d >= 1513);
    return b;
}
__device__ __forceinline__ float sigmoidf_(float x) { return 1.0f / (1.0f + expf(-x)); }
__device__ __forceinline__ float siluf_(float x) { return x / (1.0f + expf(-x)); }
__device__ __forceinline__ float gelu_tanh(float x) { const float u = 0.7978845608028654f * (x + 0.044715f * x * x * x); return 0.5f * x * (1.0f + tanhf(u)); }
typedef float f32x2_t __attribute__((ext_vector_type(2))); typedef __bf16 bf16x2_t __attribute__((ext_vector_type(2)));
__device__ __forceinline__ unsigned cvtpk_s(float lo, float hi) { f32x2_t v = {lo, hi}; bf16x2_t b = __builtin_convertvector(v, bf16x2_t); return __builtin_bit_cast(unsigned, b); }
__device__ __forceinline__ int lane_id_opaque() { unsigned z = 0u; asm volatile("" : "+v"(z)); return (int)__builtin_amdgcn_mbcnt_hi(~0u, __builtin_amdgcn_mbcnt_lo(~0u, z)); }
#define WSYNC() asm volatile("s_waitcnt lgkmcnt(0)" ::: "memory")

__device__ __forceinline__ void sincos_d(double th, double& s, double& c) {
    const double k = rint(th * 0.63661977236758134308);
    double r = fma(-k, 1.57079632679489655800, th); r = fma(-k, 6.12323399573676603587e-17, r);
    const long q = ((long)k) & 3;
    const double r2 = r * r;
    const double sp = r * (1.0 + r2 * (-1.0 / 6 + r2 * (1.0 / 120 + r2 * (-1.0 / 5040 + r2 * (1.0 / 362880 + r2 * (-1.0 / 39916800 + r2 * (1.0 / 6227020800.0 + r2 * (-1.0 / 1307674368000.0))))))));
    const double cp = 1.0 + r2 * (-0.5 + r2 * (1.0 / 24 + r2 * (-1.0 / 720 + r2 * (1.0 / 40320 + r2 * (-1.0 / 3628800 + r2 * (1.0 / 479001600.0 + r2 * (-1.0 / 87178291200.0 + r2 * (1.0 / 20922789888000.0))))))));
    if (q == 0) { s = sp; c = cp; } else if (q == 1) { s = cp; c = -sp; } else if (q == 2) { s = -sp; c = -cp; } else { s = -cp; c = sp; }
}

namespace pg8 {
#define PG8_LAS __attribute__((address_space(3)))
typedef unsigned short bf16_t;
typedef short bf16x8 __attribute__((ext_vector_type(8)));
typedef float f32x4 __attribute__((ext_vector_type(4)));
typedef unsigned u32x4 __attribute__((ext_vector_type(4)));
constexpr int BM = 256, BK = 64, HALF = 128, HTB = HALF * BK * 2  , STAGE_BYTES = 8 * HTB, NXCD = 8, WGM = 8;

__host__ __device__ __forceinline__ int lds_byte(int r, int c) { const int st = (r >> 4) * 2 + (c >> 5), rr = r & 15, cc = c & 31, ob = rr * 64 + cc * 2; return st * 1024 + (ob ^ (((ob >> 9) & 1) << 5)); }
__host__ __device__ __forceinline__ void stage_rc(int b, int& R, int& C) { const int st = b / 1024, sb = b % 1024, swz = sb ^ (((sb >> 9) & 1) << 5); R = (st >> 1) * 16 + swz / 64; C = (st & 1) * 32 + (swz % 64) / 2; }
__host__ __device__ __forceinline__ int perm32(int rho) { const int n = rho >> 4, i = rho & 15; return 8 * (i >> 2) + 4 * n + (i & 3); }

struct Unit { int pm, pn; };
struct Gemm { const bf16_t* A; const bf16_t* Bt; int M, N, K; };

struct StaticOrder {
    int nM, nN, nwg, G, c;
    __host__ __device__ void init(int M, int N, int G_, int c_) { nM = M / BM; nN = N / BM; nwg = nM * nN; G = G_; c = c_; }
    __host__ __device__ bool next(int i, Unit& u) const {
        const long L = (long)i * G + c; if (L >= nwg) return false;
        int wgid = (int)L; { const int q = nwg / NXCD, r = nwg % NXCD, xcd = wgid % NXCD, off = wgid / NXCD; wgid = (xcd < r ? xcd * (q + 1) : r * (q + 1) + (xcd - r) * q) + off; }
        const int nig = WGM * nN, gid = wgid / nig, fm = gid * WGM, gsz = (nM - fm) < WGM ? (nM - fm) : WGM;
        u.pm = fm + ((wgid % nig) % gsz); u.pn = (wgid % nig) / gsz; return true;
    }
    __device__ __forceinline__ void a_ready(const Unit&) const {}
    __device__ __forceinline__ void done(const Unit&) const {}
};

__device__ __forceinline__ unsigned cvt_pk_bf16(float lo, float hi) { unsigned r; asm volatile("v_cvt_pk_bf16_f32 %0, %1, %2" : "=v"(r) : "v"(lo), "v"(hi)); return r; }
struct EpiStoreBf16 {
    static constexpr bool PERM = true, AFTER_DRAIN = false;
    bf16_t* O; int ldc; float* kp;
    __device__ __forceinline__ void operator()(const f32x4 (&acc)[2][2][4][2], const Unit& u, int wr, int wc, int fr_, int fq_) const {
        const int ln_ = lane_id_opaque(), fr = ln_ & 15, fq = ln_ >> 4; (void)fr_; (void)fq_;
        const int row0 = u.pm * BM + wr * 64 + fr, col0 = u.pn * BM + wc * 32 + 8 * fq;
#pragma unroll
        for (int ai = 0; ai < 2; ++ai)
#pragma unroll
            for (int m = 0; m < 4; ++m) { bf16_t* rowp = O + (size_t)(row0 + ai * HALF + m * 16) * ldc + col0;
#pragma unroll
                for (int bj = 0; bj < 2; ++bj) { const f32x4 v0 = acc[ai][bj][m][0], v1 = acc[ai][bj][m][1];
                    u32x4 w; w.x = cvtpk_s(v0[0], v0[1]); w.y = cvtpk_s(v0[2], v0[3]); w.z = cvtpk_s(v1[0], v1[1]); w.w = cvtpk_s(v1[2], v1[3]);
                    *(u32x4*)(rowp + bj * HALF) = w; } }
        if (kp && u.pn == 1) {
#pragma unroll
            for (int bj = 0; bj < 2; ++bj)
#pragma unroll
                for (int n = 0; n < 2; ++n) { f32x4 s = {0.f, 0.f, 0.f, 0.f};
#pragma unroll
                    for (int ai = 0; ai < 2; ++ai)
#pragma unroll
                        for (int m = 0; m < 4; ++m) s += acc[ai][bj][m][n];
#pragma unroll
                    for (int o = 1; o < 16; o <<= 1) { s[0] += __shfl_xor(s[0], o); s[1] += __shfl_xor(s[1], o); s[2] += __shfl_xor(s[2], o); s[3] += __shfl_xor(s[3], o); }
                    if (fr == 0) *(f32x4*)(kp + (size_t)(u.pm * 2 + wr) * 256 + bj * HALF + wc * 32 + 8 * fq + 4 * n) = s; }
        }
    }
};
struct EpiGlu {
    static constexpr bool PERM = true, AFTER_DRAIN = false;
    bf16_t* O; int ldc; const bf16_t* Ain; int lda; const float* bias;
    __device__ __forceinline__ void operator()(const f32x4 (&acc)[2][2][4][2], const Unit& u, int wr, int wc, int fr_, int fq_) const {
        const int ln_ = lane_id_opaque(), fr = ln_ & 15, fq = ln_ >> 4; (void)fr_; (void)fq_;
        const int row0 = u.pm * BM + wr * 64 + fr, col0 = u.pn * BM + wc * 32 + 8 * fq;
#pragma unroll
        for (int ai = 0; ai < 2; ++ai)
#pragma unroll
            for (int m = 0; m < 4; ++m) { const size_t r = (size_t)(row0 + ai * HALF + m * 16);
#pragma unroll
                for (int bj = 0; bj < 2; ++bj) { const int c = col0 + bj * HALF;
                    const u32x4 av = *(const u32x4*)(Ain + r * lda + c);
                    const f32x4 b0 = *(const f32x4*)(bias + c), b1 = *(const f32x4*)(bias + c + 4);
                    const f32x4 v0 = acc[ai][bj][m][0] + b0, v1 = acc[ai][bj][m][1] + b1;
                    float o[8];
#pragma unroll
                    for (int j = 0; j < 4; ++j) { const float alo = __uint_as_float(av[j] << 16), ahi = __uint_as_float(av[j] & 0xffff0000u);
                        const float s0 = (j < 2) ? v0[2 * j] : v1[2 * j - 4], s1 = (j < 2) ? v0[2 * j + 1] : v1[2 * j - 3];
                        o[2 * j] = alo / (1.0f + __expf(-s0)); o[2 * j + 1] = ahi / (1.0f + __expf(-s1)); }
                    u32x4 w; w.x = cvtpk_s(o[0], o[1]); w.y = cvtpk_s(o[2], o[3]); w.z = cvtpk_s(o[4], o[5]); w.w = cvtpk_s(o[6], o[7]);
                    *(u32x4*)(O + r * ldc + c) = w; } }
    }
};
struct EpiResF32 {
    static constexpr bool PERM = false, AFTER_DRAIN = false;
    const float* res; float* out;
    __device__ __forceinline__ void operator()(const f32x4 (&acc)[2][2][4][2], const Unit& u, int wr, int wc, int fr_, int fq_) const {
        const int ln_ = lane_id_opaque(), fr = ln_ & 15, fq = ln_ >> 4; (void)fr_; (void)fq_;
        const int col0 = u.pn * BM + wc * 32 + 4 * fq;
#pragma unroll
        for (int ai = 0; ai < 2; ++ai)
#pragma unroll
            for (int m = 0; m < 4; ++m) { const size_t off = (size_t)(u.pm * BM + ai * HALF + wr * 64 + m * 16 + fr) * 1024 + col0;
#pragma unroll
                for (int bj = 0; bj < 2; ++bj)
#pragma unroll
                    for (int n = 0; n < 2; ++n) { const f32x4 rv = *(const f32x4*)(res + off + bj * HALF + n * 16);
                        *(f32x4*)(out + off + bj * HALF + n * 16) = rv * 1.4142135623730951f + acc[ai][bj][m][n]; } }
    }
};

template <class Epi, class Sched, bool ALIGN_EPI = false, bool SP2 = false>
__device__ __forceinline__ void gemm_phase(PG8_LAS unsigned char* lds, const Gemm g, const Sched& S, const Epi& E, const int tid_in  ) {
    const int tid = tid_in, wid = __builtin_amdgcn_readfirstlane(tid >> 6), lane = tid & 63, wr = wid >> 2, wc = wid & 3, fr = lane & 15, fq = lane >> 4;
    const int K = g.K, nt = K / BK;
    unsigned voffA[2], voffB[2];
#pragma unroll
    for (int i = 0; i < 2; ++i) { int R, C; stage_rc(tid * 16 + i * 8192, R, C); const int Rb = Epi::PERM ? ((R & ~31) + perm32(R & 31)) : R;
        voffA[i] = (unsigned)(R * K + C) * 2u; voffB[i] = (unsigned)(Rb * K + C) * 2u; }
    const size_t kstep = (size_t)(BK * 2);
    const size_t hstep = (size_t)HALF * K * 2;
    const size_t tstep = 2 * hstep;
    const unsigned ldsw = (unsigned)wid * 1024u;
    const int aoff = lds_byte(wr * 64 + fr, fq * 8), boff = lds_byte(wc * 32 + fr, fq * 8);
#define PG8_SA(b, h) (((b) * 2 + (h)) * HTB)
#define PG8_SB(b, h) ((4 + (b) * 2 + (h)) * HTB)
#define PG8_STAGE(bufoff, gbase, voff) do { _Pragma("unroll") for (int _i = 0; _i < 2; ++_i) \
        __builtin_amdgcn_global_load_lds((const unsigned*)((const char*)(gbase) + (voff)[_i]), (PG8_LAS unsigned*)(lds + (bufoff) + ldsw + _i * 8192), 16, 0, 0); } while (0)
#define PG8_LDA(dst, b, h) do { _Pragma("unroll") for (int m = 0; m < 4; ++m) _Pragma("unroll") for (int k = 0; k < 2; ++k) dst[m][k] = *(const PG8_LAS bf16x8*)(lds + PG8_SA(b, h) + aoff + m * 2048 + k * 1024); } while (0)
#define PG8_LDB(dst, b, h) do { _Pragma("unroll") for (int n = 0; n < 2; ++n) _Pragma("unroll") for (int k = 0; k < 2; ++k) dst[n][k] = *(const PG8_LAS bf16x8*)(lds + PG8_SB(b, h) + boff + n * 2048 + k * 1024); } while (0)
#define PG8_MMA(ai, bj, At, Bt) do { __builtin_amdgcn_s_setprio(1); _Pragma("unroll") for (int m = 0; m < 4; ++m) _Pragma("unroll") for (int n = 0; n < 2; ++n) _Pragma("unroll") for (int k = 0; k < 2; ++k) \
        acc[ai][bj][m][n] = __builtin_amdgcn_mfma_f32_16x16x32_bf16(Bt[n][k], At[m][k], acc[ai][bj][m][n], 0, 0, 0); __builtin_amdgcn_s_setprio(0); } while (0)
#define PG8_WAIT_V(n) asm volatile("s_waitcnt vmcnt(" #n ")" ::: "memory")
#define PG8_WAIT_L(n) asm volatile("s_waitcnt lgkmcnt(" #n ")" ::: "memory")
#define PG8_BAR __builtin_amdgcn_s_barrier()
#define PG8_SCHED __builtin_amdgcn_sched_barrier(0)
    Unit cur, nxt; int ui = 0;
    if (!S.next(0, cur)) return;
    f32x4 acc[2][2][4][2];
#pragma unroll
    for (int a = 0; a < 2; ++a)
#pragma unroll
        for (int b = 0; b < 2; ++b)
#pragma unroll
            for (int m = 0; m < 4; ++m)
#pragma unroll
                for (int n = 0; n < 2; ++n) acc[a][b][m][n] = (f32x4){0.f, 0.f, 0.f, 0.f};
    bf16x8 At[4][2], B0[2][2], B1[2][2];
    const char* cA = (const char*)g.A + (size_t)cur.pm * tstep; const char* cB = (const char*)g.Bt + (size_t)cur.pn * tstep;
    S.a_ready(cur);
    if constexpr (SP2) {
        PG8_STAGE(PG8_SB(0, 0), cB, voffB); PG8_STAGE(PG8_SB(0, 1), cB + hstep, voffB); PG8_STAGE(PG8_SA(0, 0), cA, voffA); PG8_STAGE(PG8_SA(0, 1), cA + hstep, voffA);
        if (wr == 1) PG8_BAR;
        PG8_WAIT_V(2); PG8_BAR;
        PG8_STAGE(PG8_SB(1, 0), cB + kstep, voffB); PG8_STAGE(PG8_SA(1, 0), cA + kstep, voffA); PG8_STAGE(PG8_SB(1, 1), cB + hstep + kstep, voffB);
        PG8_WAIT_V(6); PG8_BAR;
    } else {
        PG8_STAGE(PG8_SB(0, 0), cB, voffB); PG8_STAGE(PG8_SA(0, 0), cA, voffA); PG8_STAGE(PG8_SB(0, 1), cB + hstep, voffB); PG8_STAGE(PG8_SA(0, 1), cA + hstep, voffA);
        if (wr == 1) PG8_BAR;
        PG8_WAIT_V(4); PG8_BAR;
        PG8_STAGE(PG8_SB(1, 0), cB + kstep, voffB); PG8_STAGE(PG8_SA(1, 0), cA + kstep, voffA); PG8_STAGE(PG8_SB(1, 1), cB + hstep + kstep, voffB);
        PG8_WAIT_V(6); PG8_BAR;
    }
    for (;;) {
        const bool has_next = S.next(ui + 1, nxt);
        const char* nA = has_next ? (const char*)g.A + (size_t)nxt.pm * tstep : cA; const char* nB = has_next ? (const char*)g.Bt + (size_t)nxt.pn * tstep : cB;
        for (int t = 0; t < nt; t += 2) {
            const bool last = (t == nt - 2);
            const char* a1 = cA + (size_t)(t + 1) * kstep;
            const char* a2 = last ? nA : cA + (size_t)(t + 2) * kstep; const char* b2 = last ? nB : cB + (size_t)(t + 2) * kstep;
            const char* a3 = a2 + kstep; const char* b3 = b2 + kstep;
            if (last && has_next) S.a_ready(nxt);
            if constexpr (SP2) {
            PG8_LDB(B0, 0, 0); PG8_LDB(B1, 0, 1); PG8_SCHED; PG8_LDA(At, 0, 0); PG8_STAGE(PG8_SA(1, 1), a1 + hstep, voffA);
            PG8_WAIT_V(8); PG8_WAIT_L(0); PG8_BAR; PG8_MMA(0, 0, At, B0); PG8_MMA(0, 1, At, B1); PG8_BAR; PG8_SCHED;
            PG8_LDA(At, 0, 1); PG8_STAGE(PG8_SB(0, 0), b2, voffB); PG8_STAGE(PG8_SB(0, 1), b2 + hstep, voffB); PG8_STAGE(PG8_SA(0, 0), a2, voffA);
            PG8_WAIT_V(8); PG8_WAIT_L(0); PG8_BAR; PG8_MMA(1, 0, At, B0); PG8_MMA(1, 1, At, B1); PG8_BAR; PG8_SCHED;
            PG8_LDB(B0, 1, 0); PG8_LDB(B1, 1, 1); PG8_SCHED; PG8_LDA(At, 1, 0); PG8_STAGE(PG8_SA(0, 1), a2 + hstep, voffA);
            PG8_WAIT_V(8); PG8_WAIT_L(0); PG8_BAR; PG8_MMA(0, 0, At, B0); PG8_MMA(0, 1, At, B1); PG8_BAR; PG8_SCHED;
            PG8_LDA(At, 1, 1); PG8_STAGE(PG8_SB(1, 0), b3, voffB); PG8_STAGE(PG8_SB(1, 1), b3 + hstep, voffB); PG8_STAGE(PG8_SA(1, 0), a3, voffA);
            PG8_WAIT_V(8); PG8_WAIT_L(0); PG8_BAR; PG8_MMA(1, 0, At, B0); PG8_MMA(1, 1, At, B1); PG8_BAR; PG8_SCHED;
            } else {
            PG8_LDB(B0, 0, 0); PG8_SCHED; PG8_LDA(At, 0, 0); PG8_STAGE(PG8_SA(1, 1), a1 + hstep, voffA);
            PG8_WAIT_L(8); PG8_BAR; PG8_WAIT_L(0); PG8_MMA(0, 0, At, B0); PG8_BAR; PG8_SCHED;
            PG8_LDB(B1, 0, 1); PG8_STAGE(PG8_SB(0, 0), b2, voffB);
            PG8_BAR; PG8_WAIT_L(0); PG8_MMA(0, 1, At, B1); PG8_BAR;
            PG8_LDA(At, 0, 1); PG8_STAGE(PG8_SA(0, 0), a2, voffA);
            PG8_BAR; PG8_WAIT_L(0); PG8_MMA(1, 0, At, B0); PG8_BAR; PG8_SCHED;
            PG8_STAGE(PG8_SB(0, 1), b2 + hstep, voffB);
            PG8_WAIT_V(6); PG8_BAR; PG8_MMA(1, 1, At, B1); PG8_BAR;
            PG8_LDB(B0, 1, 0); PG8_SCHED; PG8_LDA(At, 1, 0); PG8_STAGE(PG8_SA(0, 1), a2 + hstep, voffA);
            PG8_WAIT_L(8); PG8_BAR; PG8_WAIT_L(0); PG8_MMA(0, 0, At, B0); PG8_BAR; PG8_SCHED;
            PG8_LDB(B1, 1, 1); PG8_STAGE(PG8_SB(1, 0), b3, voffB);
            PG8_BAR; PG8_WAIT_L(0); PG8_MMA(0, 1, At, B1); PG8_BAR;
            PG8_LDA(At, 1, 1); PG8_STAGE(PG8_SA(1, 0), a3, voffA);
            PG8_BAR; PG8_WAIT_L(0); PG8_MMA(1, 0, At, B0); PG8_BAR; PG8_SCHED;
            PG8_STAGE(PG8_SB(1, 1), b3 + hstep, voffB);
            PG8_WAIT_V(6); PG8_BAR; PG8_MMA(1, 1, At, B1); PG8_BAR;
            }
        }
        if constexpr (ALIGN_EPI) { if (wr == 0) PG8_BAR; }
        if constexpr (!Epi::AFTER_DRAIN) { E(acc, cur, wr, wc, fr, fq); S.done(cur); }
        if (!has_next) break;
#pragma unroll
        for (int a = 0; a < 2; ++a)
#pragma unroll
            for (int b = 0; b < 2; ++b)
#pragma unroll
                for (int m = 0; m < 4; ++m)
#pragma unroll
                    for (int n = 0; n < 2; ++n) acc[a][b][m][n] = (f32x4){0.f, 0.f, 0.f, 0.f};
        cur = nxt; cA = nA; cB = nB; ++ui;
        if constexpr (ALIGN_EPI) { if (wr == 1) PG8_BAR; }
    }
    PG8_WAIT_V(0);
    if constexpr (!ALIGN_EPI) { if (wr == 0) PG8_BAR; }
    PG8_BAR;
    if constexpr (Epi::AFTER_DRAIN) { E.fused(acc, cur, wr, wc, fr, fq, lds, wid, lane); S.done(cur); }
#undef PG8_SA
#undef PG8_SB
#undef PG8_STAGE
#undef PG8_LDA
#undef PG8_LDB
#undef PG8_MMA
#undef PG8_WAIT_V
#undef PG8_WAIT_L
#undef PG8_BAR
#undef PG8_SCHED
}
}
#define XB_TMO      128
#define XB_XCNT(j)  (256  + 64 * (j))
#define XB_XSUB(j)  (1280 + 64 * (j))
#define XB_XGEN(j)  (2304 + 64 * (j))
#define XB_TOP      3328
#define XB_TOPGEN   3392
#define XCD_BAR_WORDS 3456
#define XB_SPIN_CAP (1u << 18)

__device__ __forceinline__ unsigned xb_ld(unsigned* p)              { return __hip_atomic_load((__attribute__((address_space(1))) unsigned*)p, __ATOMIC_RELAXED, __HIP_MEMORY_SCOPE_AGENT); }
__device__ __forceinline__ unsigned xb_add(unsigned* p, unsigned v) { return __hip_atomic_fetch_add((__attribute__((address_space(1))) unsigned*)p, v, __ATOMIC_RELAXED, __HIP_MEMORY_SCOPE_AGENT); }
__device__ __forceinline__ unsigned xb_xcc_id() { return (unsigned)__builtin_amdgcn_s_getreg((3 << 11) | 20) & 0xFu; }
#define XB_SPIN(cond, bar) do { unsigned _sp = 0; while (cond) { __builtin_amdgcn_s_sleep(1); \
    if ((++_sp & 255u) == 0u) { if (xb_ld(&(bar)[XB_TMO])) break; if (_sp > XB_SPIN_CAP) { atomicAdd(&(bar)[XB_TMO], 1u); break; } } } } while (0)

struct XcdBarrier {
    unsigned* bar; unsigned x;
    volatile LAS unsigned* st;
};

__device__ __forceinline__ XcdBarrier xcd_barrier_post(unsigned* bar, volatile LAS unsigned* st) {
    XcdBarrier b; b.bar = bar; b.x = xb_xcc_id(); b.st = st;
    if (threadIdx.x == 0) (void)xb_add(&bar[XB_XCNT(b.x)], 1u);
    return b;
}
__device__ __forceinline__ void xcd_barrier_complete(unsigned* bar, unsigned x, unsigned& nloc, unsigned& nx) {
    const unsigned G = gridDim.x * gridDim.y * gridDim.z;
    unsigned sum, cnt, mine, sp = 0u;
    for (;;) {
        sum = 0u; cnt = 0u; mine = 0u;
#pragma unroll
        for (unsigned j = 0; j < 16; ++j) { const unsigned c = xb_ld(&bar[XB_XCNT(j)]); sum += c; cnt += (c > 0u) ? 1u : 0u; mine = (j == x) ? c : mine; }
        if (sum == G) break;
        __builtin_amdgcn_s_sleep(1);
        if ((++sp & 255u) == 0u) { if (xb_ld(&bar[XB_TMO])) break; if (sp > XB_SPIN_CAP) { atomicAdd(&bar[XB_TMO], 1u); break; } }
    }
    nloc = mine > 0u ? mine : 1u; nx = cnt > 0u ? cnt : 1u;
}

__device__ __forceinline__ void xcd_barrier(const XcdBarrier& b) {
    asm volatile("s_waitcnt vmcnt(0)" ::: "memory");
    __syncthreads();
    if (threadIdx.x == 0) {
        unsigned* bar = b.bar;
        __builtin_amdgcn_s_waitcnt(0);
        unsigned nloc = b.st[0], nx = b.st[1];
        if (nloc == 0u) { xcd_barrier_complete(bar, b.x, nloc, nx); b.st[0] = nloc; b.st[1] = nx; }
        const unsigned old = xb_add(&bar[XB_XSUB(b.x)], 1u);
        const unsigned gen = old / nloc;
        if (old + 1u == (gen + 1u) * nloc) {
            __builtin_amdgcn_fence(__ATOMIC_RELEASE, "agent");
            asm volatile("s_waitcnt vmcnt(0)" ::: "memory");
            const unsigned og = xb_add(&bar[XB_TOP], 1u);
            const unsigned tg = og / nx;
            if (og + 1u == (tg + 1u) * nx) xb_add(&bar[XB_TOPGEN], 1u);
            else XB_SPIN(xb_ld(&bar[XB_TOPGEN]) == tg, bar);
            __builtin_amdgcn_fence(__ATOMIC_ACQUIRE, "agent");
            xb_add(&bar[XB_XGEN(b.x)], 1u);
            asm volatile("s_waitcnt vmcnt(0)" ::: "memory");
        } else {
            XB_SPIN(xb_ld(&bar[XB_XGEN(b.x)]) == gen, bar);
            __builtin_amdgcn_fence(__ATOMIC_ACQUIRE, "agent");
            asm volatile("s_waitcnt vmcnt(0)" ::: "memory");
        }
    }
    __syncthreads();
}
namespace fa {
typedef short bf16x8 __attribute__((ext_vector_type(8)));
typedef float f32x16 __attribute__((ext_vector_type(16)));
typedef short v4i16_t __attribute__((ext_vector_type(4)));
constexpr int KT_OFF = 0, VT_OFF = 8192, LUT_OFF = 16384, OST_OFF = 24576, FA_LDS = OST_OFF + 8 * 4096;
__device__ __forceinline__ int crow(int r, int hi) { return (r & 3) + 8 * (r >> 2) + 4 * hi; }
__device__ __forceinline__ unsigned cvtpk(float lo, float hi) { return cvtpk_s(lo, hi); }
template <int B> __device__ __forceinline__ bf16x8 pack8(const f32x16& p) {
    u32x4 w; w.x = cvtpk(p[B], p[B + 1]); w.y = cvtpk(p[B + 2], p[B + 3]); w.z = cvtpk(p[B + 4], p[B + 5]); w.w = cvtpk(p[B + 6], p[B + 7]);
    return __builtin_bit_cast(bf16x8, w);
}
__device__ __forceinline__ v4i16_t trd(LAS const unsigned char* p) { return __builtin_amdgcn_ds_read_tr16_b64_v4i16((LAS v4i16_t*)p); }
__device__ __forceinline__ void stage_tile(LAS unsigned char* lds, int tid, const bf16_t* krow, const bf16_t* vrow) {
    const int row = tid >> 3, ch = tid & 7;
    u32x4 kv = {0u, 0u, 0u, 0u}, vv = {0u, 0u, 0u, 0u};
    if (krow) { kv = *(const u32x4*)(krow + ch * 8); vv = *(const u32x4*)(vrow + ch * 8); }
    *(LAS u32x4*)(lds + KT_OFF + row * 128 + ((ch ^ (row & 7)) * 16)) = kv;
    *(LAS u32x4*)(lds + VT_OFF + row * 128 + ch * 16) = vv;
}
template <class Fn> __device__ __forceinline__ void tile_step(LAS const unsigned char* lds, const bf16x8 (&qf)[4], f32x16& o0, f32x16& o1, float& m, float& l, int lane, const Fn& fn) {
    const int r32 = lane & 31, hi = lane >> 5;
    f32x16 p0, p1;
#pragma unroll
    for (int r = 0; r < 16; ++r) { p0[r] = 0.f; p1[r] = 0.f; }
#pragma unroll
    for (int s = 0; s < 4; ++s) {
        const int ch = ((2 * s + hi) ^ (r32 & 7)) * 16;
        const bf16x8 k0 = *(const LAS bf16x8*)(lds + KT_OFF + r32 * 128 + ch);
        const bf16x8 k1 = *(const LAS bf16x8*)(lds + KT_OFF + (32 + r32) * 128 + ch);
        p0 = __builtin_amdgcn_mfma_f32_32x32x16_bf16(k0, qf[s], p0, 0, 0, 0);
        p1 = __builtin_amdgcn_mfma_f32_32x32x16_bf16(k1, qf[s], p1, 0, 0, 0);
    }
    float mx = NEGF;
#pragma unroll
    for (int r = 0; r < 16; ++r) { p0[r] = fn(crow(r, hi), p0[r]); p1[r] = fn(32 + crow(r, hi), p1[r]); mx = fmaxf(mx, fmaxf(p0[r], p1[r])); }
    mx = fmaxf(mx, __shfl_xor(mx, 32));
    const float mn = fmaxf(m, mx), alpha = __expf(m - mn);
    m = mn;
    float ps = 0.f;
#pragma unroll
    for (int r = 0; r < 16; ++r) { p0[r] = __expf(p0[r] - mn); p1[r] = __expf(p1[r] - mn); ps += p0[r] + p1[r]; }
    l = l * alpha + ps;
#pragma unroll
    for (int r = 0; r < 16; ++r) { o0[r] *= alpha; o1[r] *= alpha; }
    const int q4 = (lane & 15) >> 2, p4 = lane & 3, dgrp = (lane >> 4) & 1;
    const int vb = VT_OFF + (4 * hi + q4) * 128 + (16 * dgrp + 4 * p4) * 2;
#define FA_PV(P, KH, S2) do { const bf16x8 pb = pack8<8 * (S2)>(P); \
        _Pragma("unroll") for (int blk = 0; blk < 2; ++blk) { const int a = vb + (32 * (KH) + 16 * (S2)) * 128 + blk * 64; \
            const v4i16_t lo = trd(lds + a), hh = trd(lds + a + 8 * 128); \
            const bf16x8 va = {lo[0], lo[1], lo[2], lo[3], hh[0], hh[1], hh[2], hh[3]}; \
            if (blk == 0) o0 = __builtin_amdgcn_mfma_f32_32x32x16_bf16(va, pb, o0, 0, 0, 0); else o1 = __builtin_amdgcn_mfma_f32_32x32x16_bf16(va, pb, o1, 0, 0, 0); } } while (0)
    FA_PV(p0, 0, 0); FA_PV(p0, 0, 1); FA_PV(p1, 1, 0); FA_PV(p1, 1, 1);
#undef FA_PV
}
template <class RowFn> __device__ __forceinline__ float store_o(LAS unsigned char* lds, int wave, int lane, const f32x16& o0, const f32x16& o1, float l, const RowFn& orow) {
    const int r32 = lane & 31, hi = lane >> 5;
    l += __shfl_xor(l, 32);
    const float inv = 1.0f / l;
    LAS bf16_t* stg = (LAS bf16_t*)(lds + OST_OFF + wave * 4096);
#pragma unroll
    for (int r = 0; r < 16; ++r) { const int d = crow(r, hi); stg[r32 * 64 + d] = f2bf(o0[r] * inv); stg[r32 * 64 + 32 + d] = f2bf(o1[r] * inv); }
    asm volatile("s_waitcnt lgkmcnt(0)" ::: "memory");
#pragma unroll
    for (int i = 0; i < 4; ++i) { const int row = i * 8 + (lane >> 3), ch = lane & 7; const u32x4 v = *(const LAS u32x4*)(stg + row * 64 + ch * 8); *(u32x4*)(orow(row) + ch * 8) = v; }
    asm volatile("s_waitcnt lgkmcnt(0)" ::: "memory");
    return l;
}
struct DilFn {
    int qrel; LAS const float* lut;
    int ksub0;
    __device__ __forceinline__ float operator()(int key, float s) const {
        const int d = qrel - key; const bool ok = (d >= 0) && (d <= 128) && (ksub0 + key >= 0);
        const float b = lut[min(max(d, 0), 128)];
        return ok ? fmaf(s, 0.125f, b) : NEGF;
    }
};
struct MobaFn {
    int qrel; LAS const float* lut; bool allowed; bool causal;
    __device__ __forceinline__ float operator()(int key, float s) const {
        const int d = qrel - key; const bool ok = causal ? (d >= 0) : allowed;
        const float b = lut[min(max(d, 0), 1535)];
        return ok ? fmaf(s, 0.125f, b) : NEGF;
    }
};
__device__ __forceinline__ void dilated_unit(LAS unsigned char* lds, int tid, int pi, int bh, int u, const bf16_t* __restrict__ proj, const float* __restrict__ rel_bias, bf16_t* __restrict__ PO, float* __restrict__ PL) {
    const int lane = tid & 63, wave = __builtin_amdgcn_readfirstlane(tid >> 6), r32 = lane & 31, hi = lane >> 5;
    const int dil = (pi == 0) ? 1 : (pi == 1) ? 4 : 16, b = bh >> 2, h = bh & 3;
    const int r = u % dil, sb = u / dil;
    __syncthreads();
    LAS float* lut = (LAS float*)(lds + LUT_OFF);
    if (tid <= 128) lut[tid] = rel_bias[t5_bucket(tid * dil) * 8 + 4 + h];
    const int qsub = 256 * sb + 32 * wave + r32;
    const size_t qrow = (size_t)b * SEQ + (size_t)qsub * dil + r;
    bf16x8 qf[4];
#pragma unroll
    for (int s = 0; s < 4; ++s) qf[s] = *(const bf16x8*)(proj + qrow * NIN + COL_QD + h * 64 + 16 * s + 8 * hi);
    f32x16 o0, o1;
#pragma unroll
    for (int i = 0; i < 16; ++i) { o0[i] = 0.f; o1[i] = 0.f; }
    float m = NEGF, l = 0.f;
    for (int j = (sb == 0 ? 2 : 0); j < 6; ++j) {
        const int ksub0 = 256 * sb - 128 + 64 * j;
        { const int ksub = ksub0 + (tid >> 3);
          const bf16_t* base = (ksub >= 0) ? proj + ((size_t)b * SEQ + (size_t)ksub * dil + r) * NIN + h * 64 : nullptr;
          __syncthreads();
          stage_tile(lds, tid, base ? base + COL_KD : nullptr, base ? base + COL_VD : nullptr); }
        __syncthreads();
        if (64 * j + 63 >= 32 * wave && 64 * j <= 32 * wave + 159) {
            DilFn fn{qsub - ksub0, lut, ksub0};
            tile_step(lds, qf, o0, o1, m, l, lane, fn);
        }
    }
    const size_t rbase = (size_t)b * SEQ + (size_t)(256 * sb + 32 * wave) * dil + r;
    bf16_t* po = PO + (size_t)pi * M * 256 + h * 64;
    const float lt = store_o(lds, wave, lane, o0, o1, l, [&](int q) { return po + (rbase + (size_t)q * dil) * 256; });
    if (hi == 0) PL[((size_t)pi * M + qrow) * 4 + h] = m + __logf(lt);
}
__device__ __forceinline__ void moba_unit(LAS unsigned char* lds, int tid, int bh, int own, const bf16_t* __restrict__ proj, const float* __restrict__ kmean, const float* __restrict__ rel_bias, bf16_t* __restrict__ Y) {
    const int lane = tid & 63, wave = __builtin_amdgcn_readfirstlane(tid >> 6), r32 = lane & 31, hi = lane >> 5;
    const int b = bh >> 2, h = bh & 3;
    __syncthreads();
    LAS float* lut = (LAS float*)(lds + LUT_OFF);
    for (int d = tid; d < 1536; d += 512) lut[d] = rel_bias[t5_bucket(d) * 8 + h];
    const int qpos = 256 * own + 32 * wave + r32;
    const size_t qrow = (size_t)b * SEQ + qpos;
    bf16x8 qf[4];
#pragma unroll
    for (int s = 0; s < 4; ++s) qf[s] = *(const bf16x8*)(proj + qrow * NIN + COL_QA + h * 64 + 16 * s + 8 * hi);
    unsigned selbits = 0u;
    {
        f32x16 g;
#pragma unroll
        for (int i = 0; i < 16; ++i) g[i] = 0.f;
        const float* km = kmean + ((size_t)bh * 32 + r32) * 64;
#pragma unroll
        for (int s = 0; s < 4; ++s) {
            float kv[8];
            *(float4*)&kv[0] = *(const float4*)(km + 16 * s + 8 * hi); *(float4*)&kv[4] = *(const float4*)(km + 16 * s + 8 * hi + 4);
            u32x4 wh, wl;
#pragma unroll
            for (int j = 0; j < 4; ++j) {
                const bf16_t h0 = f2bf(kv[2 * j]), h1 = f2bf(kv[2 * j + 1]);
                const bf16_t l0 = f2bf(kv[2 * j] - bf2f(h0)), l1 = f2bf(kv[2 * j + 1] - bf2f(h1));
                wh[j] = (unsigned)h0 | ((unsigned)h1 << 16); wl[j] = (unsigned)l0 | ((unsigned)l1 << 16);
            }
            g = __builtin_amdgcn_mfma_f32_32x32x16_bf16(__builtin_bit_cast(bf16x8, wh), qf[s], g, 0, 0, 0);
            g = __builtin_amdgcn_mfma_f32_32x32x16_bf16(__builtin_bit_cast(bf16x8, wl), qf[s], g, 0, 0, 0);
        }
#pragma unroll
        for (int i = 0; i < 16; ++i) if (crow(i, hi) >= own) g[i] = -INFINITY;
#pragma unroll
        for (int t = 0; t < 3; ++t) {
            float lm = -INFINITY;
#pragma unroll
            for (int i = 0; i < 16; ++i) lm = fmaxf(lm, g[i]);
            const float gm = fmaxf(lm, __shfl_xor(lm, 32));
            int cand = 99;
#pragma unroll
            for (int i = 15; i >= 0; --i) if (g[i] == gm) cand = crow(i, hi);
            cand = min(cand, __shfl_xor(cand, 32));
            if (gm > -INFINITY) {
                selbits |= 1u << cand;
#pragma unroll
                for (int i = 0; i < 16; ++i) if (crow(i, hi) == cand) g[i] = -INFINITY;
            }
        }
    }
    f32x16 o0, o1;
#pragma unroll
    for (int i = 0; i < 16; ++i) { o0[i] = 0.f; o1[i] = 0.f; }
    float m = NEGF, l = 0.f;
    for (int n = 0; n <= own; ++n) {
        const bool allowed = (selbits >> n) & 1u;
        const bool need = (n == own) || (__ballot(allowed) != 0ull);
        for (int kt = 0; kt < 4; ++kt) {
            const int kpos0 = 256 * n + 64 * kt;
            { const bf16_t* base = proj + ((size_t)b * SEQ + kpos0 + (tid >> 3)) * NIN + h * 64;
              __syncthreads();
              stage_tile(lds, tid, base + COL_KA, base + COL_VA); }
            __syncthreads();
            if (need && (n < own || 64 * kt <= 32 * wave + 31)) {
                MobaFn fn{qpos - kpos0, lut, allowed, n == own};
                tile_step(lds, qf, o0, o1, m, l, lane, fn);
            }
        }
    }
    bf16_t* yo = Y + ((size_t)b * SEQ + 256 * own + 32 * wave) * DM + h * 64;
    store_o(lds, wave, lane, o0, o1, l, [&](int q) { return yo + (size_t)q * DM; });
}
}

namespace fa2 {
using fa::bf16x8; using fa::f32x16; using fa::v4i16_t; using fa::crow; using fa::pack8; using fa::trd;
template <class Fn> __device__ __forceinline__ void step64(LAS const unsigned char* lds, int koff, int voff, const bf16x8 (&qf)[4], f32x16& o0, f32x16& o1, float& m, float& l, int lane, const Fn& fn) {
    const int r32 = lane & 31, hi = lane >> 5;
    f32x16 p0, p1;
#pragma unroll
    for (int r = 0; r < 16; ++r) { p0[r] = 0.f; p1[r] = 0.f; }
#pragma unroll
    for (int s = 0; s < 4; ++s) {
        const int ch = ((2 * s + hi) ^ (r32 & 7)) * 16;
        const bf16x8 k0 = *(const LAS bf16x8*)(lds + koff + r32 * 128 + ch);
        const bf16x8 k1 = *(const LAS bf16x8*)(lds + koff + (32 + r32) * 128 + ch);
        p0 = __builtin_amdgcn_mfma_f32_32x32x16_bf16(k0, qf[s], p0, 0, 0, 0);
        p1 = __builtin_amdgcn_mfma_f32_32x32x16_bf16(k1, qf[s], p1, 0, 0, 0);
    }
    float mx = NEGF;
#pragma unroll
    for (int r = 0; r < 16; ++r) { p0[r] = fn(crow(r, hi), p0[r]); p1[r] = fn(32 + crow(r, hi), p1[r]); mx = fmaxf(mx, fmaxf(p0[r], p1[r])); }
    mx = fmaxf(mx, __shfl_xor(mx, 32));
    const float mn = fmaxf(m, mx), alpha = __expf(m - mn);
    m = mn;
    float ps = 0.f;
#pragma unroll
    for (int r = 0; r < 16; ++r) { p0[r] = __expf(p0[r] - mn); p1[r] = __expf(p1[r] - mn); ps += p0[r] + p1[r]; }
    l = l * alpha + ps;
#pragma unroll
    for (int r = 0; r < 16; ++r) { o0[r] *= alpha; o1[r] *= alpha; }
    const int q4 = (lane & 15) >> 2, p4 = lane & 3, dgrp = (lane >> 4) & 1;
    const int vb = voff + (4 * hi + q4) * 128 + (16 * dgrp + 4 * p4) * 2;
#define FA_PV(P, KH, S2) do { const bf16x8 pb = pack8<8 * (S2)>(P); \
        _Pragma("unroll") for (int blk = 0; blk < 2; ++blk) { const int a = vb + (32 * (KH) + 16 * (S2)) * 128 + blk * 64; \
            const v4i16_t lo = trd(lds + a), hh = trd(lds + a + 8 * 128); \
            const bf16x8 va = {lo[0], lo[1], lo[2], lo[3], hh[0], hh[1], hh[2], hh[3]}; \
            if (blk == 0) o0 = __builtin_amdgcn_mfma_f32_32x32x16_bf16(va, pb, o0, 0, 0, 0); else o1 = __builtin_amdgcn_mfma_f32_32x32x16_bf16(va, pb, o1, 0, 0, 0); } } while (0)
    FA_PV(p0, 0, 0); FA_PV(p0, 0, 1); FA_PV(p1, 1, 0); FA_PV(p1, 1, 1);
#undef FA_PV
}
struct LutFn { int qrel; LAS const float* lut; int dmax; int klo;
    __device__ __forceinline__ float operator()(int key, float s) const { const int d = qrel - key; const float b = lut[min(max(d, 0), dmax)]; return (d >= 0 && key >= klo) ? fmaf(s, 0.125f, b) : NEGF; } };
struct BandFn { int qrel; LAS const float* lut; int klo;
    __device__ __forceinline__ float operator()(int key, float s) const { const int d = qrel - key; const float b = lut[min(max(d, 0), 128)]; return (d >= 0 && d <= 128 && key >= klo) ? fmaf(s, 0.125f, b) : NEGF; } };
struct ConstFn { float b;
    __device__ __forceinline__ float operator()(int, float s) const { return fmaf(s, 0.125f, b); } };
template <int NIT, class RowFn> __device__ __forceinline__ void stage_rows(LAS unsigned char* lds, int koff, int voff, int tid, int kcol, int vcol, const RowFn& rowfn) {
    u32x4 kv[NIT], vv[NIT];
#pragma unroll
    for (int i = 0; i < NIT; ++i) { const int e = tid + 512 * i, row = e >> 3, ch = e & 7; bool ok; const bf16_t* rp = rowfn(row, ok);
        kv[i] = *(const u32x4*)(rp + kcol + ch * 8); vv[i] = *(const u32x4*)(rp + vcol + ch * 8);
        if (!ok) { kv[i] = (u32x4){0u, 0u, 0u, 0u}; vv[i] = (u32x4){0u, 0u, 0u, 0u}; } }
    __builtin_amdgcn_sched_barrier(0);
#pragma unroll
    for (int i = 0; i < NIT; ++i) { const int e = tid + 512 * i, row = e >> 3, ch = e & 7;
        *(LAS u32x4*)(lds + koff + row * 128 + ((ch ^ (row & 7)) * 16)) = kv[i];
        *(LAS u32x4*)(lds + voff + row * 128 + ch * 16) = vv[i]; }
}
template <class DstFn> __device__ __forceinline__ void store_rows(LAS unsigned char* lds, int ostoff, int lane, const f32x16& o0, const f32x16& o1, float linv, const DstFn& dst) {
    const int r32 = lane & 31, hi = lane >> 5;
    LAS bf16_t* stg = (LAS bf16_t*)(lds + ostoff);
#pragma unroll
    for (int r = 0; r < 16; ++r) { const int d = crow(r, hi); stg[r32 * 64 + d] = f2bf(o0[r] * linv); stg[r32 * 64 + 32 + d] = f2bf(o1[r] * linv); }
    asm volatile("s_waitcnt lgkmcnt(0)" ::: "memory");
#pragma unroll
    for (int i = 0; i < 4; ++i) { const int row = i * 8 + (lane >> 3), ch = lane & 7; const u32x4 v = *(const LAS u32x4*)(stg + row * 64 + ch * 8); bf16_t* p = dst(row); if (p) *(u32x4*)(p + ch * 8) = v; }
    asm volatile("s_waitcnt lgkmcnt(0)" ::: "memory");
}
constexpr int D_K = 0, D_V = 49152, D_LUT = 98304, D_OST = 0;
__device__ __forceinline__ void dilated_unit(LAS unsigned char* lds, int tid, int pi, int bh, int u, const bf16_t* __restrict__ proj, const float* __restrict__ rel_bias, bf16_t* __restrict__ PO, float* __restrict__ PL) {
    const int lane = tid & 63, wave = __builtin_amdgcn_readfirstlane(tid >> 6), r32 = lane & 31, hi = lane >> 5;
    const int dil = (pi == 0) ? 1 : (pi == 1) ? 4 : 16, b = bh >> 2, h = bh & 3;
    const int r = u % dil, sb = u / dil;
    __syncthreads();
    LAS float* lut = (LAS float*)(lds + D_LUT);
    if (tid <= 128) lut[tid] = rel_bias[t5_bucket(tid * dil) * 8 + 4 + h];
    const int ks0 = 256 * sb - 128;
    stage_rows<6>(lds, D_K, D_V, tid, COL_KD + h * 64, COL_VD + h * 64, [&](int row, bool& ok) -> const bf16_t* { const int ks = ks0 + row; ok = ks >= 0; return proj + ((size_t)b * SEQ + (size_t)max(ks, 0) * dil + r) * NIN; });
    const int qsub = 256 * sb + 32 * wave + r32;
    const size_t qrow = (size_t)b * SEQ + (size_t)qsub * dil + r;
    bf16x8 qf[4];
#pragma unroll
    for (int s = 0; s < 4; ++s) qf[s] = *(const bf16x8*)(proj + qrow * NIN + COL_QD + h * 64 + 16 * s + 8 * hi);
    f32x16 o0, o1;
#pragma unroll
    for (int i = 0; i < 16; ++i) { o0[i] = 0.f; o1[i] = 0.f; }
    float m = NEGF, l = 0.f;
    __syncthreads();
    const int j0 = wave >> 1;
#pragma unroll 1
    for (int j = j0; j < j0 + 3; ++j) {
        if (ks0 + 64 * j + 63 < 0) continue;
        BandFn fn{32 * wave + r32 + 128 - 64 * j, lut, -(ks0 + 64 * j)};
        step64(lds, D_K + j * 8192, D_V + j * 8192, qf, o0, o1, m, l, lane, fn);
    }
    __syncthreads();
    l += __shfl_xor(l, 32);
    const size_t rbase = (size_t)b * SEQ + (size_t)(256 * sb + 32 * wave) * dil + r;
    bf16_t* po = PO + (size_t)pi * M * 256 + h * 64;
    store_rows(lds, D_OST + wave * 4096, lane, o0, o1, 1.0f / l, [&](int q) { return po + (rbase + (size_t)q * dil) * 256; });
    if (hi == 0) PL[((size_t)pi * M + qrow) * 4 + h] = m + __logf(l);
}
__device__ __forceinline__ void gate_item(LAS unsigned char* lds, int tid, int bh, int own, const bf16_t* __restrict__ proj, const float* __restrict__ kp, unsigned short* __restrict__ LIST, int* __restrict__ CNT) {
    const int lane = tid & 63, wave = __builtin_amdgcn_readfirstlane(tid >> 6), r32 = lane & 31, hi = lane >> 5;
    const int b = bh >> 2, h = bh & 3;
    LAS int* cnt = (LAS int*)lds;
    __syncthreads();
    if (tid < 32) cnt[tid] = 0;
    __syncthreads();
    const int qib = 32 * wave + r32;
    const size_t qrow = (size_t)b * SEQ + 256 * own + qib;
    bf16x8 qf[4];
#pragma unroll
    for (int s = 0; s < 4; ++s) qf[s] = *(const bf16x8*)(proj + qrow * NIN + COL_QA + h * 64 + 16 * s + 8 * hi);
    f32x16 g;
#pragma unroll
    for (int i = 0; i < 16; ++i) g[i] = 0.f;
    const float* k0 = kp + (size_t)((b * 32 + r32) * 2) * 256 + h * 64;
#pragma unroll
    for (int s = 0; s < 4; ++s) {
        float kv[8];
#pragma unroll
        for (int j = 0; j < 8; j += 4) { const float4 a = *(const float4*)(k0 + 16 * s + 8 * hi + j), c = *(const float4*)(k0 + 256 + 16 * s + 8 * hi + j);
            kv[j] = (a.x + c.x) * (1.0f / 256.0f); kv[j + 1] = (a.y + c.y) * (1.0f / 256.0f); kv[j + 2] = (a.z + c.z) * (1.0f / 256.0f); kv[j + 3] = (a.w + c.w) * (1.0f / 256.0f); }
        u32x4 wh, wl;
#pragma unroll
        for (int j = 0; j < 4; ++j) {
            const bf16_t h0 = f2bf(kv[2 * j]), h1 = f2bf(kv[2 * j + 1]);
            const bf16_t l0 = f2bf(kv[2 * j] - bf2f(h0)), l1 = f2bf(kv[2 * j + 1] - bf2f(h1));
            wh[j] = (unsigned)h0 | ((unsigned)h1 << 16); wl[j] = (unsigned)l0 | ((unsigned)l1 << 16);
        }
        g = __builtin_amdgcn_mfma_f32_32x32x16_bf16(__builtin_bit_cast(bf16x8, wh), qf[s], g, 0, 0, 0);
        g = __builtin_amdgcn_mfma_f32_32x32x16_bf16(__builtin_bit_cast(bf16x8, wl), qf[s], g, 0, 0, 0);
    }
#pragma unroll
    for (int i = 0; i < 16; ++i) if (crow(i, hi) >= own) g[i] = -INFINITY;
#pragma unroll
    for (int t = 0; t < 3; ++t) {
        float lm = -INFINITY;
#pragma unroll
        for (int i = 0; i < 16; ++i) lm = fmaxf(lm, g[i]);
        const float gm = fmaxf(lm, __shfl_xor(lm, 32));
        int cand = 99;
#pragma unroll
        for (int i = 15; i >= 0; --i) if (g[i] == gm) cand = crow(i, hi);
        cand = min(cand, __shfl_xor(cand, 32));
        if (gm > -INFINITY) {
#pragma unroll
            for (int i = 0; i < 16; ++i) if (crow(i, hi) == cand) g[i] = -INFINITY;
            if (hi == 0) { const int pos = atomicAdd((int*)&cnt[cand], 1); LIST[(((size_t)bh * 32 + cand) * 32 + own) * 256 + pos] = (unsigned short)((t << 8) | qib); }
        }
    }
    __syncthreads();
    if (tid < 32) CNT[((size_t)bh * 32 + tid) * 32 + own] = (tid < own) ? cnt[tid] : 0;
}
constexpr int M_K = 0, M_V = 32768, M_LUT = 65536, M_OST = 73728;
__device__ __forceinline__ void moba_item(LAS unsigned char* lds, int tid, int bh, int n, const bf16_t* __restrict__ proj, const float* __restrict__ rel_bias, const unsigned short* __restrict__ LIST, const int* __restrict__ CNT,
                                          bf16_t* __restrict__ PARTO, float* __restrict__ PARTML, bf16_t* __restrict__ Y) {
    const int lane = tid & 63, wave = __builtin_amdgcn_readfirstlane(tid >> 6), r32 = lane & 31, hi = lane >> 5;
    const int b = bh >> 2, h = bh & 3;
    __syncthreads();
    LAS float* lut = (LAS float*)(lds + M_LUT);
    for (int d = tid; d < 1792; d += 512) lut[d] = rel_bias[t5_bucket(d) * 8 + h];
    const bf16_t* kvb = proj + ((size_t)b * SEQ + 256 * n) * NIN;
    stage_rows<4>(lds, M_K, M_V, tid, COL_KA + h * 64, COL_VA + h * 64, [&](int row, bool& ok) -> const bf16_t* { ok = true; return kvb + (size_t)row * NIN; });
    int nt = 0;
    if (lane < 32) { if (lane == n) nt = 8; else if (lane > n) nt = (CNT[((size_t)bh * 32 + n) * 32 + lane] + 31) >> 5; }
    int st = nt;
#pragma unroll
    for (int o = 1; o < 32; o <<= 1) { const int v = __shfl_up(st, o); if ((lane & 31) >= o) st += v; }
    st -= nt;
    const int T = __shfl(st + nt, 31);
    const float b31 = rel_bias[31 * 8 + h];
    __syncthreads();
#pragma unroll 1
    for (int t = wave; t < T; t += 8) {
        const int seg = __popcll(__ballot(lane < 32 && st <= t)) - 1;
        const int lt = t - __shfl(st, seg);
        int slot = 3, qib = 32 * lt + r32; bool live = true;
        if (seg != n) { const int c = CNT[((size_t)bh * 32 + n) * 32 + seg]; const int e = 32 * lt + r32; live = e < c;
            const unsigned short en = LIST[(((size_t)bh * 32 + n) * 32 + seg) * 256 + (live ? e : 0)]; slot = en >> 8; qib = en & 255; }
        const int qpos = 256 * seg + qib;
        const size_t qrow = (size_t)b * SEQ + qpos;
        bf16x8 qf[4];
#pragma unroll
        for (int s = 0; s < 4; ++s) qf[s] = *(const bf16x8*)(proj + qrow * NIN + COL_QA + h * 64 + 16 * s + 8 * hi);
        f32x16 o0, o1;
#pragma unroll
        for (int i = 0; i < 16; ++i) { o0[i] = 0.f; o1[i] = 0.f; }
        float m = NEGF, l = 0.f;
        if (seg == n) {
            const int nks = (32 * lt + 31) / 64 + 1;
            for (int ks = 0; ks < nks; ++ks) { LutFn fn{qib - 64 * ks, lut, 1791, 0}; step64(lds, M_K + ks * 8192, M_V + ks * 8192, qf, o0, o1, m, l, lane, fn); }
        } else if (seg - n >= 7) {
            ConstFn fn{b31};
#pragma unroll 1
            for (int ks = 0; ks < 4; ++ks) step64(lds, M_K + ks * 8192, M_V + ks * 8192, qf, o0, o1, m, l, lane, fn);
        } else {
#pragma unroll 1
            for (int ks = 0; ks < 4; ++ks) { LutFn fn{qpos - 256 * n - 64 * ks, lut, 1791, 0}; step64(lds, M_K + ks * 8192, M_V + ks * 8192, qf, o0, o1, m, l, lane, fn); }
        }
        l += __shfl_xor(l, 32);
        bf16_t* dstp = nullptr;
        if (live) dstp = (slot == 3) ? Y + qrow * DM + h * 64 : PARTO + ((qrow * 4 + h) * 3 + slot) * 64;
        const unsigned long long dl = (unsigned long long)dstp;
        store_rows(lds, M_OST + wave * 4096, lane, o0, o1, 1.0f / l, [&](int q) { return (bf16_t*)__shfl(dl, q); });
        if (live && hi == 0) { float2 ml; ml.x = m; ml.y = l; *(float2*)(PARTML + ((qrow * 4 + h) * 4 + slot) * 2) = ml; }
    }
}
}

namespace hg {
typedef short bf16x8 __attribute__((ext_vector_type(8)));
typedef float f32x4 __attribute__((ext_vector_type(4)));
typedef unsigned u32x2 __attribute__((ext_vector_type(2)));
constexpr int SEG_OFF = 0, BT_OFF = 2048, VT_OFF = 18432, KT_OFF = 26624;
constexpr int QS_OFF = 26624, QD_OFF = 34816, QO_OFF = 43008, KD_OFF = 51200, KO_OFF = 59392;
__device__ __forceinline__ void img_put(LAS unsigned char* lds, int off, int row, int d, float v) { *(LAS bf16_t*)(lds + off + row * 128 + ((((d >> 3) ^ (row & 7))) << 4) + (d & 7) * 2) = f2bf(v); }
__device__ __forceinline__ bf16x8 img_frag(LAS const unsigned char* lds, int off, int row, int chunk) { return *(const LAS bf16x8*)(lds + off + row * 128 + ((chunk ^ (row & 7)) << 4)); }
__device__ __forceinline__ unsigned cvtpk(float lo, float hi) { return cvtpk_s(lo, hi); }
struct Ch { float f[8], b[8], qv[8], iv[8], blast; };
template <bool NEEDQ> __device__ __forceinline__ void stage(LAS unsigned char* lds, int wave, int lane, const bf16_t* __restrict__ rowp  , float lb, Ch& c) {
    float cs = 0.f;
#pragma unroll
    for (int i = 0; i < 8; ++i) {
        const bf16_t* r = rowp + (size_t)(8 * wave + i) * NIN + lane;
        const float fp = bf2f(r[COL_FC]); c.iv[i] = bf2f(r[COL_IC]);
        if (NEEDQ) { const float q = bf2f(r[COL_QC]); c.qv[i] = q / (1.0f + __expf(-q)) * 0.125f; }
        c.f[i] = lb + (1.0f - lb) / (1.0f + __expf(-fp));
        cs += __logf(c.f[i]); c.b[i] = cs;
    }
    LAS float* seg = (LAS float*)(lds + SEG_OFF);
    seg[wave * 64 + lane] = cs;
    __syncthreads();
    float off = 0.f, tot = 0.f;
#pragma unroll
    for (int w = 0; w < 8; ++w) { const float s = seg[w * 64 + lane]; tot += s; if (w < wave) off += s; }
#pragma unroll
    for (int i = 0; i < 8; ++i) c.b[i] += off;
    c.blast = tot;
}
__device__ __forceinline__ void x1_item(LAS unsigned char* lds, int wave, int lane, int item, const bf16_t* __restrict__ proj, const float* __restrict__ lbp, float* __restrict__ DS, float* __restrict__ DEC) {
    const int bh = item >> 7, ch = item & 127, b = bh >> 2, h = bh & 3;
    __syncthreads();
    Ch c; stage<false>(lds, wave, lane, proj + ((size_t)b * SEQ + ch * 64) * NIN + h * 64, lbp[h * 64 + lane], c);
    u32x4 kw, vw;
#pragma unroll
    for (int j = 0; j < 4; ++j) {
        kw[j] = cvtpk((1.0f - c.f[2 * j]) * __expf(c.blast - c.b[2 * j]), (1.0f - c.f[2 * j + 1]) * __expf(c.blast - c.b[2 * j + 1]));
        vw[j] = cvtpk(c.iv[2 * j], c.iv[2 * j + 1]);
    }
    *(LAS u32x4*)(lds + KT_OFF + lane * 128 + ((wave ^ (lane & 7)) << 4)) = kw;
    *(LAS u32x4*)(lds + VT_OFF + lane * 128 + ((wave ^ (lane & 7)) << 4)) = vw;
    if (wave == 0) DEC[(size_t)item * 64 + lane] = __expf(c.blast);
    __syncthreads();
    const int fr = lane & 15, quad = lane >> 4, mt = wave >> 1;
#pragma unroll
    for (int n2 = 0; n2 < 2; ++n2) {
        const int nt = 2 * (wave & 1) + n2;
        f32x4 acc = {0.f, 0.f, 0.f, 0.f};
#pragma unroll
        for (int kk = 0; kk < 2; ++kk)
            acc = __builtin_amdgcn_mfma_f32_16x16x32_bf16(img_frag(lds, VT_OFF, 16 * mt + fr, quad + 4 * kk), img_frag(lds, KT_OFF, 16 * nt + fr, quad + 4 * kk), acc, 0, 0, 0);
        float* o = DS + (size_t)item * 4096 + (16 * mt + 4 * quad) * 64 + 16 * nt + fr;
#pragma unroll
        for (int r = 0; r < 4; ++r) o[r * 64] = acc[r];
    }
}
__device__ __forceinline__ void x2_scan(int gtid, int nthreads, const float* __restrict__ DS, const float* __restrict__ DEC, bf16_t* __restrict__ ST) {
    for (int e = gtid; e < 16 * 1024; e += nthreads) {
        const int bh = e >> 10, q = e & 1023;
        const int d4 = q & 15;
        f32x4 s = {0.f, 0.f, 0.f, 0.f};
#pragma unroll 1
        for (int c0 = 0; c0 < 128; c0 += 8) {
            f32x4 ds[8], de[8];
#pragma unroll
            for (int i = 0; i < 8; ++i) { const size_t it = (size_t)bh * 128 + c0 + i; ds[i] = *(const f32x4*)(DS + it * 4096 + q * 4); de[i] = *(const f32x4*)(DEC + it * 64 + d4 * 4); }
#pragma unroll
            for (int i = 0; i < 8; ++i) { const size_t it = (size_t)bh * 128 + c0 + i;
                uint2 w; w.x = cvtpk(s[0], s[1]); w.y = cvtpk(s[2], s[3]); *(uint2*)(ST + it * 4096 + q * 4) = w;
                s = s * de[i] + ds[i]; }
        }
    }
}
__device__ __forceinline__ void x3_item(LAS unsigned char* lds, int wave, int lane, int item, const bf16_t* __restrict__ proj, const float* __restrict__ lbp, const bf16_t* __restrict__ ST, bf16_t* __restrict__ Y) {
    const int bh = item >> 7, ch = item & 127, b = bh >> 2, h = bh & 3;
    __syncthreads();
    Ch c; stage<true>(lds, wave, lane, proj + ((size_t)b * SEQ + ch * 64) * NIN + h * 64, lbp[h * 64 + lane], c);
    LAS float* bt = (LAS float*)(lds + BT_OFF);
#pragma unroll
    for (int i = 0; i < 8; ++i) bt[(8 * wave + i) * 64 + lane] = c.b[i];
    { u32x4 vw;
#pragma unroll
      for (int j = 0; j < 4; ++j) vw[j] = cvtpk(c.iv[2 * j], c.iv[2 * j + 1]);
      *(LAS u32x4*)(lds + VT_OFF + lane * 128 + ((wave ^ (lane & 7)) << 4)) = vw; }
    __syncthreads();
    {
        const int I = wave >> 1;
        const float cI = bt[(16 * I + 7) * 64 + lane];
        const float rI = (I > 0) ? bt[(16 * I - 1) * 64 + lane] : 0.f;
        float rN[3];
#pragma unroll
        for (int ip = 1; ip < 4; ++ip) rN[ip - 1] = bt[(16 * ip - 1) * 64 + lane];
#pragma unroll
        for (int i = 0; i < 8; ++i) {
            const int t = 8 * wave + i; const float bb = c.b[i], q = c.qv[i], k = 1.0f - c.f[i];
            img_put(lds, QS_OFF, t, lane, q * __expf(bb));
            img_put(lds, QD_OFF, t, lane, q * __expf(bb - cI));
            img_put(lds, QO_OFF, t, lane, q * __expf(bb - rI));
            img_put(lds, KD_OFF, t, lane, k * __expf(cI - bb));
#pragma unroll
            for (int ip = 1; ip < 4; ++ip) if (ip > I) img_put(lds, KO_OFF + (ip - 1) * 8192, t, lane, k * __expf(rN[ip - 1] - bb));
        }
    }
    __syncthreads();
    const int fr = lane & 15, quad = lane >> 4, I = wave >> 1, vh = wave & 1;
    unsigned sc[4][2];
#pragma unroll
    for (int J = 0; J < 4; ++J) {
        sc[J][0] = 0u; sc[J][1] = 0u;
        if (J <= I) {
            f32x4 acc = {0.f, 0.f, 0.f, 0.f};
            const int ko = (J < I) ? KO_OFF + (I - 1) * 8192 : KD_OFF, qo = (J < I) ? QO_OFF : QD_OFF;
#pragma unroll
            for (int kk = 0; kk < 2; ++kk)
                acc = __builtin_amdgcn_mfma_f32_16x16x32_bf16(img_frag(lds, ko, 16 * J + fr, quad + 4 * kk), img_frag(lds, qo, 16 * I + fr, quad + 4 * kk), acc, 0, 0, 0);
            if (J == I) {
#pragma unroll
                for (int r = 0; r < 4; ++r) if (4 * quad + r > fr) acc[r] = 0.f;
            }
            sc[J][0] = cvtpk(acc[0], acc[1]); sc[J][1] = cvtpk(acc[2], acc[3]);
        }
    }
    const bf16_t* stp = ST + (size_t)item * 4096;
    const size_t orow = (size_t)b * SEQ + ch * 64 + 16 * I + fr;
#pragma unroll
    for (int m2 = 0; m2 < 2; ++m2) {
        const int mt = 2 * vh + m2, v = 16 * mt + fr;
        f32x4 acc = {0.f, 0.f, 0.f, 0.f};
#pragma unroll
        for (int ks = 0; ks < 2; ++ks) {
            if (2 * ks <= I) {
                u32x4 bw, aw;
                bw[0] = sc[2 * ks][0]; bw[1] = sc[2 * ks][1]; bw[2] = sc[2 * ks + 1][0]; bw[3] = sc[2 * ks + 1][1];
                const LAS unsigned char* vr = lds + VT_OFF + v * 128;
                const u32x2 a0 = *(const LAS u32x2*)(vr + (((4 * ks + (quad >> 1)) ^ (v & 7)) << 4) + (quad & 1) * 8);
                u32x2 a1 = {0u, 0u};
                if (2 * ks + 1 <= I) a1 = *(const LAS u32x2*)(vr + (((4 * ks + 2 + (quad >> 1)) ^ (v & 7)) << 4) + (quad & 1) * 8);
                aw[0] = a0.x; aw[1] = a0.y; aw[2] = a1.x; aw[3] = a1.y;
                acc = __builtin_amdgcn_mfma_f32_16x16x32_bf16(__builtin_bit_cast(bf16x8, aw), __builtin_bit_cast(bf16x8, bw), acc, 0, 0, 0);
            }
        }
#pragma unroll
        for (int kk = 0; kk < 2; ++kk) {
            const bf16x8 sa = *(const bf16x8*)(stp + v * 64 + 8 * quad + 32 * kk);
            acc = __builtin_amdgcn_mfma_f32_16x16x32_bf16(sa, img_frag(lds, QS_OFF, 16 * I + fr, quad + 4 * kk), acc, 0, 0, 0);
        }
        uint2 w; w.x = cvtpk(acc[0], acc[1]); w.y = cvtpk(acc[2], acc[3]);
        *(uint2*)(Y + orow * DM + 512 + h * 64 + 16 * mt + 4 * quad) = w;
    }
}
}

namespace hw {
typedef short bf16x8 __attribute__((ext_vector_type(8)));
typedef float f32x4 __attribute__((ext_vector_type(4)));
typedef unsigned u32x2 __attribute__((ext_vector_type(2)));
#define HW_LDSW() asm volatile("s_waitcnt lgkmcnt(0)" ::: "memory")
__device__ __forceinline__ bf16x8 frag128(LAS const unsigned char* base, int row, int chunk) { return *(const LAS bf16x8*)(base + row * 128 + ((chunk ^ (row & 7)) << 4)); }
__device__ __forceinline__ void x1_wave(LAS unsigned char* wl, int lane, int item, const bf16_t* __restrict__ proj, const float* __restrict__ lbp, float* __restrict__ DS, float* __restrict__ DEC) {
    const int bh = item >> 7, ch = item & 127, b = bh >> 2, h = bh & 3;
    const bf16_t* rp = proj + ((size_t)b * SEQ + ch * 64) * NIN + h * 64 + lane;
    const float lb = lbp[h * 64 + lane];
    float f[64]; float cs = 0.f;
    HW_LDSW();
#pragma unroll
    for (int g2 = 0; g2 < 4; ++g2) {
        unsigned short rf[16], ri[16];
#pragma unroll
        for (int i = 0; i < 16; ++i) { const bf16_t* r = rp + (size_t)(16 * g2 + i) * NIN; rf[i] = r[COL_FC]; ri[i] = r[COL_IC]; }
        __builtin_amdgcn_sched_barrier(0);
#pragma unroll
        for (int i = 0; i < 16; ++i) { const float ff = lb + (1.0f - lb) / (1.0f + __expf(-bf2f(rf[i]))); f[16 * g2 + i] = ff; cs += __logf(ff); }
#pragma unroll
        for (int q = 0; q < 2; ++q) { const int g = 2 * g2 + q;
            u32x4 vw; vw[0] = (unsigned)ri[8 * q] | ((unsigned)ri[8 * q + 1] << 16); vw[1] = (unsigned)ri[8 * q + 2] | ((unsigned)ri[8 * q + 3] << 16);
            vw[2] = (unsigned)ri[8 * q + 4] | ((unsigned)ri[8 * q + 5] << 16); vw[3] = (unsigned)ri[8 * q + 6] | ((unsigned)ri[8 * q + 7] << 16);
            *(LAS u32x4*)(wl + 8192 + lane * 128 + ((g ^ (lane & 7)) << 4)) = vw; }
    }
    const float blast = cs; cs = 0.f;
#pragma unroll
    for (int g = 0; g < 8; ++g) {
        float kh[8];
#pragma unroll
        for (int i = 0; i < 8; ++i) { const float ff = f[8 * g + i]; cs += __logf(ff); kh[i] = (1.0f - ff) * __expf(blast - cs); }
        u32x4 kw; kw[0] = cvtpk_s(kh[0], kh[1]); kw[1] = cvtpk_s(kh[2], kh[3]); kw[2] = cvtpk_s(kh[4], kh[5]); kw[3] = cvtpk_s(kh[6], kh[7]);
        *(LAS u32x4*)(wl + lane * 128 + ((g ^ (lane & 7)) << 4)) = kw;
    }
    DEC[(size_t)item * 64 + lane] = __expf(blast);
    HW_LDSW();
    const int fr = lane & 15, quad = lane >> 4;
    float* dsp = DS + (size_t)item * 4096;
#pragma unroll
    for (int mt = 0; mt < 4; ++mt) {
        const bf16x8 a0 = frag128(wl + 8192, 16 * mt + fr, quad), a1 = frag128(wl + 8192, 16 * mt + fr, quad + 4);
#pragma unroll
        for (int nt = 0; nt < 4; ++nt) {
            f32x4 acc = {0.f, 0.f, 0.f, 0.f};
            acc = __builtin_amdgcn_mfma_f32_16x16x32_bf16(a0, frag128(wl, 16 * nt + fr, quad), acc, 0, 0, 0);
            acc = __builtin_amdgcn_mfma_f32_16x16x32_bf16(a1, frag128(wl, 16 * nt + fr, quad + 4), acc, 0, 0, 0);
            float* o = dsp + (16 * mt + 4 * quad) * 64 + 16 * nt + fr;
#pragma unroll
            for (int r = 0; r < 4; ++r) o[r * 64] = acc[r];
        }
    }
    HW_LDSW();
}
__device__ __forceinline__ void x3_wave(LAS unsigned char* wl, int lane, int item, const bf16_t* __restrict__ proj, const float* __restrict__ lbp, const bf16_t* __restrict__ ST, bf16_t* __restrict__ Y) {
    const int bh = item >> 7, ch = item & 127, b = bh >> 2, h = bh & 3;
    const int fr = lane & 15, quad = lane >> 4;
    const bf16_t* rp = proj + ((size_t)b * SEQ + ch * 64) * NIN + h * 64 + lane;
    const float lb = lbp[h * 64 + lane];
    f32x4 S[4][4];
    { const bf16_t* sp = ST + (size_t)item * 4096;
#pragma unroll
      for (int tv = 0; tv < 4; ++tv)
#pragma unroll
          for (int td = 0; td < 4; ++td) { const uint2 w = *(const uint2*)(sp + (16 * tv + fr) * 64 + 16 * td + 4 * quad);
              S[td][tv] = (f32x4){__uint_as_float(w.x << 16), __uint_as_float(w.x & 0xffff0000u), __uint_as_float(w.y << 16), __uint_as_float(w.y & 0xffff0000u)}; } }
    LAS float* decl = (LAS float*)(wl + 10240);
    unsigned short nf[16], nq[16], ni[16];
#pragma unroll
    for (int i = 0; i < 16; ++i) { const bf16_t* r = rp + (size_t)i * NIN; nf[i] = r[COL_FC]; nq[i] = r[COL_QC]; ni[i] = r[COL_IC]; }
#pragma unroll 1
    for (int I = 0; I < 4; ++I) {
        float ff[16], qv[16], iv[16], bb[16];
#pragma unroll
        for (int i = 0; i < 16; ++i) { ff[i] = bf2f(nf[i]); qv[i] = bf2f(nq[i]); iv[i] = bf2f(ni[i]); }
        { const int In = I < 3 ? I + 1 : 3;
#pragma unroll
          for (int i = 0; i < 16; ++i) { const bf16_t* r = rp + (size_t)(16 * In + i) * NIN; nf[i] = r[COL_FC]; nq[i] = r[COL_QC]; ni[i] = r[COL_IC]; } }
        __builtin_amdgcn_sched_barrier(0);
        float cs = 0.f;
#pragma unroll
        for (int i = 0; i < 16; ++i) { ff[i] = lb + (1.0f - lb) / (1.0f + __expf(-ff[i])); cs += __logf(ff[i]); bb[i] = cs; qv[i] = qv[i] / (1.0f + __expf(-qv[i])) * 0.125f; }
        const float cm = bb[7], be = bb[15];
        HW_LDSW();
        { u32x4 v0, v1, k0, k1;
#pragma unroll
          for (int j = 0; j < 4; ++j) { v0[j] = cvtpk_s(iv[2 * j], iv[2 * j + 1]); v1[j] = cvtpk_s(iv[8 + 2 * j], iv[9 + 2 * j]);
              k0[j] = cvtpk_s((1.0f - ff[2 * j]) * __expf(be - bb[2 * j]), (1.0f - ff[2 * j + 1]) * __expf(be - bb[2 * j + 1]));
              k1[j] = cvtpk_s((1.0f - ff[8 + 2 * j]) * __expf(be - bb[8 + 2 * j]), (1.0f - ff[9 + 2 * j]) * __expf(be - bb[9 + 2 * j])); }
          *(LAS u32x4*)(wl + 8192 + lane * 32) = v0; *(LAS u32x4*)(wl + 8192 + lane * 32 + 16) = v1;
          *(LAS u32x4*)(wl + 6144 + lane * 32) = k0; *(LAS u32x4*)(wl + 6144 + lane * 32 + 16) = k1; }
        decl[lane] = __expf(be);
#pragma unroll
        for (int i = 0; i < 16; ++i) {
            const int off = i * 128 + ((((lane >> 3) ^ (i & 7))) << 4) + (lane & 7) * 2;
            *(LAS bf16_t*)(wl + off) = f2bf(qv[i] * __expf(bb[i]));
            *(LAS bf16_t*)(wl + 2048 + off) = f2bf(qv[i] * __expf(bb[i] - cm));
            *(LAS bf16_t*)(wl + 4096 + off) = f2bf((1.0f - ff[i]) * __expf(cm - bb[i]));
        }
        HW_LDSW();
        f32x4 sc = {0.f, 0.f, 0.f, 0.f};
        sc = __builtin_amdgcn_mfma_f32_16x16x32_bf16(frag128(wl + 4096, fr, quad), frag128(wl + 2048, fr, quad), sc, 0, 0, 0);
        sc = __builtin_amdgcn_mfma_f32_16x16x32_bf16(frag128(wl + 4096, fr, quad + 4), frag128(wl + 2048, fr, quad + 4), sc, 0, 0, 0);
#pragma unroll
        for (int r = 0; r < 4; ++r) if (4 * quad + r > fr) sc[r] = 0.f;
        u32x4 scb; scb[0] = cvtpk_s(sc[0], sc[1]); scb[1] = cvtpk_s(sc[2], sc[3]); scb[2] = 0u; scb[3] = 0u;
        u32x4 qi[2];
#pragma unroll
        for (int ks = 0; ks < 2; ++ks) {
            const u32x2 lo = *(const LAS u32x2*)(wl + fr * 128 + ((((4 * ks + (quad >> 1))) ^ (fr & 7)) << 4) + (quad & 1) * 8);
            const u32x2 hi2 = *(const LAS u32x2*)(wl + fr * 128 + ((((4 * ks + 2 + (quad >> 1))) ^ (fr & 7)) << 4) + (quad & 1) * 8);
            qi[ks] = (u32x4){lo[0], lo[1], hi2[0], hi2[1]};
        }
        const size_t orow = (size_t)b * SEQ + ch * 64 + 16 * I + fr;
#pragma unroll
        for (int tv = 0; tv < 4; ++tv) {
            const u32x2 vt = *(const LAS u32x2*)(wl + 8192 + (16 * tv + fr) * 32 + quad * 8);
            f32x4 acc = {0.f, 0.f, 0.f, 0.f};
            acc = __builtin_amdgcn_mfma_f32_16x16x32_bf16(__builtin_bit_cast(bf16x8, (u32x4){vt[0], vt[1], 0u, 0u}), __builtin_bit_cast(bf16x8, scb), acc, 0, 0, 0);
#pragma unroll
            for (int ks = 0; ks < 2; ++ks) {
                u32x4 sa; sa[0] = cvtpk_s(S[2 * ks][tv][0], S[2 * ks][tv][1]); sa[1] = cvtpk_s(S[2 * ks][tv][2], S[2 * ks][tv][3]);
                sa[2] = cvtpk_s(S[2 * ks + 1][tv][0], S[2 * ks + 1][tv][1]); sa[3] = cvtpk_s(S[2 * ks + 1][tv][2], S[2 * ks + 1][tv][3]);
                acc = __builtin_amdgcn_mfma_f32_16x16x32_bf16(__builtin_bit_cast(bf16x8, sa), __builtin_bit_cast(bf16x8, qi[ks]), acc, 0, 0, 0);
            }
            uint2 w; w.x = cvtpk_s(acc[0], acc[1]); w.y = cvtpk_s(acc[2], acc[3]);
            *(uint2*)(Y + orow * DM + 512 + h * 64 + 16 * tv + 4 * quad) = w;
        }
        if (I < 3) {
#pragma unroll
            for (int td = 0; td < 4; ++td) {
                const f32x4 dc = *(const LAS f32x4*)(wl + 10240 + (16 * td + 4 * quad) * 4);
                const u32x2 kt = *(const LAS u32x2*)(wl + 6144 + (16 * td + fr) * 32 + quad * 8);
                const bf16x8 ka = __builtin_bit_cast(bf16x8, (u32x4){kt[0], kt[1], 0u, 0u});
#pragma unroll
                for (int tv = 0; tv < 4; ++tv) {
                    const u32x2 vt = *(const LAS u32x2*)(wl + 8192 + (16 * tv + fr) * 32 + quad * 8);
                    S[td][tv] = __builtin_amdgcn_mfma_f32_16x16x32_bf16(ka, __builtin_bit_cast(bf16x8, (u32x4){vt[0], vt[1], 0u, 0u}), S[td][tv] * dc, 0, 0, 0);
                }
            }
        }
    }
    HW_LDSW();
}
}

namespace s5 {
typedef short bf16x8 __attribute__((ext_vector_type(8)));
typedef float f32x4 __attribute__((ext_vector_type(4)));
__device__ __forceinline__ void cpow(double dt, double ar, double ai, int n, double& pr, double& pi) { const double mg = exp(n * dt * ar); double sn, cs; sincos_d(n * dt * ai, sn, cs); pr = mg * cs; pi = mg * sn; }
__device__ __forceinline__ void zfac(double dt, double ar, double ai, double& zr, double& zi) {
    double are, aim; cpow(dt, ar, ai, 1, are, aim);
    const double nr = are - 1.0, ni = aim, den = ar * ar + ai * ai; zr = (nr * ar + ni * ai) / den; zi = (ni * ar - nr * ai) / den;
}
__device__ __forceinline__ void tables_thread(int e, const float* a_re, const float* a_im, const float* log_dt, const float* b_re, const float* b_im, const float* c_re, const float* c_im,
                                              bf16_t* W1, bf16_t* W3, float* a64) {
    const int st = e & 63, p = (e >> 6) & 63, lg = e >> 12;
    const int id = lg * 64 + p;
    const double dt = exp((double)log_dt[lg]), ar = a_re[id], ai = a_im[id];
    double zr, zi; zfac(dt, ar, ai, zr, zi);
    { double pr, pi; cpow(dt, ar, ai, 63 - st, pr, pi);
      unsigned wr[8], wi[8];
#pragma unroll
      for (int c2 = 0; c2 < 8; ++c2) {
          float vr[2], vi[2];
#pragma unroll
          for (int q = 0; q < 2; ++q) { const int c = 2 * c2 + q; const double br = b_re[id * 16 + c], bi = b_im[id * 16 + c];
              const double bbr = zr * br - zi * bi, bbi = zr * bi + zi * br; vr[q] = (float)(pr * bbr - pi * bbi); vi[q] = (float)(pr * bbi + pi * bbr); }
          wr[c2] = pk2(vr[0], vr[1]); wi[c2] = pk2(vi[0], vi[1]);
      }
      u32x4* o0 = (u32x4*)(W1 + ((size_t)(lg * 128 + 2 * p) * 1024 + st * 16)); u32x4* o1 = (u32x4*)(W1 + ((size_t)(lg * 128 + 2 * p + 1) * 1024 + st * 16));
      o0[0] = (u32x4){wr[0], wr[1], wr[2], wr[3]}; o0[1] = (u32x4){wr[4], wr[5], wr[6], wr[7]};
      o1[0] = (u32x4){wi[0], wi[1], wi[2], wi[3]}; o1[1] = (u32x4){wi[4], wi[5], wi[6], wi[7]}; }
    { double pr, pi; cpow(dt, ar, ai, st + 1, pr, pi);
      for (int c = 0; c < 16; ++c) { const double cr = c_re[(lg * 16 + c) * 64 + p], ci = c_im[(lg * 16 + c) * 64 + p];
          *(unsigned*)(W3 + ((size_t)(lg * 1024 + st * 16 + c) * 128 + 2 * p)) = pk2((float)(cr * pr - ci * pi), -(float)(cr * pi + ci * pr)); }
      if (st == 63) { a64[id * 2] = (float)pr; a64[id * 2 + 1] = (float)pi; } }
}
__device__ __forceinline__ void kmat_item(LAS float* scr, int tid, int item, const float* a_re, const float* a_im, const float* log_dt, const float* b_re, const float* b_im, const float* c_re, const float* c_im, const float* dskip, bf16_t* KM) {
    const int tau = item & 63, lg = item >> 6;
    __syncthreads();
    { const int p = tid >> 3, c0 = (tid & 7) * 2, id = lg * 64 + p;
      const double dt = exp((double)log_dt[lg]), ar = a_re[id], ai = a_im[id];
      double zr, zi, pr, pi; zfac(dt, ar, ai, zr, zi); cpow(dt, ar, ai, tau, pr, pi);
#pragma unroll
      for (int q = 0; q < 2; ++q) { const int c = c0 + q; const double br = b_re[id * 16 + c], bi = b_im[id * 16 + c];
          const double bbr = zr * br - zi * bi, bbi = zr * bi + zi * br;
          scr[(p * 16 + c) * 2] = (float)(pr * bbr - pi * bbi); scr[(p * 16 + c) * 2 + 1] = (float)(pr * bbi + pi * bbr); } }
    __syncthreads();
    if (tid < 256) { const int c = tid >> 4, cp = tid & 15; float s = 0.f;
        for (int p = 0; p < 64; ++p) s += c_re[(lg * 16 + c) * 64 + p] * scr[(p * 16 + cp) * 2] - c_im[(lg * 16 + c) * 64 + p] * scr[(p * 16 + cp) * 2 + 1];
        if (tau == 0 && c == cp) s += dskip[lg * 16 + c];
        KM[((size_t)(lg * 64 + tau) * 16 + c) * 16 + cp] = f2bf(s); }
}
__device__ __forceinline__ size_t chunk_row(int cid) { return (size_t)(cid >> 7) * SEQ + (size_t)(cid & 127) * 64; }
__device__ __forceinline__ void x1_wave(int lane, int g, int mt, int lg, const bf16_t* __restrict__ proj, const bf16_t* __restrict__ W1, float* __restrict__ HEND) {
    const int fr = lane & 15, quad = lane >> 4;
    const bf16_t* ap = proj + (chunk_row(mt * 16 + fr) + (quad >> 1)) * NIN + COL_U + g * 16 + 8 * (quad & 1);
    const bf16_t* bp = W1 + ((size_t)(lg * 128 + fr) * 1024 + 8 * quad);
    f32x4 acc[8];
#pragma unroll
    for (int n = 0; n < 8; ++n) acc[n] = (f32x4){0.f, 0.f, 0.f, 0.f};
    bf16x8 afr[32];
#pragma unroll
    for (int kk = 0; kk < 32; ++kk) afr[kk] = *(const bf16x8*)(ap + (size_t)(2 * kk) * NIN);
#pragma unroll
    for (int kk = 0; kk < 32; ++kk) {
#pragma unroll
        for (int n = 0; n < 8; ++n) acc[n] = __builtin_amdgcn_mfma_f32_16x16x32_bf16(afr[kk], *(const bf16x8*)(bp + (size_t)n * 16 * 1024 + 32 * kk), acc[n], 0, 0, 0);
    }
#pragma unroll
    for (int n = 0; n < 8; ++n)
#pragma unroll
        for (int r = 0; r < 4; ++r) HEND[((size_t)(mt * 16 + 4 * quad + r) * 16 + g) * 128 + 16 * n + fr] = acc[n][r];
}
__device__ __forceinline__ void x2_scan(int e, const float* __restrict__ HEND, const float* __restrict__ a64, bf16_t* __restrict__ HST, int layer) {
    const int p = e & 63, g = (e >> 6) & 15, b = e >> 10;
    const float ar = a64[((layer * 16 + g) * 64 + p) * 2], ai = a64[((layer * 16 + g) * 64 + p) * 2 + 1];
    float hr = 0.f, hi = 0.f;
#pragma unroll 1
    for (int c0 = 0; c0 < 128; c0 += 16) {
        float2 he[16];
#pragma unroll
        for (int i = 0; i < 16; ++i) he[i] = *(const float2*)(HEND + ((size_t)(b * 128 + c0 + i) * 16 + g) * 128 + 2 * p);
#pragma unroll
        for (int i = 0; i < 16; ++i) {
            *(unsigned*)(HST + ((size_t)(b * 128 + c0 + i) * 16 + g) * 128 + 2 * p) = cvtpk_s(hr, hi);
            const float nr = ar * hr - ai * hi + he[i].x, ni = ar * hi + ai * hr + he[i].y; hr = nr; hi = ni;
        }
    }
}
__device__ __forceinline__ void x3_item(LAS unsigned char* lds, int wave, int lane, int item, int layer, const bf16_t* __restrict__ proj, const bf16_t* __restrict__ KM, const bf16_t* __restrict__ W3,
                                        const bf16_t* __restrict__ HST, bf16_t* __restrict__ ybpre) {
    const int g = item & 15, mtp = item >> 4, lg = layer * 16 + g;
    const int tid = wave * 64 + lane;
    __syncthreads();
    { const u32x4* src = (const u32x4*)(KM + (size_t)lg * 64 * 256);
#pragma unroll
      for (int i = 0; i < 4; ++i) ((LAS u32x4*)lds)[tid + 512 * i] = src[tid + 512 * i]; }
    __syncthreads();
    const int fr = lane & 15, quad = lane >> 4, mt = 2 * mtp + (wave >> 2), tr = wave & 3;
    const size_t crow = chunk_row(mt * 16 + fr);
    const bf16_t* ap = proj + (crow + (quad >> 1)) * NIN + COL_U + g * 16 + 8 * (quad & 1);
    f32x4 acc[16];
#pragma unroll
    for (int i = 0; i < 16; ++i) acc[i] = (f32x4){0.f, 0.f, 0.f, 0.f};
    const int kkmax = 8 * tr + 7;
    const int lbase = (fr * 16 + 8 * (quad & 1)) * 2;
#pragma unroll 1
    for (int kb = 0; kb <= kkmax; kb += 8) {
        bf16x8 a8[8];
#pragma unroll
        for (int i = 0; i < 8; ++i) a8[i] = *(const bf16x8*)(ap + (size_t)(2 * (kb + i)) * NIN);
#pragma unroll
        for (int i = 0; i < 8; ++i) {
            const int kk = kb + i;
#pragma unroll
            for (int ti = 0; ti < 16; ++ti) {
                const int t = 16 * tr + ti;
                if (2 * kk <= t) {
                    const int tau = t - 2 * kk - (quad >> 1);
                    bf16x8 bq = *(const LAS bf16x8*)(lds + max(tau, 0) * 512 + lbase);
                    if (tau < 0) bq = (bf16x8){0, 0, 0, 0, 0, 0, 0, 0};
                    acc[ti] = __builtin_amdgcn_mfma_f32_16x16x32_bf16(a8[i], bq, acc[ti], 0, 0, 0);
                }
            }
        }
    }
    {
        const bf16_t* hp = HST + ((size_t)(mt * 16 + fr) * 16 + g) * 128 + 8 * quad;
        const bf16_t* wp = W3 + ((size_t)(lg * 1024 + 16 * tr * 16 + fr) * 128 + 8 * quad);
#pragma unroll 1
        for (int kk = 0; kk < 4; ++kk) {
            const bf16x8 a = *(const bf16x8*)(hp + 32 * kk);
#pragma unroll
            for (int tb = 0; tb < 16; tb += 8) {
                bf16x8 wb[8];
#pragma unroll
                for (int ti = 0; ti < 8; ++ti) wb[ti] = *(const bf16x8*)(wp + (size_t)(tb + ti) * 16 * 128 + 32 * kk);
                __builtin_amdgcn_sched_barrier(0);
#pragma unroll
                for (int ti = 0; ti < 8; ++ti) acc[tb + ti] = __builtin_amdgcn_mfma_f32_16x16x32_bf16(a, wb[ti], acc[tb + ti], 0, 0, 0);
            }
        }
    }
#pragma unroll
    for (int ti = 0; ti < 16; ++ti)
#pragma unroll
        for (int r = 0; r < 4; ++r) {
            const size_t row = chunk_row(mt * 16 + 4 * quad + r) + 16 * tr + ti;
            const float y = acc[ti][r];
            const float uu = 1.5957691216057308f * (y + 0.044715f * y * y * y);
            ybpre[row * 256 + g * 16 + fr] = f2bf(y / (1.0f + __expf(-uu)));
        }
}
}

constexpr int NWAVES = 8;
constexpr int RING_BYTES = 131072, MISC_OFF = RING_BYTES + 320, LDS_BYTES = 147456;
typedef unsigned v4u __attribute__((ext_vector_type(4)));
#define LDS_WAIT() asm volatile("s_waitcnt lgkmcnt(0)" ::: "memory")

struct Args { const float* in[18]; float* out; unsigned char* ws; };

__device__ __forceinline__ void p0_transpose_item(const float* W, int K, int N, bf16_t* WT, LAS float* scr, int item, int lane) {
    const int nblk = N / 32, kb = item / nblk, nb = item % nblk, k0 = 64 * kb, n0 = 32 * nb;
#pragma unroll 8
    for (int i = 0; i < 32; ++i) { const int kk = 2 * i + (lane >> 5); scr[kk * 33 + (lane & 31)] = W[(size_t)(k0 + kk) * N + n0 + (lane & 31)]; }
    LDS_WAIT();
    const int c = lane & 7;
#pragma unroll
    for (int j = 0; j < 4; ++j) { const int n = (lane >> 3) + 8 * j; const LAS float* s = scr + (8 * c) * 33 + n;
        v4u o; o.x = pk2(s[0 * 33], s[1 * 33]); o.y = pk2(s[2 * 33], s[3 * 33]); o.z = pk2(s[4 * 33], s[5 * 33]); o.w = pk2(s[6 * 33], s[7 * 33]);
        *(v4u*)(WT + (size_t)(n0 + n) * K + k0 + 8 * c) = o; }
    LDS_WAIT();
}
__device__ __forceinline__ void prep_small(int id, const float* a_re, const float* a_im, const float* log_dt, const float* b_re, const float* b_im, const float* hl, float* sm) {
    if (id < DEPTH * 16 * 64) {
        const int lg = id >> 6;
        const double dt = exp((double)log_dt[lg]), ar = a_re[id], ai = a_im[id];
        const double mag = exp(dt * ar); double sn, cs; sincos_d(dt * ai, sn, cs);
        const double are = mag * cs, aim = mag * sn, nr = are - 1.0, ni = aim, den = ar * ar + ai * ai;
        const double zr = (nr * ar + ni * ai) / den, zi = (ni * ar - nr * ai) / den;
        sm[SM_ABAR + id * 2] = (float)are; sm[SM_ABAR + id * 2 + 1] = (float)aim;
        for (int c = 0; c < 16; ++c) {
            const double br = b_re[id * 16 + c], bi = b_im[id * 16 + c];
            sm[SM_BBAR + (id * 16 + c) * 2] = (float)(zr * br - zi * bi);
            sm[SM_BBAR + (id * 16 + c) * 2 + 1] = (float)(zr * bi + zi * br);
        }
    }
    if (id < 256) {
        const float h0 = hl[id], h1 = hl[256 + id], mx = fmaxf(h0, h1), e0 = expf(h0 - mx), e1 = expf(h1 - mx);
        sm[SM_LB + id] = 0.0f; sm[SM_LB + 256 + id] = e1 / (e0 + e1);
    }
}

__device__ __forceinline__ float dot64(const float* qs, const bf16_t* krow) {
    float s = 0.f;
#pragma unroll
    for (int i = 0; i < 8; ++i) {
        const u32x4 v = *(const u32x4*)(krow + i * 8);
#pragma unroll
        for (int j = 0; j < 4; ++j) { s = fmaf(qs[i * 8 + 2 * j], __uint_as_float(v[j] << 16), s); s = fmaf(qs[i * 8 + 2 * j + 1], __uint_as_float(v[j] & 0xffff0000u), s); }
    }
    return s;
}
__device__ __forceinline__ void moba_simple(int gid, int lane, float* scr, const bf16_t* __restrict__ proj, const float* __restrict__ kmean, const float* __restrict__ rel_bias, bf16_t* __restrict__ Y) {
    const int s = gid % SEQ, h = (gid / SEQ) & 3, b = gid / (SEQ * 4);
    float* qs = scr; float* ps = scr + 64;
    const size_t row = (size_t)b * SEQ + s;
    WSYNC();
    qs[lane] = bf2f(proj[row * NIN + COL_QA + h * 64 + lane]);
    WSYNC();
    const int own = s >> 8;
    float g = -INFINITY;
    if (lane < own) { const float* km = kmean + ((b * 4 + h) * 32 + lane) * 64; float a = 0.f; for (int d = 0; d < 64; ++d) a = fmaf(qs[d], km[d], a); g = a; }
    int blk[4]; bool val[4];
#pragma unroll
    for (int t = 0; t < 3; ++t) {
        const float mx = wave_max(g);
        val[t] = mx > -INFINITY;
        const unsigned long long mk = __ballot(g == mx);
        const int idx = val[t] ? (__ffsll((long long)mk) - 1) : own;
        blk[t] = idx;
        if (val[t] && lane == idx) g = -INFINITY;
    }
    blk[3] = own; val[3] = true;
    float lmax = NEGF;
#pragma unroll
    for (int t = 0; t < 4; ++t) {
        for (int i = 0; i < 4; ++i) {
            const int kk = lane + 64 * i, kpos = blk[t] * 256 + kk;
            const bool ok = (t < 3) ? val[t] : (kpos <= s);
            float lg = NEGF;
            if (ok) lg = dot64(qs, proj + ((size_t)b * SEQ + kpos) * NIN + COL_KA + h * 64) * 0.125f + rel_bias[t5_bucket(s - kpos) * 8 + h];
            ps[t * 256 + kk] = lg; lmax = fmaxf(lmax, lg);
        }
    }
    const float mx = wave_max(lmax);
    float lsum = 0.f;
    for (int i = 0; i < 16; ++i) { const float p = expf(ps[lane + 64 * i] - mx); ps[lane + 64 * i] = p; lsum += p; }
    const float tot = wave_sum(lsum);
    WSYNC();
    float acc = 0.f;
#pragma unroll
    for (int t = 0; t < 4; ++t) {
        if (!val[t]) continue;
        const bf16_t* vp = proj + ((size_t)b * SEQ + blk[t] * 256) * NIN + COL_VA + h * 64 + lane;
        const int nk = (t < 3) ? 256 : (s - own * 256 + 1);
        for (int kk = 0; kk < nk; ++kk) acc = fmaf(ps[t * 256 + kk], bf2f(vp[(size_t)kk * NIN]), acc);
    }
    Y[row * DM + h * 64 + lane] = f2bf(acc / tot);
}
__device__ __forceinline__ void dilated_simple(int gid, int lane, float* scr, const bf16_t* __restrict__ proj, const float* __restrict__ rel_bias, bf16_t* __restrict__ Y) {
    const int s = gid % SEQ, h = (gid / SEQ) & 3, b = gid / (SEQ * 4);
    float* qs = scr; float* ps = scr + 64;
    const size_t row = (size_t)b * SEQ + s;
    WSYNC();
    qs[lane] = bf2f(proj[row * NIN + COL_QD + h * 64 + lane]);
    WSYNC();
    float lse[3], ssum[3];
#pragma unroll
    for (int pi = 0; pi < 3; ++pi) {
        const int dil = (pi == 0) ? 1 : (pi == 1) ? 4 : 16;
        float lmax = NEGF;
        for (int i = 0; i < 3; ++i) {
            const int j = lane + 64 * i, kpos = s - j * dil;
            float lg = NEGF;
            if (j <= 128 && kpos >= 0) lg = dot64(qs, proj + ((size_t)b * SEQ + kpos) * NIN + COL_KD + h * 64) * 0.125f + rel_bias[t5_bucket(j * dil) * 8 + 4 + h];
            ps[pi * 192 + j] = lg; lmax = fmaxf(lmax, lg);
        }
        const float mx = wave_max(lmax);
        float lsum = 0.f;
        for (int i = 0; i < 3; ++i) { const int j = lane + 64 * i; const float p = expf(ps[pi * 192 + j] - mx); ps[pi * 192 + j] = p; lsum += p; }
        ssum[pi] = wave_sum(lsum);
        lse[pi] = mx + logf(ssum[pi]);
    }
    WSYNC();
    const float lm = fmaxf(lse[0], fmaxf(lse[1], lse[2]));
    const float w0 = expf(lse[0] - lm), w1 = expf(lse[1] - lm), w2 = expf(lse[2] - lm), wt = w0 + w1 + w2;
    const float wgt[3] = {w0 / wt, w1 / wt, w2 / wt};
    float out = 0.f;
#pragma unroll
    for (int pi = 0; pi < 3; ++pi) {
        const int dil = (pi == 0) ? 1 : (pi == 1) ? 4 : 16;
        float acc = 0.f;
        for (int j = 0; j <= 128; ++j) {
            const int kpos = s - j * dil; if (kpos < 0) break;
            acc = fmaf(ps[pi * 192 + j], bf2f(proj[((size_t)b * SEQ + kpos) * NIN + COL_VD + h * 64 + lane]), acc);
        }
        out += wgt[pi] * acc / ssum[pi];
    }
    Y[row * DM + 768 + h * 64 + lane] = f2bf(out);
}
__device__ __forceinline__ void s5_simple(int b, int g, int lane, float* scr, const bf16_t* __restrict__ proj, const float* __restrict__ sm, const float* __restrict__ c_re, const float* __restrict__ c_im,
                                          const float* __restrict__ dskip, bf16_t* __restrict__ ybpre, int layer) {
    float* hs = scr; float* us = scr + 8192; float* cs = scr + 8192 + 1024;
    const int pid = (layer * 16 + g) * 64 + lane;
    const float are = sm[SM_ABAR + pid * 2], aim = sm[SM_ABAR + pid * 2 + 1];
    float bbr[16], bbi[16];
#pragma unroll
    for (int c = 0; c < 16; ++c) { bbr[c] = sm[SM_BBAR + (pid * 16 + c) * 2]; bbi[c] = sm[SM_BBAR + (pid * 16 + c) * 2 + 1]; }
    for (int c = 0; c < 16; ++c) { cs[(c * 65 + lane) * 2] = c_re[((layer * 16 + g) * 16 + c) * 64 + lane]; cs[(c * 65 + lane) * 2 + 1] = c_im[((layer * 16 + g) * 16 + c) * 64 + lane]; }
    const int oc = lane & 15, otq = lane >> 4;
    const float dsk = dskip[layer * 256 + g * 16 + oc];
    float hr = 0.f, hi = 0.f;
#pragma unroll 1
    for (int t0 = 0; t0 < SEQ; t0 += 64) {
        WSYNC();
#pragma unroll 1
        for (int e = lane; e < 1024; e += 64) { const int t = e >> 4, c = e & 15; us[t * 16 + c] = bf2f(proj[((size_t)b * SEQ + t0 + t) * NIN + COL_U + g * 16 + c]); }
        WSYNC();
#pragma unroll 1
        for (int t = 0; t < 64; ++t) {
            float xr = 0.f, xi = 0.f;
#pragma unroll
            for (int c = 0; c < 16; ++c) { const float u = us[t * 16 + c]; xr = fmaf(bbr[c], u, xr); xi = fmaf(bbi[c], u, xi); }
            const float nr = are * hr - aim * hi + xr, ni = are * hi + aim * hr + xi;
            hr = nr; hi = ni;
            hs[(t * 64 + lane) * 2] = hr; hs[(t * 64 + lane) * 2 + 1] = hi;
        }
        WSYNC();
#pragma unroll 1
        for (int i = 0; i < 16; ++i) {
            const int t = otq + 4 * i;
            float y = 0.f;
#pragma unroll 4
            for (int p = 0; p < 64; ++p) y += hs[(t * 64 + p) * 2] * cs[(oc * 65 + p) * 2] - hs[(t * 64 + p) * 2 + 1] * cs[(oc * 65 + p) * 2 + 1];
            y += dsk * us[t * 16 + oc];
            ybpre[((size_t)b * SEQ + t0 + t) * 256 + g * 16 + oc] = f2bf(gelu_tanh(y));
        }
    }
}
__device__ __forceinline__ void hgrn_simple(int b, int h, int lane, float* scr, const bf16_t* __restrict__ proj, const float* __restrict__ sm, bf16_t* __restrict__ Y, int layer) {
    float* fs = scr; float* qs = scr + 4096; float* is = scr + 8192;
    const float lb = sm[SM_LB + layer * 256 + h * 64 + lane];
    float S[64];
#pragma unroll
    for (int d = 0; d < 64; ++d) S[d] = 0.f;
    for (int t0 = 0; t0 < SEQ; t0 += 64) {
        WSYNC();
        for (int t = 0; t < 64; ++t) {
            const bf16_t* r = proj + ((size_t)b * SEQ + t0 + t) * NIN + h * 64 + lane;
            const float qv = bf2f(r[COL_QC]), fv = bf2f(r[COL_FC]), iv = bf2f(r[COL_IC]);
            fs[t * 64 + lane] = lb + (1.0f - lb) * sigmoidf_(fv); qs[t * 64 + lane] = siluf_(qv) * 0.125f; is[t * 64 + lane] = iv;
        }
        WSYNC();
        for (int t = 0; t < 64; ++t) {
            const float iv = is[t * 64 + lane];
            float o = 0.f;
#pragma unroll
            for (int d = 0; d < 64; ++d) { const float f = fs[t * 64 + d]; S[d] = fmaf(f, S[d] - iv, iv); o = fmaf(qs[t * 64 + d], S[d], o); }
            Y[((size_t)b * SEQ + t0 + t) * DM + 512 + h * 64 + lane] = f2bf(o);
        }
    }
}
__device__ __forceinline__ void unpack16(const bf16_t* p, float* v) {
    const u32x4 y0 = *(const u32x4*)p, y1 = *(const u32x4*)(p + 8);
#pragma unroll
    for (int j = 0; j < 4; ++j) { v[2 * j] = __uint_as_float(y0[j] << 16); v[2 * j + 1] = __uint_as_float(y0[j] & 0xffff0000u); v[8 + 2 * j] = __uint_as_float(y1[j] << 16); v[8 + 2 * j + 1] = __uint_as_float(y1[j] & 0xffff0000u); }
}
__device__ __forceinline__ void combine_row(size_t row, int lane, bf16_t* __restrict__ Y, const bf16_t* __restrict__ proj, const float* __restrict__ gain, const bf16_t* __restrict__ PO, const float* __restrict__ PL, const bf16_t* __restrict__ PARTO, const float* __restrict__ PARTML) {
    bf16_t* yp = Y + row * DM + lane * 16; const bf16_t* gp = proj + row * NIN + COL_G + lane * 16;
    float v[16], gt[16]; float ss = 0.f;
    unpack16(gp, gt);
    if (lane < 48) unpack16(yp, v);
    if (lane < 16) {
        const int h = lane >> 2, own = (int)((row % SEQ) >> 8), nv = own < 3 ? own : 3;
        const float* ml = PARTML + ((row * 4 + h) * 4) * 2;
        const float4 ml01 = *(const float4*)ml, ml23 = *(const float4*)(ml + 4);
        const float mm[4] = {ml01.x, ml01.z, ml23.x, ml23.z}, ll[4] = {ml01.y, ml01.w, ml23.y, ml23.w};
        float mx = mm[3];
#pragma unroll
        for (int t = 0; t < 3; ++t) if (t < nv) mx = fmaxf(mx, mm[t]);
        float w3 = ll[3] * __expf(mm[3] - mx), wsum = w3;
#pragma unroll
        for (int i = 0; i < 16; ++i) v[i] *= w3;
#pragma unroll
        for (int t = 0; t < 3; ++t) if (t < nv) {
            const float wt = ll[t] * __expf(mm[t] - mx); wsum += wt;
            float pv[16]; unpack16(PARTO + ((row * 4 + h) * 3 + t) * 64 + (lane & 3) * 16, pv);
#pragma unroll
            for (int i = 0; i < 16; ++i) v[i] = fmaf(wt, pv[i], v[i]);
        }
        const float wi = 1.0f / wsum;
#pragma unroll
        for (int i = 0; i < 16; ++i) v[i] *= wi;
    }
    if (lane >= 48) {
        const int h = (lane - 48) >> 2;
        const float l0 = PL[(0 * (size_t)M + row) * 4 + h], l1 = PL[(1 * (size_t)M + row) * 4 + h], l2 = PL[(2 * (size_t)M + row) * 4 + h];
        const float lm = fmaxf(l0, fmaxf(l1, l2)), w0 = __expf(l0 - lm), w1 = __expf(l1 - lm), w2 = __expf(l2 - lm), wi = 1.0f / (w0 + w1 + w2);
        float a0[16], a1[16], a2[16];
        unpack16(PO + (0 * (size_t)M + row) * 256 + (lane - 48) * 16, a0); unpack16(PO + (1 * (size_t)M + row) * 256 + (lane - 48) * 16, a1); unpack16(PO + (2 * (size_t)M + row) * 256 + (lane - 48) * 16, a2);
#pragma unroll
        for (int i = 0; i < 16; ++i) v[i] = (w0 * a0[i] + w1 * a1[i] + w2 * a2[i]) * wi;
    }
#pragma unroll
    for (int i = 0; i < 16; ++i) ss = fmaf(v[i], v[i], ss);
    ss += __shfl_xor(ss, 1); ss += __shfl_xor(ss, 2);
    const float r = rsqrtf(ss * (1.0f / 64.0f) + RMS_EPS);
    float o[16];
#pragma unroll
    for (int i = 0; i < 16; ++i) o[i] = v[i] * r * gain[lane * 16 + i] * siluf_(gt[i]);
    u32x4 w0, w1;
    w0.x = pk2(o[0], o[1]); w0.y = pk2(o[2], o[3]); w0.z = pk2(o[4], o[5]); w0.w = pk2(o[6], o[7]);
    w1.x = pk2(o[8], o[9]); w1.y = pk2(o[10], o[11]); w1.z = pk2(o[12], o[13]); w1.w = pk2(o[14], o[15]);
    *(u32x4*)yp = w0; *(u32x4*)(yp + 8) = w1;
}
__device__ __forceinline__ void layernorm_row(size_t row, int lane, float* __restrict__ z, bf16_t* __restrict__ xb, const float* __restrict__ lg, const float* __restrict__ lbias) {
    float4* zp = (float4*)(z + row * DM) + lane;
    float4 v[4]; float s = 0.f;
#pragma unroll
    for (int j = 0; j < 4; ++j) { v[j] = zp[64 * j]; s += (v[j].x + v[j].y) + (v[j].z + v[j].w); }
    const float mean = wave_sum(s) * (1.0f / DM); float q = 0.f;
#pragma unroll
    for (int j = 0; j < 4; ++j) { v[j].x -= mean; v[j].y -= mean; v[j].z -= mean; v[j].w -= mean; q += (v[j].x * v[j].x + v[j].y * v[j].y) + (v[j].z * v[j].z + v[j].w * v[j].w); }
    const float rstd = rsqrtf(wave_sum(q) * (1.0f / DM) + LN_EPS);
#pragma unroll
    for (int j = 0; j < 4; ++j) {
        const float4 gg = ((const float4*)lg)[lane + 64 * j], bb = ((const float4*)lbias)[lane + 64 * j];
        float4 o; o.x = v[j].x * rstd * gg.x + bb.x; o.y = v[j].y * rstd * gg.y + bb.y; o.z = v[j].z * rstd * gg.z + bb.z; o.w = v[j].w * rstd * gg.w + bb.w;
        zp[64 * j] = o;
        uint2 ob; ob.x = pk2(o.x, o.y); ob.y = pk2(o.z, o.w);
        ((uint2*)(xb + row * DM))[lane + 64 * j] = ob;
    }
}


#define OPQS(x) asm volatile("" : "+s"(x))
#define OPQ(x) asm volatile("" : "+v"(x))
__global__ void __launch_bounds__(NWAVES * 64, 2) mega_fwd(Args args) {
    extern __shared__ __attribute__((aligned(16))) unsigned char lds[];
#define LANE_ID() ({ unsigned z_ = 0u; asm volatile("" : "+v"(z_)); (int)__builtin_amdgcn_mbcnt_hi(~0u, __builtin_amdgcn_mbcnt_lo(~0u, z_)); })
#define TID_() (wave * 64 + LANE_ID())
#define tid_ TID_()
#define lane_ LANE_ID()
    const int wave = __builtin_amdgcn_readfirstlane((int)threadIdx.x >> 6);
    const int G = gridDim.x, bx = blockIdx.x, bx_ = bx;
    LAS unsigned char* ldsl = (LAS unsigned char*)lds;
    volatile LAS unsigned* MISC = (volatile LAS unsigned*)(ldsl + MISC_OFF);
    for (int u = tid_; u < (LDS_BYTES - RING_BYTES) / 4; u += NWAVES * 64) ((LAS unsigned*)(ldsl + RING_BYTES))[u] = 0u;
    __syncthreads();
    const XcdBarrier bar = xcd_barrier_post((unsigned*)(args.ws + WS_CTL) + CW_BAR, MISC + 8);
    const int gw = bx * NWAVES + wave, NGW = G * NWAVES;
#ifdef PROBE_A
#define STAMP(k) do { if (bx_ == 0 && threadIdx.x == 0) MISC[16 + (k)] = (unsigned)__builtin_amdgcn_s_memrealtime(); } while (0)
#else
#define STAMP(k) do { } while (0)
#endif
#define SUBSTAMP(k) STAMP(32 + (k))
    int stamp_i = 0;
#define GRID_BAR() do { GRID_BAR0(); ++stamp_i; STAMP(stamp_i); } while (0)
#define GRID_BAR0() do { XcdBarrier b_ = bar; unsigned x_ = b_.x; unsigned* p_ = b_.bar; asm volatile("" : "+s"(x_), "+s"(p_)); b_.x = x_; b_.bar = p_; xcd_barrier(b_); } while (0)

    STAMP(0);
    {
        const Args* A = &args; unsigned char* ws = A->ws;
        int lane = lane_, tid = tid_; OPQ(lane); OPQ(tid);
        const float* x = A->in[0]; const float* w_in = A->in[1]; const float* glu_w = A->in[11]; const float* w_out = A->in[15];
        bf16_t* wtin = (bf16_t*)(ws + WS_WTIN); bf16_t* wtout = (bf16_t*)(ws + WS_WTOUT); bf16_t* gluwt = (bf16_t*)(ws + WS_GLUWT); bf16_t* xb = (bf16_t*)(ws + WS_XB);
        LAS float* scr = (LAS float*)(ldsl + wave * 16384);
        constexpr int I_IN = (DM / 64) * (NIN / 32), I_OUT = (DM / 64) * (DM / 32), I_GLU = (BW / 64) * (BW / 32), I_L = I_IN + I_OUT + I_GLU;
        for (int it = gw; it < DEPTH * I_L; it += NGW) {
            const int l = it / I_L; int r = it % I_L;
            if (r < I_IN) { p0_transpose_item(w_in + (size_t)l * DM * NIN, DM, NIN, wtin + (size_t)l * NIN * DM, scr, r, lane); continue; } r -= I_IN;
            if (r < I_OUT) { p0_transpose_item(w_out + (size_t)l * DM * DM, DM, DM, wtout + (size_t)l * DM * DM, scr, r, lane); continue; } r -= I_OUT;
            p0_transpose_item(glu_w + (size_t)l * BW * BW, BW, BW, gluwt + (size_t)l * BW * BW, scr, r, lane);
        }
        for (size_t i = (size_t)bx * 512 + tid; i < (size_t)M * DM / 4; i += (size_t)G * 512) {
            const float4 v = ((const float4*)x)[i]; uint2 o; o.x = pk2(v.x, v.y); o.y = pk2(v.z, v.w); ((uint2*)xb)[i] = o;
        }
        if (bx < 8 && tid < 256) prep_small(bx * 256 + tid, A->in[3], A->in[4], A->in[5], A->in[6], A->in[7], A->in[13], (float*)(ws + WS_SMALL));
        if (bx == 8) { float* smc = (float*)(ws + WS_SMALL);
            for (int i = tid; i < 256; i += 512) smc[SM_RELB + i] = A->in[2][i];
            for (int i = tid; i < 512; i += 512) smc[SM_GLUB + i] = A->in[12][i];
            for (int i = tid; i < 2048; i += 512) { smc[SM_GAIN + i] = A->in[14][i]; smc[SM_LNG + i] = A->in[16][i]; smc[SM_LNB + i] = A->in[17][i]; } }
        for (int e = bx * 512 + tid; e < 2 * 16 * 64 * 64; e += G * 512)
            s5::tables_thread(e, A->in[3], A->in[4], A->in[5], A->in[6], A->in[7], A->in[8], A->in[9], (bf16_t*)(ws + WS_W1), (bf16_t*)(ws + WS_W3), (float*)(ws + WS_SMALL) + SM_A64);
        for (int it = bx; it < 2 * 16 * 64; it += G)
            s5::kmat_item((LAS float*)ldsl, tid, it, A->in[3], A->in[4], A->in[5], A->in[6], A->in[7], A->in[8], A->in[9], A->in[10], (bf16_t*)(ws + WS_KM));
    }
    GRID_BAR();

#pragma unroll 1
    for (int l = 0; l < DEPTH; ++l) {
        {
            const Args* A = &args; unsigned char* ws = A->ws;
            pg8::Gemm g{(const bf16_t*)(ws + WS_XB), (const bf16_t*)(ws + WS_WTIN) + (size_t)l * NIN * DM, M, NIN, DM}; int tidg = tid_, bxg = bx; OPQ(tidg); OPQS(bxg); pg8::StaticOrder S; S.init(M, NIN, G, bxg);
            pg8::EpiStoreBf16 E{(bf16_t*)(ws + WS_PROJ), NIN, (float*)(ws + WS_KP)};
            pg8::gemm_phase<pg8::EpiStoreBf16, pg8::StaticOrder, true, true>(ldsl, g, S, E, tidg);
        }
        GRID_BAR();
        {
            const Args* A = &args; unsigned char* ws = A->ws;
            const bf16_t* proj = (const bf16_t*)(ws + WS_PROJ);
            int lane = lane_; OPQ(lane); const int tid = wave * 64 + lane;
            const float* lbp = (const float*)(ws + WS_SMALL) + SM_LB + l * 256;
            unsigned* wq = (unsigned*)(ws + WS_CTL) + CW_WQ + 64 * l;
            for (int it = gw; it < 2048; it += NGW) hw::x1_wave(ldsl + wave * 16384, lane, it, proj, lbp, (float*)(ws + WS_DS), (float*)(ws + WS_DEC));
            SUBSTAMP(0);
            for (int wi = gw; wi < 512; wi += NGW) s5::x1_wave(lane, wi & 15, wi >> 4, l * 16 + (wi & 15), proj, (const bf16_t*)(ws + WS_W1), (float*)(ws + WS_HEND));
            SUBSTAMP(1);
            constexpr int N_DIL = 1536, N_GATE = 512;
            for (;;) {
                __syncthreads();
                if (tid == 0) MISC[4] = __hip_atomic_fetch_add(wq, 1u, __ATOMIC_RELAXED, __HIP_MEMORY_SCOPE_AGENT);
                __syncthreads();
                int it = (int)MISC[4];
                if (it >= N_DIL + N_GATE) break;
                if (it < N_DIL) { const int pi = 2 - it / 512, bh = (it >> 5) & 15, u = it & 31; fa2::dilated_unit(ldsl, tid, pi, bh, u, proj, (const float*)(ws + WS_SMALL) + SM_RELB, (bf16_t*)(ws + WS_PO), (float*)(ws + WS_PL)); continue; }
                it -= N_DIL;
                fa2::gate_item(ldsl, tid, it & 15, 31 - (it >> 4), proj, (const float*)(ws + WS_KP), (unsigned short*)(ws + WS_LIST), (int*)(ws + WS_CNT));
            }
            SUBSTAMP(2);
        }
        GRID_BAR();
        {
            const Args* A = &args; unsigned char* ws = A->ws;
            const bf16_t* proj = (const bf16_t*)(ws + WS_PROJ); const float* sm = (const float*)(ws + WS_SMALL);
            int lane = lane_; OPQ(lane);
            int bx = bx_; OPQS(bx);
            const int tid = wave * 64 + lane;
            if (bx < 32) hg::x2_scan(bx * 512 + tid, 32 * 512, (const float*)(ws + WS_DS), (const float*)(ws + WS_DEC), (bf16_t*)(ws + WS_ST));
            else if (bx < 40) s5::x2_scan((bx - 32) * 512 + tid, (const float*)(ws + WS_HEND), sm + SM_A64, (bf16_t*)(ws + WS_HST), l);
            unsigned* wq = (unsigned*)(ws + WS_CTL) + CW_WQ + 64 * (2 + l);
            for (;;) {
                __syncthreads();
                if (tid == 0) MISC[4] = __hip_atomic_fetch_add(wq, 1u, __ATOMIC_RELAXED, __HIP_MEMORY_SCOPE_AGENT);
                __syncthreads();
                const int it = (int)MISC[4];
                if (it >= 512) break;
                fa2::moba_item(ldsl, tid, it & 15, it >> 4, proj, sm + SM_RELB, (const unsigned short*)(ws + WS_LIST), (const int*)(ws + WS_CNT), (bf16_t*)(ws + WS_PARTO), (float*)(ws + WS_PARTML), (bf16_t*)(ws + WS_Y));
            }
        }
        GRID_BAR();
        {
            const Args* A = &args; unsigned char* ws = A->ws;
            int lane = lane_; OPQ(lane);
            const float* lbp = (const float*)(ws + WS_SMALL) + SM_LB + l * 256;
            for (int it = bx; it < 256; it += G) s5::x3_item(ldsl, wave, lane, it, l, (const bf16_t*)(ws + WS_PROJ), (const bf16_t*)(ws + WS_KM), (const bf16_t*)(ws + WS_W3), (const bf16_t*)(ws + WS_HST), (bf16_t*)(ws + WS_YBPRE));
            __syncthreads(); SUBSTAMP(3);
            for (int it = gw; it < 2048; it += NGW) hw::x3_wave(ldsl + wave * 16384, lane, it, (const bf16_t*)(ws + WS_PROJ), lbp, (const bf16_t*)(ws + WS_ST), (bf16_t*)(ws + WS_Y));
            SUBSTAMP(4);
        }
        GRID_BAR();
        {
            const Args* A = &args; unsigned char* ws = A->ws;
            const bf16_t* ybpre = (const bf16_t*)(ws + WS_YBPRE);
            pg8::Gemm g{ybpre, (const bf16_t*)(ws + WS_GLUWT) + (size_t)l * BW * BW, M, BW, BW}; int tidg = tid_, bxg = bx; OPQ(tidg); OPQS(bxg); pg8::StaticOrder S; S.init(M, BW, G, bxg);
            pg8::EpiGlu E{(bf16_t*)(ws + WS_Y) + 256, DM, ybpre, BW, (const float*)(ws + WS_SMALL) + SM_GLUB + l * BW};
            pg8::gemm_phase<pg8::EpiGlu, pg8::StaticOrder, true, true>(ldsl, g, S, E, tidg);
        }
        GRID_BAR();
        {
            const Args* A = &args; unsigned char* ws = A->ws;
            int lane = lane_; OPQ(lane);
            for (int r = gw; r < M; r += NGW) combine_row((size_t)r, lane, (bf16_t*)(ws + WS_Y), (const bf16_t*)(ws + WS_PROJ), (const float*)(ws + WS_SMALL) + SM_GAIN + l * DM, (const bf16_t*)(ws + WS_PO), (const float*)(ws + WS_PL), (const bf16_t*)(ws + WS_PARTO), (const float*)(ws + WS_PARTML));
        }
        GRID_BAR();
        {
            const Args* A = &args; unsigned char* ws = A->ws;
            pg8::Gemm g{(const bf16_t*)(ws + WS_Y), (const bf16_t*)(ws + WS_WTOUT) + (size_t)l * DM * DM, M, DM, DM}; int tidg = tid_, bxg = bx; OPQ(tidg); OPQS(bxg); pg8::StaticOrder S; S.init(M, DM, G, bxg);
            pg8::EpiResF32 E{l == 0 ? A->in[0] : A->out, A->out};
            pg8::gemm_phase<pg8::EpiResF32, pg8::StaticOrder, true, true>(ldsl, g, S, E, tidg);
        }
        GRID_BAR();
        {
            const Args* A = &args; unsigned char* ws = A->ws;
            int lane = lane_; OPQ(lane);
            for (int r = gw; r < M; r += NGW) layernorm_row((size_t)r, lane, A->out, (bf16_t*)(ws + WS_XB), (const float*)(ws + WS_SMALL) + SM_LNG + l * DM, (const float*)(ws + WS_SMALL) + SM_LNB + l * DM);
        }
        if (l + 1 < DEPTH) GRID_BAR();
    }
#ifdef PROBE_A
    ++stamp_i; STAMP(stamp_i);
    if (bx_ == 0 && threadIdx.x == 0) { asm volatile("s_waitcnt vmcnt(0) lgkmcnt(0)" ::: "memory"); args.out[0] += (float)(MISC[16 + PROBE_B] - MISC[16 + PROBE_A]) * 1e-4f; }
#endif
}

extern "C" void kernel_launch(void* const* d_in, const int* in_sizes, int n_in, void* d_out, int out_size, void* d_ws, size_t ws_size, hipStream_t stream) {
    static int grid = 0;
    if (grid == 0) {
        if (n_in != 18 || in_sizes[0] != M * DM || out_size != M * DM || ws_size < WS_END) { fprintf(stderr, "kernel_launch: unexpected shapes (n_in %d, in0 %d, out %d, ws %zu)\n", n_in, n_in > 0 ? in_sizes[0] : -1, out_size, ws_size); grid = -1; return; }
        int dev = 0, cus = 0, per_cu = 0;
        if (hipGetDevice(&dev) != hipSuccess || hipDeviceGetAttribute(&cus, hipDeviceAttributeMultiprocessorCount, dev) != hipSuccess) { grid = -1; return; }
        if (hipFuncSetAttribute((const void*)mega_fwd, hipFuncAttributeMaxDynamicSharedMemorySize, LDS_BYTES) != hipSuccess) { fprintf(stderr, "kernel_launch: hipFuncSetAttribute failed\n"); grid = -1; return; }
        if (hipOccupancyMaxActiveBlocksPerMultiprocessor(&per_cu, (const void*)mega_fwd, NWAVES * 64, LDS_BYTES) != hipSuccess || per_cu < 1) { fprintf(stderr, "kernel_launch: occupancy query says %d\n", per_cu); }
        (void)hipGetLastError();
        grid = cus;
    }
    if (grid < 0) return;
    if (hipMemsetAsync((char*)d_ws + WS_CTL, 0, CTL_ZERO_BYTES, stream) != hipSuccess) return;
    Args a{};
    for (int i = 0; i < 18; ++i) a.in[i] = (const float*)d_in[i];
    a.out = (float*)d_out; a.ws = (unsigned char*)d_ws;
    hipLaunchKernelGGL(mega_fwd, dim3(grid), dim3(NWAVES * 64), LDS_BYTES, stream, a);
}
```

```cpp
#include <hip/hip_runtime.h>
#include <stdint.h>
#include <cstdio>

typedef unsigned short bf16_t;
typedef unsigned u32x4 __attribute__((ext_vector_type(4)));
#define LAS __attribute__((address_space(3)))
#define GAS __attribute__((address_space(1)))

constexpr int BATCH = 4, SEQ = 8192, DM = 1024, M = BATCH * SEQ, BW = 256, NIN = 3584, HD = 64, DEPTH = 2;
constexpr int COL_QA = 0, COL_KA = 256, COL_VA = 512, COL_U = 768, COL_QC = 1024, COL_FC = 1280, COL_IC = 1536, COL_QD = 1792, COL_KD = 2048, COL_VD = 2304, COL_G = 2560;
constexpr float ALPHA = 1.4142135623730951f;
constexpr float LN_EPS = 1e-5f, RMS_EPS = 1e-6f, NEGF = -1e30f;

constexpr size_t MiB = 1u << 20;
constexpr size_t WS_CTL = 0, CTL_ZERO_BYTES = 1 * MiB;
constexpr size_t WS_SMALL = 1 * MiB;
constexpr size_t WS_WTIN = 2 * MiB;
constexpr size_t WS_WTOUT = 16 * MiB;
constexpr size_t WS_GLUWT = 20 * MiB;
constexpr size_t WS_KP = 21 * MiB;
constexpr size_t WS_XB = 22 * MiB;
constexpr size_t WS_PARTO = WS_XB;
constexpr size_t WS_PARTML = WS_XB + 48 * MiB;
constexpr size_t WS_LIST = WS_XB + 52 * MiB;
constexpr size_t WS_CNT = WS_XB + 60 * MiB;
constexpr size_t WS_PROJ = 86 * MiB;
constexpr size_t WS_Y = 310 * MiB;
constexpr size_t WS_YBPRE = 374 * MiB;
constexpr size_t WS_PO = 390 * MiB;
constexpr size_t WS_PL = 438 * MiB;
constexpr size_t WS_DS = 440 * MiB;
constexpr size_t WS_ST = 472 * MiB;
constexpr size_t WS_DEC = 488 * MiB;
constexpr size_t WS_KM = 489 * MiB;
constexpr size_t WS_W1 = 490 * MiB;
constexpr size_t WS_W3 = 498 * MiB;
constexpr size_t WS_HEND = 506 * MiB;
constexpr size_t WS_HST = 510 * MiB;
constexpr size_t WS_END = 512 * MiB;
constexpr int SM_LB = 0;
constexpr int SM_ABAR = 512;
constexpr int SM_BBAR = SM_ABAR + 2 * 16 * 64 * 2;
constexpr int SM_A64 = SM_BBAR + 2 * 16 * 64 * 16 * 2;
constexpr int SM_RELB = SM_A64 + 2 * 16 * 64 * 2, SM_GLUB = SM_RELB + 256, SM_GAIN = SM_GLUB + 512, SM_LNG = SM_GAIN + 2048, SM_LNB = SM_LNG + 2048, SM_END = SM_LNB + 2048;
constexpr int SM_LUTM = SM_END, SM_LUTD = SM_LUTM + 4 * 1888, SM_END2 = SM_LUTD + 3 * 4 * 256;
constexpr int CW_BAR = 4096;
constexpr int CW_SEAM = 32768;
constexpr int CW_WQ = 16384;

__device__ __forceinline__ float bf2f(bf16_t v) { return __uint_as_float(((unsigned)v) << 16); }
__device__ __forceinline__ bf16_t f2bf(float f) { unsigned u = __float_as_uint(f); return (bf16_t)((u + 0x7fffu + ((u >> 16) & 1u)) >> 16); }
__device__ __forceinline__ unsigned pk2(float lo, float hi) { return (unsigned)f2bf(lo) | ((unsigned)f2bf(hi) << 16); }
__device__ __forceinline__ float wave_max(float v) {
#pragma unroll
    for (int o = 1; o < 64; o <<= 1) v = fmaxf(v, __shfl_xor(v, o));
    return v;
}
__device__ __forceinline__ float wave_sum(float v) {
#pragma unroll
    for (int o = 1; o < 64; o <<= 1) v += __shfl_xor(v, o);
    return v;
}
__device__ __forceinline__ int t5_bucket(int d) {
    if (d < 16) return d;
    int b = 16;
    b += (d >= 22); b += (d >= 30); b += (d >= 40); b += (d >= 54); b += (d >= 73); b += (d >= 99); b += (d >= 134); b += (d >= 182);
    b += (d >= 246); b += (d >= 332); b += (d >= 450); b += (d >= 609); b += (d >= 825); b += (d >= 1117); b += (d >= 1513);
    return b;
}
__device__ __forceinline__ float sigmoidf_(float x) { return 1.0f / (1.0f + expf(-x)); }
__device__ __forceinline__ float siluf_(float x) { return x / (1.0f + expf(-x)); }
__device__ __forceinline__ float gelu_tanh(float x) { const float u = 0.7978845608028654f * (x + 0.044715f * x * x * x); return 0.5f * x * (1.0f + tanhf(u)); }
typedef float f32x2_t __attribute__((ext_vector_type(2))); typedef __bf16 bf16x2_t __attribute__((ext_vector_type(2)));
__device__ __forceinline__ unsigned cvtpk_s(float lo, float hi) { f32x2_t v = {lo, hi}; bf16x2_t b = __builtin_convertvector(v, bf16x2_t); return __builtin_bit_cast(unsigned, b); }
__device__ __forceinline__ int lane_id_opaque() { unsigned z = 0u; asm volatile("" : "+v"(z)); return (int)__builtin_amdgcn_mbcnt_hi(~0u, __builtin_amdgcn_mbcnt_lo(~0u, z)); }
template <class T> __device__ __forceinline__ T* launder_g(T* p) { unsigned long long v = (unsigned long long)p; asm volatile("" : "+s"(v)); return (T*)(__attribute__((address_space(1))) T*)v; }
#define WSYNC() asm volatile("s_waitcnt lgkmcnt(0)" ::: "memory")

__device__ __forceinline__ void sincos_d(double th, double& s, double& c) {
    const double k = rint(th * 0.63661977236758134308);
    double r = fma(-k, 1.57079632679489655800, th); r = fma(-k, 6.12323399573676603587e-17, r);
    const long q = ((long)k) & 3;
    const double r2 = r * r;
    const double sp = r * (1.0 + r2 * (-1.0 / 6 + r2 * (1.0 / 120 + r2 * (-1.0 / 5040 + r2 * (1.0 / 362880 + r2 * (-1.0 / 39916800 + r2 * (1.0 / 6227020800.0 + r2 * (-1.0 / 1307674368000.0))))))));
    const double cp = 1.0 + r2 * (-0.5 + r2 * (1.0 / 24 + r2 * (-1.0 / 720 + r2 * (1.0 / 40320 + r2 * (-1.0 / 3628800 + r2 * (1.0 / 479001600.0 + r2 * (-1.0 / 87178291200.0 + r2 * (1.0 / 20922789888000.0))))))));
    if (q == 0) { s = sp; c = cp; } else if (q == 1) { s = cp; c = -sp; } else if (q == 2) { s = -sp; c = -cp; } else { s = -cp; c = sp; }
}

namespace pg8 {
#define PG8_LAS __attribute__((address_space(3)))
typedef unsigned short bf16_t;
typedef short bf16x8 __attribute__((ext_vector_type(8)));
typedef float f32x4 __attribute__((ext_vector_type(4)));
typedef unsigned u32x4 __attribute__((ext_vector_type(4)));
constexpr int BM = 256, BK = 64, HALF = 128, HTB = HALF * BK * 2  , STAGE_BYTES = 8 * HTB, NXCD = 8, WGM = 8;

__host__ __device__ __forceinline__ int lds_byte(int r, int c) { const int st = (r >> 4) * 2 + (c >> 5), rr = r & 15, cc = c & 31, ob = rr * 64 + cc * 2; return st * 1024 + (ob ^ (((ob >> 9) & 1) << 5)); }
__host__ __device__ __forceinline__ void stage_rc(int b, int& R, int& C) { const int st = b / 1024, sb = b % 1024, swz = sb ^ (((sb >> 9) & 1) << 5); R = (st >> 1) * 16 + swz / 64; C = (st & 1) * 32 + (swz % 64) / 2; }
__host__ __device__ __forceinline__ int perm32(int rho) { const int n = rho >> 4, i = rho & 15; return 8 * (i >> 2) + 4 * n + (i & 3); }

struct Unit { int pm, pn; };
struct Gemm { const bf16_t* A; const bf16_t* Bt; int M, N, K; };

struct StaticOrder {
    int nM, nN, nwg, G, c;
    __host__ __device__ void init(int M, int N, int G_, int c_) { nM = M / BM; nN = N / BM; nwg = nM * nN; G = G_; c = c_; }
    __host__ __device__ bool next(int i, Unit& u) const {
        const long L = (long)i * G + c; if (L >= nwg) return false;
        int wgid = (int)L; { const int q = nwg / NXCD, r = nwg % NXCD, xcd = wgid % NXCD, off = wgid / NXCD; wgid = (xcd < r ? xcd * (q + 1) : r * (q + 1) + (xcd - r) * q) + off; }
        const int nig = WGM * nN, gid = wgid / nig, fm = gid * WGM, gsz = (nM - fm) < WGM ? (nM - fm) : WGM;
        u.pm = fm + ((wgid % nig) % gsz); u.pn = (wgid % nig) / gsz; return true;
    }
    __device__ __forceinline__ void a_ready(const Unit&) const {}
    __device__ __forceinline__ void done(const Unit&) const {}
};

__device__ __forceinline__ unsigned cvt_pk_bf16(float lo, float hi) { unsigned r; asm volatile("v_cvt_pk_bf16_f32 %0, %1, %2" : "=v"(r) : "v"(lo), "v"(hi)); return r; }
struct EpiStoreBf16 {
    static constexpr bool PERM = true, AFTER_DRAIN = false;
    bf16_t* O; int ldc; float* kp;
    __device__ __forceinline__ void operator()(const f32x4 (&acc)[2][2][4][2], const Unit& u, int wr, int wc, int fr_, int fq_) const {
        const int ln_ = lane_id_opaque(), fr = ln_ & 15, fq = ln_ >> 4; (void)fr_; (void)fq_;
        const int row0 = u.pm * BM + wr * 64 + fr, col0 = u.pn * BM + wc * 32 + 8 * fq;
#pragma unroll
        for (int ai = 0; ai < 2; ++ai)
#pragma unroll
            for (int m = 0; m < 4; ++m) { bf16_t* rowp = O + (size_t)(row0 + ai * HALF + m * 16) * ldc + col0;
#pragma unroll
                for (int bj = 0; bj < 2; ++bj) { const f32x4 v0 = acc[ai][bj][m][0], v1 = acc[ai][bj][m][1];
                    u32x4 w; w.x = cvtpk_s(v0[0], v0[1]); w.y = cvtpk_s(v0[2], v0[3]); w.z = cvtpk_s(v1[0], v1[1]); w.w = cvtpk_s(v1[2], v1[3]);
                    *(u32x4*)(rowp + bj * HALF) = w; } }
        if (kp && u.pn == 1) {
#pragma unroll
            for (int bj = 0; bj < 2; ++bj)
#pragma unroll
                for (int n = 0; n < 2; ++n) { f32x4 s = {0.f, 0.f, 0.f, 0.f};
#pragma unroll
                    for (int ai = 0; ai < 2; ++ai)
#pragma unroll
                        for (int m = 0; m < 4; ++m) s += acc[ai][bj][m][n];
#pragma unroll
                    for (int o = 1; o < 16; o <<= 1) { s[0] += __shfl_xor(s[0], o); s[1] += __shfl_xor(s[1], o); s[2] += __shfl_xor(s[2], o); s[3] += __shfl_xor(s[3], o); }
                    if (fr == 0) *(f32x4*)(kp + (size_t)(u.pm * 2 + wr) * 256 + bj * HALF + wc * 32 + 8 * fq + 4 * n) = s; }
        }
    }
};
struct EpiGlu {
    static constexpr bool PERM = true, AFTER_DRAIN = false;
    bf16_t* O; int ldc; const bf16_t* Ain; int lda; const float* bias;
    __device__ __forceinline__ void operator()(const f32x4 (&acc)[2][2][4][2], const Unit& u, int wr, int wc, int fr_, int fq_) const {
        const int ln_ = lane_id_opaque(), fr = ln_ & 15, fq = ln_ >> 4; (void)fr_; (void)fq_;
        const int row0 = u.pm * BM + wr * 64 + fr, col0 = u.pn * BM + wc * 32 + 8 * fq;
        bf16_t* O = launder_g(this->O); const bf16_t* Ain = launder_g(this->Ain); const float* bias = launder_g(this->bias);
#pragma unroll
        for (int ai = 0; ai < 2; ++ai)
#pragma unroll
            for (int m = 0; m < 4; ++m) { const size_t r = (size_t)(row0 + ai * HALF + m * 16);
#pragma unroll
                for (int bj = 0; bj < 2; ++bj) { const int c = col0 + bj * HALF;
                    const u32x4 av = *(const u32x4*)(Ain + r * lda + c);
                    const f32x4 b0 = *(const f32x4*)(bias + c), b1 = *(const f32x4*)(bias + c + 4);
                    const f32x4 v0 = acc[ai][bj][m][0] + b0, v1 = acc[ai][bj][m][1] + b1;
                    float o[8];
#pragma unroll
                    for (int j = 0; j < 4; ++j) { const float alo = __uint_as_float(av[j] << 16), ahi = __uint_as_float(av[j] & 0xffff0000u);
                        const float s0 = (j < 2) ? v0[2 * j] : v1[2 * j - 4], s1 = (j < 2) ? v0[2 * j + 1] : v1[2 * j - 3];
                        o[2 * j] = alo / (1.0f + __expf(-s0)); o[2 * j + 1] = ahi / (1.0f + __expf(-s1)); }
                    u32x4 w; w.x = cvtpk_s(o[0], o[1]); w.y = cvtpk_s(o[2], o[3]); w.z = cvtpk_s(o[4], o[5]); w.w = cvtpk_s(o[6], o[7]);
                    *(u32x4*)(O + r * ldc + c) = w; } }
    }
};
struct EpiResF32 {
    static constexpr bool PERM = false, AFTER_DRAIN = false;
    const float* res; float* out;
    __device__ __forceinline__ void operator()(const f32x4 (&acc)[2][2][4][2], const Unit& u, int wr, int wc, int fr_, int fq_) const {
        const int ln_ = lane_id_opaque(), fr = ln_ & 15, fq = ln_ >> 4; (void)fr_; (void)fq_;
        const int col0 = u.pn * BM + wc * 32 + 4 * fq;
#pragma unroll
        for (int ai = 0; ai < 2; ++ai)
#pragma unroll
            for (int m = 0; m < 4; ++m) { const size_t off = (size_t)(u.pm * BM + ai * HALF + wr * 64 + m * 16 + fr) * 1024 + col0;
#pragma unroll
                for (int bj = 0; bj < 2; ++bj)
#pragma unroll
                    for (int n = 0; n < 2; ++n) { const f32x4 rv = *(const f32x4*)(res + off + bj * HALF + n * 16);
                        *(f32x4*)(out + off + bj * HALF + n * 16) = rv * 1.4142135623730951f + acc[ai][bj][m][n]; } }
    }
};

struct EpiResLn {
    static constexpr bool PERM = false, AFTER_DRAIN = false;
    const float* res; float* out; bf16_t* xb; const float* gam; const float* bet; unsigned long long* xbuf; unsigned* cnt; PG8_LAS unsigned char* tbl;
    __device__ __forceinline__ void operator()(f32x4 (&acc)[2][2][4][2], const Unit& u, int wr, int wc, int fr_, int fq_) const {
        typedef float f32x2v __attribute__((ext_vector_type(2)));
        const int lane = lane_id_opaque(), fr = lane & 15, fq = lane >> 4; (void)fr_; (void)fq_;
        const int wid = wr * 4 + wc;
        const int col0 = u.pn * BM + wc * 32 + 4 * fq;
        PG8_LAS f32x2v* Pt = (PG8_LAS f32x2v*)tbl;
        PG8_LAS f32x2v* St = (PG8_LAS f32x2v*)(tbl + 8192);
#pragma unroll
        for (int ai = 0; ai < 2; ++ai)
#pragma unroll
            for (int m = 0; m < 4; ++m) {
                const size_t off = (size_t)(u.pm * BM + ai * HALF + wr * 64 + m * 16 + fr) * 1024 + col0;
                f32x4 rv[2][2];
#pragma unroll
                for (int bj = 0; bj < 2; ++bj)
#pragma unroll
                    for (int n = 0; n < 2; ++n) rv[bj][n] = *(const f32x4*)(res + off + bj * HALF + n * 16);
                float s = 0.f;
#pragma unroll
                for (int bj = 0; bj < 2; ++bj)
#pragma unroll
                    for (int n = 0; n < 2; ++n) { acc[ai][bj][m][n] = rv[bj][n] * 1.4142135623730951f + acc[ai][bj][m][n]; const f32x4 x = acc[ai][bj][m][n]; s += (x[0] + x[1]) + (x[2] + x[3]); }
                s += __shfl_xor(s, 16); s += __shfl_xor(s, 32);
                const float mw = s * (1.0f / 64.0f); float q = 0.f;
#pragma unroll
                for (int bj = 0; bj < 2; ++bj)
#pragma unroll
                    for (int n = 0; n < 2; ++n) { const f32x4 d = acc[ai][bj][m][n] - mw; q += (d[0] * d[0] + d[1] * d[1]) + (d[2] * d[2] + d[3] * d[3]); }
                q += __shfl_xor(q, 16); q += __shfl_xor(q, 32);
                if (fq == 0) Pt[(ai * HALF + wr * 64 + m * 16 + fr) * 4 + wc] = (f32x2v){mw, q};
            }
        asm volatile("s_waitcnt lgkmcnt(0)" ::: "memory"); __builtin_amdgcn_s_barrier(); asm volatile("" ::: "memory");
        const int row = wid * 32 + (lane & 31);
        unsigned* cw = cnt + 64 * u.pm;
        if (lane < 32) {
            const f32x2v a = Pt[row * 4 + 0], b2 = Pt[row * 4 + 1], c = Pt[row * 4 + 2], d = Pt[row * 4 + 3];
            const float mt = (a.x + b2.x + c.x + d.x) * 0.25f;
            const float da = a.x - mt, db = b2.x - mt, dc = c.x - mt, dd = d.x - mt;
            const float m2 = (a.y + b2.y) + (c.y + d.y) + 64.0f * ((da * da + db * db) + (dc * dc + dd * dd));
            __hip_atomic_store(xbuf + ((size_t)(u.pm * BM + row) * 4 + u.pn), ((unsigned long long)__float_as_uint(m2) << 32) | __float_as_uint(mt), __ATOMIC_RELAXED, __HIP_MEMORY_SCOPE_AGENT);
        }
        asm volatile("s_waitcnt vmcnt(0)" ::: "memory");
        if (lane == 0) __hip_atomic_fetch_add(cw, 1u, __ATOMIC_RELAXED, __HIP_MEMORY_SCOPE_AGENT);
        if (wid == 0) {
            unsigned sp = 0;
            while ((unsigned)__builtin_amdgcn_readfirstlane(__hip_atomic_load(cw, __ATOMIC_RELAXED, __HIP_MEMORY_SCOPE_AGENT)) < 32u) { __builtin_amdgcn_s_sleep(2); if (++sp > (1u << 22)) break; }
            __builtin_amdgcn_fence(__ATOMIC_ACQUIRE, "agent");
        }
        asm volatile("s_waitcnt vmcnt(0) lgkmcnt(0)" ::: "memory"); __builtin_amdgcn_s_barrier(); asm volatile("" ::: "memory");
        if (lane < 32) {
            const unsigned long long* slot = xbuf + (size_t)(u.pm * BM + row) * 4; float mt[4], m2[4]; float ms = 0.f;
#pragma unroll
            for (int t = 0; t < 4; ++t) { const unsigned long long w = __hip_atomic_load(slot + t, __ATOMIC_RELAXED, __HIP_MEMORY_SCOPE_AGENT); mt[t] = __uint_as_float((unsigned)w); m2[t] = __uint_as_float((unsigned)(w >> 32)); ms += mt[t]; }
            const float mean = ms * 0.25f; float q = 0.f;
#pragma unroll
            for (int t = 0; t < 4; ++t) { const float dm = mt[t] - mean; q += m2[t] + 256.0f * dm * dm; }
            St[row] = (f32x2v){mean, 1.0f / sqrtf(q * (1.0f / 1024.0f) + 1e-5f)};
        }
        asm volatile("s_waitcnt lgkmcnt(0)" ::: "memory"); __builtin_amdgcn_s_barrier(); asm volatile("" ::: "memory");
#pragma unroll
        for (int bj = 0; bj < 2; ++bj)
#pragma unroll
            for (int n = 0; n < 2; ++n) {
                const f32x4 gv = *(const f32x4*)(gam + col0 + bj * HALF + n * 16), bv = *(const f32x4*)(bet + col0 + bj * HALF + n * 16);
#pragma unroll
                for (int ai = 0; ai < 2; ++ai)
#pragma unroll
                    for (int m = 0; m < 4; ++m) { const int r = ai * HALF + wr * 64 + m * 16 + fr; const f32x2v sr = St[r]; const size_t off = (size_t)(u.pm * BM + r) * 1024 + col0 + bj * HALF + n * 16;
                        const f32x4 o = (acc[ai][bj][m][n] - sr.x) * sr.y * gv + bv;
                        *(f32x4*)(out + off) = o;
                        uint2 w; w.x = cvtpk_s(o[0], o[1]); w.y = cvtpk_s(o[2], o[3]); *(uint2*)(xb + off) = w; }
            }
    }
};

template <class Epi, class Sched, bool ALIGN_EPI = false, bool SP2 = false>
__device__ __forceinline__ void gemm_phase(PG8_LAS unsigned char* lds, const Gemm g, const Sched& S, const Epi& E, const int tid_in  ) {
    const int tid = tid_in, wid = __builtin_amdgcn_readfirstlane(tid >> 6), lane = tid & 63, wr = wid >> 2, wc = wid & 3, fr = lane & 15, fq = lane >> 4;
    const int K = g.K, nt = K / BK;
    unsigned voffA[2], voffB[2];
#pragma unroll
    for (int i = 0; i < 2; ++i) { int R, C; stage_rc(tid * 16 + i * 8192, R, C); const int Rb = Epi::PERM ? ((R & ~31) + perm32(R & 31)) : R;
        voffA[i] = (unsigned)(R * K + C) * 2u; voffB[i] = (unsigned)(Rb * K + C) * 2u; }
    const size_t kstep = (size_t)(BK * 2);
    const size_t hstep = (size_t)HALF * K * 2;
    const size_t tstep = 2 * hstep;
    const unsigned ldsw = (unsigned)wid * 1024u;
    const int aoff = lds_byte(wr * 64 + fr, fq * 8), boff = lds_byte(wc * 32 + fr, fq * 8);
#define PG8_SA(b, h) (((b) * 2 + (h)) * HTB)
#define PG8_SB(b, h) ((4 + (b) * 2 + (h)) * HTB)
#define PG8_STAGE(bufoff, gbase, voff) do { _Pragma("unroll") for (int _i = 0; _i < 2; ++_i) \
        __builtin_amdgcn_global_load_lds((const unsigned*)((const char*)(gbase) + (voff)[_i]), (PG8_LAS unsigned*)(lds + (bufoff) + ldsw + _i * 8192), 16, 0, 0); } while (0)
#define PG8_LDA(dst, b, h) do { _Pragma("unroll") for (int m = 0; m < 4; ++m) _Pragma("unroll") for (int k = 0; k < 2; ++k) dst[m][k] = *(const PG8_LAS bf16x8*)(lds + PG8_SA(b, h) + aoff + m * 2048 + k * 1024); } while (0)
#define PG8_LDB(dst, b, h) do { _Pragma("unroll") for (int n = 0; n < 2; ++n) _Pragma("unroll") for (int k = 0; k < 2; ++k) dst[n][k] = *(const PG8_LAS bf16x8*)(lds + PG8_SB(b, h) + boff + n * 2048 + k * 1024); } while (0)
#define PG8_MMA(ai, bj, At, Bt) do { __builtin_amdgcn_s_setprio(1); _Pragma("unroll") for (int m = 0; m < 4; ++m) _Pragma("unroll") for (int n = 0; n < 2; ++n) _Pragma("unroll") for (int k = 0; k < 2; ++k) \
        acc[ai][bj][m][n] = __builtin_amdgcn_mfma_f32_16x16x32_bf16(Bt[n][k], At[m][k], acc[ai][bj][m][n], 0, 0, 0); __builtin_amdgcn_s_setprio(0); } while (0)
#define PG8_WAIT_V(n) asm volatile("s_waitcnt vmcnt(" #n ")" ::: "memory")
#define PG8_WAIT_L(n) asm volatile("s_waitcnt lgkmcnt(" #n ")" ::: "memory")
#define PG8_BAR __builtin_amdgcn_s_barrier()
#define PG8_SCHED __builtin_amdgcn_sched_barrier(0)
    Unit cur, nxt; int ui = 0;
    if (!S.next(0, cur)) return;
    f32x4 acc[2][2][4][2];
#pragma unroll
    for (int a = 0; a < 2; ++a)
#pragma unroll
        for (int b = 0; b < 2; ++b)
#pragma unroll
            for (int m = 0; m < 4; ++m)
#pragma unroll
                for (int n = 0; n < 2; ++n) acc[a][b][m][n] = (f32x4){0.f, 0.f, 0.f, 0.f};
    bf16x8 At[4][2], B0[2][2], B1[2][2];
    const char* cA = (const char*)g.A + (size_t)cur.pm * tstep; const char* cB = (const char*)g.Bt + (size_t)cur.pn * tstep;
    S.a_ready(cur);
    if constexpr (SP2) {
        PG8_STAGE(PG8_SB(0, 0), cB, voffB); PG8_STAGE(PG8_SB(0, 1), cB + hstep, voffB); PG8_STAGE(PG8_SA(0, 0), cA, voffA); PG8_STAGE(PG8_SA(0, 1), cA + hstep, voffA);
        if (wr == 1) PG8_BAR;
        PG8_WAIT_V(2); PG8_BAR;
        PG8_STAGE(PG8_SB(1, 0), cB + kstep, voffB); PG8_STAGE(PG8_SA(1, 0), cA + kstep, voffA); PG8_STAGE(PG8_SB(1, 1), cB + hstep + kstep, voffB);
        PG8_WAIT_V(6); PG8_BAR;
    } else {
        PG8_STAGE(PG8_SB(0, 0), cB, voffB); PG8_STAGE(PG8_SA(0, 0), cA, voffA); PG8_STAGE(PG8_SB(0, 1), cB + hstep, voffB); PG8_STAGE(PG8_SA(0, 1), cA + hstep, voffA);
        if (wr == 1) PG8_BAR;
        PG8_WAIT_V(4); PG8_BAR;
        PG8_STAGE(PG8_SB(1, 0), cB + kstep, voffB); PG8_STAGE(PG8_SA(1, 0), cA + kstep, voffA); PG8_STAGE(PG8_SB(1, 1), cB + hstep + kstep, voffB);
        PG8_WAIT_V(6); PG8_BAR;
    }
    for (;;) {
        const bool has_next = S.next(ui + 1, nxt);
        const char* nA = has_next ? (const char*)g.A + (size_t)nxt.pm * tstep : cA; const char* nB = has_next ? (const char*)g.Bt + (size_t)nxt.pn * tstep : cB;
        for (int t = 0; t < nt; t += 2) {
            const bool last = (t == nt - 2);
            const char* a1 = cA + (size_t)(t + 1) * kstep;
            const char* a2 = last ? nA : cA + (size_t)(t + 2) * kstep; const char* b2 = last ? nB : cB + (size_t)(t + 2) * kstep;
            const char* a3 = a2 + kstep; const char* b3 = b2 + kstep;
            if (last && has_next) S.a_ready(nxt);
            if constexpr (SP2) {
            PG8_LDB(B0, 0, 0); PG8_LDB(B1, 0, 1); PG8_SCHED; PG8_LDA(At, 0, 0); PG8_STAGE(PG8_SA(1, 1), a1 + hstep, voffA);
            PG8_WAIT_V(8); PG8_WAIT_L(0); PG8_BAR; PG8_MMA(0, 0, At, B0); PG8_MMA(0, 1, At, B1); PG8_BAR; PG8_SCHED;
            PG8_LDA(At, 0, 1); PG8_STAGE(PG8_SB(0, 0), b2, voffB); PG8_STAGE(PG8_SB(0, 1), b2 + hstep, voffB); PG8_STAGE(PG8_SA(0, 0), a2, voffA);
            PG8_WAIT_V(8); PG8_WAIT_L(0); PG8_BAR; PG8_MMA(1, 0, At, B0); PG8_MMA(1, 1, At, B1); PG8_BAR; PG8_SCHED;
            PG8_LDB(B0, 1, 0); PG8_LDB(B1, 1, 1); PG8_SCHED; PG8_LDA(At, 1, 0); PG8_STAGE(PG8_SA(0, 1), a2 + hstep, voffA);
            PG8_WAIT_V(8); PG8_WAIT_L(0); PG8_BAR; PG8_MMA(0, 0, At, B0); PG8_MMA(0, 1, At, B1); PG8_BAR; PG8_SCHED;
            PG8_LDA(At, 1, 1); PG8_STAGE(PG8_SB(1, 0), b3, voffB); PG8_STAGE(PG8_SB(1, 1), b3 + hstep, voffB); PG8_STAGE(PG8_SA(1, 0), a3, voffA);
            PG8_WAIT_V(8); PG8_WAIT_L(0); PG8_BAR; PG8_MMA(1, 0, At, B0); PG8_MMA(1, 1, At, B1); PG8_BAR; PG8_SCHED;
            } else {
            PG8_LDB(B0, 0, 0); PG8_SCHED; PG8_LDA(At, 0, 0); PG8_STAGE(PG8_SA(1, 1), a1 + hstep, voffA);
            PG8_WAIT_L(8); PG8_BAR; PG8_WAIT_L(0); PG8_MMA(0, 0, At, B0); PG8_BAR; PG8_SCHED;
            PG8_LDB(B1, 0, 1); PG8_STAGE(PG8_SB(0, 0), b2, voffB);
            PG8_BAR; PG8_WAIT_L(0); PG8_MMA(0, 1, At, B1); PG8_BAR;
            PG8_LDA(At, 0, 1); PG8_STAGE(PG8_SA(0, 0), a2, voffA);
            PG8_BAR; PG8_WAIT_L(0); PG8_MMA(1, 0, At, B0); PG8_BAR; PG8_SCHED;
            PG8_STAGE(PG8_SB(0, 1), b2 + hstep, voffB);
            PG8_WAIT_V(6); PG8_BAR; PG8_MMA(1, 1, At, B1); PG8_BAR;
            PG8_LDB(B0, 1, 0); PG8_SCHED; PG8_LDA(At, 1, 0); PG8_STAGE(PG8_SA(0, 1), a2 + hstep, voffA);
            PG8_WAIT_L(8); PG8_BAR; PG8_WAIT_L(0); PG8_MMA(0, 0, At, B0); PG8_BAR; PG8_SCHED;
            PG8_LDB(B1, 1, 1); PG8_STAGE(PG8_SB(1, 0), b3, voffB);
            PG8_BAR; PG8_WAIT_L(0); PG8_MMA(0, 1, At, B1); PG8_BAR;
            PG8_LDA(At, 1, 1); PG8_STAGE(PG8_SA(1, 0), a3, voffA);
            PG8_BAR; PG8_WAIT_L(0); PG8_MMA(1, 0, At, B0); PG8_BAR; PG8_SCHED;
            PG8_STAGE(PG8_SB(1, 1), b3 + hstep, voffB);
            PG8_WAIT_V(6); PG8_BAR; PG8_MMA(1, 1, At, B1); PG8_BAR;
            }
        }
        if constexpr (ALIGN_EPI) { if (wr == 0) PG8_BAR; }
        if constexpr (!Epi::AFTER_DRAIN) { E(acc, cur, wr, wc, fr, fq); S.done(cur); }
        if (!has_next) break;
#pragma unroll
        for (int a = 0; a < 2; ++a)
#pragma unroll
            for (int b = 0; b < 2; ++b)
#pragma unroll
                for (int m = 0; m < 4; ++m)
#pragma unroll
                    for (int n = 0; n < 2; ++n) acc[a][b][m][n] = (f32x4){0.f, 0.f, 0.f, 0.f};
        cur = nxt; cA = nA; cB = nB; ++ui;
        if constexpr (ALIGN_EPI) { if (wr == 1) PG8_BAR; }
    }
    PG8_WAIT_V(0);
    if constexpr (!ALIGN_EPI) { if (wr == 0) PG8_BAR; }
    PG8_BAR;
    if constexpr (Epi::AFTER_DRAIN) { E.fused(acc, cur, wr, wc, fr, fq, lds, wid, lane); S.done(cur); }
#undef PG8_SA
#undef PG8_SB
#undef PG8_STAGE
#undef PG8_LDA
#undef PG8_LDB
#undef PG8_MMA
#undef PG8_WAIT_V
#undef PG8_WAIT_L
#undef PG8_BAR
#undef PG8_SCHED
}
}
#define XB_TMO      128
#define XB_XCNT(j)  (256  + 64 * (j))
#define XB_XSUB(j)  (1280 + 64 * (j))
#define XB_XGEN(j)  (2304 + 64 * (j))
#define XB_TOP      3328
#define XB_TOPGEN   3392
#define XCD_BAR_WORDS 3456
#define XB_SPIN_CAP (1u << 18)

__device__ __forceinline__ unsigned xb_ld(unsigned* p)              { return __hip_atomic_load((__attribute__((address_space(1))) unsigned*)p, __ATOMIC_RELAXED, __HIP_MEMORY_SCOPE_AGENT); }
__device__ __forceinline__ unsigned xb_add(unsigned* p, unsigned v) { return __hip_atomic_fetch_add((__attribute__((address_space(1))) unsigned*)p, v, __ATOMIC_RELAXED, __HIP_MEMORY_SCOPE_AGENT); }
__device__ __forceinline__ unsigned xb_xcc_id() { return (unsigned)__builtin_amdgcn_s_getreg((3 << 11) | 20) & 0xFu; }
#define XB_SPIN(cond, bar) do { unsigned _sp = 0; while (cond) { __builtin_amdgcn_s_sleep(1); \
    if ((++_sp & 255u) == 0u) { if (xb_ld(&(bar)[XB_TMO])) break; if (_sp > XB_SPIN_CAP) { atomicAdd(&(bar)[XB_TMO], 1u); break; } } } } while (0)

struct XcdBarrier {
    unsigned* bar; unsigned x;
    volatile LAS unsigned* st;
};

__device__ __forceinline__ XcdBarrier xcd_barrier_post(unsigned* bar, volatile LAS unsigned* st) {
    XcdBarrier b; b.bar = bar; b.x = xb_xcc_id(); b.st = st;
    if (threadIdx.x == 0) (void)xb_add(&bar[XB_XCNT(b.x)], 1u);
    return b;
}
__device__ __forceinline__ void xcd_barrier_complete(unsigned* bar, unsigned x, unsigned& nloc, unsigned& nx) {
    const unsigned G = gridDim.x * gridDim.y * gridDim.z;
    unsigned sum, cnt, mine, sp = 0u;
    for (;;) {
        sum = 0u; cnt = 0u; mine = 0u;
#pragma unroll
        for (unsigned j = 0; j < 16; ++j) { const unsigned c = xb_ld(&bar[XB_XCNT(j)]); sum += c; cnt += (c > 0u) ? 1u : 0u; mine = (j == x) ? c : mine; }
        if (sum == G) break;
        __builtin_amdgcn_s_sleep(1);
        if ((++sp & 255u) == 0u) { if (xb_ld(&bar[XB_TMO])) break; if (sp > XB_SPIN_CAP) { atomicAdd(&bar[XB_TMO], 1u); break; } }
    }
    nloc = mine > 0u ? mine : 1u; nx = cnt > 0u ? cnt : 1u;
}

__device__ __forceinline__ void xcd_barrier(const XcdBarrier& b) {
    asm volatile("s_waitcnt vmcnt(0)" ::: "memory");
    __syncthreads();
    if (threadIdx.x == 0) {
        unsigned* bar = b.bar;
        __builtin_amdgcn_s_waitcnt(0);
        unsigned nloc = b.st[0], nx = b.st[1];
        if (nloc == 0u) { xcd_barrier_complete(bar, b.x, nloc, nx); b.st[0] = nloc; b.st[1] = nx; }
        const unsigned old = xb_add(&bar[XB_XSUB(b.x)], 1u);
        const unsigned gen = old / nloc;
        if (old + 1u == (gen + 1u) * nloc) {
            __builtin_amdgcn_fence(__ATOMIC_RELEASE, "agent");
            asm volatile("s_waitcnt vmcnt(0)" ::: "memory");
            const unsigned og = xb_add(&bar[XB_TOP], 1u);
            const unsigned tg = og / nx;
            if (og + 1u == (tg + 1u) * nx) xb_add(&bar[XB_TOPGEN], 1u);
            else XB_SPIN(xb_ld(&bar[XB_TOPGEN]) == tg, bar);
            __builtin_amdgcn_fence(__ATOMIC_ACQUIRE, "agent");
            xb_add(&bar[XB_XGEN(b.x)], 1u);
            asm volatile("s_waitcnt vmcnt(0)" ::: "memory");
        } else {
            XB_SPIN(xb_ld(&bar[XB_XGEN(b.x)]) == gen, bar);
            __builtin_amdgcn_fence(__ATOMIC_ACQUIRE, "agent");
            asm volatile("s_waitcnt vmcnt(0)" ::: "memory");
        }
    }
    __syncthreads();
}
namespace fa {
typedef short bf16x8 __attribute__((ext_vector_type(8)));
typedef float f32x16 __attribute__((ext_vector_type(16)));
typedef short v4i16_t __attribute__((ext_vector_type(4)));
constexpr int KT_OFF = 0, VT_OFF = 8192, LUT_OFF = 16384, OST_OFF = 24576, FA_LDS = OST_OFF + 8 * 4096;
__device__ __forceinline__ int crow(int r, int hi) { return (r & 3) + 8 * (r >> 2) + 4 * hi; }
__device__ __forceinline__ unsigned cvtpk(float lo, float hi) { return cvtpk_s(lo, hi); }
template <int B> __device__ __forceinline__ bf16x8 pack8(const f32x16& p) {
    u32x4 w; w.x = cvtpk(p[B], p[B + 1]); w.y = cvtpk(p[B + 2], p[B + 3]); w.z = cvtpk(p[B + 4], p[B + 5]); w.w = cvtpk(p[B + 6], p[B + 7]);
    return __builtin_bit_cast(bf16x8, w);
}
__device__ __forceinline__ v4i16_t trd(LAS const unsigned char* p) { return __builtin_amdgcn_ds_read_tr16_b64_v4i16((LAS v4i16_t*)p); }
__device__ __forceinline__ void stage_tile(LAS unsigned char* lds, int tid, const bf16_t* krow, const bf16_t* vrow) {
    const int row = tid >> 3, ch = tid & 7;
    u32x4 kv = {0u, 0u, 0u, 0u}, vv = {0u, 0u, 0u, 0u};
    if (krow) { kv = *(const u32x4*)(krow + ch * 8); vv = *(const u32x4*)(vrow + ch * 8); }
    *(LAS u32x4*)(lds + KT_OFF + row * 128 + ((ch ^ (row & 7)) * 16)) = kv;
    *(LAS u32x4*)(lds + VT_OFF + row * 128 + ch * 16) = vv;
}
template <class Fn> __device__ __forceinline__ void tile_step(LAS const unsigned char* lds, const bf16x8 (&qf)[4], f32x16& o0, f32x16& o1, float& m, float& l, int lane, const Fn& fn) {
    const int r32 = lane & 31, hi = lane >> 5;
    f32x16 p0, p1;
#pragma unroll
    for (int r = 0; r < 16; ++r) { p0[r] = 0.f; p1[r] = 0.f; }
#pragma unroll
    for (int s = 0; s < 4; ++s) {
        const int ch = ((2 * s + hi) ^ (r32 & 7)) * 16;
        const bf16x8 k0 = *(const LAS bf16x8*)(lds + KT_OFF + r32 * 128 + ch);
        const bf16x8 k1 = *(const LAS bf16x8*)(lds + KT_OFF + (32 + r32) * 128 + ch);
        p0 = __builtin_amdgcn_mfma_f32_32x32x16_bf16(k0, qf[s], p0, 0, 0, 0);
        p1 = __builtin_amdgcn_mfma_f32_32x32x16_bf16(k1, qf[s], p1, 0, 0, 0);
    }
    float mx = NEGF;
#pragma unroll
    for (int r = 0; r < 16; ++r) { p0[r] = fn(crow(r, hi), p0[r]); p1[r] = fn(32 + crow(r, hi), p1[r]); mx = fmaxf(mx, fmaxf(p0[r], p1[r])); }
    mx = fmaxf(mx, __shfl_xor(mx, 32));
    const float mn = fmaxf(m, mx), alpha = __expf(m - mn);
    m = mn;
    float ps = 0.f;
#pragma unroll
    for (int r = 0; r < 16; ++r) { p0[r] = __expf(p0[r] - mn); p1[r] = __expf(p1[r] - mn); ps += p0[r] + p1[r]; }
    l = l * alpha + ps;
#pragma unroll
    for (int r = 0; r < 16; ++r) { o0[r] *= alpha; o1[r] *= alpha; }
    const int q4 = (lane & 15) >> 2, p4 = lane & 3, dgrp = (lane >> 4) & 1;
    const int vb = VT_OFF + (4 * hi + q4) * 128 + (16 * dgrp + 4 * p4) * 2;
#define FA_PV(P, KH, S2) do { const bf16x8 pb = pack8<8 * (S2)>(P); \
        _Pragma("unroll") for (int blk = 0; blk < 2; ++blk) { const int a = vb + (32 * (KH) + 16 * (S2)) * 128 + blk * 64; \
            const v4i16_t lo = trd(lds + a), hh = trd(lds + a + 8 * 128); \
            const bf16x8 va = {lo[0], lo[1], lo[2], lo[3], hh[0], hh[1], hh[2], hh[3]}; \
            if (blk == 0) o0 = __builtin_amdgcn_mfma_f32_32x32x16_bf16(va, pb, o0, 0, 0, 0); else o1 = __builtin_amdgcn_mfma_f32_32x32x16_bf16(va, pb, o1, 0, 0, 0); } } while (0)
    FA_PV(p0, 0, 0); FA_PV(p0, 0, 1); FA_PV(p1, 1, 0); FA_PV(p1, 1, 1);
#undef FA_PV
}
template <class RowFn> __device__ __forceinline__ float store_o(LAS unsigned char* lds, int wave, int lane, const f32x16& o0, const f32x16& o1, float l, const RowFn& orow) {
    const int r32 = lane & 31, hi = lane >> 5;
    l += __shfl_xor(l, 32);
    const float inv = 1.0f / l;
    LAS bf16_t* stg = (LAS bf16_t*)(lds + OST_OFF + wave * 4096);
#pragma unroll
    for (int r = 0; r < 16; ++r) { const int d = crow(r, hi); stg[r32 * 64 + d] = f2bf(o0[r] * inv); stg[r32 * 64 + 32 + d] = f2bf(o1[r] * inv); }
    asm volatile("s_waitcnt lgkmcnt(0)" ::: "memory");
#pragma unroll
    for (int i = 0; i < 4; ++i) { const int row = i * 8 + (lane >> 3), ch = lane & 7; const u32x4 v = *(const LAS u32x4*)(stg + row * 64 + ch * 8); *(u32x4*)(orow(row) + ch * 8) = v; }
    asm volatile("s_waitcnt lgkmcnt(0)" ::: "memory");
    return l;
}
struct DilFn {
    int qrel; LAS const float* lut;
    int ksub0;
    __device__ __forceinline__ float operator()(int key, float s) const {
        const int d = qrel - key; const bool ok = (d >= 0) && (d <= 128) && (ksub0 + key >= 0);
        const float b = lut[min(max(d, 0), 128)];
        return ok ? fmaf(s, 0.125f, b) : NEGF;
    }
};
struct MobaFn {
    int qrel; LAS const float* lut; bool allowed; bool causal;
    __device__ __forceinline__ float operator()(int key, float s) const {
        const int d = qrel - key; const bool ok = causal ? (d >= 0) : allowed;
        const float b = lut[min(max(d, 0), 1535)];
        return ok ? fmaf(s, 0.125f, b) : NEGF;
    }
};
__device__ __forceinline__ void dilated_unit(LAS unsigned char* lds, int tid, int pi, int bh, int u, const bf16_t* __restrict__ proj, const float* __restrict__ rel_bias, bf16_t* __restrict__ PO, float* __restrict__ PL) {
    const int lane = tid & 63, wave = __builtin_amdgcn_readfirstlane(tid >> 6), r32 = lane & 31, hi = lane >> 5;
    const int dil = (pi == 0) ? 1 : (pi == 1) ? 4 : 16, b = bh >> 2, h = bh & 3;
    const int r = u % dil, sb = u / dil;
    __syncthreads();
    LAS float* lut = (LAS float*)(lds + LUT_OFF);
    if (tid <= 128) lut[tid] = rel_bias[t5_bucket(tid * dil) * 8 + 4 + h];
    const int qsub = 256 * sb + 32 * wave + r32;
    const size_t qrow = (size_t)b * SEQ + (size_t)qsub * dil + r;
    bf16x8 qf[4];
#pragma unroll
    for (int s = 0; s < 4; ++s) qf[s] = *(const bf16x8*)(proj + qrow * NIN + COL_QD + h * 64 + 16 * s + 8 * hi);
    f32x16 o0, o1;
#pragma unroll
    for (int i = 0; i < 16; ++i) { o0[i] = 0.f; o1[i] = 0.f; }
    float m = NEGF, l = 0.f;
    for (int j = (sb == 0 ? 2 : 0); j < 6; ++j) {
        const int ksub0 = 256 * sb - 128 + 64 * j;
        { const int ksub = ksub0 + (tid >> 3);
          const bf16_t* base = (ksub >= 0) ? proj + ((size_t)b * SEQ + (size_t)ksub * dil + r) * NIN + h * 64 : nullptr;
          __syncthreads();
          stage_tile(lds, tid, base ? base + COL_KD : nullptr, base ? base + COL_VD : nullptr); }
        __syncthreads();
        if (64 * j + 63 >= 32 * wave && 64 * j <= 32 * wave + 159) {
            DilFn fn{qsub - ksub0, lut, ksub0};
            tile_step(lds, qf, o0, o1, m, l, lane, fn);
        }
    }
    const size_t rbase = (size_t)b * SEQ + (size_t)(256 * sb + 32 * wave) * dil + r;
    bf16_t* po = PO + (size_t)pi * M * 256 + h * 64;
    const float lt = store_o(lds, wave, lane, o0, o1, l, [&](int q) { return po + (rbase + (size_t)q * dil) * 256; });
    if (hi == 0) PL[((size_t)pi * M + qrow) * 4 + h] = m + __logf(lt);
}
__device__ __forceinline__ void moba_unit(LAS unsigned char* lds, int tid, int bh, int own, const bf16_t* __restrict__ proj, const float* __restrict__ kmean, const float* __restrict__ rel_bias, bf16_t* __restrict__ Y) {
    const int lane = tid & 63, wave = __builtin_amdgcn_readfirstlane(tid >> 6), r32 = lane & 31, hi = lane >> 5;
    const int b = bh >> 2, h = bh & 3;
    __syncthreads();
    LAS float* lut = (LAS float*)(lds + LUT_OFF);
    for (int d = tid; d < 1536; d += 512) lut[d] = rel_bias[t5_bucket(d) * 8 + h];
    const int qpos = 256 * own + 32 * wave + r32;
    const size_t qrow = (size_t)b * SEQ + qpos;
    bf16x8 qf[4];
#pragma unroll
    for (int s = 0; s < 4; ++s) qf[s] = *(const bf16x8*)(proj + qrow * NIN + COL_QA + h * 64 + 16 * s + 8 * hi);
    unsigned selbits = 0u;
    {
        f32x16 g;
#pragma unroll
        for (int i = 0; i < 16; ++i) g[i] = 0.f;
        const float* km = kmean + ((size_t)bh * 32 + r32) * 64;
#pragma unroll
        for (int s = 0; s < 4; ++s) {
            float kv[8];
            *(float4*)&kv[0] = *(const float4*)(km + 16 * s + 8 * hi); *(float4*)&kv[4] = *(const float4*)(km + 16 * s + 8 * hi + 4);
            u32x4 wh, wl;
#pragma unroll
            for (int j = 0; j < 4; ++j) {
                const bf16_t h0 = f2bf(kv[2 * j]), h1 = f2bf(kv[2 * j + 1]);
                const bf16_t l0 = f2bf(kv[2 * j] - bf2f(h0)), l1 = f2bf(kv[2 * j + 1] - bf2f(h1));
                wh[j] = (unsigned)h0 | ((unsigned)h1 << 16); wl[j] = (unsigned)l0 | ((unsigned)l1 << 16);
            }
            g = __builtin_amdgcn_mfma_f32_32x32x16_bf16(__builtin_bit_cast(bf16x8, wh), qf[s], g, 0, 0, 0);
            g = __builtin_amdgcn_mfma_f32_32x32x16_bf16(__builtin_bit_cast(bf16x8, wl), qf[s], g, 0, 0, 0);
        }
#pragma unroll
        for (int i = 0; i < 16; ++i) if (crow(i, hi) >= own) g[i] = -INFINITY;
#pragma unroll
        for (int t = 0; t < 3; ++t) {
            float lm = -INFINITY;
#pragma unroll
            for (int i = 0; i < 16; ++i) lm = fmaxf(lm, g[i]);
            const float gm = fmaxf(lm, __shfl_xor(lm, 32));
            int cand = 99;
#pragma unroll
            for (int i = 15; i >= 0; --i) if (g[i] == gm) cand = crow(i, hi);
            cand = min(cand, __shfl_xor(cand, 32));
            if (gm > -INFINITY) {
                selbits |= 1u << cand;
#pragma unroll
                for (int i = 0; i < 16; ++i) if (crow(i, hi) == cand) g[i] = -INFINITY;
            }
        }
    }
    f32x16 o0, o1;
#pragma unroll
    for (int i = 0; i < 16; ++i) { o0[i] = 0.f; o1[i] = 0.f; }
    float m = NEGF, l = 0.f;
    for (int n = 0; n <= own; ++n) {
        const bool allowed = (selbits >> n) & 1u;
        const bool need = (n == own) || (__ballot(allowed) != 0ull);
        for (int kt = 0; kt < 4; ++kt) {
            const int kpos0 = 256 * n + 64 * kt;
            { const bf16_t* base = proj + ((size_t)b * SEQ + kpos0 + (tid >> 3)) * NIN + h * 64;
              __syncthreads();
              stage_tile(lds, tid, base + COL_KA, base + COL_VA); }
            __syncthreads();
            if (need && (n < own || 64 * kt <= 32 * wave + 31)) {
                MobaFn fn{qpos - kpos0, lut, allowed, n == own};
                tile_step(lds, qf, o0, o1, m, l, lane, fn);
            }
        }
    }
    bf16_t* yo = Y + ((size_t)b * SEQ + 256 * own + 32 * wave) * DM + h * 64;
    store_o(lds, wave, lane, o0, o1, l, [&](int q) { return yo + (size_t)q * DM; });
}
}

namespace fa2 {
using fa::bf16x8; using fa::f32x16; using fa::v4i16_t; using fa::crow; using fa::pack8; using fa::trd;
constexpr float C2LOG = 0.125f * 1.4426950408889634f;
template <class Fn> __device__ __forceinline__ void step64(LAS const unsigned char* lds, int koff, int voff, const bf16x8 (&qf)[4], f32x16& o0, f32x16& o1, float& m, float& l, int lane, const Fn& fn) {
    const int r32 = lane & 31, hi = lane >> 5;
    f32x16 p0, p1;
#pragma unroll
    for (int r = 0; r < 16; ++r) { p0[r] = 0.f; p1[r] = 0.f; }
#pragma unroll
    for (int s = 0; s < 4; ++s) {
        const int ch = ((2 * s + hi) ^ (r32 & 7)) * 16;
        const bf16x8 k0 = *(const LAS bf16x8*)(lds + koff + r32 * 128 + ch);
        const bf16x8 k1 = *(const LAS bf16x8*)(lds + koff + (32 + r32) * 128 + ch);
        p0 = __builtin_amdgcn_mfma_f32_32x32x16_bf16(k0, qf[s], p0, 0, 0, 0);
        p1 = __builtin_amdgcn_mfma_f32_32x32x16_bf16(k1, qf[s], p1, 0, 0, 0);
    }
    float mx = NEGF;
#pragma unroll
    for (int r = 0; r < 16; ++r) { const int kc = (r & 3) + 8 * (r >> 2); p0[r] = fn(kc, p0[r]); p1[r] = fn(32 + kc, p1[r]); mx = fmaxf(mx, fmaxf(p0[r], p1[r])); }
    mx = fmaxf(mx, __shfl_xor(mx, 32));
    const float mn = fmaxf(m, mx), alpha = __builtin_amdgcn_exp2f(m - mn);
    m = mn;
    float ps = 0.f;
#pragma unroll
    for (int r = 0; r < 16; ++r) { p0[r] = __builtin_amdgcn_exp2f(p0[r] - mn); p1[r] = __builtin_amdgcn_exp2f(p1[r] - mn); ps += p0[r] + p1[r]; }
    l = l * alpha + ps;
    if (!__all(alpha == 1.0f)) {
#pragma unroll
        for (int r = 0; r < 16; ++r) { o0[r] *= alpha; o1[r] *= alpha; }
    }
    const int q4 = (lane & 15) >> 2, p4 = lane & 3, dgrp = (lane >> 4) & 1;
    const int vb = voff + (4 * hi + q4) * 128 + (16 * dgrp + 4 * p4) * 2;
#define FA_PV(P, KH, S2) do { const bf16x8 pb = pack8<8 * (S2)>(P); \
        _Pragma("unroll") for (int blk = 0; blk < 2; ++blk) { const int a = vb + (32 * (KH) + 16 * (S2)) * 128 + blk * 64; \
            const v4i16_t lo = trd(lds + a), hh = trd(lds + a + 8 * 128); \
            const bf16x8 va = {lo[0], lo[1], lo[2], lo[3], hh[0], hh[1], hh[2], hh[3]}; \
            if (blk == 0) o0 = __builtin_amdgcn_mfma_f32_32x32x16_bf16(va, pb, o0, 0, 0, 0); else o1 = __builtin_amdgcn_mfma_f32_32x32x16_bf16(va, pb, o1, 0, 0, 0); } } while (0)
    FA_PV(p0, 0, 0); FA_PV(p0, 0, 1); FA_PV(p1, 1, 0); FA_PV(p1, 1, 1);
#undef FA_PV
}
struct TabFn { LAS const float* base;
    __device__ __forceinline__ float operator()(int kc, float s) const { return fmaf(s, C2LOG, base[59 - kc]); } };
struct TabLoFn { LAS const float* base; int klo4;
    __device__ __forceinline__ float operator()(int kc, float s) const { return kc >= klo4 ? fmaf(s, C2LOG, base[59 - kc]) : NEGF; } };
struct ConstFn { float b2;
    __device__ __forceinline__ float operator()(int, float s) const { return fmaf(s, C2LOG, b2); } };
template <int NIT, class RowFn> __device__ __forceinline__ void stage_rows(LAS unsigned char* lds, int koff, int voff, int tid, int kcol, int vcol, const RowFn& rowfn) {
    u32x4 kv[NIT], vv[NIT];
#pragma unroll
    for (int i = 0; i < NIT; ++i) { const int e = tid + 512 * i, row = e >> 3, ch = e & 7; bool ok; const bf16_t* rp = rowfn(row, ok);
        kv[i] = *(const u32x4*)(rp + kcol + ch * 8); vv[i] = *(const u32x4*)(rp + vcol + ch * 8);
        if (!ok) { kv[i] = (u32x4){0u, 0u, 0u, 0u}; vv[i] = (u32x4){0u, 0u, 0u, 0u}; } }
    __builtin_amdgcn_sched_barrier(0);
#pragma unroll
    for (int i = 0; i < NIT; ++i) { const int e = tid + 512 * i, row = e >> 3, ch = e & 7;
        *(LAS u32x4*)(lds + koff + row * 128 + ((ch ^ (row & 7)) * 16)) = kv[i];
        *(LAS u32x4*)(lds + voff + row * 128 + ch * 16) = vv[i]; }
}
template <class DstFn> __device__ __forceinline__ void store_rows(LAS unsigned char* lds, int ostoff, int lane, const f32x16& o0, const f32x16& o1, float linv, const DstFn& dst) {
    const int r32 = lane & 31, hi = lane >> 5;
    LAS unsigned char* stg = lds + ostoff;
#pragma unroll
    for (int r = 0; r < 16; r += 2) { const int d = crow(r, hi);
        *(LAS unsigned*)(stg + r32 * 128 + ((((d >> 3)) ^ (r32 & 7)) << 4) + (d & 7) * 2) = cvtpk_s(o0[r] * linv, o0[r + 1] * linv);
        *(LAS unsigned*)(stg + r32 * 128 + ((((d >> 3) + 4) ^ (r32 & 7)) << 4) + (d & 7) * 2) = cvtpk_s(o1[r] * linv, o1[r + 1] * linv); }
    asm volatile("s_waitcnt lgkmcnt(0)" ::: "memory");
#pragma unroll
    for (int i = 0; i < 4; ++i) { const int row = i * 8 + (lane >> 3), ch = lane & 7; const u32x4 v = *(const LAS u32x4*)(stg + row * 128 + ((ch ^ (row & 7)) << 4)); bf16_t* p = dst(row); if (p) *(u32x4*)(p + ch * 8) = v; }
    asm volatile("s_waitcnt lgkmcnt(0)" ::: "memory");
}
constexpr int D_K = 0, D_V = 49152, D_LUT = 98304, D_OST = 0;
template <class Hook> __device__ __forceinline__ void dilated_unit(const Hook& after_stage, LAS unsigned char* lds, int tid, int pi, int bh, int u, const bf16_t* __restrict__ proj, const float* __restrict__ lutd, bf16_t* __restrict__ PO, float* __restrict__ PL) {
    const int lane = tid & 63, wave = __builtin_amdgcn_readfirstlane(tid >> 6), r32 = lane & 31, hi = lane >> 5;
    const int dil = (pi == 0) ? 1 : (pi == 1) ? 4 : 16, b = bh >> 2, h = bh & 3;
    const int r = u % dil, sb = u / dil;
    __syncthreads();
    LAS float* lut = (LAS float*)(lds + D_LUT);
    if (tid < 64) ((LAS u32x4*)lut)[tid] = ((const u32x4*)(lutd + (pi * 4 + h) * 256))[tid];
    const int ks0 = 256 * sb - 128;
    stage_rows<6>(lds, D_K, D_V, tid, COL_KD + h * 64, COL_VD + h * 64, [&](int row, bool& ok) -> const bf16_t* { const int ks = ks0 + row; ok = ks >= 0; return proj + ((size_t)b * SEQ + (size_t)max(ks, 0) * dil + r) * NIN; });
    after_stage();
    const int qsub = 256 * sb + 32 * wave + r32;
    const size_t qrow = (size_t)b * SEQ + (size_t)qsub * dil + r;
    bf16x8 qf[4];
#pragma unroll
    for (int s = 0; s < 4; ++s) qf[s] = *(const bf16x8*)(proj + qrow * NIN + COL_QD + h * 64 + 16 * s + 8 * hi);
    f32x16 o0, o1;
#pragma unroll
    for (int i = 0; i < 16; ++i) { o0[i] = 0.f; o1[i] = 0.f; }
    float m = NEGF, l = 0.f;
    __syncthreads();
    const int j0 = wave >> 1;
#pragma unroll 1
    for (int j = j0; j < j0 + 3; ++j) {
        if (ks0 + 64 * j + 63 < 0) continue;
        const int qrel = 32 * wave + r32 + 128 - 64 * j, klo = -(ks0 + 64 * j);
        if (klo > 0) { TabLoFn fn{lut + (qrel - 4 * hi + 64 - 59), klo - 4 * hi}; step64(lds, D_K + j * 8192, D_V + j * 8192, qf, o0, o1, m, l, lane, fn); }
        else { TabFn fn{lut + (qrel - 4 * hi + 64 - 59)}; step64(lds, D_K + j * 8192, D_V + j * 8192, qf, o0, o1, m, l, lane, fn); }
    }
    __syncthreads();
    l += __shfl_xor(l, 32);
    const size_t rbase = (size_t)b * SEQ + (size_t)(256 * sb + 32 * wave) * dil + r;
    bf16_t* po = PO + (size_t)pi * M * 256 + h * 64;
    store_rows(lds, D_OST + wave * 4096, lane, o0, o1, 1.0f / l, [&](int q) { return po + (rbase + (size_t)q * dil) * 256; });
    if (hi == 0) PL[((size_t)pi * M + qrow) * 4 + h] = m * 0.6931471805599453f + __logf(l);
}
__device__ __forceinline__ void gate_item(LAS unsigned char* lds, int tid, int bh, int own, const bf16_t* __restrict__ proj, const float* __restrict__ kp, unsigned short* __restrict__ LIST, int* __restrict__ CNT) {
    const int lane = tid & 63, wave = __builtin_amdgcn_readfirstlane(tid >> 6), r32 = lane & 31, hi = lane >> 5;
    const int b = bh >> 2, h = bh & 3;
    LAS int* cnt = (LAS int*)lds;
    __syncthreads();
    if (tid < 32) cnt[tid] = 0;
    __syncthreads();
    const int qib = 32 * wave + r32;
    const size_t qrow = (size_t)b * SEQ + 256 * own + qib;
    bf16x8 qf[4];
#pragma unroll
    for (int s = 0; s < 4; ++s) qf[s] = *(const bf16x8*)(proj + qrow * NIN + COL_QA + h * 64 + 16 * s + 8 * hi);
    f32x16 g;
#pragma unroll
    for (int i = 0; i < 16; ++i) g[i] = 0.f;
    const float* k0 = kp + (size_t)((b * 32 + r32) * 2) * 256 + h * 64;
#pragma unroll
    for (int s = 0; s < 4; ++s) {
        float kv[8];
#pragma unroll
        for (int j = 0; j < 8; j += 4) { const float4 a = *(const float4*)(k0 + 16 * s + 8 * hi + j), c = *(const float4*)(k0 + 256 + 16 * s + 8 * hi + j);
            kv[j] = (a.x + c.x) * (1.0f / 256.0f); kv[j + 1] = (a.y + c.y) * (1.0f / 256.0f); kv[j + 2] = (a.z + c.z) * (1.0f / 256.0f); kv[j + 3] = (a.w + c.w) * (1.0f / 256.0f); }
        u32x4 wh, wl;
#pragma unroll
        for (int j = 0; j < 4; ++j) {
            const bf16_t h0 = f2bf(kv[2 * j]), h1 = f2bf(kv[2 * j + 1]);
            const bf16_t l0 = f2bf(kv[2 * j] - bf2f(h0)), l1 = f2bf(kv[2 * j + 1] - bf2f(h1));
            wh[j] = (unsigned)h0 | ((unsigned)h1 << 16); wl[j] = (unsigned)l0 | ((unsigned)l1 << 16);
        }
        g = __builtin_amdgcn_mfma_f32_32x32x16_bf16(__builtin_bit_cast(bf16x8, wh), qf[s], g, 0, 0, 0);
        g = __builtin_amdgcn_mfma_f32_32x32x16_bf16(__builtin_bit_cast(bf16x8, wl), qf[s], g, 0, 0, 0);
    }
#pragma unroll
    for (int i = 0; i < 16; ++i) if (crow(i, hi) >= own) g[i] = -INFINITY;
#pragma unroll
    for (int t = 0; t < 3; ++t) {
        float lm = -INFINITY;
#pragma unroll
        for (int i = 0; i < 16; ++i) lm = fmaxf(lm, g[i]);
        const float gm = fmaxf(lm, __shfl_xor(lm, 32));
        int cand = 99;
#pragma unroll
        for (int i = 15; i >= 0; --i) if (g[i] == gm) cand = crow(i, hi);
        cand = min(cand, __shfl_xor(cand, 32));
        if (gm > -INFINITY) {
#pragma unroll
            for (int i = 0; i < 16; ++i) if (crow(i, hi) == cand) g[i] = -INFINITY;
            if (hi == 0) { const int pos = atomicAdd((int*)&cnt[cand], 1); LIST[(((size_t)bh * 32 + cand) * 32 + own) * 256 + pos] = (unsigned short)((t << 8) | qib); }
        }
    }
    __syncthreads();
    if (tid < 32) CNT[((size_t)bh * 32 + tid) * 32 + own] = (tid < own) ? cnt[tid] : 0;
}
constexpr int M_K = 0, M_V = 32768, M_LUT = 65536, M_OST = 73728;
template <class Hook> __device__ __forceinline__ void moba_item(const Hook& after_stage, LAS unsigned char* lds, int tid, int bh, int n, int part, int nparts, const bf16_t* __restrict__ proj, const float* __restrict__ rel_bias, const float* __restrict__ lutm, const unsigned short* __restrict__ LIST, const int* __restrict__ CNT,
                                          bf16_t* __restrict__ PARTO, float* __restrict__ PARTML, bf16_t* __restrict__ Y) {
    const int lane = tid & 63, wave = __builtin_amdgcn_readfirstlane(tid >> 6), r32 = lane & 31, hi = lane >> 5;
    const int b = bh >> 2, h = bh & 3;
    __syncthreads();
    LAS float* lut = (LAS float*)(lds + M_LUT);
    if (tid < 472) ((LAS u32x4*)lut)[tid] = ((const u32x4*)(lutm + h * 1888))[tid];
    const bf16_t* kvb = proj + ((size_t)b * SEQ + 256 * n) * NIN;
    stage_rows<4>(lds, M_K, M_V, tid, COL_KA + h * 64, COL_VA + h * 64, [&](int row, bool& ok) -> const bf16_t* { ok = true; return kvb + (size_t)row * NIN; });
    after_stage();
    int cj = 0, nt = 0;
    if (lane < 32) { if (lane == n) nt = 8; else if (lane > n) { cj = CNT[((size_t)bh * 32 + n) * 32 + lane]; nt = (cj + 31) >> 5; } }
    int st = nt;
#pragma unroll
    for (int o = 1; o < 32; o <<= 1) { const int v = __shfl_up(st, o); if ((lane & 31) >= o) st += v; }
    st -= nt;
    const int T = __shfl(st + nt, 31);
    const float b31 = rel_bias[31 * 8 + h] * 1.4426950408889634f;
    const unsigned short* lbase = LIST + (((size_t)bh * 32 + n) * 32) * 256;
    const int stride = 8 * nparts, t0 = wave + 8 * part;
    struct EA { int seg, lt; unsigned short raw; bool live; };
    auto stageA = [&](int t) -> EA { EA e; const int tt = min(t, T - 1);
        e.seg = __popcll(__ballot(lane < 32 && st <= tt)) - 1; e.lt = tt - __shfl(st, e.seg); e.live = true; e.raw = 0;
        if (e.seg != n) { const int c = __shfl(cj, e.seg), idx = 32 * e.lt + r32; e.live = idx < c; e.raw = lbase[(size_t)e.seg * 256 + (e.live ? idx : 0)]; }
        return e; };
    struct EB { int seg, slot, qib; bool live; size_t qrow; };
    auto stageB = [&](const EA& e, bf16x8 (&q)[4]) -> EB { EB m; m.seg = e.seg; m.live = e.live;
        if (e.seg == n) { m.slot = 3; m.qib = 32 * e.lt + r32; } else { m.slot = e.raw >> 8; m.qib = e.raw & 255; }
        m.qrow = (size_t)b * SEQ + 256 * e.seg + m.qib;
#pragma unroll
        for (int s = 0; s < 4; ++s) q[s] = *(const bf16x8*)(proj + m.qrow * NIN + COL_QA + h * 64 + 16 * s + 8 * hi);
        return m; };
    __syncthreads();
    if (t0 < T) {
        EA ea1 = stageA(t0);
        bf16x8 q0[4], q1[4];
        EB m0 = stageB(ea1, q0);
        ea1 = stageA(t0 + stride);
#pragma unroll 1
        for (int t = t0; t < T; t += stride) {
            const EB m1 = stageB(ea1, q1);
            ea1 = stageA(t + 2 * stride);
            __builtin_amdgcn_sched_barrier(0);
            f32x16 o0, o1;
#pragma unroll
            for (int i = 0; i < 16; ++i) { o0[i] = 0.f; o1[i] = 0.f; }
            float m = NEGF, l = 0.f;
            const int seg = m0.seg, qpos = 256 * seg + m0.qib;
            if (seg == n) {
                const int nks = (m0.qib - r32 + 31) / 64 + 1;
                for (int ks = 0; ks < nks; ++ks) { TabFn fn{lut + (m0.qib - 64 * ks - 4 * hi + 96 - 59)}; step64(lds, M_K + ks * 8192, M_V + ks * 8192, q0, o0, o1, m, l, lane, fn); }
            } else if (seg - n >= 7) {
                ConstFn fn{b31};
#pragma unroll 1
                for (int ks = 0; ks < 4; ++ks) step64(lds, M_K + ks * 8192, M_V + ks * 8192, q0, o0, o1, m, l, lane, fn);
            } else {
#pragma unroll 1
                for (int ks = 0; ks < 4; ++ks) { TabFn fn{lut + (qpos - 256 * n - 64 * ks - 4 * hi + 96 - 59)}; step64(lds, M_K + ks * 8192, M_V + ks * 8192, q0, o0, o1, m, l, lane, fn); }
            }
            l += __shfl_xor(l, 32);
            bf16_t* dstp = nullptr;
            if (m0.live) dstp = (m0.slot == 3) ? Y + m0.qrow * DM + h * 64 : PARTO + ((m0.qrow * 4 + h) * 3 + m0.slot) * 64;
            const unsigned long long dl = (unsigned long long)dstp;
            store_rows(lds, M_OST + wave * 4096, lane, o0, o1, 1.0f / l, [&](int q) { return (bf16_t*)__shfl(dl, q); });
            if (m0.live && hi == 0) { float2 ml; ml.x = m; ml.y = l; *(float2*)(PARTML + ((m0.qrow * 4 + h) * 4 + m0.slot) * 2) = ml; }
            m0 = m1;
#pragma unroll
            for (int s = 0; s < 4; ++s) q0[s] = q1[s];
        }
    }
}
}

namespace hg {
typedef short bf16x8 __attribute__((ext_vector_type(8)));
typedef float f32x4 __attribute__((ext_vector_type(4)));
typedef unsigned u32x2 __attribute__((ext_vector_type(2)));
constexpr int SEG_OFF = 0, BT_OFF = 2048, VT_OFF = 18432, KT_OFF = 26624;
constexpr int QS_OFF = 26624, QD_OFF = 34816, QO_OFF = 43008, KD_OFF = 51200, KO_OFF = 59392;
__device__ __forceinline__ void img_put(LAS unsigned char* lds, int off, int row, int d, float v) { *(LAS bf16_t*)(lds + off + row * 128 + ((((d >> 3) ^ (row & 7))) << 4) + (d & 7) * 2) = f2bf(v); }
__device__ __forceinline__ bf16x8 img_frag(LAS const unsigned char* lds, int off, int row, int chunk) { return *(const LAS bf16x8*)(lds + off + row * 128 + ((chunk ^ (row & 7)) << 4)); }
__device__ __forceinline__ unsigned cvtpk(float lo, float hi) { return cvtpk_s(lo, hi); }
struct Ch { float f[8], b[8], qv[8], iv[8], blast; };
template <bool NEEDQ> __device__ __forceinline__ void stage(LAS unsigned char* lds, int wave, int lane, const bf16_t* __restrict__ rowp  , float lb, Ch& c) {
    float cs = 0.f;
#pragma unroll
    for (int i = 0; i < 8; ++i) {
        const bf16_t* r = rowp + (size_t)(8 * wave + i) * NIN + lane;
        const float fp = bf2f(r[COL_FC]); c.iv[i] = bf2f(r[COL_IC]);
        if (NEEDQ) { const float q = bf2f(r[COL_QC]); c.qv[i] = q / (1.0f + __expf(-q)) * 0.125f; }
        c.f[i] = lb + (1.0f - lb) / (1.0f + __expf(-fp));
        cs += __logf(c.f[i]); c.b[i] = cs;
    }
    LAS float* seg = (LAS float*)(lds + SEG_OFF);
    seg[wave * 64 + lane] = cs;
    __syncthreads();
    float off = 0.f, tot = 0.f;
#pragma unroll
    for (int w = 0; w < 8; ++w) { const float s = seg[w * 64 + lane]; tot += s; if (w < wave) off += s; }
#pragma unroll
    for (int i = 0; i < 8; ++i) c.b[i] += off;
    c.blast = tot;
}
__device__ __forceinline__ void x1_item(LAS unsigned char* lds, int wave, int lane, int item, const bf16_t* __restrict__ proj, const float* __restrict__ lbp, float* __restrict__ DS, float* __restrict__ DEC) {
    const int bh = item >> 7, ch = item & 127, b = bh >> 2, h = bh & 3;
    __syncthreads();
    Ch c; stage<false>(lds, wave, lane, proj + ((size_t)b * SEQ + ch * 64) * NIN + h * 64, lbp[h * 64 + lane], c);
    u32x4 kw, vw;
#pragma unroll
    for (int j = 0; j < 4; ++j) {
        kw[j] = cvtpk((1.0f - c.f[2 * j]) * __expf(c.blast - c.b[2 * j]), (1.0f - c.f[2 * j + 1]) * __expf(c.blast - c.b[2 * j + 1]));
        vw[j] = cvtpk(c.iv[2 * j], c.iv[2 * j + 1]);
    }
    *(LAS u32x4*)(lds + KT_OFF + lane * 128 + ((wave ^ (lane & 7)) << 4)) = kw;
    *(LAS u32x4*)(lds + VT_OFF + lane * 128 + ((wave ^ (lane & 7)) << 4)) = vw;
    if (wave == 0) DEC[(size_t)item * 64 + lane] = __expf(c.blast);
    __syncthreads();
    const int fr = lane & 15, quad = lane >> 4, mt = wave >> 1;
#pragma unroll
    for (int n2 = 0; n2 < 2; ++n2) {
        const int nt = 2 * (wave & 1) + n2;
        f32x4 acc = {0.f, 0.f, 0.f, 0.f};
#pragma unroll
        for (int kk = 0; kk < 2; ++kk)
            acc = __builtin_amdgcn_mfma_f32_16x16x32_bf16(img_frag(lds, VT_OFF, 16 * mt + fr, quad + 4 * kk), img_frag(lds, KT_OFF, 16 * nt + fr, quad + 4 * kk), acc, 0, 0, 0);
        float* o = DS + (size_t)item * 4096 + (16 * mt + 4 * quad) * 64 + 16 * nt + fr;
#pragma unroll
        for (int r = 0; r < 4; ++r) o[r * 64] = acc[r];
    }
}
__device__ __forceinline__ void x2_scan(int gtid, int nthreads, const float* __restrict__ DS, const float* __restrict__ DEC, bf16_t* __restrict__ ST) {
    for (int e = gtid; e < 16 * 1024; e += nthreads) {
        const int bh = e >> 10, q = e & 1023;
        const int d4 = q & 15;
        f32x4 s = {0.f, 0.f, 0.f, 0.f};
#pragma unroll 1
        for (int c0 = 0; c0 < 128; c0 += 8) {
            f32x4 ds[8], de[8];
#pragma unroll
            for (int i = 0; i < 8; ++i) { const size_t it = (size_t)bh * 128 + c0 + i; ds[i] = *(const f32x4*)(DS + it * 4096 + q * 4); de[i] = *(const f32x4*)(DEC + it * 64 + d4 * 4); }
#pragma unroll
            for (int i = 0; i < 8; ++i) { const size_t it = (size_t)bh * 128 + c0 + i;
                uint2 w; w.x = cvtpk(s[0], s[1]); w.y = cvtpk(s[2], s[3]); *(uint2*)(ST + it * 4096 + q * 4) = w;
                s = s * de[i] + ds[i]; }
        }
    }
}
__device__ __forceinline__ void x3_item(LAS unsigned char* lds, int wave, int lane, int item, const bf16_t* __restrict__ proj, const float* __restrict__ lbp, const bf16_t* __restrict__ ST, bf16_t* __restrict__ Y) {
    const int bh = item >> 7, ch = item & 127, b = bh >> 2, h = bh & 3;
    __syncthreads();
    Ch c; stage<true>(lds, wave, lane, proj + ((size_t)b * SEQ + ch * 64) * NIN + h * 64, lbp[h * 64 + lane], c);
    LAS float* bt = (LAS float*)(lds + BT_OFF);
#pragma unroll
    for (int i = 0; i < 8; ++i) bt[(8 * wave + i) * 64 + lane] = c.b[i];
    { u32x4 vw;
#pragma unroll
      for (int j = 0; j < 4; ++j) vw[j] = cvtpk(c.iv[2 * j], c.iv[2 * j + 1]);
      *(LAS u32x4*)(lds + VT_OFF + lane * 128 + ((wave ^ (lane & 7)) << 4)) = vw; }
    __syncthreads();
    {
        const int I = wave >> 1;
        const float cI = bt[(16 * I + 7) * 64 + lane];
        const float rI = (I > 0) ? bt[(16 * I - 1) * 64 + lane] : 0.f;
        float rN[3];
#pragma unroll
        for (int ip = 1; ip < 4; ++ip) rN[ip - 1] = bt[(16 * ip - 1) * 64 + lane];
#pragma unroll
        for (int i = 0; i < 8; ++i) {
            const int t = 8 * wave + i; const float bb = c.b[i], q = c.qv[i], k = 1.0f - c.f[i];
            img_put(lds, QS_OFF, t, lane, q * __expf(bb));
            img_put(lds, QD_OFF, t, lane, q * __expf(bb - cI));
            img_put(lds, QO_OFF, t, lane, q * __expf(bb - rI));
            img_put(lds, KD_OFF, t, lane, k * __expf(cI - bb));
#pragma unroll
            for (int ip = 1; ip < 4; ++ip) if (ip > I) img_put(lds, KO_OFF + (ip - 1) * 8192, t, lane, k * __expf(rN[ip - 1] - bb));
        }
    }
    __syncthreads();
    const int fr = lane & 15, quad = lane >> 4, I = wave >> 1, vh = wave & 1;
    unsigned sc[4][2];
#pragma unroll
    for (int J = 0; J < 4; ++J) {
        sc[J][0] = 0u; sc[J][1] = 0u;
        if (J <= I) {
            f32x4 acc = {0.f, 0.f, 0.f, 0.f};
            const int ko = (J < I) ? KO_OFF + (I - 1) * 8192 : KD_OFF, qo = (J < I) ? QO_OFF : QD_OFF;
#pragma unroll
            for (int kk = 0; kk < 2; ++kk)
                acc = __builtin_amdgcn_mfma_f32_16x16x32_bf16(img_frag(lds, ko, 16 * J + fr, quad + 4 * kk), img_frag(lds, qo, 16 * I + fr, quad + 4 * kk), acc, 0, 0, 0);
            if (J == I) {
#pragma unroll
                for (int r = 0; r < 4; ++r) if (4 * quad + r > fr) acc[r] = 0.f;
            }
            sc[J][0] = cvtpk(acc[0], acc[1]); sc[J][1] = cvtpk(acc[2], acc[3]);
        }
    }
    const bf16_t* stp = ST + (size_t)item * 4096;
    const size_t orow = (size_t)b * SEQ + ch * 64 + 16 * I + fr;
#pragma unroll
    for (int m2 = 0; m2 < 2; ++m2) {
        const int mt = 2 * vh + m2, v = 16 * mt + fr;
        f32x4 acc = {0.f, 0.f, 0.f, 0.f};
#pragma unroll
        for (int ks = 0; ks < 2; ++ks) {
            if (2 * ks <= I) {
                u32x4 bw, aw;
                bw[0] = sc[2 * ks][0]; bw[1] = sc[2 * ks][1]; bw[2] = sc[2 * ks + 1][0]; bw[3] = sc[2 * ks + 1][1];
                const LAS unsigned char* vr = lds + VT_OFF + v * 128;
                const u32x2 a0 = *(const LAS u32x2*)(vr + (((4 * ks + (quad >> 1)) ^ (v & 7)) << 4) + (quad & 1) * 8);
                u32x2 a1 = {0u, 0u};
                if (2 * ks + 1 <= I) a1 = *(const LAS u32x2*)(vr + (((4 * ks + 2 + (quad >> 1)) ^ (v & 7)) << 4) + (quad & 1) * 8);
                aw[0] = a0.x; aw[1] = a0.y; aw[2] = a1.x; aw[3] = a1.y;
                acc = __builtin_amdgcn_mfma_f32_16x16x32_bf16(__builtin_bit_cast(bf16x8, aw), __builtin_bit_cast(bf16x8, bw), acc, 0, 0, 0);
            }
        }
#pragma unroll
        for (int kk = 0; kk < 2; ++kk) {
            const bf16x8 sa = *(const bf16x8*)(stp + v * 64 + 8 * quad + 32 * kk);
            acc = __builtin_amdgcn_mfma_f32_16x16x32_bf16(sa, img_frag(lds, QS_OFF, 16 * I + fr, quad + 4 * kk), acc, 0, 0, 0);
        }
        uint2 w; w.x = cvtpk(acc[0], acc[1]); w.y = cvtpk(acc[2], acc[3]);
        *(uint2*)(Y + orow * DM + 512 + h * 64 + 16 * mt + 4 * quad) = w;
    }
}
}

namespace hw {
typedef short bf16x8 __attribute__((ext_vector_type(8)));
typedef float f32x4 __attribute__((ext_vector_type(4)));
typedef unsigned u32x2 __attribute__((ext_vector_type(2)));
#define HW_LDSW() asm volatile("s_waitcnt lgkmcnt(0)" ::: "memory")
__device__ __forceinline__ bf16x8 frag128(LAS const unsigned char* base, int row, int chunk) { return *(const LAS bf16x8*)(base + row * 128 + ((chunk ^ (row & 7)) << 4)); }
__device__ __forceinline__ void x1_wave(LAS unsigned char* wl, int lane, int item, const bf16_t* __restrict__ proj, const float* __restrict__ lbp, float* __restrict__ DS, float* __restrict__ DEC) {
    const int bh = item >> 7, ch = item & 127, b = bh >> 2, h = bh & 3;
    const bf16_t* rp = proj + ((size_t)b * SEQ + ch * 64) * NIN + h * 64 + lane;
    const float lb = lbp[h * 64 + lane];
    float f[64]; float cs = 0.f;
    HW_LDSW();
#pragma unroll
    for (int g2 = 0; g2 < 4; ++g2) {
        unsigned short rf[16], ri[16];
#pragma unroll
        for (int i = 0; i < 16; ++i) { const bf16_t* r = rp + (size_t)(16 * g2 + i) * NIN; rf[i] = r[COL_FC]; ri[i] = r[COL_IC]; }
        __builtin_amdgcn_sched_barrier(0);
#pragma unroll
        for (int i = 0; i < 16; ++i) { const float ff = lb + (1.0f - lb) / (1.0f + __expf(-bf2f(rf[i]))); f[16 * g2 + i] = ff; cs += __logf(ff); }
#pragma unroll
        for (int q = 0; q < 2; ++q) { const int g = 2 * g2 + q;
            u32x4 vw; vw[0] = (unsigned)ri[8 * q] | ((unsigned)ri[8 * q + 1] << 16); vw[1] = (unsigned)ri[8 * q + 2] | ((unsigned)ri[8 * q + 3] << 16);
            vw[2] = (unsigned)ri[8 * q + 4] | ((unsigned)ri[8 * q + 5] << 16); vw[3] = (unsigned)ri[8 * q + 6] | ((unsigned)ri[8 * q + 7] << 16);
            *(LAS u32x4*)(wl + 8192 + lane * 128 + ((g ^ (lane & 7)) << 4)) = vw; }
    }
    const float blast = cs; cs = 0.f;
#pragma unroll
    for (int g = 0; g < 8; ++g) {
        float kh[8];
#pragma unroll
        for (int i = 0; i < 8; ++i) { const float ff = f[8 * g + i]; cs += __logf(ff); kh[i] = (1.0f - ff) * __expf(blast - cs); }
        u32x4 kw; kw[0] = cvtpk_s(kh[0], kh[1]); kw[1] = cvtpk_s(kh[2], kh[3]); kw[2] = cvtpk_s(kh[4], kh[5]); kw[3] = cvtpk_s(kh[6], kh[7]);
        *(LAS u32x4*)(wl + lane * 128 + ((g ^ (lane & 7)) << 4)) = kw;
    }
    DEC[(size_t)item * 64 + lane] = __expf(blast);
    HW_LDSW();
    const int fr = lane & 15, quad = lane >> 4;
    float* dsp = DS + (size_t)item * 4096;
#pragma unroll
    for (int mt = 0; mt < 4; ++mt) {
        const bf16x8 a0 = frag128(wl + 8192, 16 * mt + fr, quad), a1 = frag128(wl + 8192, 16 * mt + fr, quad + 4);
#pragma unroll
        for (int nt = 0; nt < 4; ++nt) {
            f32x4 acc = {0.f, 0.f, 0.f, 0.f};
            acc = __builtin_amdgcn_mfma_f32_16x16x32_bf16(a0, frag128(wl, 16 * nt + fr, quad), acc, 0, 0, 0);
            acc = __builtin_amdgcn_mfma_f32_16x16x32_bf16(a1, frag128(wl, 16 * nt + fr, quad + 4), acc, 0, 0, 0);
            float* o = dsp + (16 * mt + 4 * quad) * 64 + 16 * nt + fr;
#pragma unroll
            for (int r = 0; r < 4; ++r) o[r * 64] = acc[r];
        }
    }
    HW_LDSW();
}
__device__ __forceinline__ void x3_wave(LAS unsigned char* wl, int lane, int item, const bf16_t* __restrict__ proj, const float* __restrict__ lbp, const bf16_t* __restrict__ ST, bf16_t* __restrict__ Y) {
    const int bh = item >> 7, ch = item & 127, b = bh >> 2, h = bh & 3;
    const int fr = lane & 15, quad = lane >> 4;
    const bf16_t* rp = proj + ((size_t)b * SEQ + ch * 64) * NIN + h * 64 + lane;
    const float lb = lbp[h * 64 + lane];
    f32x4 S[4][4];
    { const bf16_t* sp = ST + (size_t)item * 4096;
#pragma unroll
      for (int tv = 0; tv < 4; ++tv)
#pragma unroll
          for (int td = 0; td < 4; ++td) { const uint2 w = *(const uint2*)(sp + (16 * tv + fr) * 64 + 16 * td + 4 * quad);
              S[td][tv] = (f32x4){__uint_as_float(w.x << 16), __uint_as_float(w.x & 0xffff0000u), __uint_as_float(w.y << 16), __uint_as_float(w.y & 0xffff0000u)}; } }
    LAS float* decl = (LAS float*)(wl + 10240);
    unsigned short nf[16], nq[16], ni[16];
#pragma unroll
    for (int i = 0; i < 16; ++i) { const bf16_t* r = rp + (size_t)i * NIN; nf[i] = r[COL_FC]; nq[i] = r[COL_QC]; ni[i] = r[COL_IC]; }
#pragma unroll 1
    for (int I = 0; I < 4; ++I) {
        float ff[16], qv[16], iv[16], bb[16];
#pragma unroll
        for (int i = 0; i < 16; ++i) { ff[i] = bf2f(nf[i]); qv[i] = bf2f(nq[i]); iv[i] = bf2f(ni[i]); }
        { const int In = I < 3 ? I + 1 : 3;
#pragma unroll
          for (int i = 0; i < 16; ++i) { const bf16_t* r = rp + (size_t)(16 * In + i) * NIN; nf[i] = r[COL_FC]; nq[i] = r[COL_QC]; ni[i] = r[COL_IC]; } }
        __builtin_amdgcn_sched_barrier(0);
        float cs = 0.f;
#pragma unroll
        for (int i = 0; i < 16; ++i) { ff[i] = lb + (1.0f - lb) / (1.0f + __expf(-ff[i])); cs += __logf(ff[i]); bb[i] = cs; qv[i] = qv[i] / (1.0f + __expf(-qv[i])) * 0.125f; }
        const float cm = bb[7], be = bb[15];
        HW_LDSW();
        { u32x4 v0, v1, k0, k1;
#pragma unroll
          for (int j = 0; j < 4; ++j) { v0[j] = cvtpk_s(iv[2 * j], iv[2 * j + 1]); v1[j] = cvtpk_s(iv[8 + 2 * j], iv[9 + 2 * j]);
              k0[j] = cvtpk_s((1.0f - ff[2 * j]) * __expf(be - bb[2 * j]), (1.0f - ff[2 * j + 1]) * __expf(be - bb[2 * j + 1]));
              k1[j] = cvtpk_s((1.0f - ff[8 + 2 * j]) * __expf(be - bb[8 + 2 * j]), (1.0f - ff[9 + 2 * j]) * __expf(be - bb[9 + 2 * j])); }
          *(LAS u32x4*)(wl + 8192 + lane * 32) = v0; *(LAS u32x4*)(wl + 8192 + lane * 32 + 16) = v1;
          *(LAS u32x4*)(wl + 6144 + lane * 32) = k0; *(LAS u32x4*)(wl + 6144 + lane * 32 + 16) = k1; }
        decl[lane] = __expf(be);
#pragma unroll
        for (int i = 0; i < 16; ++i) {
            const int off = i * 128 + ((((lane >> 3) ^ (i & 7))) << 4) + (lane & 7) * 2;
            *(LAS bf16_t*)(wl + off) = f2bf(qv[i] * __expf(bb[i]));
            *(LAS bf16_t*)(wl + 2048 + off) = f2bf(qv[i] * __expf(bb[i] - cm));
            *(LAS bf16_t*)(wl + 4096 + off) = f2bf((1.0f - ff[i]) * __expf(cm - bb[i]));
        }
        HW_LDSW();
        f32x4 sc = {0.f, 0.f, 0.f, 0.f};
        sc = __builtin_amdgcn_mfma_f32_16x16x32_bf16(frag128(wl + 4096, fr, quad), frag128(wl + 2048, fr, quad), sc, 0, 0, 0);
        sc = __builtin_amdgcn_mfma_f32_16x16x32_bf16(frag128(wl + 4096, fr, quad + 4), frag128(wl + 2048, fr, quad + 4), sc, 0, 0, 0);
#pragma unroll
        for (int r = 0; r < 4; ++r) if (4 * quad + r > fr) sc[r] = 0.f;
        u32x4 scb; scb[0] = cvtpk_s(sc[0], sc[1]); scb[1] = cvtpk_s(sc[2], sc[3]); scb[2] = 0u; scb[3] = 0u;
        u32x4 qi[2];
#pragma unroll
        for (int ks = 0; ks < 2; ++ks) {
            const u32x2 lo = *(const LAS u32x2*)(wl + fr * 128 + ((((4 * ks + (quad >> 1))) ^ (fr & 7)) << 4) + (quad & 1) * 8);
            const u32x2 hi2 = *(const LAS u32x2*)(wl + fr * 128 + ((((4 * ks + 2 + (quad >> 1))) ^ (fr & 7)) << 4) + (quad & 1) * 8);
            qi[ks] = (u32x4){lo[0], lo[1], hi2[0], hi2[1]};
        }
        const size_t orow = (size_t)b * SEQ + ch * 64 + 16 * I + fr;
#pragma unroll
        for (int tv = 0; tv < 4; ++tv) {
            const u32x2 vt = *(const LAS u32x2*)(wl + 8192 + (16 * tv + fr) * 32 + quad * 8);
            f32x4 acc = {0.f, 0.f, 0.f, 0.f};
            acc = __builtin_amdgcn_mfma_f32_16x16x32_bf16(__builtin_bit_cast(bf16x8, (u32x4){vt[0], vt[1], 0u, 0u}), __builtin_bit_cast(bf16x8, scb), acc, 0, 0, 0);
#pragma unroll
            for (int ks = 0; ks < 2; ++ks) {
                u32x4 sa; sa[0] = cvtpk_s(S[2 * ks][tv][0], S[2 * ks][tv][1]); sa[1] = cvtpk_s(S[2 * ks][tv][2], S[2 * ks][tv][3]);
                sa[2] = cvtpk_s(S[2 * ks + 1][tv][0], S[2 * ks + 1][tv][1]); sa[3] = cvtpk_s(S[2 * ks + 1][tv][2], S[2 * ks + 1][tv][3]);
                acc = __builtin_amdgcn_mfma_f32_16x16x32_bf16(__builtin_bit_cast(bf16x8, sa), __builtin_bit_cast(bf16x8, qi[ks]), acc, 0, 0, 0);
            }
            uint2 w; w.x = cvtpk_s(acc[0], acc[1]); w.y = cvtpk_s(acc[2], acc[3]);
            *(uint2*)(Y + orow * DM + 512 + h * 64 + 16 * tv + 4 * quad) = w;
        }
        if (I < 3) {
#pragma unroll
            for (int td = 0; td < 4; ++td) {
                const f32x4 dc = *(const LAS f32x4*)(wl + 10240 + (16 * td + 4 * quad) * 4);
                const u32x2 kt = *(const LAS u32x2*)(wl + 6144 + (16 * td + fr) * 32 + quad * 8);
                const bf16x8 ka = __builtin_bit_cast(bf16x8, (u32x4){kt[0], kt[1], 0u, 0u});
#pragma unroll
                for (int tv = 0; tv < 4; ++tv) {
                    const u32x2 vt = *(const LAS u32x2*)(wl + 8192 + (16 * tv + fr) * 32 + quad * 8);
                    S[td][tv] = __builtin_amdgcn_mfma_f32_16x16x32_bf16(ka, __builtin_bit_cast(bf16x8, (u32x4){vt[0], vt[1], 0u, 0u}), S[td][tv] * dc, 0, 0, 0);
                }
            }
        }
    }
    HW_LDSW();
}
}

namespace s5 {
typedef short bf16x8 __attribute__((ext_vector_type(8)));
typedef float f32x4 __attribute__((ext_vector_type(4)));
__device__ __forceinline__ void cpow(double dt, double ar, double ai, int n, double& pr, double& pi) { const double mg = exp(n * dt * ar); double sn, cs; sincos_d(n * dt * ai, sn, cs); pr = mg * cs; pi = mg * sn; }
__device__ __forceinline__ void zfac(double dt, double ar, double ai, double& zr, double& zi) {
    double are, aim; cpow(dt, ar, ai, 1, are, aim);
    const double nr = are - 1.0, ni = aim, den = ar * ar + ai * ai; zr = (nr * ar + ni * ai) / den; zi = (ni * ar - nr * ai) / den;
}
__device__ __forceinline__ void tables_thread(int e, const float* a_re, const float* a_im, const float* log_dt, const float* b_re, const float* b_im, const float* c_re, const float* c_im,
                                              bf16_t* W1, bf16_t* W3, float* a64) {
    const int st = e & 63, p = (e >> 6) & 63, lg = e >> 12;
    const int id = lg * 64 + p;
    const double dt = exp((double)log_dt[lg]), ar = a_re[id], ai = a_im[id];
    double zr, zi; zfac(dt, ar, ai, zr, zi);
    { double pr, pi; cpow(dt, ar, ai, 63 - st, pr, pi);
      unsigned wr[8], wi[8];
#pragma unroll
      for (int c2 = 0; c2 < 8; ++c2) {
          float vr[2], vi[2];
#pragma unroll
          for (int q = 0; q < 2; ++q) { const int c = 2 * c2 + q; const double br = b_re[id * 16 + c], bi = b_im[id * 16 + c];
              const double bbr = zr * br - zi * bi, bbi = zr * bi + zi * br; vr[q] = (float)(pr * bbr - pi * bbi); vi[q] = (float)(pr * bbi + pi * bbr); }
          wr[c2] = pk2(vr[0], vr[1]); wi[c2] = pk2(vi[0], vi[1]);
      }
      u32x4* o0 = (u32x4*)(W1 + ((size_t)(lg * 128 + 2 * p) * 1024 + st * 16)); u32x4* o1 = (u32x4*)(W1 + ((size_t)(lg * 128 + 2 * p + 1) * 1024 + st * 16));
      o0[0] = (u32x4){wr[0], wr[1], wr[2], wr[3]}; o0[1] = (u32x4){wr[4], wr[5], wr[6], wr[7]};
      o1[0] = (u32x4){wi[0], wi[1], wi[2], wi[3]}; o1[1] = (u32x4){wi[4], wi[5], wi[6], wi[7]}; }
    { double pr, pi; cpow(dt, ar, ai, st + 1, pr, pi);
      for (int c = 0; c < 16; ++c) { const double cr = c_re[(lg * 16 + c) * 64 + p], ci = c_im[(lg * 16 + c) * 64 + p];
          *(unsigned*)(W3 + ((size_t)(lg * 1024 + st * 16 + c) * 128 + 2 * p)) = pk2((float)(cr * pr - ci * pi), -(float)(cr * pi + ci * pr)); }
      if (st == 63) { a64[id * 2] = (float)pr; a64[id * 2 + 1] = (float)pi; } }
}
__device__ __forceinline__ void kmat_item(LAS float* scr, int tid, int item, const float* a_re, const float* a_im, const float* log_dt, const float* b_re, const float* b_im, const float* c_re, const float* c_im, const float* dskip, bf16_t* KM) {
    const int tau = item & 63, lg = item >> 6;
    __syncthreads();
    { const int p = tid >> 3, c0 = (tid & 7) * 2, id = lg * 64 + p;
      const double dt = exp((double)log_dt[lg]), ar = a_re[id], ai = a_im[id];
      double zr, zi, pr, pi; zfac(dt, ar, ai, zr, zi); cpow(dt, ar, ai, tau, pr, pi);
#pragma unroll
      for (int q = 0; q < 2; ++q) { const int c = c0 + q; const double br = b_re[id * 16 + c], bi = b_im[id * 16 + c];
          const double bbr = zr * br - zi * bi, bbi = zr * bi + zi * br;
          scr[(p * 16 + c) * 2] = (float)(pr * bbr - pi * bbi); scr[(p * 16 + c) * 2 + 1] = (float)(pr * bbi + pi * bbr); } }
    __syncthreads();
    if (tid < 256) { const int c = tid >> 4, cp = tid & 15; float s = 0.f;
        for (int p = 0; p < 64; ++p) s += c_re[(lg * 16 + c) * 64 + p] * scr[(p * 16 + cp) * 2] - c_im[(lg * 16 + c) * 64 + p] * scr[(p * 16 + cp) * 2 + 1];
        if (tau == 0 && c == cp) s += dskip[lg * 16 + c];
        KM[((size_t)(lg * 64 + tau) * 16 + c) * 16 + cp] = f2bf(s); }
}
__device__ __forceinline__ size_t chunk_row(int cid) { return (size_t)(cid >> 7) * SEQ + (size_t)(cid & 127) * 64; }
__device__ __forceinline__ void x1_wave(int lane, int g, int mt, int lg, const bf16_t* __restrict__ proj, const bf16_t* __restrict__ W1, float* __restrict__ HEND) {
    const int fr = lane & 15, quad = lane >> 4;
    const bf16_t* ap = proj + (chunk_row(mt * 16 + fr) + (quad >> 1)) * NIN + COL_U + g * 16 + 8 * (quad & 1);
    const bf16_t* bp = W1 + ((size_t)(lg * 128 + fr) * 1024 + 8 * quad);
    f32x4 acc[8];
#pragma unroll
    for (int n = 0; n < 8; ++n) acc[n] = (f32x4){0.f, 0.f, 0.f, 0.f};
    bf16x8 afr[32];
#pragma unroll
    for (int kk = 0; kk < 32; ++kk) afr[kk] = *(const bf16x8*)(ap + (size_t)(2 * kk) * NIN);
#pragma unroll
    for (int kk = 0; kk < 32; ++kk) {
#pragma unroll
        for (int n = 0; n < 8; ++n) acc[n] = __builtin_amdgcn_mfma_f32_16x16x32_bf16(afr[kk], *(const bf16x8*)(bp + (size_t)n * 16 * 1024 + 32 * kk), acc[n], 0, 0, 0);
    }
#pragma unroll
    for (int n = 0; n < 8; ++n)
#pragma unroll
        for (int r = 0; r < 4; ++r) HEND[((size_t)(mt * 16 + 4 * quad + r) * 16 + g) * 128 + 16 * n + fr] = acc[n][r];
}
__device__ __forceinline__ void x2_scan(int e, const float* __restrict__ HEND, const float* __restrict__ a64, bf16_t* __restrict__ HST, int layer) {
    const int p = e & 63, g = (e >> 6) & 15, b = e >> 10;
    const float ar = a64[((layer * 16 + g) * 64 + p) * 2], ai = a64[((layer * 16 + g) * 64 + p) * 2 + 1];
    float hr = 0.f, hi = 0.f;
#pragma unroll 1
    for (int c0 = 0; c0 < 128; c0 += 16) {
        float2 he[16];
#pragma unroll
        for (int i = 0; i < 16; ++i) he[i] = *(const float2*)(HEND + ((size_t)(b * 128 + c0 + i) * 16 + g) * 128 + 2 * p);
#pragma unroll
        for (int i = 0; i < 16; ++i) {
            *(unsigned*)(HST + ((size_t)(b * 128 + c0 + i) * 16 + g) * 128 + 2 * p) = cvtpk_s(hr, hi);
            const float nr = ar * hr - ai * hi + he[i].x, ni = ar * hi + ai * hr + he[i].y; hr = nr; hi = ni;
        }
    }
}
__device__ __forceinline__ void x3_item(LAS unsigned char* lds, int wave, int lane, int item, int layer, const bf16_t* __restrict__ proj, const bf16_t* __restrict__ KM, const bf16_t* __restrict__ W3,
                                        const bf16_t* __restrict__ HST, bf16_t* __restrict__ ybpre) {
    const int g = item & 15, mtp = item >> 4, lg = layer * 16 + g;
    const int tid = wave * 64 + lane;
    __syncthreads();
    { const u32x4* src = (const u32x4*)(KM + (size_t)lg * 64 * 256);
#pragma unroll
      for (int i = 0; i < 4; ++i) ((LAS u32x4*)lds)[tid + 512 * i] = src[tid + 512 * i]; }
    __syncthreads();
    const int fr = lane & 15, quad = lane >> 4, mt = 2 * mtp + (wave >> 2), tr = wave & 3;
    const size_t crow = chunk_row(mt * 16 + fr);
    const bf16_t* ap = proj + (crow + (quad >> 1)) * NIN + COL_U + g * 16 + 8 * (quad & 1);
    f32x4 acc[16];
#pragma unroll
    for (int i = 0; i < 16; ++i) acc[i] = (f32x4){0.f, 0.f, 0.f, 0.f};
    const int kkmax = 8 * tr + 7;
    const int lbase = (fr * 16 + 8 * (quad & 1)) * 2;
#pragma unroll 1
    for (int kb = 0; kb <= kkmax; kb += 8) {
        bf16x8 a8[8];
#pragma unroll
        for (int i = 0; i < 8; ++i) a8[i] = *(const bf16x8*)(ap + (size_t)(2 * (kb + i)) * NIN);
#pragma unroll
        for (int i = 0; i < 8; ++i) {
            const int kk = kb + i;
#pragma unroll
            for (int ti = 0; ti < 16; ++ti) {
                const int t = 16 * tr + ti;
                if (2 * kk <= t) {
                    const int tau = t - 2 * kk - (quad >> 1);
                    bf16x8 bq = *(const LAS bf16x8*)(lds + max(tau, 0) * 512 + lbase);
                    if (tau < 0) bq = (bf16x8){0, 0, 0, 0, 0, 0, 0, 0};
                    acc[ti] = __builtin_amdgcn_mfma_f32_16x16x32_bf16(a8[i], bq, acc[ti], 0, 0, 0);
                }
            }
        }
    }
    {
        const bf16_t* hp = HST + ((size_t)(mt * 16 + fr) * 16 + g) * 128 + 8 * quad;
        const bf16_t* wp = W3 + ((size_t)(lg * 1024 + 16 * tr * 16 + fr) * 128 + 8 * quad);
#pragma unroll 1
        for (int kk = 0; kk < 4; ++kk) {
            const bf16x8 a = *(const bf16x8*)(hp + 32 * kk);
#pragma unroll
            for (int tb = 0; tb < 16; tb += 8) {
                bf16x8 wb[8];
#pragma unroll
                for (int ti = 0; ti < 8; ++ti) wb[ti] = *(const bf16x8*)(wp + (size_t)(tb + ti) * 16 * 128 + 32 * kk);
                __builtin_amdgcn_sched_barrier(0);
#pragma unroll
                for (int ti = 0; ti < 8; ++ti) acc[tb + ti] = __builtin_amdgcn_mfma_f32_16x16x32_bf16(a, wb[ti], acc[tb + ti], 0, 0, 0);
            }
        }
    }
#pragma unroll
    for (int ti = 0; ti < 16; ++ti)
#pragma unroll
        for (int r = 0; r < 4; ++r) {
            const size_t row = chunk_row(mt * 16 + 4 * quad + r) + 16 * tr + ti;
            const float y = acc[ti][r];
            const float uu = 1.5957691216057308f * (y + 0.044715f * y * y * y);
            ybpre[row * 256 + g * 16 + fr] = f2bf(y / (1.0f + __expf(-uu)));
        }
}
}

constexpr int NWAVES = 8;
constexpr int RING_BYTES = 131072, MISC_OFF = RING_BYTES + 320, LDS_BYTES = 147456;
typedef unsigned v4u __attribute__((ext_vector_type(4)));
#define LDS_WAIT() asm volatile("s_waitcnt lgkmcnt(0)" ::: "memory")

struct Args { const float* in[18]; float* out; unsigned char* ws; };

__device__ __forceinline__ void p0_transpose_item(const float* W, int K, int N, bf16_t* WT, LAS float* scr, int item, int lane) {
    const int nblk = N / 32, kb = item / nblk, nb = item % nblk, k0 = 64 * kb, n0 = 32 * nb;
#pragma unroll 8
    for (int i = 0; i < 32; ++i) { const int kk = 2 * i + (lane >> 5); scr[kk * 33 + (lane & 31)] = W[(size_t)(k0 + kk) * N + n0 + (lane & 31)]; }
    LDS_WAIT();
    const int c = lane & 7;
#pragma unroll
    for (int j = 0; j < 4; ++j) { const int n = (lane >> 3) + 8 * j; const LAS float* s = scr + (8 * c) * 33 + n;
        v4u o; o.x = pk2(s[0 * 33], s[1 * 33]); o.y = pk2(s[2 * 33], s[3 * 33]); o.z = pk2(s[4 * 33], s[5 * 33]); o.w = pk2(s[6 * 33], s[7 * 33]);
        *(v4u*)(WT + (size_t)(n0 + n) * K + k0 + 8 * c) = o; }
    LDS_WAIT();
}
__device__ __forceinline__ void prep_small(int id, const float* a_re, const float* a_im, const float* log_dt, const float* b_re, const float* b_im, const float* hl, float* sm) {
    if (id < DEPTH * 16 * 64) {
        const int lg = id >> 6;
        const double dt = exp((double)log_dt[lg]), ar = a_re[id], ai = a_im[id];
        const double mag = exp(dt * ar); double sn, cs; sincos_d(dt * ai, sn, cs);
        const double are = mag * cs, aim = mag * sn, nr = are - 1.0, ni = aim, den = ar * ar + ai * ai;
        const double zr = (nr * ar + ni * ai) / den, zi = (ni * ar - nr * ai) / den;
        sm[SM_ABAR + id * 2] = (float)are; sm[SM_ABAR + id * 2 + 1] = (float)aim;
        for (int c = 0; c < 16; ++c) {
            const double br = b_re[id * 16 + c], bi = b_im[id * 16 + c];
            sm[SM_BBAR + (id * 16 + c) * 2] = (float)(zr * br - zi * bi);
            sm[SM_BBAR + (id * 16 + c) * 2 + 1] = (float)(zr * bi + zi * br);
        }
    }
    if (id < 256) {
        const float h0 = hl[id], h1 = hl[256 + id], mx = fmaxf(h0, h1), e0 = expf(h0 - mx), e1 = expf(h1 - mx);
        sm[SM_LB + id] = 0.0f; sm[SM_LB + 256 + id] = e1 / (e0 + e1);
    }
}

__device__ __forceinline__ float dot64(const float* qs, const bf16_t* krow) {
    float s = 0.f;
#pragma unroll
    for (int i = 0; i < 8; ++i) {
        const u32x4 v = *(const u32x4*)(krow + i * 8);
#pragma unroll
        for (int j = 0; j < 4; ++j) { s = fmaf(qs[i * 8 + 2 * j], __uint_as_float(v[j] << 16), s); s = fmaf(qs[i * 8 + 2 * j + 1], __uint_as_float(v[j] & 0xffff0000u), s); }
    }
    return s;
}
__device__ __forceinline__ void moba_simple(int gid, int lane, float* scr, const bf16_t* __restrict__ proj, const float* __restrict__ kmean, const float* __restrict__ rel_bias, bf16_t* __restrict__ Y) {
    const int s = gid % SEQ, h = (gid / SEQ) & 3, b = gid / (SEQ * 4);
    float* qs = scr; float* ps = scr + 64;
    const size_t row = (size_t)b * SEQ + s;
    WSYNC();
    qs[lane] = bf2f(proj[row * NIN + COL_QA + h * 64 + lane]);
    WSYNC();
    const int own = s >> 8;
    float g = -INFINITY;
    if (lane < own) { const float* km = kmean + ((b * 4 + h) * 32 + lane) * 64; float a = 0.f; for (int d = 0; d < 64; ++d) a = fmaf(qs[d], km[d], a); g = a; }
    int blk[4]; bool val[4];
#pragma unroll
    for (int t = 0; t < 3; ++t) {
        const float mx = wave_max(g);
        val[t] = mx > -INFINITY;
        const unsigned long long mk = __ballot(g == mx);
        const int idx = val[t] ? (__ffsll((long long)mk) - 1) : own;
        blk[t] = idx;
        if (val[t] && lane == idx) g = -INFINITY;
    }
    blk[3] = own; val[3] = true;
    float lmax = NEGF;
#pragma unroll
    for (int t = 0; t < 4; ++t) {
        for (int i = 0; i < 4; ++i) {
            const int kk = lane + 64 * i, kpos = blk[t] * 256 + kk;
            const bool ok = (t < 3) ? val[t] : (kpos <= s);
            float lg = NEGF;
            if (ok) lg = dot64(qs, proj + ((size_t)b * SEQ + kpos) * NIN + COL_KA + h * 64) * 0.125f + rel_bias[t5_bucket(s - kpos) * 8 + h];
            ps[t * 256 + kk] = lg; lmax = fmaxf(lmax, lg);
        }
    }
    const float mx = wave_max(lmax);
    float lsum = 0.f;
    for (int i = 0; i < 16; ++i) { const float p = expf(ps[lane + 64 * i] - mx); ps[lane + 64 * i] = p; lsum += p; }
    const float tot = wave_sum(lsum);
    WSYNC();
    float acc = 0.f;
#pragma unroll
    for (int t = 0; t < 4; ++t) {
        if (!val[t]) continue;
        const bf16_t* vp = proj + ((size_t)b * SEQ + blk[t] * 256) * NIN + COL_VA + h * 64 + lane;
        const int nk = (t < 3) ? 256 : (s - own * 256 + 1);
        for (int kk = 0; kk < nk; ++kk) acc = fmaf(ps[t * 256 + kk], bf2f(vp[(size_t)kk * NIN]), acc);
    }
    Y[row * DM + h * 64 + lane] = f2bf(acc / tot);
}
__device__ __forceinline__ void dilated_simple(int gid, int lane, float* scr, const bf16_t* __restrict__ proj, const float* __restrict__ rel_bias, bf16_t* __restrict__ Y) {
    const int s = gid % SEQ, h = (gid / SEQ) & 3, b = gid / (SEQ * 4);
    float* qs = scr; float* ps = scr + 64;
    const size_t row = (size_t)b * SEQ + s;
    WSYNC();
    qs[lane] = bf2f(proj[row * NIN + COL_QD + h * 64 + lane]);
    WSYNC();
    float lse[3], ssum[3];
#pragma unroll
    for (int pi = 0; pi < 3; ++pi) {
        const int dil = (pi == 0) ? 1 : (pi == 1) ? 4 : 16;
        float lmax = NEGF;
        for (int i = 0; i < 3; ++i) {
            const int j = lane + 64 * i, kpos = s - j * dil;
            float lg = NEGF;
            if (j <= 128 && kpos >= 0) lg = dot64(qs, proj + ((size_t)b * SEQ + kpos) * NIN + COL_KD + h * 64) * 0.125f + rel_bias[t5_bucket(j * dil) * 8 + 4 + h];
            ps[pi * 192 + j] = lg; lmax = fmaxf(lmax, lg);
        }
        const float mx = wave_max(lmax);
        float lsum = 0.f;
        for (int i = 0; i < 3; ++i) { const int j = lane + 64 * i; const float p = expf(ps[pi * 192 + j] - mx); ps[pi * 192 + j] = p; lsum += p; }
        ssum[pi] = wave_sum(lsum);
        lse[pi] = mx + logf(ssum[pi]);
    }
    WSYNC();
    const float lm = fmaxf(lse[0], fmaxf(lse[1], lse[2]));
    const float w0 = expf(lse[0] - lm), w1 = expf(lse[1] - lm), w2 = expf(lse[2] - lm), wt = w0 + w1 + w2;
    const float wgt[3] = {w0 / wt, w1 / wt, w2 / wt};
    float out = 0.f;
#pragma unroll
    for (int pi = 0; pi < 3; ++pi) {
        const int dil = (pi == 0) ? 1 : (pi == 1) ? 4 : 16;
        float acc = 0.f;
        for (int j = 0; j <= 128; ++j) {
            const int kpos = s - j * dil; if (kpos < 0) break;
            acc = fmaf(ps[pi * 192 + j], bf2f(proj[((size_t)b * SEQ + kpos) * NIN + COL_VD + h * 64 + lane]), acc);
        }
        out += wgt[pi] * acc / ssum[pi];
    }
    Y[row * DM + 768 + h * 64 + lane] = f2bf(out);
}
__device__ __forceinline__ void s5_simple(int b, int g, int lane, float* scr, const bf16_t* __restrict__ proj, const float* __restrict__ sm, const float* __restrict__ c_re, const float* __restrict__ c_im,
                                          const float* __restrict__ dskip, bf16_t* __restrict__ ybpre, int layer) {
    float* hs = scr; float* us = scr + 8192; float* cs = scr + 8192 + 1024;
    const int pid = (layer * 16 + g) * 64 + lane;
    const float are = sm[SM_ABAR + pid * 2], aim = sm[SM_ABAR + pid * 2 + 1];
    float bbr[16], bbi[16];
#pragma unroll
    for (int c = 0; c < 16; ++c) { bbr[c] = sm[SM_BBAR + (pid * 16 + c) * 2]; bbi[c] = sm[SM_BBAR + (pid * 16 + c) * 2 + 1]; }
    for (int c = 0; c < 16; ++c) { cs[(c * 65 + lane) * 2] = c_re[((layer * 16 + g) * 16 + c) * 64 + lane]; cs[(c * 65 + lane) * 2 + 1] = c_im[((layer * 16 + g) * 16 + c) * 64 + lane]; }
    const int oc = lane & 15, otq = lane >> 4;
    const float dsk = dskip[layer * 256 + g * 16 + oc];
    float hr = 0.f, hi = 0.f;
#pragma unroll 1
    for (int t0 = 0; t0 < SEQ; t0 += 64) {
        WSYNC();
#pragma unroll 1
        for (int e = lane; e < 1024; e += 64) { const int t = e >> 4, c = e & 15; us[t * 16 + c] = bf2f(proj[((size_t)b * SEQ + t0 + t) * NIN + COL_U + g * 16 + c]); }
        WSYNC();
#pragma unroll 1
        for (int t = 0; t < 64; ++t) {
            float xr = 0.f, xi = 0.f;
#pragma unroll
            for (int c = 0; c < 16; ++c) { const float u = us[t * 16 + c]; xr = fmaf(bbr[c], u, xr); xi = fmaf(bbi[c], u, xi); }
            const float nr = are * hr - aim * hi + xr, ni = are * hi + aim * hr + xi;
            hr = nr; hi = ni;
            hs[(t * 64 + lane) * 2] = hr; hs[(t * 64 + lane) * 2 + 1] = hi;
        }
        WSYNC();
#pragma unroll 1
        for (int i = 0; i < 16; ++i) {
            const int t = otq + 4 * i;
            float y = 0.f;
#pragma unroll 4
            for (int p = 0; p < 64; ++p) y += hs[(t * 64 + p) * 2] * cs[(oc * 65 + p) * 2] - hs[(t * 64 + p) * 2 + 1] * cs[(oc * 65 + p) * 2 + 1];
            y += dsk * us[t * 16 + oc];
            ybpre[((size_t)b * SEQ + t0 + t) * 256 + g * 16 + oc] = f2bf(gelu_tanh(y));
        }
    }
}
__device__ __forceinline__ void hgrn_simple(int b, int h, int lane, float* scr, const bf16_t* __restrict__ proj, const float* __restrict__ sm, bf16_t* __restrict__ Y, int layer) {
    float* fs = scr; float* qs = scr + 4096; float* is = scr + 8192;
    const float lb = sm[SM_LB + layer * 256 + h * 64 + lane];
    float S[64];
#pragma unroll
    for (int d = 0; d < 64; ++d) S[d] = 0.f;
    for (int t0 = 0; t0 < SEQ; t0 += 64) {
        WSYNC();
        for (int t = 0; t < 64; ++t) {
            const bf16_t* r = proj + ((size_t)b * SEQ + t0 + t) * NIN + h * 64 + lane;
            const float qv = bf2f(r[COL_QC]), fv = bf2f(r[COL_FC]), iv = bf2f(r[COL_IC]);
            fs[t * 64 + lane] = lb + (1.0f - lb) * sigmoidf_(fv); qs[t * 64 + lane] = siluf_(qv) * 0.125f; is[t * 64 + lane] = iv;
        }
        WSYNC();
        for (int t = 0; t < 64; ++t) {
            const float iv = is[t * 64 + lane];
            float o = 0.f;
#pragma unroll
            for (int d = 0; d < 64; ++d) { const float f = fs[t * 64 + d]; S[d] = fmaf(f, S[d] - iv, iv); o = fmaf(qs[t * 64 + d], S[d], o); }
            Y[((size_t)b * SEQ + t0 + t) * DM + 512 + h * 64 + lane] = f2bf(o);
        }
    }
}
__device__ __forceinline__ void unpack16(const bf16_t* p, float* v) {
    const u32x4 y0 = *(const u32x4*)p, y1 = *(const u32x4*)(p + 8);
#pragma unroll
    for (int j = 0; j < 4; ++j) { v[2 * j] = __uint_as_float(y0[j] << 16); v[2 * j + 1] = __uint_as_float(y0[j] & 0xffff0000u); v[8 + 2 * j] = __uint_as_float(y1[j] << 16); v[8 + 2 * j + 1] = __uint_as_float(y1[j] & 0xffff0000u); }
}
__device__ __forceinline__ void combine_row(size_t row, int lane, bf16_t* __restrict__ Y, const bf16_t* __restrict__ proj, const float* __restrict__ gain, const bf16_t* __restrict__ PO, const float* __restrict__ PL, const bf16_t* __restrict__ PARTO, const float* __restrict__ PARTML, const bf16_t* __restrict__ ybpre, const float* __restrict__ glub) {
    bf16_t* yp = Y + row * DM + lane * 16; const bf16_t* gp = proj + row * NIN + COL_G + lane * 16;
    const bool is_m = lane < 16, is_d = lane >= 48, is_s = (lane >= 16) && (lane < 32);
    const int hm = (lane >> 2) & 3;
    const bf16_t* s0 = yp; const bf16_t* s1 = yp; const bf16_t* s2 = yp; const bf16_t* s3 = yp;
    if (is_m) { const bf16_t* pb = PARTO + ((row * 4 + hm) * 3) * 64 + (lane & 3) * 16; s1 = pb; s2 = pb + 64; s3 = pb + 128; }
    if (is_s) s1 = ybpre + row * 256 + (lane - 16) * 16;
    if (is_d) { const bf16_t* pb = PO + row * 256 + (lane - 48) * 16; s0 = pb; s1 = pb + (size_t)M * 256; s2 = pb + 2 * (size_t)M * 256; s3 = pb; }
    const float* wp = is_m ? PARTML + ((row * 4 + hm) * 4) * 2 : PL + row * 4 + hm;
    const u32x4 g0 = *(const u32x4*)gp, g1 = *(const u32x4*)(gp + 8);
    const u32x4 a0 = *(const u32x4*)s0, a1 = *(const u32x4*)(s0 + 8), b0 = *(const u32x4*)s1, b1 = *(const u32x4*)(s1 + 8);
    const u32x4 c0 = *(const u32x4*)s2, c1 = *(const u32x4*)(s2 + 8), d0 = *(const u32x4*)s3, d1 = *(const u32x4*)(s3 + 8);
    float4 w01 = {0.f, 0.f, 0.f, 0.f}, w23 = {0.f, 0.f, 0.f, 0.f}; float p1 = 0.f, p2 = 0.f;
    if (is_m) { w01 = *(const float4*)wp; w23 = *(const float4*)(wp + 4); }
    if (is_d) { w01.x = wp[0]; p1 = wp[(size_t)M * 4]; p2 = wp[2 * (size_t)M * 4]; }
    __builtin_amdgcn_sched_barrier(0);
    float wa = 1.f, wb = 0.f, wc = 0.f, wd = 0.f;
    if (is_m) {
        const int own = (int)((row % SEQ) >> 8);
        const float m3 = w23.z, l3 = w23.w;
        const float m0 = own > 0 ? w01.x : NEGF, m1 = own > 1 ? w01.z : NEGF, m2 = own > 2 ? w23.x : NEGF;
        const float mx = fmaxf(fmaxf(m3, m0), fmaxf(m1, m2));
        wa = l3 * __builtin_amdgcn_exp2f(m3 - mx); wb = own > 0 ? w01.y * __builtin_amdgcn_exp2f(m0 - mx) : 0.f; wc = own > 1 ? w01.w * __builtin_amdgcn_exp2f(m1 - mx) : 0.f; wd = own > 2 ? w23.y * __builtin_amdgcn_exp2f(m2 - mx) : 0.f;
        const float wi = 1.0f / (wa + wb + wc + wd); wa *= wi; wb *= wi; wc *= wi; wd *= wi;
    }
    if (is_d) { const float mx = fmaxf(w01.x, fmaxf(p1, p2)); wa = __expf(w01.x - mx); wb = __expf(p1 - mx); wc = __expf(p2 - mx); const float wi = 1.0f / (wa + wb + wc); wa *= wi; wb *= wi; wc *= wi; wd = 0.f; }
    float v[16], gt[16];
#define CB_LO(x) __uint_as_float((x) << 16)
#define CB_HI(x) __uint_as_float((x) & 0xffff0000u)
#pragma unroll
    for (int j = 0; j < 4; ++j) {
        v[2 * j] = wa * CB_LO(a0[j]) + wb * CB_LO(b0[j]) + wc * CB_LO(c0[j]) + wd * CB_LO(d0[j]);         v[2 * j + 1] = wa * CB_HI(a0[j]) + wb * CB_HI(b0[j]) + wc * CB_HI(c0[j]) + wd * CB_HI(d0[j]);
        v[8 + 2 * j] = wa * CB_LO(a1[j]) + wb * CB_LO(b1[j]) + wc * CB_LO(c1[j]) + wd * CB_LO(d1[j]);     v[9 + 2 * j] = wa * CB_HI(a1[j]) + wb * CB_HI(b1[j]) + wc * CB_HI(c1[j]) + wd * CB_HI(d1[j]);
        gt[2 * j] = CB_LO(g0[j]); gt[2 * j + 1] = CB_HI(g0[j]); gt[8 + 2 * j] = CB_LO(g1[j]); gt[9 + 2 * j] = CB_HI(g1[j]);
    }
#undef CB_LO
#undef CB_HI
    if (is_s) {
#pragma unroll
        for (int j = 0; j < 4; ++j) {
            const float z0 = __uint_as_float(a0[j] << 16) + glub[(lane - 16) * 16 + 2 * j], z1 = __uint_as_float(a0[j] & 0xffff0000u) + glub[(lane - 16) * 16 + 2 * j + 1];
            const float z2 = __uint_as_float(a1[j] << 16) + glub[(lane - 16) * 16 + 8 + 2 * j], z3 = __uint_as_float(a1[j] & 0xffff0000u) + glub[(lane - 16) * 16 + 9 + 2 * j];
            v[2 * j] = __uint_as_float(b0[j] << 16) / (1.0f + __expf(-z0)); v[2 * j + 1] = __uint_as_float(b0[j] & 0xffff0000u) / (1.0f + __expf(-z1));
            v[8 + 2 * j] = __uint_as_float(b1[j] << 16) / (1.0f + __expf(-z2)); v[9 + 2 * j] = __uint_as_float(b1[j] & 0xffff0000u) / (1.0f + __expf(-z3));
        }
    }
    float ss = 0.f;
#pragma unroll
    for (int i = 0; i < 16; ++i) ss = fmaf(v[i], v[i], ss);
    ss += __shfl_xor(ss, 1); ss += __shfl_xor(ss, 2);
    const float r = rsqrtf(ss * (1.0f / 64.0f) + RMS_EPS);
    float o[16];
#pragma unroll
    for (int i = 0; i < 16; ++i) o[i] = v[i] * r * gain[lane * 16 + i] * (gt[i] / (1.0f + __expf(-gt[i])));
    u32x4 q0, q1;
    q0.x = cvtpk_s(o[0], o[1]); q0.y = cvtpk_s(o[2], o[3]); q0.z = cvtpk_s(o[4], o[5]); q0.w = cvtpk_s(o[6], o[7]);
    q1.x = cvtpk_s(o[8], o[9]); q1.y = cvtpk_s(o[10], o[11]); q1.z = cvtpk_s(o[12], o[13]); q1.w = cvtpk_s(o[14], o[15]);
    *(u32x4*)yp = q0; *(u32x4*)(yp + 8) = q1;
}
__device__ __forceinline__ void layernorm_row(size_t row, int lane, float* __restrict__ z, bf16_t* __restrict__ xb, const float* __restrict__ lg, const float* __restrict__ lbias) {
    float4* zp = (float4*)(z + row * DM) + lane;
    float4 v[4]; float s = 0.f;
#pragma unroll
    for (int j = 0; j < 4; ++j) { v[j] = zp[64 * j]; s += (v[j].x + v[j].y) + (v[j].z + v[j].w); }
    const float mean = wave_sum(s) * (1.0f / DM); float q = 0.f;
#pragma unroll
    for (int j = 0; j < 4; ++j) { v[j].x -= mean; v[j].y -= mean; v[j].z -= mean; v[j].w -= mean; q += (v[j].x * v[j].x + v[j].y * v[j].y) + (v[j].z * v[j].z + v[j].w * v[j].w); }
    const float rstd = rsqrtf(wave_sum(q) * (1.0f / DM) + LN_EPS);
#pragma unroll
    for (int j = 0; j < 4; ++j) {
        const float4 gg = ((const float4*)lg)[lane + 64 * j], bb = ((const float4*)lbias)[lane + 64 * j];
        float4 o; o.x = v[j].x * rstd * gg.x + bb.x; o.y = v[j].y * rstd * gg.y + bb.y; o.z = v[j].z * rstd * gg.z + bb.z; o.w = v[j].w * rstd * gg.w + bb.w;
        zp[64 * j] = o;
        uint2 ob; ob.x = pk2(o.x, o.y); ob.y = pk2(o.z, o.w);
        ((uint2*)(xb + row * DM))[lane + 64 * j] = ob;
    }
}


#define OPQS(x) asm volatile("" : "+s"(x))
#define OPQ(x) asm volatile("" : "+v"(x))
__global__ void __launch_bounds__(NWAVES * 64, 2) mega_fwd(Args args) {
    extern __shared__ __attribute__((aligned(16))) unsigned char lds[];
#define LANE_ID() ({ unsigned z_ = 0u; asm volatile("" : "+v"(z_)); (int)__builtin_amdgcn_mbcnt_hi(~0u, __builtin_amdgcn_mbcnt_lo(~0u, z_)); })
#define TID_() (wave * 64 + LANE_ID())
#define tid_ TID_()
#define lane_ LANE_ID()
    const int wave = __builtin_amdgcn_readfirstlane((int)threadIdx.x >> 6);
    const int G = gridDim.x, bx = blockIdx.x, bx_ = bx;
    LAS unsigned char* ldsl = (LAS unsigned char*)lds;
    volatile LAS unsigned* MISC = (volatile LAS unsigned*)(ldsl + MISC_OFF);
    for (int u = tid_; u < (LDS_BYTES - RING_BYTES) / 4; u += NWAVES * 64) ((LAS unsigned*)(ldsl + RING_BYTES))[u] = 0u;
    __syncthreads();
    const XcdBarrier bar = xcd_barrier_post((unsigned*)(args.ws + WS_CTL) + CW_BAR, MISC + 8);
    const int gw = bx * NWAVES + wave, NGW = G * NWAVES;
#ifdef PROBE_A
#define STAMP(k) do { if (bx_ == 0 && threadIdx.x == 0) MISC[16 + (k)] = (unsigned)__builtin_amdgcn_s_memrealtime(); } while (0)
#else
#define STAMP(k) do { } while (0)
#endif
#define SUBSTAMP(k) STAMP(32 + (k))
    int stamp_i = 0;
#define GRID_BAR() do { GRID_BAR0(); ++stamp_i; STAMP(stamp_i); } while (0)
#define GRID_BAR0() do { XcdBarrier b_ = bar; unsigned x_ = b_.x; unsigned* p_ = b_.bar; asm volatile("" : "+s"(x_), "+s"(p_)); b_.x = x_; b_.bar = p_; xcd_barrier(b_); } while (0)

    STAMP(0);
    {
        const Args* A = &args; unsigned char* ws = launder_g(args.ws);
        int lane = lane_, tid = tid_; OPQ(lane); OPQ(tid);
        const float* x = A->in[0]; const float* w_in = A->in[1]; const float* glu_w = A->in[11]; const float* w_out = A->in[15];
        bf16_t* wtin = (bf16_t*)(ws + WS_WTIN); bf16_t* wtout = (bf16_t*)(ws + WS_WTOUT); bf16_t* gluwt = (bf16_t*)(ws + WS_GLUWT); bf16_t* xb = (bf16_t*)(ws + WS_XB);
        LAS float* scr = (LAS float*)(ldsl + wave * 16384);
        constexpr int I_IN = (DM / 64) * (NIN / 32), I_OUT = (DM / 64) * (DM / 32), I_GLU = (BW / 64) * (BW / 32), I_L = I_IN + I_OUT + I_GLU;
        for (int it = gw; it < DEPTH * I_L; it += NGW) {
            const int l = it / I_L; int r = it % I_L;
            if (r < I_IN) { p0_transpose_item(w_in + (size_t)l * DM * NIN, DM, NIN, wtin + (size_t)l * NIN * DM, scr, r, lane); continue; } r -= I_IN;
            if (r < I_OUT) { p0_transpose_item(w_out + (size_t)l * DM * DM, DM, DM, wtout + (size_t)l * DM * DM, scr, r, lane); continue; } r -= I_OUT;
            p0_transpose_item(glu_w + (size_t)l * BW * BW, BW, BW, gluwt + (size_t)l * BW * BW, scr, r, lane);
        }
        for (size_t i = (size_t)bx * 512 + tid; i < (size_t)M * DM / 4; i += (size_t)G * 512) {
            const float4 v = ((const float4*)x)[i]; uint2 o; o.x = pk2(v.x, v.y); o.y = pk2(v.z, v.w); ((uint2*)xb)[i] = o;
        }
        if (bx < 8 && tid < 256) prep_small(bx * 256 + tid, A->in[3], A->in[4], A->in[5], A->in[6], A->in[7], A->in[13], (float*)(ws + WS_SMALL));
        if (bx == 8) { float* smc = (float*)(ws + WS_SMALL);
            for (int i = tid; i < 256; i += 512) smc[SM_RELB + i] = A->in[2][i];
            for (int i = tid; i < 512; i += 512) smc[SM_GLUB + i] = A->in[12][i];
            for (int i = tid; i < 2048; i += 512) { smc[SM_GAIN + i] = A->in[14][i]; smc[SM_LNG + i] = A->in[16][i]; smc[SM_LNB + i] = A->in[17][i]; } }
        if (bx == 9) { float* smc = (float*)(ws + WS_SMALL); const float* rb = A->in[2];
            for (int i = tid; i < 4 * 1888; i += 512) { const int h = i / 1888, dd = i % 1888 - 96; smc[SM_LUTM + i] = dd >= 0 ? rb[t5_bucket(dd) * 8 + h] * 1.4426950408889634f : NEGF; }
            for (int i = tid; i < 3 * 4 * 256; i += 512) { const int pi = i >> 10, h = (i >> 8) & 3, dd = (i & 255) - 64, dil = (pi == 0) ? 1 : (pi == 1) ? 4 : 16;
                smc[SM_LUTD + i] = (dd >= 0 && dd <= 128) ? rb[t5_bucket(dd * dil) * 8 + 4 + h] * 1.4426950408889634f : NEGF; } }
        for (int e = bx * 512 + tid; e < 2 * 16 * 64 * 64; e += G * 512)
            s5::tables_thread(e, A->in[3], A->in[4], A->in[5], A->in[6], A->in[7], A->in[8], A->in[9], (bf16_t*)(ws + WS_W1), (bf16_t*)(ws + WS_W3), (float*)(ws + WS_SMALL) + SM_A64);
        for (int it = bx; it < 2 * 16 * 64; it += G)
            s5::kmat_item((LAS float*)ldsl, tid, it, A->in[3], A->in[4], A->in[5], A->in[6], A->in[7], A->in[8], A->in[9], A->in[10], (bf16_t*)(ws + WS_KM));
    }
    GRID_BAR();

#pragma unroll 1
    for (int l = 0; l < DEPTH; ++l) {
        {
            const Args* A = &args; unsigned char* ws = launder_g(args.ws);
            pg8::Gemm g{(const bf16_t*)(ws + WS_XB), (const bf16_t*)(ws + WS_WTIN) + (size_t)l * NIN * DM, M, NIN, DM}; int tidg = tid_, bxg = bx; OPQ(tidg); OPQS(bxg); pg8::StaticOrder S; S.init(M, NIN, G, bxg);
            pg8::EpiStoreBf16 E{(bf16_t*)(ws + WS_PROJ), NIN, (float*)(ws + WS_KP)};
            pg8::gemm_phase<pg8::EpiStoreBf16, pg8::StaticOrder, true, true>(ldsl, g, S, E, tidg);
        }
        GRID_BAR();
        {
            const Args* A = &args; unsigned char* ws = launder_g(args.ws);
            const bf16_t* proj = (const bf16_t*)(ws + WS_PROJ);
            int lane = lane_; OPQ(lane); const int tid = wave * 64 + lane;
            const float* lbp = (const float*)(ws + WS_SMALL) + SM_LB + l * 256;
            unsigned* wq = (unsigned*)(ws + WS_CTL) + CW_WQ + 64 * l;
            for (int it = gw; it < 2048; it += NGW) hw::x1_wave(ldsl + wave * 16384, lane, it, proj, lbp, (float*)(ws + WS_DS), (float*)(ws + WS_DEC));
            SUBSTAMP(0);
            for (int wi = gw; wi < 512; wi += NGW) s5::x1_wave(lane, wi & 15, wi >> 4, l * 16 + (wi & 15), proj, (const bf16_t*)(ws + WS_W1), (float*)(ws + WS_HEND));
            SUBSTAMP(1);
            constexpr int N_GATE = 512;
            for (;;) {
                __syncthreads();
                if (tid == 0) MISC[4] = __hip_atomic_fetch_add(wq, 1u, __ATOMIC_RELAXED, __HIP_MEMORY_SCOPE_AGENT);
                __syncthreads();
                int it = (int)MISC[4];
                if (it >= N_GATE) break;
                fa2::gate_item(ldsl, tid, it & 15, 31 - (it >> 4), proj, (const float*)(ws + WS_KP), (unsigned short*)(ws + WS_LIST), (int*)(ws + WS_CNT));
            }
            SUBSTAMP(2);
        }
        GRID_BAR();
        {
            const Args* A = &args; unsigned char* ws = launder_g(args.ws);
            const bf16_t* proj = (const bf16_t*)(ws + WS_PROJ); const float* sm = (const float*)(ws + WS_SMALL);
            int lane = lane_; OPQ(lane);
            int bx = bx_; OPQS(bx);
            const int tid = wave * 64 + lane;
            if (bx < 32) hg::x2_scan(bx * 512 + tid, 32 * 512, (const float*)(ws + WS_DS), (const float*)(ws + WS_DEC), (bf16_t*)(ws + WS_ST));
            else if (bx < 40) s5::x2_scan((bx - 32) * 512 + tid, (const float*)(ws + WS_HEND), sm + SM_A64, (bf16_t*)(ws + WS_HST), l);
            unsigned* wq = (unsigned*)(ws + WS_CTL) + CW_WQ + 64 * (2 + l);
            const float* lutm = sm + SM_LUTM; const float* lutd = sm + SM_LUTD;
            __syncthreads();
            if (tid == 0) MISC[4] = __hip_atomic_fetch_add(wq, 1u, __ATOMIC_RELAXED, __HIP_MEMORY_SCOPE_AGENT);
            for (;;) {
                __syncthreads();
                int it = (int)MISC[4];
                constexpr int N_MOBA = 8 * 64 + 12 * 32 + 12 * 16, N_DIL = 1536;
                if (it >= N_MOBA + N_DIL) break;
                unsigned nxt = 0u;
                if (tid == 0) nxt = __hip_atomic_fetch_add(wq, 1u, __ATOMIC_RELAXED, __HIP_MEMORY_SCOPE_AGENT);
                int tidq = tid; OPQ(tidq);
                auto park = [&]() { if (tidq == 0) MISC[4] = nxt; };
                if (it < N_MOBA) {
                    int n, part, np;
                    if (it < 512) { n = it >> 6; part = (it >> 4) & 3; np = 4; } else if (it < 896) { const int j = it - 512; n = 8 + (j >> 5); part = (j >> 4) & 1; np = 2; } else { n = 20 + ((it - 896) >> 4); part = 0; np = 1; }
                    fa2::moba_item(park, ldsl, tidq, it & 15, n, part, np, proj, sm + SM_RELB, lutm, (const unsigned short*)(ws + WS_LIST), (const int*)(ws + WS_CNT), (bf16_t*)(ws + WS_PARTO), (float*)(ws + WS_PARTML), (bf16_t*)(ws + WS_Y));
                } else { it -= N_MOBA; const int pi = 2 - it / 512, bh = (it >> 5) & 15, u = it & 31; fa2::dilated_unit(park, ldsl, tidq, pi, bh, u, proj, lutd, (bf16_t*)(ws + WS_PO), (float*)(ws + WS_PL)); }
            }
        }
        GRID_BAR();
        {
            const Args* A = &args; unsigned char* ws = launder_g(args.ws);
            int lane = lane_; OPQ(lane);
            const float* lbp = (const float*)(ws + WS_SMALL) + SM_LB + l * 256;
            for (int it = bx; it < 256; it += G) s5::x3_item(ldsl, wave, lane, it, l, (const bf16_t*)(ws + WS_PROJ), (const bf16_t*)(ws + WS_KM), (const bf16_t*)(ws + WS_W3), (const bf16_t*)(ws + WS_HST), (bf16_t*)(ws + WS_YBPRE));
            __syncthreads(); SUBSTAMP(3);
            for (int it = gw; it < 2048; it += NGW) hw::x3_wave(ldsl + wave * 16384, lane, it, (const bf16_t*)(ws + WS_PROJ), lbp, (const bf16_t*)(ws + WS_ST), (bf16_t*)(ws + WS_Y));
            SUBSTAMP(4);
        }
        GRID_BAR();
        {
            const Args* A = &args; unsigned char* ws = launder_g(args.ws);
            const bf16_t* ybpre = (const bf16_t*)(ws + WS_YBPRE);
            pg8::Gemm g{ybpre, (const bf16_t*)(ws + WS_GLUWT) + (size_t)l * BW * BW, M, BW, BW}; int tidg = tid_, bxg = bx; OPQ(tidg); OPQS(bxg); pg8::StaticOrder S; S.init(M, BW, G, bxg);
            pg8::EpiStoreBf16 E{(bf16_t*)(ws + WS_Y) + 256, DM, nullptr};
            pg8::gemm_phase<pg8::EpiStoreBf16, pg8::StaticOrder, true, true>(ldsl, g, S, E, tidg);
        }
        GRID_BAR();
        {
            const Args* A = &args; unsigned char* ws = launder_g(args.ws);
            int lane = lane_; OPQ(lane);
            for (int r = gw; r < M; r += NGW) combine_row((size_t)r, lane, (bf16_t*)(ws + WS_Y), (const bf16_t*)(ws + WS_PROJ), (const float*)(ws + WS_SMALL) + SM_GAIN + l * DM, (const bf16_t*)(ws + WS_PO), (const float*)(ws + WS_PL), (const bf16_t*)(ws + WS_PARTO), (const float*)(ws + WS_PARTML), (const bf16_t*)(ws + WS_YBPRE), (const float*)(ws + WS_SMALL) + SM_GLUB + l * BW);
        }
        GRID_BAR();
        {
            const Args* A = &args; unsigned char* ws = launder_g(args.ws);
            pg8::Gemm g{(const bf16_t*)(ws + WS_Y), (const bf16_t*)(ws + WS_WTOUT) + (size_t)l * DM * DM, M, DM, DM}; int tidg = tid_, bxg = bx; OPQ(tidg); OPQS(bxg); pg8::StaticOrder S; S.init(M, DM, G, bxg);
            const float* smp = (const float*)(ws + WS_SMALL);
            float* outp = launder_g(args.out); const float* resp = launder_g(args.in[0]);
            pg8::EpiResLn E{l == 0 ? resp : outp, outp, (bf16_t*)(ws + WS_XB), smp + SM_LNG + l * DM, smp + SM_LNB + l * DM, (unsigned long long*)(ws + WS_YBPRE), (unsigned*)(ws + WS_CTL) + CW_SEAM + l * 128 * 64, ldsl + RING_BYTES + 1024};
            pg8::gemm_phase<pg8::EpiResLn, pg8::StaticOrder, true, true>(ldsl, g, S, E, tidg);
        }
        if (l + 1 < DEPTH) GRID_BAR();
    }
#ifdef PROBE_A
    ++stamp_i; STAMP(stamp_i);
    if (bx_ == 0 && threadIdx.x == 0) { asm volatile("s_waitcnt vmcnt(0) lgkmcnt(0)" ::: "memory"); args.out[0] += (float)(MISC[16 + PROBE_B] - MISC[16 + PROBE_A]) * 1e-4f; }
#endif
}

extern "C" void kernel_launch(void* const* d_in, const int* in_sizes, int n_in, void* d_out, int out_size, void* d_ws, size_t ws_size, hipStream_t stream) {
    static int grid = 0;
    if (grid == 0) {
        if (n_in != 18 || in_sizes[0] != M * DM || out_size != M * DM || ws_size < WS_END) { fprintf(stderr, "kernel_launch: unexpected shapes (n_in %d, in0 %d, out %d, ws %zu)\n", n_in, n_in > 0 ? in_sizes[0] : -1, out_size, ws_size); grid = -1; return; }
        int dev = 0, cus = 0, per_cu = 0;
        if (hipGetDevice(&dev) != hipSuccess || hipDeviceGetAttribute(&cus, hipDeviceAttributeMultiprocessorCount, dev) != hipSuccess) { grid = -1; return; }
        if (hipFuncSetAttribute((const void*)mega_fwd, hipFuncAttributeMaxDynamicSharedMemorySize, LDS_BYTES) != hipSuccess) { fprintf(stderr, "kernel_launch: hipFuncSetAttribute failed\n"); grid = -1; return; }
        if (hipOccupancyMaxActiveBlocksPerMultiprocessor(&per_cu, (const void*)mega_fwd, NWAVES * 64, LDS_BYTES) != hipSuccess || per_cu < 1) { fprintf(stderr, "kernel_launch: occupancy query says %d\n", per_cu); }
        (void)hipGetLastError();
        grid = cus;
    }
    if (grid < 0) return;
    if (hipMemsetAsync((char*)d_ws + WS_CTL, 0, CTL_ZERO_BYTES, stream) != hipSuccess) return;
    Args a{};
    for (int i = 0; i < 18; ++i) a.in[i] = (const float*)d_in[i];
    a.out = (float*)d_out; a.ws = (unsigned char*)d_ws;
    hipLaunchKernelGGL(mega_fwd, dim3(grid), dim3(NWAVES * 64), LDS_BYTES, stream, a);
}
```

```cpp
#include <hip/hip_runtime.h>
#include <stdint.h>
#include <cstdio>
#include <type_traits>

typedef unsigned short bf16_t;
typedef unsigned u32x4 __attribute__((ext_vector_type(4)));
#define LAS __attribute__((address_space(3)))
#define GAS __attribute__((address_space(1)))

constexpr int BATCH = 4, SEQ = 8192, DM = 1024, M = BATCH * SEQ, BW = 256, NIN = 3584, HD = 64, DEPTH = 2;
constexpr int COL_QA = 0, COL_KA = 256, COL_VA = 512, COL_U = 768, COL_QC = 1024, COL_FC = 1280, COL_IC = 1536, COL_QD = 1792, COL_KD = 2048, COL_VD = 2304, COL_G = 2560;
constexpr float ALPHA = 1.4142135623730951f;
constexpr float LN_EPS = 1e-5f, RMS_EPS = 1e-6f, NEGF = -1e30f;

constexpr size_t MiB = 1u << 20;
constexpr size_t WS_CTL = 0, CTL_ZERO_BYTES = 1 * MiB;
constexpr size_t WS_SMALL = 1 * MiB;
constexpr size_t WS_WTIN = 2 * MiB;
constexpr size_t WS_WTOUT = 16 * MiB;
constexpr size_t WS_GLUWT = 20 * MiB;
constexpr size_t WS_KP = 21 * MiB;
constexpr size_t WS_XB = 22 * MiB;
constexpr size_t WS_PARTO = WS_XB;
constexpr size_t WS_PARTML = WS_XB + 48 * MiB;
constexpr size_t WS_LIST = WS_XB + 52 * MiB;
constexpr size_t WS_CNT = WS_XB + 60 * MiB;
constexpr size_t WS_PROJ = 86 * MiB;
constexpr size_t WS_Y = 310 * MiB;
constexpr size_t WS_YBPRE = 374 * MiB;
constexpr size_t WS_PO = 390 * MiB;
constexpr size_t WS_PL = 438 * MiB;
constexpr size_t WS_DS = 440 * MiB;
constexpr size_t WS_ST = 472 * MiB;
constexpr size_t WS_DEC = 488 * MiB;
constexpr size_t WS_KM = 489 * MiB;
constexpr size_t WS_W1 = 490 * MiB;
constexpr size_t WS_W3 = 498 * MiB;
constexpr size_t WS_HEND = 506 * MiB;
constexpr size_t WS_HST = 510 * MiB;
constexpr size_t WS_END = 512 * MiB;
constexpr int SM_LB = 0;
constexpr int SM_ABAR = 512;
constexpr int SM_BBAR = SM_ABAR + 2 * 16 * 64 * 2;
constexpr int SM_A64 = SM_BBAR + 2 * 16 * 64 * 16 * 2;
constexpr int SM_RELB = SM_A64 + 2 * 16 * 64 * 2, SM_GLUB = SM_RELB + 256, SM_GAIN = SM_GLUB + 512, SM_LNG = SM_GAIN + 2048, SM_LNB = SM_LNG + 2048, SM_END = SM_LNB + 2048;
constexpr int SM_LUTM = SM_END, SM_LUTD = SM_LUTM + 4 * 1888, SM_END2 = SM_LUTD + 3 * 4 * 256;
constexpr int CW_BAR = 4096;
constexpr int CW_SEAM = 32768;
constexpr int CW_WQ = 16384;

__device__ __forceinline__ float bf2f(bf16_t v) { return __uint_as_float(((unsigned)v) << 16); }
__device__ __forceinline__ bf16_t f2bf(float f) { unsigned u = __float_as_uint(f); return (bf16_t)((u + 0x7fffu + ((u >> 16) & 1u)) >> 16); }
__device__ __forceinline__ unsigned pk2(float lo, float hi) { return (unsigned)f2bf(lo) | ((unsigned)f2bf(hi) << 16); }
__device__ __forceinline__ float wave_max(float v) {
#pragma unroll
    for (int o = 1; o < 64; o <<= 1) v = fmaxf(v, __shfl_xor(v, o));
    return v;
}
__device__ __forceinline__ float wave_sum(float v) {
#pragma unroll
    for (int o = 1; o < 64; o <<= 1) v += __shfl_xor(v, o);
    return v;
}
__device__ __forceinline__ int t5_bucket(int d) {
    if (d < 16) return d;
    int b = 16;
    b += (d >= 22); b += (d >= 30); b += (d >= 40); b += (d >= 54); b += (d >= 73); b += (d >= 99); b += (d >= 134); b += (d >= 182);
    b += (d >= 246); b += (d >= 332); b += (d >= 450); b += (d >= 609); b += (d >= 825); b += (d >= 1117); b += (d >= 1513);
    return b;
}
__device__ __forceinline__ float sigmoidf_(float x) { return 1.0f / (1.0f + expf(-x)); }
__device__ __forceinline__ float siluf_(float x) { return x / (1.0f + expf(-x)); }
__device__ __forceinline__ float gelu_tanh(float x) { const float u = 0.7978845608028654f * (x + 0.044715f * x * x * x); return 0.5f * x * (1.0f + tanhf(u)); }
typedef float f32x2_t __attribute__((ext_vector_type(2))); typedef __bf16 bf16x2_t __attribute__((ext_vector_type(2)));
__device__ __forceinline__ unsigned cvtpk_s(float lo, float hi) { f32x2_t v = {lo, hi}; bf16x2_t b = __builtin_convertvector(v, bf16x2_t); return __builtin_bit_cast(unsigned, b); }
__device__ __forceinline__ int lane_id_opaque() { unsigned z = 0u; asm volatile("" : "+v"(z)); return (int)__builtin_amdgcn_mbcnt_hi(~0u, __builtin_amdgcn_mbcnt_lo(~0u, z)); }
template <class T> __device__ __forceinline__ T* launder_g(T* p) { unsigned long long v = (unsigned long long)p; asm volatile("" : "+s"(v)); return (T*)(__attribute__((address_space(1))) T*)v; }
#define WSYNC() asm volatile("s_waitcnt lgkmcnt(0)" ::: "memory")

__device__ __forceinline__ void sincos_d(double th, double& s, double& c) {
    const double k = rint(th * 0.63661977236758134308);
    double r = fma(-k, 1.57079632679489655800, th); r = fma(-k, 6.12323399573676603587e-17, r);
    const long q = ((long)k) & 3;
    const double r2 = r * r;
    const double sp = r * (1.0 + r2 * (-1.0 / 6 + r2 * (1.0 / 120 + r2 * (-1.0 / 5040 + r2 * (1.0 / 362880 + r2 * (-1.0 / 39916800 + r2 * (1.0 / 6227020800.0 + r2 * (-1.0 / 1307674368000.0))))))));
    const double cp = 1.0 + r2 * (-0.5 + r2 * (1.0 / 24 + r2 * (-1.0 / 720 + r2 * (1.0 / 40320 + r2 * (-1.0 / 3628800 + r2 * (1.0 / 479001600.0 + r2 * (-1.0 / 87178291200.0 + r2 * (1.0 / 20922789888000.0))))))));
    if (q == 0) { s = sp; c = cp; } else if (q == 1) { s = cp; c = -sp; } else if (q == 2) { s = -sp; c = -cp; } else { s = -cp; c = sp; }
}

namespace pg8 {
#define PG8_LAS __attribute__((address_space(3)))
typedef unsigned short bf16_t;
typedef short bf16x8 __attribute__((ext_vector_type(8)));
typedef float f32x4 __attribute__((ext_vector_type(4)));
typedef unsigned u32x4 __attribute__((ext_vector_type(4)));
constexpr int BM = 256, BK = 64, HALF = 128, HTB = HALF * BK * 2  , STAGE_BYTES = 8 * HTB, NXCD = 8, WGM = 8;

__host__ __device__ __forceinline__ int lds_byte(int r, int c) { const int st = (r >> 4) * 2 + (c >> 5), rr = r & 15, cc = c & 31, ob = rr * 64 + cc * 2; return st * 1024 + (ob ^ (((ob >> 9) & 1) << 5)); }
__host__ __device__ __forceinline__ void stage_rc(int b, int& R, int& C) { const int st = b / 1024, sb = b % 1024, swz = sb ^ (((sb >> 9) & 1) << 5); R = (st >> 1) * 16 + swz / 64; C = (st & 1) * 32 + (swz % 64) / 2; }
__host__ __device__ __forceinline__ int perm32(int rho) { const int n = rho >> 4, i = rho & 15; return 8 * (i >> 2) + 4 * n + (i & 3); }

struct Unit { int pm, pn; };
struct Gemm { const bf16_t* A; const bf16_t* Bt; int M, N, K; };

struct StaticOrder {
    int nM, nN, nwg, G, c;
    __host__ __device__ void init(int M, int N, int G_, int c_) { nM = M / BM; nN = N / BM; nwg = nM * nN; G = G_; c = c_; }
    __host__ __device__ bool next(int i, Unit& u) const {
        const long L = (long)i * G + c; if (L >= nwg) return false;
        int wgid = (int)L; { const int q = nwg / NXCD, r = nwg % NXCD, xcd = wgid % NXCD, off = wgid / NXCD; wgid = (xcd < r ? xcd * (q + 1) : r * (q + 1) + (xcd - r) * q) + off; }
        const int nig = WGM * nN, gid = wgid / nig, fm = gid * WGM, gsz = (nM - fm) < WGM ? (nM - fm) : WGM;
        u.pm = fm + ((wgid % nig) % gsz); u.pn = (wgid % nig) / gsz; return true;
    }
    __device__ __forceinline__ void a_ready(const Unit&) const {}
    __device__ __forceinline__ void done(const Unit&) const {}
};

__device__ __forceinline__ unsigned cvt_pk_bf16(float lo, float hi) { unsigned r; asm volatile("v_cvt_pk_bf16_f32 %0, %1, %2" : "=v"(r) : "v"(lo), "v"(hi)); return r; }
struct EpiStoreBf16 {
    static constexpr bool PERM = true, AFTER_DRAIN = false;
    bf16_t* O; int ldc; float* kp;
    __device__ __forceinline__ void operator()(const f32x4 (&acc)[2][2][4][2], const Unit& u, int wr, int wc, int fr_, int fq_) const {
        const int ln_ = lane_id_opaque(), fr = ln_ & 15, fq = ln_ >> 4; (void)fr_; (void)fq_;
        const int row0 = u.pm * BM + wr * 64 + fr, col0 = u.pn * BM + wc * 32 + 8 * fq;
#pragma unroll
        for (int ai = 0; ai < 2; ++ai)
#pragma unroll
            for (int m = 0; m < 4; ++m) { bf16_t* rowp = O + (size_t)(row0 + ai * HALF + m * 16) * ldc + col0;
#pragma unroll
                for (int bj = 0; bj < 2; ++bj) { const f32x4 v0 = acc[ai][bj][m][0], v1 = acc[ai][bj][m][1];
                    u32x4 w; w.x = cvtpk_s(v0[0], v0[1]); w.y = cvtpk_s(v0[2], v0[3]); w.z = cvtpk_s(v1[0], v1[1]); w.w = cvtpk_s(v1[2], v1[3]);
                    *(u32x4*)(rowp + bj * HALF) = w; } }
        if (kp && u.pn == 1) {
#pragma unroll
            for (int bj = 0; bj < 2; ++bj)
#pragma unroll
                for (int n = 0; n < 2; ++n) { f32x4 s = {0.f, 0.f, 0.f, 0.f};
#pragma unroll
                    for (int ai = 0; ai < 2; ++ai)
#pragma unroll
                        for (int m = 0; m < 4; ++m) s += acc[ai][bj][m][n];
#pragma unroll
                    for (int o = 1; o < 16; o <<= 1) { s[0] += __shfl_xor(s[0], o); s[1] += __shfl_xor(s[1], o); s[2] += __shfl_xor(s[2], o); s[3] += __shfl_xor(s[3], o); }
                    if (fr == 0) *(f32x4*)(kp + (size_t)(u.pm * 2 + wr) * 256 + bj * HALF + wc * 32 + 8 * fq + 4 * n) = s; }
        }
    }
};
struct EpiGlu {
    static constexpr bool PERM = true, AFTER_DRAIN = false;
    bf16_t* O; int ldc; const bf16_t* Ain; int lda; const float* bias;
    __device__ __forceinline__ void operator()(const f32x4 (&acc)[2][2][4][2], const Unit& u, int wr, int wc, int fr_, int fq_) const {
        const int ln_ = lane_id_opaque(), fr = ln_ & 15, fq = ln_ >> 4; (void)fr_; (void)fq_;
        const int row0 = u.pm * BM + wr * 64 + fr, col0 = u.pn * BM + wc * 32 + 8 * fq;
        bf16_t* O = launder_g(this->O); const bf16_t* Ain = launder_g(this->Ain); const float* bias = launder_g(this->bias);
#pragma unroll
        for (int ai = 0; ai < 2; ++ai)
#pragma unroll
            for (int m = 0; m < 4; ++m) { const size_t r = (size_t)(row0 + ai * HALF + m * 16);
#pragma unroll
                for (int bj = 0; bj < 2; ++bj) { const int c = col0 + bj * HALF;
                    const u32x4 av = *(const u32x4*)(Ain + r * lda + c);
                    const f32x4 b0 = *(const f32x4*)(bias + c), b1 = *(const f32x4*)(bias + c + 4);
                    const f32x4 v0 = acc[ai][bj][m][0] + b0, v1 = acc[ai][bj][m][1] + b1;
                    float o[8];
#pragma unroll
                    for (int j = 0; j < 4; ++j) { const float alo = __uint_as_float(av[j] << 16), ahi = __uint_as_float(av[j] & 0xffff0000u);
                        const float s0 = (j < 2) ? v0[2 * j] : v1[2 * j - 4], s1 = (j < 2) ? v0[2 * j + 1] : v1[2 * j - 3];
                        o[2 * j] = alo / (1.0f + __expf(-s0)); o[2 * j + 1] = ahi / (1.0f + __expf(-s1)); }
                    u32x4 w; w.x = cvtpk_s(o[0], o[1]); w.y = cvtpk_s(o[2], o[3]); w.z = cvtpk_s(o[4], o[5]); w.w = cvtpk_s(o[6], o[7]);
                    *(u32x4*)(O + r * ldc + c) = w; } }
    }
};
struct EpiResF32 {
    static constexpr bool PERM = false, AFTER_DRAIN = false;
    const float* res; float* out;
    __device__ __forceinline__ void operator()(const f32x4 (&acc)[2][2][4][2], const Unit& u, int wr, int wc, int fr_, int fq_) const {
        const int ln_ = lane_id_opaque(), fr = ln_ & 15, fq = ln_ >> 4; (void)fr_; (void)fq_;
        const int col0 = u.pn * BM + wc * 32 + 4 * fq;
#pragma unroll
        for (int ai = 0; ai < 2; ++ai)
#pragma unroll
            for (int m = 0; m < 4; ++m) { const size_t off = (size_t)(u.pm * BM + ai * HALF + wr * 64 + m * 16 + fr) * 1024 + col0;
#pragma unroll
                for (int bj = 0; bj < 2; ++bj)
#pragma unroll
                    for (int n = 0; n < 2; ++n) { const f32x4 rv = *(const f32x4*)(res + off + bj * HALF + n * 16);
                        *(f32x4*)(out + off + bj * HALF + n * 16) = rv * 1.4142135623730951f + acc[ai][bj][m][n]; } }
    }
};

struct EpiResLn {
    static constexpr bool PERM = false, AFTER_DRAIN = false;
    const float* res; float* out; bf16_t* xb; const float* gam; const float* bet; unsigned long long* xbuf; unsigned* cnt; PG8_LAS unsigned char* tbl;
    __device__ __forceinline__ void operator()(f32x4 (&acc)[2][2][4][2], const Unit& u, int wr, int wc, int fr_, int fq_) const {
        typedef float f32x2v __attribute__((ext_vector_type(2)));
        const int lane = lane_id_opaque(), fr = lane & 15, fq = lane >> 4; (void)fr_; (void)fq_;
        const int wid = wr * 4 + wc;
        const int col0 = u.pn * BM + wc * 32 + 4 * fq;
        PG8_LAS f32x2v* Pt = (PG8_LAS f32x2v*)tbl;
        PG8_LAS f32x2v* St = (PG8_LAS f32x2v*)(tbl + 8192);
#pragma unroll
        for (int ai = 0; ai < 2; ++ai)
#pragma unroll
            for (int m = 0; m < 4; ++m) {
                const size_t off = (size_t)(u.pm * BM + ai * HALF + wr * 64 + m * 16 + fr) * 1024 + col0;
                f32x4 rv[2][2];
#pragma unroll
                for (int bj = 0; bj < 2; ++bj)
#pragma unroll
                    for (int n = 0; n < 2; ++n) rv[bj][n] = *(const f32x4*)(res + off + bj * HALF + n * 16);
                float s = 0.f;
#pragma unroll
                for (int bj = 0; bj < 2; ++bj)
#pragma unroll
                    for (int n = 0; n < 2; ++n) { acc[ai][bj][m][n] = rv[bj][n] * 1.4142135623730951f + acc[ai][bj][m][n]; const f32x4 x = acc[ai][bj][m][n]; s += (x[0] + x[1]) + (x[2] + x[3]); }
                s += __shfl_xor(s, 16); s += __shfl_xor(s, 32);
                const float mw = s * (1.0f / 64.0f); float q = 0.f;
#pragma unroll
                for (int bj = 0; bj < 2; ++bj)
#pragma unroll
                    for (int n = 0; n < 2; ++n) { const f32x4 d = acc[ai][bj][m][n] - mw; q += (d[0] * d[0] + d[1] * d[1]) + (d[2] * d[2] + d[3] * d[3]); }
                q += __shfl_xor(q, 16); q += __shfl_xor(q, 32);
                if (fq == 0) Pt[(ai * HALF + wr * 64 + m * 16 + fr) * 4 + wc] = (f32x2v){mw, q};
            }
        asm volatile("s_waitcnt lgkmcnt(0)" ::: "memory"); __builtin_amdgcn_s_barrier(); asm volatile("" ::: "memory");
        const int row = wid * 32 + (lane & 31);
        unsigned* cw = cnt + 64 * u.pm;
        if (lane < 32) {
            const f32x2v a = Pt[row * 4 + 0], b2 = Pt[row * 4 + 1], c = Pt[row * 4 + 2], d = Pt[row * 4 + 3];
            const float mt = (a.x + b2.x + c.x + d.x) * 0.25f;
            const float da = a.x - mt, db = b2.x - mt, dc = c.x - mt, dd = d.x - mt;
            const float m2 = (a.y + b2.y) + (c.y + d.y) + 64.0f * ((da * da + db * db) + (dc * dc + dd * dd));
            __hip_atomic_store(xbuf + ((size_t)(u.pm * BM + row) * 4 + u.pn), ((unsigned long long)__float_as_uint(m2) << 32) | __float_as_uint(mt), __ATOMIC_RELAXED, __HIP_MEMORY_SCOPE_AGENT);
        }
        asm volatile("s_waitcnt vmcnt(0)" ::: "memory");
        if (lane == 0) __hip_atomic_fetch_add(cw, 1u, __ATOMIC_RELAXED, __HIP_MEMORY_SCOPE_AGENT);
        if (wid == 0) {
            unsigned sp = 0;
            while ((unsigned)__builtin_amdgcn_readfirstlane(__hip_atomic_load(cw, __ATOMIC_RELAXED, __HIP_MEMORY_SCOPE_AGENT)) < 32u) { __builtin_amdgcn_s_sleep(2); if (++sp > (1u << 22)) break; }
            __builtin_amdgcn_fence(__ATOMIC_ACQUIRE, "agent");
        }
        asm volatile("s_waitcnt vmcnt(0) lgkmcnt(0)" ::: "memory"); __builtin_amdgcn_s_barrier(); asm volatile("" ::: "memory");
        if (lane < 32) {
            const unsigned long long* slot = xbuf + (size_t)(u.pm * BM + row) * 4; float mt[4], m2[4]; float ms = 0.f;
#pragma unroll
            for (int t = 0; t < 4; ++t) { const unsigned long long w = __hip_atomic_load(slot + t, __ATOMIC_RELAXED, __HIP_MEMORY_SCOPE_AGENT); mt[t] = __uint_as_float((unsigned)w); m2[t] = __uint_as_float((unsigned)(w >> 32)); ms += mt[t]; }
            const float mean = ms * 0.25f; float q = 0.f;
#pragma unroll
            for (int t = 0; t < 4; ++t) { const float dm = mt[t] - mean; q += m2[t] + 256.0f * dm * dm; }
            St[row] = (f32x2v){mean, 1.0f / sqrtf(q * (1.0f / 1024.0f) + 1e-5f)};
        }
        asm volatile("s_waitcnt lgkmcnt(0)" ::: "memory"); __builtin_amdgcn_s_barrier(); asm volatile("" ::: "memory");
#pragma unroll
        for (int bj = 0; bj < 2; ++bj)
#pragma unroll
            for (int n = 0; n < 2; ++n) {
                const f32x4 gv = *(const f32x4*)(gam + col0 + bj * HALF + n * 16), bv = *(const f32x4*)(bet + col0 + bj * HALF + n * 16);
#pragma unroll
                for (int ai = 0; ai < 2; ++ai)
#pragma unroll
                    for (int m = 0; m < 4; ++m) { const int r = ai * HALF + wr * 64 + m * 16 + fr; const f32x2v sr = St[r]; const size_t off = (size_t)(u.pm * BM + r) * 1024 + col0 + bj * HALF + n * 16;
                        const f32x4 o = (acc[ai][bj][m][n] - sr.x) * sr.y * gv + bv;
                        *(f32x4*)(out + off) = o;
                        uint2 w; w.x = cvtpk_s(o[0], o[1]); w.y = cvtpk_s(o[2], o[3]); *(uint2*)(xb + off) = w; }
            }
    }
};

struct EpiGluNorm {
    static constexpr bool PERM = true, AFTER_DRAIN = false;
    bf16_t* Yo; const bf16_t* ybp; const bf16_t* proj; const float* bias; const float* gain; PG8_LAS unsigned char* tbl;
    __device__ __forceinline__ void operator()(f32x4 (&acc)[2][2][4][2], const Unit& u, int wr, int wc, int fr_, int fq_) const {
        const int lane = lane_id_opaque(), fr = lane & 15, fq = lane >> 4; (void)fr_; (void)fq_;
        bf16_t* Yo_ = launder_g(Yo); const bf16_t* ybp_ = launder_g(ybp); const bf16_t* proj_ = launder_g(proj); const float* bias_ = launder_g(bias); const float* gain_ = launder_g(gain);
        const int row0 = u.pm * BM + wr * 64 + fr, cw = wc * 32 + 8 * fq;
        PG8_LAS float* Pt = (PG8_LAS float*)tbl;
#pragma unroll
        for (int bj = 0; bj < 2; ++bj) {
            const int c = cw + bj * HALF;
            const f32x4 b0 = *(const f32x4*)(bias_ + c), b1 = *(const f32x4*)(bias_ + c + 4);
#pragma unroll
            for (int ai = 0; ai < 2; ++ai)
#pragma unroll
                for (int m = 0; m < 4; ++m) {
                    const size_t r = (size_t)(row0 + ai * HALF + m * 16);
                    const u32x4 av = *(const u32x4*)(ybp_ + r * 256 + c);
                    f32x4 v0 = acc[ai][bj][m][0] + b0, v1 = acc[ai][bj][m][1] + b1; float ss = 0.f;
#pragma unroll
                    for (int j = 0; j < 4; ++j) { const float alo = __uint_as_float(av[j] << 16), ahi = __uint_as_float(av[j] & 0xffff0000u);
                        if (j < 2) { const float s0 = alo / (1.0f + __expf(-v0[2 * j])), s1 = ahi / (1.0f + __expf(-v0[2 * j + 1])); v0[2 * j] = s0; v0[2 * j + 1] = s1; ss += s0 * s0 + s1 * s1; }
                        else { const float s0 = alo / (1.0f + __expf(-v1[2 * j - 4])), s1 = ahi / (1.0f + __expf(-v1[2 * j - 3])); v1[2 * j - 4] = s0; v1[2 * j - 3] = s1; ss += s0 * s0 + s1 * s1; } }
                    acc[ai][bj][m][0] = v0; acc[ai][bj][m][1] = v1;
                    ss += __shfl_xor(ss, 16); ss += __shfl_xor(ss, 32);
                    if (fq == 0) Pt[((ai * HALF + wr * 64 + m * 16 + fr) * 2 + bj) * 4 + wc] = ss;
                }
        }
        asm volatile("s_waitcnt lgkmcnt(0)" ::: "memory"); __builtin_amdgcn_s_barrier(); asm volatile("" ::: "memory");
#pragma unroll
        for (int bj = 0; bj < 2; ++bj) {
            const int c = cw + bj * HALF;
            const f32x4 g0 = *(const f32x4*)(gain_ + 256 + c), g1 = *(const f32x4*)(gain_ + 256 + c + 4);
#pragma unroll
            for (int ai = 0; ai < 2; ++ai)
#pragma unroll
                for (int m = 0; m < 4; ++m) {
                    const int rl = ai * HALF + wr * 64 + m * 16 + fr; const size_t r = (size_t)(u.pm * BM + rl);
                    const float rs = rsqrtf((Pt[(rl * 2 + bj) * 4 + (wc & 2)] + Pt[(rl * 2 + bj) * 4 + (wc | 1)]) * (1.0f / 64.0f) + 1e-6f);
                    const u32x4 gv = *(const u32x4*)(proj_ + r * 3584 + 2560 + 256 + c);
                    const f32x4 v0 = acc[ai][bj][m][0] * rs * g0, v1 = acc[ai][bj][m][1] * rs * g1;
                    float o[8];
#pragma unroll
                    for (int j = 0; j < 4; ++j) { const float tl = __uint_as_float(gv[j] << 16), th = __uint_as_float(gv[j] & 0xffff0000u);
                        const float x0 = (j < 2) ? v0[2 * j] : v1[2 * j - 4], x1 = (j < 2) ? v0[2 * j + 1] : v1[2 * j - 3];
                        o[2 * j] = x0 * (tl / (1.0f + __expf(-tl))); o[2 * j + 1] = x1 * (th / (1.0f + __expf(-th))); }
                    u32x4 w; w.x = cvtpk_s(o[0], o[1]); w.y = cvtpk_s(o[2], o[3]); w.z = cvtpk_s(o[4], o[5]); w.w = cvtpk_s(o[6], o[7]);
                    *(u32x4*)(Yo_ + r * 1024 + 256 + c) = w;
                }
        }
        asm volatile("s_waitcnt lgkmcnt(0)" ::: "memory"); __builtin_amdgcn_s_barrier(); asm volatile("" ::: "memory");
    }
};

template <class Epi, class Sched, bool ALIGN_EPI = false, bool SP2 = false>
__device__ __forceinline__ void gemm_phase(PG8_LAS unsigned char* lds, const Gemm g, const Sched& S, const Epi& E, const int tid_in  ) {
    const int tid = tid_in, wid = __builtin_amdgcn_readfirstlane(tid >> 6), lane = tid & 63, wr = wid >> 2, wc = wid & 3, fr = lane & 15, fq = lane >> 4;
    const int K = g.K, nt = K / BK;
    unsigned voffA[2], voffB[2];
#pragma unroll
    for (int i = 0; i < 2; ++i) { int R, C; stage_rc(tid * 16 + i * 8192, R, C); const int Rb = Epi::PERM ? ((R & ~31) + perm32(R & 31)) : R;
        voffA[i] = (unsigned)(R * K + C) * 2u; voffB[i] = (unsigned)(Rb * K + C) * 2u; }
    const size_t kstep = (size_t)(BK * 2);
    const size_t hstep = (size_t)HALF * K * 2;
    const size_t tstep = 2 * hstep;
    const unsigned ldsw = (unsigned)wid * 1024u;
    const int aoff = lds_byte(wr * 64 + fr, fq * 8), boff = lds_byte(wc * 32 + fr, fq * 8);
#define PG8_SA(b, h) (((b) * 2 + (h)) * HTB)
#define PG8_SB(b, h) ((4 + (b) * 2 + (h)) * HTB)
#define PG8_STAGE(bufoff, gbase, voff) do { _Pragma("unroll") for (int _i = 0; _i < 2; ++_i) \
        __builtin_amdgcn_global_load_lds((const unsigned*)((const char*)(gbase) + (voff)[_i]), (PG8_LAS unsigned*)(lds + (bufoff) + ldsw + _i * 8192), 16, 0, 0); } while (0)
#define PG8_LDA(dst, b, h) do { _Pragma("unroll") for (int m = 0; m < 4; ++m) _Pragma("unroll") for (int k = 0; k < 2; ++k) dst[m][k] = *(const PG8_LAS bf16x8*)(lds + PG8_SA(b, h) + aoff + m * 2048 + k * 1024); } while (0)
#define PG8_LDB(dst, b, h) do { _Pragma("unroll") for (int n = 0; n < 2; ++n) _Pragma("unroll") for (int k = 0; k < 2; ++k) dst[n][k] = *(const PG8_LAS bf16x8*)(lds + PG8_SB(b, h) + boff + n * 2048 + k * 1024); } while (0)
#define PG8_MMA(ai, bj, At, Bt) do { __builtin_amdgcn_s_setprio(1); _Pragma("unroll") for (int m = 0; m < 4; ++m) _Pragma("unroll") for (int n = 0; n < 2; ++n) _Pragma("unroll") for (int k = 0; k < 2; ++k) \
        acc[ai][bj][m][n] = __builtin_amdgcn_mfma_f32_16x16x32_bf16(Bt[n][k], At[m][k], acc[ai][bj][m][n], 0, 0, 0); __builtin_amdgcn_s_setprio(0); } while (0)
#define PG8_WAIT_V(n) asm volatile("s_waitcnt vmcnt(" #n ")" ::: "memory")
#define PG8_WAIT_L(n) asm volatile("s_waitcnt lgkmcnt(" #n ")" ::: "memory")
#define PG8_BAR __builtin_amdgcn_s_barrier()
#define PG8_SCHED __builtin_amdgcn_sched_barrier(0)
    Unit cur, nxt; int ui = 0;
    if (!S.next(0, cur)) return;
    f32x4 acc[2][2][4][2];
#pragma unroll
    for (int a = 0; a < 2; ++a)
#pragma unroll
        for (int b = 0; b < 2; ++b)
#pragma unroll
            for (int m = 0; m < 4; ++m)
#pragma unroll
                for (int n = 0; n < 2; ++n) acc[a][b][m][n] = (f32x4){0.f, 0.f, 0.f, 0.f};
    bf16x8 At[4][2], B0[2][2], B1[2][2];
    const char* cA = (const char*)g.A + (size_t)cur.pm * tstep; const char* cB = (const char*)g.Bt + (size_t)cur.pn * tstep;
    S.a_ready(cur);
    if constexpr (SP2) {
        PG8_STAGE(PG8_SB(0, 0), cB, voffB); PG8_STAGE(PG8_SB(0, 1), cB + hstep, voffB); PG8_STAGE(PG8_SA(0, 0), cA, voffA); PG8_STAGE(PG8_SA(0, 1), cA + hstep, voffA);
        if (wr == 1) PG8_BAR;
        PG8_WAIT_V(2); PG8_BAR;
        PG8_STAGE(PG8_SB(1, 0), cB + kstep, voffB); PG8_STAGE(PG8_SA(1, 0), cA + kstep, voffA); PG8_STAGE(PG8_SB(1, 1), cB + hstep + kstep, voffB);
        PG8_WAIT_V(6); PG8_BAR;
    } else {
        PG8_STAGE(PG8_SB(0, 0), cB, voffB); PG8_STAGE(PG8_SA(0, 0), cA, voffA); PG8_STAGE(PG8_SB(0, 1), cB + hstep, voffB); PG8_STAGE(PG8_SA(0, 1), cA + hstep, voffA);
        if (wr == 1) PG8_BAR;
        PG8_WAIT_V(4); PG8_BAR;
        PG8_STAGE(PG8_SB(1, 0), cB + kstep, voffB); PG8_STAGE(PG8_SA(1, 0), cA + kstep, voffA); PG8_STAGE(PG8_SB(1, 1), cB + hstep + kstep, voffB);
        PG8_WAIT_V(6); PG8_BAR;
    }
    for (;;) {
        const bool has_next = S.next(ui + 1, nxt);
        const char* nA = has_next ? (const char*)g.A + (size_t)nxt.pm * tstep : cA; const char* nB = has_next ? (const char*)g.Bt + (size_t)nxt.pn * tstep : cB;
        for (int t = 0; t < nt; t += 2) {
            const bool last = (t == nt - 2);
            const char* a1 = cA + (size_t)(t + 1) * kstep;
            const char* a2 = last ? nA : cA + (size_t)(t + 2) * kstep; const char* b2 = last ? nB : cB + (size_t)(t + 2) * kstep;
            const char* a3 = a2 + kstep; const char* b3 = b2 + kstep;
            if (last && has_next) S.a_ready(nxt);
            if constexpr (SP2) {
            PG8_LDB(B0, 0, 0); PG8_LDB(B1, 0, 1); PG8_SCHED; PG8_LDA(At, 0, 0); PG8_STAGE(PG8_SA(1, 1), a1 + hstep, voffA);
            PG8_WAIT_V(8); PG8_WAIT_L(0); PG8_BAR; PG8_MMA(0, 0, At, B0); PG8_MMA(0, 1, At, B1); PG8_BAR; PG8_SCHED;
            PG8_LDA(At, 0, 1); PG8_STAGE(PG8_SB(0, 0), b2, voffB); PG8_STAGE(PG8_SB(0, 1), b2 + hstep, voffB); PG8_STAGE(PG8_SA(0, 0), a2, voffA);
            PG8_WAIT_V(8); PG8_WAIT_L(0); PG8_BAR; PG8_MMA(1, 0, At, B0); PG8_MMA(1, 1, At, B1); PG8_BAR; PG8_SCHED;
            PG8_LDB(B0, 1, 0); PG8_LDB(B1, 1, 1); PG8_SCHED; PG8_LDA(At, 1, 0); PG8_STAGE(PG8_SA(0, 1), a2 + hstep, voffA);
            PG8_WAIT_V(8); PG8_WAIT_L(0); PG8_BAR; PG8_MMA(0, 0, At, B0); PG8_MMA(0, 1, At, B1); PG8_BAR; PG8_SCHED;
            PG8_LDA(At, 1, 1); PG8_STAGE(PG8_SB(1, 0), b3, voffB); PG8_STAGE(PG8_SB(1, 1), b3 + hstep, voffB); PG8_STAGE(PG8_SA(1, 0), a3, voffA);
            PG8_WAIT_V(8); PG8_WAIT_L(0); PG8_BAR; PG8_MMA(1, 0, At, B0); PG8_MMA(1, 1, At, B1); PG8_BAR; PG8_SCHED;
            } else {
            PG8_LDB(B0, 0, 0); PG8_SCHED; PG8_LDA(At, 0, 0); PG8_STAGE(PG8_SA(1, 1), a1 + hstep, voffA);
            PG8_WAIT_L(8); PG8_BAR; PG8_WAIT_L(0); PG8_MMA(0, 0, At, B0); PG8_BAR; PG8_SCHED;
            PG8_LDB(B1, 0, 1); PG8_STAGE(PG8_SB(0, 0), b2, voffB);
            PG8_BAR; PG8_WAIT_L(0); PG8_MMA(0, 1, At, B1); PG8_BAR;
            PG8_LDA(At, 0, 1); PG8_STAGE(PG8_SA(0, 0), a2, voffA);
            PG8_BAR; PG8_WAIT_L(0); PG8_MMA(1, 0, At, B0); PG8_BAR; PG8_SCHED;
            PG8_STAGE(PG8_SB(0, 1), b2 + hstep, voffB);
            PG8_WAIT_V(6); PG8_BAR; PG8_MMA(1, 1, At, B1); PG8_BAR;
            PG8_LDB(B0, 1, 0); PG8_SCHED; PG8_LDA(At, 1, 0); PG8_STAGE(PG8_SA(0, 1), a2 + hstep, voffA);
            PG8_WAIT_L(8); PG8_BAR; PG8_WAIT_L(0); PG8_MMA(0, 0, At, B0); PG8_BAR; PG8_SCHED;
            PG8_LDB(B1, 1, 1); PG8_STAGE(PG8_SB(1, 0), b3, voffB);
            PG8_BAR; PG8_WAIT_L(0); PG8_MMA(0, 1, At, B1); PG8_BAR;
            PG8_LDA(At, 1, 1); PG8_STAGE(PG8_SA(1, 0), a3, voffA);
            PG8_BAR; PG8_WAIT_L(0); PG8_MMA(1, 0, At, B0); PG8_BAR; PG8_SCHED;
            PG8_STAGE(PG8_SB(1, 1), b3 + hstep, voffB);
            PG8_WAIT_V(6); PG8_BAR; PG8_MMA(1, 1, At, B1); PG8_BAR;
            }
        }
        if constexpr (ALIGN_EPI) { if (wr == 0) PG8_BAR; }
        if constexpr (!Epi::AFTER_DRAIN) { E(acc, cur, wr, wc, fr, fq); S.done(cur); }
        if (!has_next) break;
#pragma unroll
        for (int a = 0; a < 2; ++a)
#pragma unroll
            for (int b = 0; b < 2; ++b)
#pragma unroll
                for (int m = 0; m < 4; ++m)
#pragma unroll
                    for (int n = 0; n < 2; ++n) acc[a][b][m][n] = (f32x4){0.f, 0.f, 0.f, 0.f};
        cur = nxt; cA = nA; cB = nB; ++ui;
        if constexpr (ALIGN_EPI) { if (wr == 1) PG8_BAR; }
    }
    PG8_WAIT_V(0);
    if constexpr (!ALIGN_EPI) { if (wr == 0) PG8_BAR; }
    PG8_BAR;
    if constexpr (Epi::AFTER_DRAIN) { E.fused(acc, cur, wr, wc, fr, fq, lds, wid, lane); S.done(cur); }
#undef PG8_SA
#undef PG8_SB
#undef PG8_STAGE
#undef PG8_LDA
#undef PG8_LDB
#undef PG8_MMA
#undef PG8_WAIT_V
#undef PG8_WAIT_L
#undef PG8_BAR
#undef PG8_SCHED
}
}
#define XB_TMO      128
#define XB_XCNT(j)  (256  + 64 * (j))
#define XB_XSUB(j)  (1280 + 64 * (j))
#define XB_XGEN(j)  (2304 + 64 * (j))
#define XB_TOP      3328
#define XB_TOPGEN   3392
#define XCD_BAR_WORDS 3456
#define XB_SPIN_CAP (1u << 18)

__device__ __forceinline__ unsigned xb_ld(unsigned* p)              { return __hip_atomic_load((__attribute__((address_space(1))) unsigned*)p, __ATOMIC_RELAXED, __HIP_MEMORY_SCOPE_AGENT); }
__device__ __forceinline__ unsigned xb_add(unsigned* p, unsigned v) { return __hip_atomic_fetch_add((__attribute__((address_space(1))) unsigned*)p, v, __ATOMIC_RELAXED, __HIP_MEMORY_SCOPE_AGENT); }
__device__ __forceinline__ unsigned xb_xcc_id() { return (unsigned)__builtin_amdgcn_s_getreg((3 << 11) | 20) & 0xFu; }
#define XB_SPIN(cond, bar) do { unsigned _sp = 0; while (cond) { __builtin_amdgcn_s_sleep(1); \
    if ((++_sp & 255u) == 0u) { if (xb_ld(&(bar)[XB_TMO])) break; if (_sp > XB_SPIN_CAP) { atomicAdd(&(bar)[XB_TMO], 1u); break; } } } } while (0)

struct XcdBarrier {
    unsigned* bar; unsigned x;
    volatile LAS unsigned* st;
};

__device__ __forceinline__ XcdBarrier xcd_barrier_post(unsigned* bar, volatile LAS unsigned* st) {
    XcdBarrier b; b.bar = bar; b.x = xb_xcc_id(); b.st = st;
    if (threadIdx.x == 0) (void)xb_add(&bar[XB_XCNT(b.x)], 1u);
    return b;
}
__device__ __forceinline__ void xcd_barrier_complete(unsigned* bar, unsigned x, unsigned& nloc, unsigned& nx) {
    const unsigned G = gridDim.x * gridDim.y * gridDim.z;
    unsigned sum, cnt, mine, sp = 0u;
    for (;;) {
        sum = 0u; cnt = 0u; mine = 0u;
#pragma unroll
        for (unsigned j = 0; j < 16; ++j) { const unsigned c = xb_ld(&bar[XB_XCNT(j)]); sum += c; cnt += (c > 0u) ? 1u : 0u; mine = (j == x) ? c : mine; }
        if (sum == G) break;
        __builtin_amdgcn_s_sleep(1);
        if ((++sp & 255u) == 0u) { if (xb_ld(&bar[XB_TMO])) break; if (sp > XB_SPIN_CAP) { atomicAdd(&bar[XB_TMO], 1u); break; } }
    }
    nloc = mine > 0u ? mine : 1u; nx = cnt > 0u ? cnt : 1u;
}

__device__ __forceinline__ void xcd_barrier(const XcdBarrier& b) {
    asm volatile("s_waitcnt vmcnt(0)" ::: "memory");
    __syncthreads();
    if (threadIdx.x == 0) {
        unsigned* bar = b.bar;
        __builtin_amdgcn_s_waitcnt(0);
        unsigned nloc = b.st[0], nx = b.st[1];
        if (nloc == 0u) { xcd_barrier_complete(bar, b.x, nloc, nx); b.st[0] = nloc; b.st[1] = nx; }
        const unsigned old = xb_add(&bar[XB_XSUB(b.x)], 1u);
        const unsigned gen = old / nloc;
        if (old + 1u == (gen + 1u) * nloc) {
            __builtin_amdgcn_fence(__ATOMIC_RELEASE, "agent");
            asm volatile("s_waitcnt vmcnt(0)" ::: "memory");
            const unsigned og = xb_add(&bar[XB_TOP], 1u);
            const unsigned tg = og / nx;
            if (og + 1u == (tg + 1u) * nx) xb_add(&bar[XB_TOPGEN], 1u);
            else XB_SPIN(xb_ld(&bar[XB_TOPGEN]) == tg, bar);
            __builtin_amdgcn_fence(__ATOMIC_ACQUIRE, "agent");
            xb_add(&bar[XB_XGEN(b.x)], 1u);
            asm volatile("s_waitcnt vmcnt(0)" ::: "memory");
        } else {
            XB_SPIN(xb_ld(&bar[XB_XGEN(b.x)]) == gen, bar);
            __builtin_amdgcn_fence(__ATOMIC_ACQUIRE, "agent");
            asm volatile("s_waitcnt vmcnt(0)" ::: "memory");
        }
    }
    __syncthreads();
}
namespace fa {
typedef short bf16x8 __attribute__((ext_vector_type(8)));
typedef float f32x16 __attribute__((ext_vector_type(16)));
typedef short v4i16_t __attribute__((ext_vector_type(4)));
constexpr int KT_OFF = 0, VT_OFF = 8192, LUT_OFF = 16384, OST_OFF = 24576, FA_LDS = OST_OFF + 8 * 4096;
__device__ __forceinline__ int crow(int r, int hi) { return (r & 3) + 8 * (r >> 2) + 4 * hi; }
__device__ __forceinline__ unsigned cvtpk(float lo, float hi) { return cvtpk_s(lo, hi); }
template <int B> __device__ __forceinline__ bf16x8 pack8(const f32x16& p) {
    u32x4 w; w.x = cvtpk(p[B], p[B + 1]); w.y = cvtpk(p[B + 2], p[B + 3]); w.z = cvtpk(p[B + 4], p[B + 5]); w.w = cvtpk(p[B + 6], p[B + 7]);
    return __builtin_bit_cast(bf16x8, w);
}
__device__ __forceinline__ v4i16_t trd(LAS const unsigned char* p) { return __builtin_amdgcn_ds_read_tr16_b64_v4i16((LAS v4i16_t*)p); }
__device__ __forceinline__ void stage_tile(LAS unsigned char* lds, int tid, const bf16_t* krow, const bf16_t* vrow) {
    const int row = tid >> 3, ch = tid & 7;
    u32x4 kv = {0u, 0u, 0u, 0u}, vv = {0u, 0u, 0u, 0u};
    if (krow) { kv = *(const u32x4*)(krow + ch * 8); vv = *(const u32x4*)(vrow + ch * 8); }
    *(LAS u32x4*)(lds + KT_OFF + row * 128 + ((ch ^ (row & 7)) * 16)) = kv;
    *(LAS u32x4*)(lds + VT_OFF + row * 128 + ch * 16) = vv;
}
template <class Fn> __device__ __forceinline__ void tile_step(LAS const unsigned char* lds, const bf16x8 (&qf)[4], f32x16& o0, f32x16& o1, float& m, float& l, int lane, const Fn& fn) {
    const int r32 = lane & 31, hi = lane >> 5;
    f32x16 p0, p1;
#pragma unroll
    for (int r = 0; r < 16; ++r) { p0[r] = 0.f; p1[r] = 0.f; }
#pragma unroll
    for (int s = 0; s < 4; ++s) {
        const int ch = ((2 * s + hi) ^ (r32 & 7)) * 16;
        const bf16x8 k0 = *(const LAS bf16x8*)(lds + KT_OFF + r32 * 128 + ch);
        const bf16x8 k1 = *(const LAS bf16x8*)(lds + KT_OFF + (32 + r32) * 128 + ch);
        p0 = __builtin_amdgcn_mfma_f32_32x32x16_bf16(k0, qf[s], p0, 0, 0, 0);
        p1 = __builtin_amdgcn_mfma_f32_32x32x16_bf16(k1, qf[s], p1, 0, 0, 0);
    }
    float mx = NEGF;
#pragma unroll
    for (int r = 0; r < 16; ++r) { p0[r] = fn(crow(r, hi), p0[r]); p1[r] = fn(32 + crow(r, hi), p1[r]); mx = fmaxf(mx, fmaxf(p0[r], p1[r])); }
    mx = fmaxf(mx, __shfl_xor(mx, 32));
    const float mn = fmaxf(m, mx), alpha = __expf(m - mn);
    m = mn;
    float ps = 0.f;
#pragma unroll
    for (int r = 0; r < 16; ++r) { p0[r] = __expf(p0[r] - mn); p1[r] = __expf(p1[r] - mn); ps += p0[r] + p1[r]; }
    l = l * alpha + ps;
#pragma unroll
    for (int r = 0; r < 16; ++r) { o0[r] *= alpha; o1[r] *= alpha; }
    const int q4 = (lane & 15) >> 2, p4 = lane & 3, dgrp = (lane >> 4) & 1;
    const int vb = VT_OFF + (4 * hi + q4) * 128 + (16 * dgrp + 4 * p4) * 2;
#define FA_PV(P, KH, S2) do { const bf16x8 pb = pack8<8 * (S2)>(P); \
        _Pragma("unroll") for (int blk = 0; blk < 2; ++blk) { const int a = vb + (32 * (KH) + 16 * (S2)) * 128 + blk * 64; \
            const v4i16_t lo = trd(lds + a), hh = trd(lds + a + 8 * 128); \
            const bf16x8 va = {lo[0], lo[1], lo[2], lo[3], hh[0], hh[1], hh[2], hh[3]}; \
            if (blk == 0) o0 = __builtin_amdgcn_mfma_f32_32x32x16_bf16(va, pb, o0, 0, 0, 0); else o1 = __builtin_amdgcn_mfma_f32_32x32x16_bf16(va, pb, o1, 0, 0, 0); } } while (0)
    FA_PV(p0, 0, 0); FA_PV(p0, 0, 1); FA_PV(p1, 1, 0); FA_PV(p1, 1, 1);
#undef FA_PV
}
template <class RowFn> __device__ __forceinline__ float store_o(LAS unsigned char* lds, int wave, int lane, const f32x16& o0, const f32x16& o1, float l, const RowFn& orow) {
    const int r32 = lane & 31, hi = lane >> 5;
    l += __shfl_xor(l, 32);
    const float inv = 1.0f / l;
    LAS bf16_t* stg = (LAS bf16_t*)(lds + OST_OFF + wave * 4096);
#pragma unroll
    for (int r = 0; r < 16; ++r) { const int d = crow(r, hi); stg[r32 * 64 + d] = f2bf(o0[r] * inv); stg[r32 * 64 + 32 + d] = f2bf(o1[r] * inv); }
    asm volatile("s_waitcnt lgkmcnt(0)" ::: "memory");
#pragma unroll
    for (int i = 0; i < 4; ++i) { const int row = i * 8 + (lane >> 3), ch = lane & 7; const u32x4 v = *(const LAS u32x4*)(stg + row * 64 + ch * 8); *(u32x4*)(orow(row) + ch * 8) = v; }
    asm volatile("s_waitcnt lgkmcnt(0)" ::: "memory");
    return l;
}
struct DilFn {
    int qrel; LAS const float* lut;
    int ksub0;
    __device__ __forceinline__ float operator()(int key, float s) const {
        const int d = qrel - key; const bool ok = (d >= 0) && (d <= 128) && (ksub0 + key >= 0);
        const float b = lut[min(max(d, 0), 128)];
        return ok ? fmaf(s, 0.125f, b) : NEGF;
    }
};
struct MobaFn {
    int qrel; LAS const float* lut; bool allowed; bool causal;
    __device__ __forceinline__ float operator()(int key, float s) const {
        const int d = qrel - key; const bool ok = causal ? (d >= 0) : allowed;
        const float b = lut[min(max(d, 0), 1535)];
        return ok ? fmaf(s, 0.125f, b) : NEGF;
    }
};
__device__ __forceinline__ void dilated_unit(LAS unsigned char* lds, int tid, int pi, int bh, int u, const bf16_t* __restrict__ proj, const float* __restrict__ rel_bias, bf16_t* __restrict__ PO, float* __restrict__ PL) {
    const int lane = tid & 63, wave = __builtin_amdgcn_readfirstlane(tid >> 6), r32 = lane & 31, hi = lane >> 5;
    const int dil = (pi == 0) ? 1 : (pi == 1) ? 4 : 16, b = bh >> 2, h = bh & 3;
    const int r = u % dil, sb = u / dil;
    __syncthreads();
    LAS float* lut = (LAS float*)(lds + LUT_OFF);
    if (tid <= 128) lut[tid] = rel_bias[t5_bucket(tid * dil) * 8 + 4 + h];
    const int qsub = 256 * sb + 32 * wave + r32;
    const size_t qrow = (size_t)b * SEQ + (size_t)qsub * dil + r;
    bf16x8 qf[4];
#pragma unroll
    for (int s = 0; s < 4; ++s) qf[s] = *(const bf16x8*)(proj + qrow * NIN + COL_QD + h * 64 + 16 * s + 8 * hi);
    f32x16 o0, o1;
#pragma unroll
    for (int i = 0; i < 16; ++i) { o0[i] = 0.f; o1[i] = 0.f; }
    float m = NEGF, l = 0.f;
    for (int j = (sb == 0 ? 2 : 0); j < 6; ++j) {
        const int ksub0 = 256 * sb - 128 + 64 * j;
        { const int ksub = ksub0 + (tid >> 3);
          const bf16_t* base = (ksub >= 0) ? proj + ((size_t)b * SEQ + (size_t)ksub * dil + r) * NIN + h * 64 : nullptr;
          __syncthreads();
          stage_tile(lds, tid, base ? base + COL_KD : nullptr, base ? base + COL_VD : nullptr); }
        __syncthreads();
        if (64 * j + 63 >= 32 * wave && 64 * j <= 32 * wave + 159) {
            DilFn fn{qsub - ksub0, lut, ksub0};
            tile_step(lds, qf, o0, o1, m, l, lane, fn);
        }
    }
    const size_t rbase = (size_t)b * SEQ + (size_t)(256 * sb + 32 * wave) * dil + r;
    bf16_t* po = PO + (size_t)pi * M * 256 + h * 64;
    const float lt = store_o(lds, wave, lane, o0, o1, l, [&](int q) { return po + (rbase + (size_t)q * dil) * 256; });
    if (hi == 0) PL[((size_t)pi * M + qrow) * 4 + h] = m + __logf(lt);
}
__device__ __forceinline__ void moba_unit(LAS unsigned char* lds, int tid, int bh, int own, const bf16_t* __restrict__ proj, const float* __restrict__ kmean, const float* __restrict__ rel_bias, bf16_t* __restrict__ Y) {
    const int lane = tid & 63, wave = __builtin_amdgcn_readfirstlane(tid >> 6), r32 = lane & 31, hi = lane >> 5;
    const int b = bh >> 2, h = bh & 3;
    __syncthreads();
    LAS float* lut = (LAS float*)(lds + LUT_OFF);
    for (int d = tid; d < 1536; d += 512) lut[d] = rel_bias[t5_bucket(d) * 8 + h];
    const int qpos = 256 * own + 32 * wave + r32;
    const size_t qrow = (size_t)b * SEQ + qpos;
    bf16x8 qf[4];
#pragma unroll
    for (int s = 0; s < 4; ++s) qf[s] = *(const bf16x8*)(proj + qrow * NIN + COL_QA + h * 64 + 16 * s + 8 * hi);
    unsigned selbits = 0u;
    {
        f32x16 g;
#pragma unroll
        for (int i = 0; i < 16; ++i) g[i] = 0.f;
        const float* km = kmean + ((size_t)bh * 32 + r32) * 64;
#pragma unroll
        for (int s = 0; s < 4; ++s) {
            float kv[8];
            *(float4*)&kv[0] = *(const float4*)(km + 16 * s + 8 * hi); *(float4*)&kv[4] = *(const float4*)(km + 16 * s + 8 * hi + 4);
            u32x4 wh, wl;
#pragma unroll
            for (int j = 0; j < 4; ++j) {
                const bf16_t h0 = f2bf(kv[2 * j]), h1 = f2bf(kv[2 * j + 1]);
                const bf16_t l0 = f2bf(kv[2 * j] - bf2f(h0)), l1 = f2bf(kv[2 * j + 1] - bf2f(h1));
                wh[j] = (unsigned)h0 | ((unsigned)h1 << 16); wl[j] = (unsigned)l0 | ((unsigned)l1 << 16);
            }
            g = __builtin_amdgcn_mfma_f32_32x32x16_bf16(__builtin_bit_cast(bf16x8, wh), qf[s], g, 0, 0, 0);
            g = __builtin_amdgcn_mfma_f32_32x32x16_bf16(__builtin_bit_cast(bf16x8, wl), qf[s], g, 0, 0, 0);
        }
#pragma unroll
        for (int i = 0; i < 16; ++i) if (crow(i, hi) >= own) g[i] = -INFINITY;
#pragma unroll
        for (int t = 0; t < 3; ++t) {
            float lm = -INFINITY;
#pragma unroll
            for (int i = 0; i < 16; ++i) lm = fmaxf(lm, g[i]);
            const float gm = fmaxf(lm, __shfl_xor(lm, 32));
            int cand = 99;
#pragma unroll
            for (int i = 15; i >= 0; --i) if (g[i] == gm) cand = crow(i, hi);
            cand = min(cand, __shfl_xor(cand, 32));
            if (gm > -INFINITY) {
                selbits |= 1u << cand;
#pragma unroll
                for (int i = 0; i < 16; ++i) if (crow(i, hi) == cand) g[i] = -INFINITY;
            }
        }
    }
    f32x16 o0, o1;
#pragma unroll
    for (int i = 0; i < 16; ++i) { o0[i] = 0.f; o1[i] = 0.f; }
    float m = NEGF, l = 0.f;
    for (int n = 0; n <= own; ++n) {
        const bool allowed = (selbits >> n) & 1u;
        const bool need = (n == own) || (__ballot(allowed) != 0ull);
        for (int kt = 0; kt < 4; ++kt) {
            const int kpos0 = 256 * n + 64 * kt;
            { const bf16_t* base = proj + ((size_t)b * SEQ + kpos0 + (tid >> 3)) * NIN + h * 64;
              __syncthreads();
              stage_tile(lds, tid, base + COL_KA, base + COL_VA); }
            __syncthreads();
            if (need && (n < own || 64 * kt <= 32 * wave + 31)) {
                MobaFn fn{qpos - kpos0, lut, allowed, n == own};
                tile_step(lds, qf, o0, o1, m, l, lane, fn);
            }
        }
    }
    bf16_t* yo = Y + ((size_t)b * SEQ + 256 * own + 32 * wave) * DM + h * 64;
    store_o(lds, wave, lane, o0, o1, l, [&](int q) { return yo + (size_t)q * DM; });
}
}

namespace fa2 {
using fa::bf16x8; using fa::f32x16; using fa::v4i16_t; using fa::crow; using fa::pack8; using fa::trd;
constexpr float C2LOG = 0.125f * 1.4426950408889634f;
template <class Fn> __device__ __forceinline__ void step64(LAS const unsigned char* lds, int koff, int voff, const bf16x8 (&qf)[4], f32x16& o0, f32x16& o1, float& m, float& l, int lane, const Fn& fn) {
    const int r32 = lane & 31, hi = lane >> 5;
    f32x16 p0, p1;
    const f32x16 zero16 = {0.f, 0.f, 0.f, 0.f, 0.f, 0.f, 0.f, 0.f, 0.f, 0.f, 0.f, 0.f, 0.f, 0.f, 0.f, 0.f};
    LAS const unsigned char* kp = lds + koff + r32 * 128;
#pragma unroll
    for (int s = 0; s < 4; ++s) {
        const int ch = ((2 * s + hi) ^ (r32 & 7)) * 16;
        const bf16x8 k0 = *(const LAS bf16x8*)(kp + ch);
        const bf16x8 k1 = *(const LAS bf16x8*)(kp + ch + 32 * 128);
        p0 = __builtin_amdgcn_mfma_f32_32x32x16_bf16(k0, qf[s], s == 0 ? zero16 : p0, 0, 0, 0);
        p1 = __builtin_amdgcn_mfma_f32_32x32x16_bf16(k1, qf[s], s == 0 ? zero16 : p1, 0, 0, 0);
    }
    float mx = NEGF;
#pragma unroll
    for (int r = 0; r < 16; ++r) { const int kc = (r & 3) + 8 * (r >> 2); p0[r] = fn(kc, p0[r]); p1[r] = fn(32 + kc, p1[r]); mx = fmaxf(mx, fmaxf(p0[r], p1[r])); }
    mx = fmaxf(mx, __shfl_xor(mx, 32));
    const float mn = fmaxf(m, mx), alpha = __builtin_amdgcn_exp2f(m - mn);
    m = mn;
    float ps = 0.f;
#pragma unroll
    for (int r = 0; r < 16; ++r) { p0[r] = __builtin_amdgcn_exp2f(p0[r] - mn); p1[r] = __builtin_amdgcn_exp2f(p1[r] - mn); ps += p0[r] + p1[r]; }
    l = l * alpha + ps;
    if (!__all(alpha == 1.0f)) {
#pragma unroll
        for (int r = 0; r < 16; ++r) { o0[r] *= alpha; o1[r] *= alpha; }
    }
    const int q4 = (lane & 15) >> 2, p4 = lane & 3, dgrp = (lane >> 4) & 1;
    LAS const unsigned char* vp = lds + voff + (4 * hi + q4) * 128 + (16 * dgrp + 4 * p4) * 2;
#define FA_PV(P, KH, S2) do { const bf16x8 pb = pack8<8 * (S2)>(P); \
        _Pragma("unroll") for (int blk = 0; blk < 2; ++blk) { \
            const v4i16_t lo = trd(vp + ((32 * (KH) + 16 * (S2)) * 128 + blk * 64)), hh = trd(vp + ((32 * (KH) + 16 * (S2) + 8) * 128 + blk * 64)); \
            const bf16x8 va = {lo[0], lo[1], lo[2], lo[3], hh[0], hh[1], hh[2], hh[3]}; \
            if (blk == 0) o0 = __builtin_amdgcn_mfma_f32_32x32x16_bf16(va, pb, o0, 0, 0, 0); else o1 = __builtin_amdgcn_mfma_f32_32x32x16_bf16(va, pb, o1, 0, 0, 0); } } while (0)
    FA_PV(p0, 0, 0); FA_PV(p0, 0, 1); FA_PV(p1, 1, 0); FA_PV(p1, 1, 1);
#undef FA_PV
}
struct TabFn { LAS const float* base;
    __device__ __forceinline__ float operator()(int kc, float s) const { return fmaf(s, C2LOG, base[59 - kc]); } };
struct TabLoFn { LAS const float* base; int klo4;
    __device__ __forceinline__ float operator()(int kc, float s) const { return kc >= klo4 ? fmaf(s, C2LOG, base[59 - kc]) : NEGF; } };
struct ConstFn { float b2;
    __device__ __forceinline__ float operator()(int, float s) const { return fmaf(s, C2LOG, b2); } };
template <int NIT, class RowFn> __device__ __forceinline__ void stage_rows(LAS unsigned char* lds, int koff, int voff, int tid, int kcol, int vcol, const RowFn& rowfn) {
    u32x4 kv[NIT], vv[NIT];
#pragma unroll
    for (int i = 0; i < NIT; ++i) { const int e = tid + 512 * i, row = e >> 3, ch = e & 7; bool ok; const bf16_t* rp = rowfn(row, ok);
        kv[i] = *(const u32x4*)(rp + kcol + ch * 8); vv[i] = *(const u32x4*)(rp + vcol + ch * 8);
        if (!ok) { kv[i] = (u32x4){0u, 0u, 0u, 0u}; vv[i] = (u32x4){0u, 0u, 0u, 0u}; } }
    __builtin_amdgcn_sched_barrier(0);
#pragma unroll
    for (int i = 0; i < NIT; ++i) { const int e = tid + 512 * i, row = e >> 3, ch = e & 7;
        *(LAS u32x4*)(lds + koff + row * 128 + ((ch ^ (row & 7)) * 16)) = kv[i];
        *(LAS u32x4*)(lds + voff + row * 128 + ch * 16) = vv[i]; }
}
template <class DstFn> __device__ __forceinline__ void store_rows(LAS unsigned char* lds, int ostoff, int lane, const f32x16& o0, const f32x16& o1, float linv, const DstFn& dst) {
    const int r32 = lane & 31, hi = lane >> 5;
    LAS unsigned char* stg = lds + ostoff;
#pragma unroll
    for (int r = 0; r < 16; r += 2) { const int d = crow(r, hi);
        *(LAS unsigned*)(stg + r32 * 128 + ((((d >> 3)) ^ (r32 & 7)) << 4) + (d & 7) * 2) = cvtpk_s(o0[r] * linv, o0[r + 1] * linv);
        *(LAS unsigned*)(stg + r32 * 128 + ((((d >> 3) + 4) ^ (r32 & 7)) << 4) + (d & 7) * 2) = cvtpk_s(o1[r] * linv, o1[r + 1] * linv); }
    asm volatile("s_waitcnt lgkmcnt(0)" ::: "memory");
#pragma unroll
    for (int i = 0; i < 4; ++i) { const int row = i * 8 + (lane >> 3), ch = lane & 7; const u32x4 v = *(const LAS u32x4*)(stg + row * 128 + ((ch ^ (row & 7)) << 4)); bf16_t* p = dst(row); if (p) *(u32x4*)(p + ch * 8) = v; }
    asm volatile("s_waitcnt lgkmcnt(0)" ::: "memory");
}
constexpr int D_K = 0, D_V = 49152, D_LUT = 98304, D_OST = 0;
template <class Hook> __device__ __forceinline__ void dilated_unit(const Hook& after_stage, LAS unsigned char* lds, int tid, int pi, int bh, int u, const bf16_t* __restrict__ proj, const float* __restrict__ lutd, bf16_t* __restrict__ PO, float* __restrict__ PL) {
    const int lane = tid & 63, wave = __builtin_amdgcn_readfirstlane(tid >> 6), r32 = lane & 31, hi = lane >> 5;
    const int dil = (pi == 0) ? 1 : (pi == 1) ? 4 : 16, b = bh >> 2, h = bh & 3;
    const int r = u % dil, sb = u / dil;
    __syncthreads();
    LAS float* lut = (LAS float*)(lds + D_LUT);
    if (tid < 64) ((LAS u32x4*)lut)[tid] = ((const u32x4*)(lutd + (pi * 4 + h) * 256))[tid];
    const int ks0 = 256 * sb - 128;
    stage_rows<6>(lds, D_K, D_V, tid, COL_KD + h * 64, COL_VD + h * 64, [&](int row, bool& ok) -> const bf16_t* { const int ks = ks0 + row; ok = ks >= 0; return proj + ((size_t)b * SEQ + (size_t)max(ks, 0) * dil + r) * NIN; });
    after_stage();
    const int qsub = 256 * sb + 32 * wave + r32;
    const size_t qrow = (size_t)b * SEQ + (size_t)qsub * dil + r;
    bf16x8 qf[4];
#pragma unroll
    for (int s = 0; s < 4; ++s) qf[s] = *(const bf16x8*)(proj + qrow * NIN + COL_QD + h * 64 + 16 * s + 8 * hi);
    f32x16 o0, o1;
#pragma unroll
    for (int i = 0; i < 16; ++i) { o0[i] = 0.f; o1[i] = 0.f; }
    float m = NEGF, l = 0.f;
    __syncthreads();
    const int j0 = wave >> 1;
#pragma unroll 1
    for (int j = j0; j < j0 + 3; ++j) {
        if (ks0 + 64 * j + 63 < 0) continue;
        const int qrel = 32 * wave + r32 + 128 - 64 * j, klo = -(ks0 + 64 * j);
        if (klo > 0) { TabLoFn fn{lut + (qrel - 4 * hi + 64 - 59), klo - 4 * hi}; step64(lds, D_K + j * 8192, D_V + j * 8192, qf, o0, o1, m, l, lane, fn); }
        else { TabFn fn{lut + (qrel - 4 * hi + 64 - 59)}; step64(lds, D_K + j * 8192, D_V + j * 8192, qf, o0, o1, m, l, lane, fn); }
    }
    __syncthreads();
    l += __shfl_xor(l, 32);
    const size_t rbase = (size_t)b * SEQ + (size_t)(256 * sb + 32 * wave) * dil + r;
    bf16_t* po = PO + (size_t)pi * M * 256 + h * 64;
    store_rows(lds, D_OST + wave * 4096, lane, o0, o1, 1.0f / l, [&](int q) { return po + (rbase + (size_t)q * dil) * 256; });
    if (hi == 0) PL[((size_t)pi * M + qrow) * 4 + h] = m * 0.6931471805599453f + __logf(l);
}
__device__ __forceinline__ void gate_item(LAS unsigned char* lds, int tid, int bh, int own, const bf16_t* __restrict__ proj, const float* __restrict__ kp, unsigned short* __restrict__ LIST, int* __restrict__ CNT) {
    const int lane = tid & 63, wave = __builtin_amdgcn_readfirstlane(tid >> 6), r32 = lane & 31, hi = lane >> 5;
    const int b = bh >> 2, h = bh & 3;
    LAS int* cnt = (LAS int*)lds;
    __syncthreads();
    if (tid < 32) cnt[tid] = 0;
    __syncthreads();
    const int qib = 32 * wave + r32;
    const size_t qrow = (size_t)b * SEQ + 256 * own + qib;
    bf16x8 qf[4];
#pragma unroll
    for (int s = 0; s < 4; ++s) qf[s] = *(const bf16x8*)(proj + qrow * NIN + COL_QA + h * 64 + 16 * s + 8 * hi);
    f32x16 g;
#pragma unroll
    for (int i = 0; i < 16; ++i) g[i] = 0.f;
    const float* k0 = kp + (size_t)((b * 32 + r32) * 2) * 256 + h * 64;
#pragma unroll
    for (int s = 0; s < 4; ++s) {
        float kv[8];
#pragma unroll
        for (int j = 0; j < 8; j += 4) { const float4 a = *(const float4*)(k0 + 16 * s + 8 * hi + j), c = *(const float4*)(k0 + 256 + 16 * s + 8 * hi + j);
            kv[j] = (a.x + c.x) * (1.0f / 256.0f); kv[j + 1] = (a.y + c.y) * (1.0f / 256.0f); kv[j + 2] = (a.z + c.z) * (1.0f / 256.0f); kv[j + 3] = (a.w + c.w) * (1.0f / 256.0f); }
        u32x4 wh, wl;
#pragma unroll
        for (int j = 0; j < 4; ++j) {
            const bf16_t h0 = f2bf(kv[2 * j]), h1 = f2bf(kv[2 * j + 1]);
            const bf16_t l0 = f2bf(kv[2 * j] - bf2f(h0)), l1 = f2bf(kv[2 * j + 1] - bf2f(h1));
            wh[j] = (unsigned)h0 | ((unsigned)h1 << 16); wl[j] = (unsigned)l0 | ((unsigned)l1 << 16);
        }
        g = __builtin_amdgcn_mfma_f32_32x32x16_bf16(__builtin_bit_cast(bf16x8, wh), qf[s], g, 0, 0, 0);
        g = __builtin_amdgcn_mfma_f32_32x32x16_bf16(__builtin_bit_cast(bf16x8, wl), qf[s], g, 0, 0, 0);
    }
#pragma unroll
    for (int i = 0; i < 16; ++i) if (crow(i, hi) >= own) g[i] = -INFINITY;
#pragma unroll
    for (int t = 0; t < 3; ++t) {
        float lm = -INFINITY;
#pragma unroll
        for (int i = 0; i < 16; ++i) lm = fmaxf(lm, g[i]);
        const float gm = fmaxf(lm, __shfl_xor(lm, 32));
        int cand = 99;
#pragma unroll
        for (int i = 15; i >= 0; --i) if (g[i] == gm) cand = crow(i, hi);
        cand = min(cand, __shfl_xor(cand, 32));
        if (gm > -INFINITY) {
#pragma unroll
            for (int i = 0; i < 16; ++i) if (crow(i, hi) == cand) g[i] = -INFINITY;
            if (hi == 0) { const int pos = atomicAdd((int*)&cnt[cand], 1); LIST[(((size_t)bh * 32 + cand) * 32 + own) * 256 + pos] = (unsigned short)((t << 8) | qib); }
        }
    }
    __syncthreads();
    if (tid < 32) CNT[((size_t)bh * 32 + tid) * 32 + own] = (tid < own) ? cnt[tid] : 0;
}
constexpr int M_K = 0, M_V = 32768, M_LUT = 65536, M_OST = 73728;
template <class Hook> __device__ __forceinline__ void moba_item(const Hook& after_stage, LAS unsigned char* lds, int tid, int bh, int n, int part, int nparts, const bf16_t* __restrict__ proj, const float* __restrict__ rel_bias, const float* __restrict__ lutm, const unsigned short* __restrict__ LIST, const int* __restrict__ CNT,
                                          bf16_t* __restrict__ PARTO, float* __restrict__ PARTML, bf16_t* __restrict__ Y) {
    const int lane = tid & 63, wave = __builtin_amdgcn_readfirstlane(tid >> 6), r32 = lane & 31, hi = lane >> 5;
    const int b = bh >> 2, h = bh & 3;
    __syncthreads();
    LAS float* lut = (LAS float*)(lds + M_LUT);
    if (tid < 472) ((LAS u32x4*)lut)[tid] = ((const u32x4*)(lutm + h * 1888))[tid];
    const bf16_t* kvb = proj + ((size_t)b * SEQ + 256 * n) * NIN;
    stage_rows<4>(lds, M_K, M_V, tid, COL_KA + h * 64, COL_VA + h * 64, [&](int row, bool& ok) -> const bf16_t* { ok = true; return kvb + (size_t)row * NIN; });
    after_stage();
    int cj = 0, nt = 0;
    if (lane < 32) { if (lane == n) nt = 8; else if (lane > n) { cj = CNT[((size_t)bh * 32 + n) * 32 + lane]; nt = (cj + 31) >> 5; } }
    int st = nt;
#pragma unroll
    for (int o = 1; o < 32; o <<= 1) { const int v = __shfl_up(st, o); if ((lane & 31) >= o) st += v; }
    st -= nt;
    const int T = __shfl(st + nt, 31);
    const float b31 = rel_bias[31 * 8 + h] * 1.4426950408889634f;
    const unsigned short* lbase = LIST + (((size_t)bh * 32 + n) * 32) * 256;
    const int stride = 8 * nparts, t0 = wave + 8 * part;
    struct EA { int seg, lt; unsigned short raw; bool live; };
    auto stageA = [&](int t) -> EA { EA e; const int tt = min(t, T - 1);
        e.seg = __popcll(__ballot(lane < 32 && st <= tt)) - 1; e.lt = tt - __shfl(st, e.seg); e.live = true; e.raw = 0;
        if (e.seg != n) { const int c = __shfl(cj, e.seg), idx = 32 * e.lt + r32; e.live = idx < c; e.raw = lbase[(size_t)e.seg * 256 + (e.live ? idx : 0)]; }
        return e; };
    struct EB { int seg, slot, qib; bool live; size_t qrow; };
    auto stageB = [&](const EA& e, bf16x8 (&q)[4]) -> EB { EB m; m.seg = e.seg; m.live = e.live;
        if (e.seg == n) { m.slot = 3; m.qib = 32 * e.lt + r32; } else { m.slot = e.raw >> 8; m.qib = e.raw & 255; }
        m.qrow = (size_t)b * SEQ + 256 * e.seg + m.qib;
#pragma unroll
        for (int s = 0; s < 4; ++s) q[s] = *(const bf16x8*)(proj + m.qrow * NIN + COL_QA + h * 64 + 16 * s + 8 * hi);
        return m; };
    __syncthreads();
    if (t0 < T) {
        EA ea1 = stageA(t0);
        bf16x8 q0[4], q1[4];
        EB m0 = stageB(ea1, q0);
        ea1 = stageA(t0 + stride);
#pragma unroll 1
        for (int t = t0; t < T; t += stride) {
            const EB m1 = stageB(ea1, q1);
            ea1 = stageA(t + 2 * stride);
            __builtin_amdgcn_sched_barrier(0);
            f32x16 o0, o1;
#pragma unroll
            for (int i = 0; i < 16; ++i) { o0[i] = 0.f; o1[i] = 0.f; }
            float m = NEGF, l = 0.f;
            const int seg = m0.seg, qpos = 256 * seg + m0.qib;
            if (seg == n) {
                const int nks = (m0.qib - r32 + 31) / 64 + 1;
                for (int ks = 0; ks < nks; ++ks) { TabFn fn{lut + (m0.qib - 64 * ks - 4 * hi + 96 - 59)}; step64(lds, M_K + ks * 8192, M_V + ks * 8192, q0, o0, o1, m, l, lane, fn); }
            } else if (seg - n >= 7) {
                ConstFn fn{b31};
#pragma unroll 1
                for (int ks = 0; ks < 4; ++ks) step64(lds, M_K + ks * 8192, M_V + ks * 8192, q0, o0, o1, m, l, lane, fn);
            } else {
#pragma unroll 1
                for (int ks = 0; ks < 4; ++ks) { TabFn fn{lut + (qpos - 256 * n - 64 * ks - 4 * hi + 96 - 59)}; step64(lds, M_K + ks * 8192, M_V + ks * 8192, q0, o0, o1, m, l, lane, fn); }
            }
            l += __shfl_xor(l, 32);
            bf16_t* dstp = nullptr;
            if (m0.live) dstp = (m0.slot == 3) ? Y + m0.qrow * DM + h * 64 : PARTO + ((m0.qrow * 4 + h) * 3 + m0.slot) * 64;
            const unsigned long long dl = (unsigned long long)dstp;
            store_rows(lds, M_OST + wave * 4096, lane, o0, o1, 1.0f / l, [&](int q) { return (bf16_t*)__shfl(dl, q); });
            if (m0.live && hi == 0) { float2 ml; ml.x = m; ml.y = l; *(float2*)(PARTML + ((m0.qrow * 4 + h) * 4 + m0.slot) * 2) = ml; }
            m0 = m1;
#pragma unroll
            for (int s = 0; s < 4; ++s) q0[s] = q1[s];
        }
    }
}
}

namespace hg {
typedef short bf16x8 __attribute__((ext_vector_type(8)));
typedef float f32x4 __attribute__((ext_vector_type(4)));
typedef unsigned u32x2 __attribute__((ext_vector_type(2)));
constexpr int SEG_OFF = 0, BT_OFF = 2048, VT_OFF = 18432, KT_OFF = 26624;
constexpr int QS_OFF = 26624, QD_OFF = 34816, QO_OFF = 43008, KD_OFF = 51200, KO_OFF = 59392;
__device__ __forceinline__ void img_put(LAS unsigned char* lds, int off, int row, int d, float v) { *(LAS bf16_t*)(lds + off + row * 128 + ((((d >> 3) ^ (row & 7))) << 4) + (d & 7) * 2) = f2bf(v); }
__device__ __forceinline__ bf16x8 img_frag(LAS const unsigned char* lds, int off, int row, int chunk) { return *(const LAS bf16x8*)(lds + off + row * 128 + ((chunk ^ (row & 7)) << 4)); }
__device__ __forceinline__ unsigned cvtpk(float lo, float hi) { return cvtpk_s(lo, hi); }
struct Ch { float f[8], b[8], qv[8], iv[8], blast; };
template <bool NEEDQ> __device__ __forceinline__ void stage(LAS unsigned char* lds, int wave, int lane, const bf16_t* __restrict__ rowp  , float lb, Ch& c) {
    float cs = 0.f;
#pragma unroll
    for (int i = 0; i < 8; ++i) {
        const bf16_t* r = rowp + (size_t)(8 * wave + i) * NIN + lane;
        const float fp = bf2f(r[COL_FC]); c.iv[i] = bf2f(r[COL_IC]);
        if (NEEDQ) { const float q = bf2f(r[COL_QC]); c.qv[i] = q / (1.0f + __expf(-q)) * 0.125f; }
        c.f[i] = lb + (1.0f - lb) / (1.0f + __expf(-fp));
        cs += __logf(c.f[i]); c.b[i] = cs;
    }
    LAS float* seg = (LAS float*)(lds + SEG_OFF);
    seg[wave * 64 + lane] = cs;
    __syncthreads();
    float off = 0.f, tot = 0.f;
#pragma unroll
    for (int w = 0; w < 8; ++w) { const float s = seg[w * 64 + lane]; tot += s; if (w < wave) off += s; }
#pragma unroll
    for (int i = 0; i < 8; ++i) c.b[i] += off;
    c.blast = tot;
}
__device__ __forceinline__ void x1_item(LAS unsigned char* lds, int wave, int lane, int item, const bf16_t* __restrict__ proj, const float* __restrict__ lbp, float* __restrict__ DS, float* __restrict__ DEC) {
    const int bh = item >> 7, ch = item & 127, b = bh >> 2, h = bh & 3;
    __syncthreads();
    Ch c; stage<false>(lds, wave, lane, proj + ((size_t)b * SEQ + ch * 64) * NIN + h * 64, lbp[h * 64 + lane], c);
    u32x4 kw, vw;
#pragma unroll
    for (int j = 0; j < 4; ++j) {
        kw[j] = cvtpk((1.0f - c.f[2 * j]) * __expf(c.blast - c.b[2 * j]), (1.0f - c.f[2 * j + 1]) * __expf(c.blast - c.b[2 * j + 1]));
        vw[j] = cvtpk(c.iv[2 * j], c.iv[2 * j + 1]);
    }
    *(LAS u32x4*)(lds + KT_OFF + lane * 128 + ((wave ^ (lane & 7)) << 4)) = kw;
    *(LAS u32x4*)(lds + VT_OFF + lane * 128 + ((wave ^ (lane & 7)) << 4)) = vw;
    if (wave == 0) DEC[(size_t)item * 64 + lane] = __expf(c.blast);
    __syncthreads();
    const int fr = lane & 15, quad = lane >> 4, mt = wave >> 1;
#pragma unroll
    for (int n2 = 0; n2 < 2; ++n2) {
        const int nt = 2 * (wave & 1) + n2;
        f32x4 acc = {0.f, 0.f, 0.f, 0.f};
#pragma unroll
        for (int kk = 0; kk < 2; ++kk)
            acc = __builtin_amdgcn_mfma_f32_16x16x32_bf16(img_frag(lds, VT_OFF, 16 * mt + fr, quad + 4 * kk), img_frag(lds, KT_OFF, 16 * nt + fr, quad + 4 * kk), acc, 0, 0, 0);
        float* o = DS + (size_t)item * 4096 + (16 * mt + 4 * quad) * 64 + 16 * nt + fr;
#pragma unroll
        for (int r = 0; r < 4; ++r) o[r * 64] = acc[r];
    }
}
__device__ __forceinline__ void x2_scan(int gtid, int nthreads, const float* __restrict__ DS, const float* __restrict__ DEC, bf16_t* __restrict__ ST) {
    for (int e = gtid; e < 16 * 1024; e += nthreads) {
        const int bh = e >> 10, q = e & 1023;
        const int d4 = q & 15;
        f32x4 s = {0.f, 0.f, 0.f, 0.f};
#pragma unroll 1
        for (int c0 = 0; c0 < 128; c0 += 8) {
            f32x4 ds[8], de[8];
#pragma unroll
            for (int i = 0; i < 8; ++i) { const size_t it = (size_t)bh * 128 + c0 + i; ds[i] = *(const f32x4*)(DS + it * 4096 + q * 4); de[i] = *(const f32x4*)(DEC + it * 64 + d4 * 4); }
#pragma unroll
            for (int i = 0; i < 8; ++i) { const size_t it = (size_t)bh * 128 + c0 + i;
                uint2 w; w.x = cvtpk(s[0], s[1]); w.y = cvtpk(s[2], s[3]); *(uint2*)(ST + it * 4096 + q * 4) = w;
                s = s * de[i] + ds[i]; }
        }
    }
}
__device__ __forceinline__ void x3_item(LAS unsigned char* lds, int wave, int lane, int item, const bf16_t* __restrict__ proj, const float* __restrict__ lbp, const bf16_t* __restrict__ ST, bf16_t* __restrict__ Y) {
    const int bh = item >> 7, ch = item & 127, b = bh >> 2, h = bh & 3;
    __syncthreads();
    Ch c; stage<true>(lds, wave, lane, proj + ((size_t)b * SEQ + ch * 64) * NIN + h * 64, lbp[h * 64 + lane], c);
    LAS float* bt = (LAS float*)(lds + BT_OFF);
#pragma unroll
    for (int i = 0; i < 8; ++i) bt[(8 * wave + i) * 64 + lane] = c.b[i];
    { u32x4 vw;
#pragma unroll
      for (int j = 0; j < 4; ++j) vw[j] = cvtpk(c.iv[2 * j], c.iv[2 * j + 1]);
      *(LAS u32x4*)(lds + VT_OFF + lane * 128 + ((wave ^ (lane & 7)) << 4)) = vw; }
    __syncthreads();
    {
        const int I = wave >> 1;
        const float cI = bt[(16 * I + 7) * 64 + lane];
        const float rI = (I > 0) ? bt[(16 * I - 1) * 64 + lane] : 0.f;
        float rN[3];
#pragma unroll
        for (int ip = 1; ip < 4; ++ip) rN[ip - 1] = bt[(16 * ip - 1) * 64 + lane];
#pragma unroll
        for (int i = 0; i < 8; ++i) {
            const int t = 8 * wave + i; const float bb = c.b[i], q = c.qv[i], k = 1.0f - c.f[i];
            img_put(lds, QS_OFF, t, lane, q * __expf(bb));
            img_put(lds, QD_OFF, t, lane, q * __expf(bb - cI));
            img_put(lds, QO_OFF, t, lane, q * __expf(bb - rI));
            img_put(lds, KD_OFF, t, lane, k * __expf(cI - bb));
#pragma unroll
            for (int ip = 1; ip < 4; ++ip) if (ip > I) img_put(lds, KO_OFF + (ip - 1) * 8192, t, lane, k * __expf(rN[ip - 1] - bb));
        }
    }
    __syncthreads();
    const int fr = lane & 15, quad = lane >> 4, I = wave >> 1, vh = wave & 1;
    unsigned sc[4][2];
#pragma unroll
    for (int J = 0; J < 4; ++J) {
        sc[J][0] = 0u; sc[J][1] = 0u;
        if (J <= I) {
            f32x4 acc = {0.f, 0.f, 0.f, 0.f};
            const int ko = (J < I) ? KO_OFF + (I - 1) * 8192 : KD_OFF, qo = (J < I) ? QO_OFF : QD_OFF;
#pragma unroll
            for (int kk = 0; kk < 2; ++kk)
                acc = __builtin_amdgcn_mfma_f32_16x16x32_bf16(img_frag(lds, ko, 16 * J + fr, quad + 4 * kk), img_frag(lds, qo, 16 * I + fr, quad + 4 * kk), acc, 0, 0, 0);
            if (J == I) {
#pragma unroll
                for (int r = 0; r < 4; ++r) if (4 * quad + r > fr) acc[r] = 0.f;
            }
            sc[J][0] = cvtpk(acc[0], acc[1]); sc[J][1] = cvtpk(acc[2], acc[3]);
        }
    }
    const bf16_t* stp = ST + (size_t)item * 4096;
    const size_t orow = (size_t)b * SEQ + ch * 64 + 16 * I + fr;
#pragma unroll
    for (int m2 = 0; m2 < 2; ++m2) {
        const int mt = 2 * vh + m2, v = 16 * mt + fr;
        f32x4 acc = {0.f, 0.f, 0.f, 0.f};
#pragma unroll
        for (int ks = 0; ks < 2; ++ks) {
            if (2 * ks <= I) {
                u32x4 bw, aw;
                bw[0] = sc[2 * ks][0]; bw[1] = sc[2 * ks][1]; bw[2] = sc[2 * ks + 1][0]; bw[3] = sc[2 * ks + 1][1];
                const LAS unsigned char* vr = lds + VT_OFF + v * 128;
                const u32x2 a0 = *(const LAS u32x2*)(vr + (((4 * ks + (quad >> 1)) ^ (v & 7)) << 4) + (quad & 1) * 8);
                u32x2 a1 = {0u, 0u};
                if (2 * ks + 1 <= I) a1 = *(const LAS u32x2*)(vr + (((4 * ks + 2 + (quad >> 1)) ^ (v & 7)) << 4) + (quad & 1) * 8);
                aw[0] = a0.x; aw[1] = a0.y; aw[2] = a1.x; aw[3] = a1.y;
                acc = __builtin_amdgcn_mfma_f32_16x16x32_bf16(__builtin_bit_cast(bf16x8, aw), __builtin_bit_cast(bf16x8, bw), acc, 0, 0, 0);
            }
        }
#pragma unroll
        for (int kk = 0; kk < 2; ++kk) {
            const bf16x8 sa = *(const bf16x8*)(stp + v * 64 + 8 * quad + 32 * kk);
            acc = __builtin_amdgcn_mfma_f32_16x16x32_bf16(sa, img_frag(lds, QS_OFF, 16 * I + fr, quad + 4 * kk), acc, 0, 0, 0);
        }
        uint2 w; w.x = cvtpk(acc[0], acc[1]); w.y = cvtpk(acc[2], acc[3]);
        *(uint2*)(Y + orow * DM + 512 + h * 64 + 16 * mt + 4 * quad) = w;
    }
}
}

namespace hw {
typedef short bf16x8 __attribute__((ext_vector_type(8)));
typedef float f32x4 __attribute__((ext_vector_type(4)));
typedef unsigned u32x2 __attribute__((ext_vector_type(2)));
#define HW_LDSW() asm volatile("s_waitcnt lgkmcnt(0)" ::: "memory")
__device__ __forceinline__ bf16x8 frag128(LAS const unsigned char* base, int row, int chunk) { return *(const LAS bf16x8*)(base + row * 128 + ((chunk ^ (row & 7)) << 4)); }
__device__ __forceinline__ void x1_wave(LAS unsigned char* wl, int lane, int item, const bf16_t* __restrict__ proj, const float* __restrict__ lbp, float* __restrict__ DS, float* __restrict__ DEC) {
    const int bh = item >> 7, ch = item & 127, b = bh >> 2, h = bh & 3;
    const bf16_t* rp = proj + ((size_t)b * SEQ + ch * 64) * NIN + h * 64 + lane;
    const float lb = lbp[h * 64 + lane];
    float f[64]; float cs = 0.f;
    HW_LDSW();
#pragma unroll
    for (int g2 = 0; g2 < 4; ++g2) {
        unsigned short rf[16], ri[16];
#pragma unroll
        for (int i = 0; i < 16; ++i) { const bf16_t* r = rp + (size_t)(16 * g2 + i) * NIN; rf[i] = r[COL_FC]; ri[i] = r[COL_IC]; }
        __builtin_amdgcn_sched_barrier(0);
#pragma unroll
        for (int i = 0; i < 16; ++i) { const float ff = lb + (1.0f - lb) / (1.0f + __expf(-bf2f(rf[i]))); f[16 * g2 + i] = ff; cs += __logf(ff); }
#pragma unroll
        for (int q = 0; q < 2; ++q) { const int g = 2 * g2 + q;
            u32x4 vw; vw[0] = (unsigned)ri[8 * q] | ((unsigned)ri[8 * q + 1] << 16); vw[1] = (unsigned)ri[8 * q + 2] | ((unsigned)ri[8 * q + 3] << 16);
            vw[2] = (unsigned)ri[8 * q + 4] | ((unsigned)ri[8 * q + 5] << 16); vw[3] = (unsigned)ri[8 * q + 6] | ((unsigned)ri[8 * q + 7] << 16);
            *(LAS u32x4*)(wl + 8192 + lane * 128 + ((g ^ (lane & 7)) << 4)) = vw; }
    }
    const float blast = cs; cs = 0.f;
#pragma unroll
    for (int g = 0; g < 8; ++g) {
        float kh[8];
#pragma unroll
        for (int i = 0; i < 8; ++i) { const float ff = f[8 * g + i]; cs += __logf(ff); kh[i] = (1.0f - ff) * __expf(blast - cs); }
        u32x4 kw; kw[0] = cvtpk_s(kh[0], kh[1]); kw[1] = cvtpk_s(kh[2], kh[3]); kw[2] = cvtpk_s(kh[4], kh[5]); kw[3] = cvtpk_s(kh[6], kh[7]);
        *(LAS u32x4*)(wl + lane * 128 + ((g ^ (lane & 7)) << 4)) = kw;
    }
    DEC[(size_t)item * 64 + lane] = __expf(blast);
    HW_LDSW();
    const int fr = lane & 15, quad = lane >> 4;
    float* dsp = DS + (size_t)item * 4096;
#pragma unroll
    for (int mt = 0; mt < 4; ++mt) {
        const bf16x8 a0 = frag128(wl + 8192, 16 * mt + fr, quad), a1 = frag128(wl + 8192, 16 * mt + fr, quad + 4);
#pragma unroll
        for (int nt = 0; nt < 4; ++nt) {
            f32x4 acc = {0.f, 0.f, 0.f, 0.f};
            acc = __builtin_amdgcn_mfma_f32_16x16x32_bf16(a0, frag128(wl, 16 * nt + fr, quad), acc, 0, 0, 0);
            acc = __builtin_amdgcn_mfma_f32_16x16x32_bf16(a1, frag128(wl, 16 * nt + fr, quad + 4), acc, 0, 0, 0);
            float* o = dsp + (16 * mt + 4 * quad) * 64 + 16 * nt + fr;
#pragma unroll
            for (int r = 0; r < 4; ++r) o[r * 64] = acc[r];
        }
    }
    HW_LDSW();
}
__device__ __forceinline__ void x3_wave(LAS unsigned char* wl, int lane, int item, const bf16_t* __restrict__ proj, const float* __restrict__ lbp, const bf16_t* __restrict__ ST, bf16_t* __restrict__ Y) {
    const int bh = item >> 7, ch = item & 127, b = bh >> 2, h = bh & 3;
    const int fr = lane & 15, quad = lane >> 4;
    const bf16_t* rp = proj + ((size_t)b * SEQ + ch * 64) * NIN + h * 64 + lane;
    const float lb = lbp[h * 64 + lane];
    f32x4 S[4][4];
    { const bf16_t* sp = ST + (size_t)item * 4096;
#pragma unroll
      for (int tv = 0; tv < 4; ++tv)
#pragma unroll
          for (int td = 0; td < 4; ++td) { const uint2 w = *(const uint2*)(sp + (16 * tv + fr) * 64 + 16 * td + 4 * quad);
              S[td][tv] = (f32x4){__uint_as_float(w.x << 16), __uint_as_float(w.x & 0xffff0000u), __uint_as_float(w.y << 16), __uint_as_float(w.y & 0xffff0000u)}; } }
    LAS float* decl = (LAS float*)(wl + 10240);
    unsigned short nf[16], nq[16], ni[16];
#pragma unroll
    for (int i = 0; i < 16; ++i) { const bf16_t* r = rp + (size_t)i * NIN; nf[i] = r[COL_FC]; nq[i] = r[COL_QC]; ni[i] = r[COL_IC]; }
#pragma unroll 1
    for (int I = 0; I < 4; ++I) {
        float ff[16], qv[16], iv[16], bb[16];
#pragma unroll
        for (int i = 0; i < 16; ++i) { ff[i] = bf2f(nf[i]); qv[i] = bf2f(nq[i]); iv[i] = bf2f(ni[i]); }
        { const int In = I < 3 ? I + 1 : 3;
#pragma unroll
          for (int i = 0; i < 16; ++i) { const bf16_t* r = rp + (size_t)(16 * In + i) * NIN; nf[i] = r[COL_FC]; nq[i] = r[COL_QC]; ni[i] = r[COL_IC]; } }
        __builtin_amdgcn_sched_barrier(0);
        float cs = 0.f;
#pragma unroll
        for (int i = 0; i < 16; ++i) { ff[i] = lb + (1.0f - lb) / (1.0f + __expf(-ff[i])); cs += __logf(ff[i]); bb[i] = cs; qv[i] = qv[i] / (1.0f + __expf(-qv[i])) * 0.125f; }
        const float cm = bb[7], be = bb[15];
        HW_LDSW();
        { u32x4 v0, v1, k0, k1;
#pragma unroll
          for (int j = 0; j < 4; ++j) { v0[j] = cvtpk_s(iv[2 * j], iv[2 * j + 1]); v1[j] = cvtpk_s(iv[8 + 2 * j], iv[9 + 2 * j]);
              k0[j] = cvtpk_s((1.0f - ff[2 * j]) * __expf(be - bb[2 * j]), (1.0f - ff[2 * j + 1]) * __expf(be - bb[2 * j + 1]));
              k1[j] = cvtpk_s((1.0f - ff[8 + 2 * j]) * __expf(be - bb[8 + 2 * j]), (1.0f - ff[9 + 2 * j]) * __expf(be - bb[9 + 2 * j])); }
          *(LAS u32x4*)(wl + 8192 + lane * 32) = v0; *(LAS u32x4*)(wl + 8192 + lane * 32 + 16) = v1;
          *(LAS u32x4*)(wl + 6144 + lane * 32) = k0; *(LAS u32x4*)(wl + 6144 + lane * 32 + 16) = k1; }
        decl[lane] = __expf(be);
#pragma unroll
        for (int i = 0; i < 16; ++i) {
            const int off = i * 128 + ((((lane >> 3) ^ (i & 7))) << 4) + (lane & 7) * 2;
            *(LAS bf16_t*)(wl + off) = f2bf(qv[i] * __expf(bb[i]));
            *(LAS bf16_t*)(wl + 2048 + off) = f2bf(qv[i] * __expf(bb[i] - cm));
            *(LAS bf16_t*)(wl + 4096 + off) = f2bf((1.0f - ff[i]) * __expf(cm - bb[i]));
        }
        HW_LDSW();
        f32x4 sc = {0.f, 0.f, 0.f, 0.f};
        sc = __builtin_amdgcn_mfma_f32_16x16x32_bf16(frag128(wl + 4096, fr, quad), frag128(wl + 2048, fr, quad), sc, 0, 0, 0);
        sc = __builtin_amdgcn_mfma_f32_16x16x32_bf16(frag128(wl + 4096, fr, quad + 4), frag128(wl + 2048, fr, quad + 4), sc, 0, 0, 0);
#pragma unroll
        for (int r = 0; r < 4; ++r) if (4 * quad + r > fr) sc[r] = 0.f;
        u32x4 scb; scb[0] = cvtpk_s(sc[0], sc[1]); scb[1] = cvtpk_s(sc[2], sc[3]); scb[2] = 0u; scb[3] = 0u;
        u32x4 qi[2];
#pragma unroll
        for (int ks = 0; ks < 2; ++ks) {
            const u32x2 lo = *(const LAS u32x2*)(wl + fr * 128 + ((((4 * ks + (quad >> 1))) ^ (fr & 7)) << 4) + (quad & 1) * 8);
            const u32x2 hi2 = *(const LAS u32x2*)(wl + fr * 128 + ((((4 * ks + 2 + (quad >> 1))) ^ (fr & 7)) << 4) + (quad & 1) * 8);
            qi[ks] = (u32x4){lo[0], lo[1], hi2[0], hi2[1]};
        }
        const size_t orow = (size_t)b * SEQ + ch * 64 + 16 * I + fr;
#pragma unroll
        for (int tv = 0; tv < 4; ++tv) {
            const u32x2 vt = *(const LAS u32x2*)(wl + 8192 + (16 * tv + fr) * 32 + quad * 8);
            f32x4 acc = {0.f, 0.f, 0.f, 0.f};
            acc = __builtin_amdgcn_mfma_f32_16x16x32_bf16(__builtin_bit_cast(bf16x8, (u32x4){vt[0], vt[1], 0u, 0u}), __builtin_bit_cast(bf16x8, scb), acc, 0, 0, 0);
#pragma unroll
            for (int ks = 0; ks < 2; ++ks) {
                u32x4 sa; sa[0] = cvtpk_s(S[2 * ks][tv][0], S[2 * ks][tv][1]); sa[1] = cvtpk_s(S[2 * ks][tv][2], S[2 * ks][tv][3]);
                sa[2] = cvtpk_s(S[2 * ks + 1][tv][0], S[2 * ks + 1][tv][1]); sa[3] = cvtpk_s(S[2 * ks + 1][tv][2], S[2 * ks + 1][tv][3]);
                acc = __builtin_amdgcn_mfma_f32_16x16x32_bf16(__builtin_bit_cast(bf16x8, sa), __builtin_bit_cast(bf16x8, qi[ks]), acc, 0, 0, 0);
            }
            uint2 w; w.x = cvtpk_s(acc[0], acc[1]); w.y = cvtpk_s(acc[2], acc[3]);
            *(uint2*)(Y + orow * DM + 512 + h * 64 + 16 * tv + 4 * quad) = w;
        }
        if (I < 3) {
#pragma unroll
            for (int td = 0; td < 4; ++td) {
                const f32x4 dc = *(const LAS f32x4*)(wl + 10240 + (16 * td + 4 * quad) * 4);
                const u32x2 kt = *(const LAS u32x2*)(wl + 6144 + (16 * td + fr) * 32 + quad * 8);
                const bf16x8 ka = __builtin_bit_cast(bf16x8, (u32x4){kt[0], kt[1], 0u, 0u});
#pragma unroll
                for (int tv = 0; tv < 4; ++tv) {
                    const u32x2 vt = *(const LAS u32x2*)(wl + 8192 + (16 * tv + fr) * 32 + quad * 8);
                    S[td][tv] = __builtin_amdgcn_mfma_f32_16x16x32_bf16(ka, __builtin_bit_cast(bf16x8, (u32x4){vt[0], vt[1], 0u, 0u}), S[td][tv] * dc, 0, 0, 0);
                }
            }
        }
    }
    HW_LDSW();
}
}

namespace s5 {
typedef short bf16x8 __attribute__((ext_vector_type(8)));
typedef float f32x4 __attribute__((ext_vector_type(4)));
__device__ __forceinline__ void cpow(double dt, double ar, double ai, int n, double& pr, double& pi) { const double mg = exp(n * dt * ar); double sn, cs; sincos_d(n * dt * ai, sn, cs); pr = mg * cs; pi = mg * sn; }
__device__ __forceinline__ void zfac(double dt, double ar, double ai, double& zr, double& zi) {
    double are, aim; cpow(dt, ar, ai, 1, are, aim);
    const double nr = are - 1.0, ni = aim, den = ar * ar + ai * ai; zr = (nr * ar + ni * ai) / den; zi = (ni * ar - nr * ai) / den;
}
__device__ __forceinline__ void tables_thread(int e, const float* a_re, const float* a_im, const float* log_dt, const float* b_re, const float* b_im, const float* c_re, const float* c_im,
                                              bf16_t* W1, bf16_t* W3, float* a64) {
    const int st = e & 63, p = (e >> 6) & 63, lg = e >> 12;
    const int id = lg * 64 + p;
    float brv[16], biv[16], crv[16], civ[16];
#pragma unroll
    for (int c4 = 0; c4 < 4; ++c4) { const float4 x = *(const float4*)(b_re + id * 16 + 4 * c4), y = *(const float4*)(b_im + id * 16 + 4 * c4);
        brv[4 * c4] = x.x; brv[4 * c4 + 1] = x.y; brv[4 * c4 + 2] = x.z; brv[4 * c4 + 3] = x.w; biv[4 * c4] = y.x; biv[4 * c4 + 1] = y.y; biv[4 * c4 + 2] = y.z; biv[4 * c4 + 3] = y.w; }
#pragma unroll
    for (int c = 0; c < 16; ++c) { crv[c] = c_re[(lg * 16 + c) * 64 + p]; civ[c] = c_im[(lg * 16 + c) * 64 + p]; }
    const double dt = exp((double)log_dt[lg]), ar = a_re[id], ai = a_im[id];
    __builtin_amdgcn_sched_barrier(0);
    double zr, zi; zfac(dt, ar, ai, zr, zi);
    { double pr, pi; cpow(dt, ar, ai, 63 - st, pr, pi);
      unsigned wr[8], wi[8];
#pragma unroll
      for (int c2 = 0; c2 < 8; ++c2) {
          float vr[2], vi[2];
#pragma unroll
          for (int q = 0; q < 2; ++q) { const int c = 2 * c2 + q; const double br = brv[c], bi = biv[c];
              const double bbr = zr * br - zi * bi, bbi = zr * bi + zi * br; vr[q] = (float)(pr * bbr - pi * bbi); vi[q] = (float)(pr * bbi + pi * bbr); }
          wr[c2] = pk2(vr[0], vr[1]); wi[c2] = pk2(vi[0], vi[1]);
      }
      u32x4* o0 = (u32x4*)(W1 + ((size_t)(lg * 128 + 2 * p) * 1024 + st * 16)); u32x4* o1 = (u32x4*)(W1 + ((size_t)(lg * 128 + 2 * p + 1) * 1024 + st * 16));
      o0[0] = (u32x4){wr[0], wr[1], wr[2], wr[3]}; o0[1] = (u32x4){wr[4], wr[5], wr[6], wr[7]};
      o1[0] = (u32x4){wi[0], wi[1], wi[2], wi[3]}; o1[1] = (u32x4){wi[4], wi[5], wi[6], wi[7]}; }
    { double pr, pi; cpow(dt, ar, ai, st + 1, pr, pi);
#pragma unroll
      for (int c = 0; c < 16; ++c) { const double cr = crv[c], ci = civ[c];
          *(unsigned*)(W3 + ((size_t)(lg * 1024 + st * 16 + c) * 128 + 2 * p)) = pk2((float)(cr * pr - ci * pi), -(float)(cr * pi + ci * pr)); }
      if (st == 63) { a64[id * 2] = (float)pr; a64[id * 2 + 1] = (float)pi; } }
}
__device__ __forceinline__ void kmat_item(LAS float* scr, int tid, int item, const float* a_re, const float* a_im, const float* log_dt, const float* b_re, const float* b_im, const float* c_re, const float* c_im, const float* dskip, bf16_t* KM) {
    const int tau = item & 63, lg = item >> 6;
    __syncthreads();
    if (tid < 256) ((LAS f32x4*)(scr + 2048))[tid] = ((const f32x4*)(c_re + (size_t)lg * 1024))[tid];
    else ((LAS f32x4*)(scr + 3072))[tid - 256] = ((const f32x4*)(c_im + (size_t)lg * 1024))[tid - 256];
    { const int p = tid >> 3, c0 = (tid & 7) * 2, id = lg * 64 + p;
      const double dt = exp((double)log_dt[lg]), ar = a_re[id], ai = a_im[id];
      double zr, zi, pr, pi; zfac(dt, ar, ai, zr, zi); cpow(dt, ar, ai, tau, pr, pi);
#pragma unroll
      for (int q = 0; q < 2; ++q) { const int c = c0 + q; const double br = b_re[id * 16 + c], bi = b_im[id * 16 + c];
          const double bbr = zr * br - zi * bi, bbi = zr * bi + zi * br;
          scr[(p * 16 + c) * 2] = (float)(pr * bbr - pi * bbi); scr[(p * 16 + c) * 2 + 1] = (float)(pr * bbi + pi * bbr); } }
    __syncthreads();
    if (tid < 256) { const int c = tid >> 4, cp = tid & 15; float s = 0.f;
#pragma unroll 8
        for (int p = 0; p < 64; ++p) s += scr[2048 + c * 64 + p] * scr[(p * 16 + cp) * 2] - scr[3072 + c * 64 + p] * scr[(p * 16 + cp) * 2 + 1];
        if (tau == 0 && c == cp) s += dskip[lg * 16 + c];
        KM[((size_t)(lg * 64 + tau) * 16 + c) * 16 + cp] = f2bf(s); }
}
__device__ __forceinline__ size_t chunk_row(int cid) { return (size_t)(cid >> 7) * SEQ + (size_t)(cid & 127) * 64; }
__device__ __forceinline__ void x1_wave(int lane, int g, int mt, int lg, const bf16_t* __restrict__ proj, const bf16_t* __restrict__ W1, float* __restrict__ HEND) {
    const int fr = lane & 15, quad = lane >> 4;
    const bf16_t* ap = proj + (chunk_row(mt * 16 + fr) + (quad >> 1)) * NIN + COL_U + g * 16 + 8 * (quad & 1);
    const bf16_t* bp = W1 + ((size_t)(lg * 128 + fr) * 1024 + 8 * quad);
    f32x4 acc[8];
#pragma unroll
    for (int n = 0; n < 8; ++n) acc[n] = (f32x4){0.f, 0.f, 0.f, 0.f};
    bf16x8 afr[32];
#pragma unroll
    for (int kk = 0; kk < 32; ++kk) afr[kk] = *(const bf16x8*)(ap + (size_t)(2 * kk) * NIN);
#pragma unroll
    for (int kk = 0; kk < 32; ++kk) {
#pragma unroll
        for (int n = 0; n < 8; ++n) acc[n] = __builtin_amdgcn_mfma_f32_16x16x32_bf16(afr[kk], *(const bf16x8*)(bp + (size_t)n * 16 * 1024 + 32 * kk), acc[n], 0, 0, 0);
    }
#pragma unroll
    for (int n = 0; n < 8; ++n)
#pragma unroll
        for (int r = 0; r < 4; ++r) HEND[((size_t)(mt * 16 + 4 * quad + r) * 16 + g) * 128 + 16 * n + fr] = acc[n][r];
}
__device__ __forceinline__ void x2_scan(int e, const float* __restrict__ HEND, const float* __restrict__ a64, bf16_t* __restrict__ HST, int layer) {
    const int p = e & 63, g = (e >> 6) & 15, b = e >> 10;
    const float ar = a64[((layer * 16 + g) * 64 + p) * 2], ai = a64[((layer * 16 + g) * 64 + p) * 2 + 1];
    float hr = 0.f, hi = 0.f;
#pragma unroll 1
    for (int c0 = 0; c0 < 128; c0 += 16) {
        float2 he[16];
#pragma unroll
        for (int i = 0; i < 16; ++i) he[i] = *(const float2*)(HEND + ((size_t)(b * 128 + c0 + i) * 16 + g) * 128 + 2 * p);
#pragma unroll
        for (int i = 0; i < 16; ++i) {
            *(unsigned*)(HST + ((size_t)(b * 128 + c0 + i) * 16 + g) * 128 + 2 * p) = cvtpk_s(hr, hi);
            const float nr = ar * hr - ai * hi + he[i].x, ni = ar * hi + ai * hr + he[i].y; hr = nr; hi = ni;
        }
    }
}
__device__ __forceinline__ void x3_item(LAS unsigned char* lds, int wave, int lane, int item, int layer, const bf16_t* __restrict__ proj, const bf16_t* __restrict__ KM, const bf16_t* __restrict__ W3,
                                        const bf16_t* __restrict__ HST, bf16_t* __restrict__ ybpre) {
    const int g = item & 15, mt = item >> 4, lg = layer * 16 + g;
    const int tid = wave * 64 + lane;
    __syncthreads();
    { const u32x4* src = (const u32x4*)(KM + (size_t)lg * 64 * 256);
      u32x4 kv[4];
#pragma unroll
      for (int i = 0; i < 4; ++i) kv[i] = src[tid + 512 * i];
#pragma unroll
      for (int i = 0; i < 4; ++i) ((LAS u32x4*)lds)[tid + 512 * i] = kv[i];
      if (tid < 32) ((LAS u32x4*)(lds + 32768))[tid] = (u32x4){0u, 0u, 0u, 0u}; }
    __syncthreads();
    const int fr = lane & 15, quad = lane >> 4;
    const size_t crow = chunk_row(mt * 16 + fr);
    const bf16_t* ap = proj + (crow + (quad >> 1)) * NIN + COL_U + g * 16 + 8 * (quad & 1);
    f32x4 acc[8];
#pragma unroll
    for (int i = 0; i < 8; ++i) acc[i] = (f32x4){0.f, 0.f, 0.f, 0.f};
    const int tlo = 4 * wave, thi = 60 - 4 * wave;
    const int kkmax = (thi + 3) >> 1;
    const int lbase = (fr * 16 + 8 * (quad & 1)) * 2;
    const int kboth = 2 * wave + 1;
#define S5_B(t_, kk_) ({ const int tau_ = (t_) - 2 * (kk_) - (quad >> 1); *(const LAS bf16x8*)(lds + (tau_ < 0 ? 64 : tau_) * 512 + lbase); })
#pragma unroll 1
    for (int kb = 0; kb <= kkmax; kb += 8) {
        bf16x8 a8[8];
#pragma unroll
        for (int i = 0; i < 8; ++i) a8[i] = *(const bf16x8*)(ap + (size_t)(2 * (kb + i)) * NIN);
        __builtin_amdgcn_sched_barrier(0);
#pragma unroll
        for (int i = 0; i < 8; ++i) {
            const int kk = kb + i;
            if (kk <= kboth) {
#pragma unroll
                for (int ti = 0; ti < 4; ++ti) acc[ti] = __builtin_amdgcn_mfma_f32_16x16x32_bf16(a8[i], S5_B(tlo + ti, kk), acc[ti], 0, 0, 0);
            }
            if (kk <= kkmax) {
#pragma unroll
                for (int ti = 0; ti < 4; ++ti) acc[4 + ti] = __builtin_amdgcn_mfma_f32_16x16x32_bf16(a8[i], S5_B(thi + ti, kk), acc[4 + ti], 0, 0, 0);
            }
        }
    }
#undef S5_B
    {
        const bf16_t* hp = HST + ((size_t)(mt * 16 + fr) * 16 + g) * 128 + 8 * quad;
        const bf16_t* wlo = W3 + ((size_t)(lg * 1024 + tlo * 16 + fr) * 128 + 8 * quad);
        const bf16_t* whi = W3 + ((size_t)(lg * 1024 + thi * 16 + fr) * 128 + 8 * quad);
#pragma unroll 1
        for (int kk = 0; kk < 4; ++kk) {
            const bf16x8 a = *(const bf16x8*)(hp + 32 * kk);
            bf16x8 wb[8];
#pragma unroll
            for (int ti = 0; ti < 8; ++ti) wb[ti] = *(const bf16x8*)((ti < 4 ? wlo + (size_t)ti * 16 * 128 : whi + (size_t)(ti - 4) * 16 * 128) + 32 * kk);
            __builtin_amdgcn_sched_barrier(0);
#pragma unroll
            for (int ti = 0; ti < 8; ++ti) acc[ti] = __builtin_amdgcn_mfma_f32_16x16x32_bf16(a, wb[ti], acc[ti], 0, 0, 0);
        }
    }
#pragma unroll
    for (int ti = 0; ti < 8; ++ti)
#pragma unroll
        for (int r = 0; r < 4; ++r) {
            const int t = ti < 4 ? tlo + ti : thi + ti - 4;
            const size_t row = chunk_row(mt * 16 + 4 * quad + r) + t;
            const float y = acc[ti][r];
            const float uu = 1.5957691216057308f * (y + 0.044715f * y * y * y);
            ybpre[row * 256 + g * 16 + fr] = f2bf(y / (1.0f + __expf(-uu)));
        }
}
}

constexpr int NWAVES = 8;
constexpr int RING_BYTES = 131072, MISC_OFF = RING_BYTES + 320, LDS_BYTES = 147456;
typedef unsigned v4u __attribute__((ext_vector_type(4)));
#define LDS_WAIT() asm volatile("s_waitcnt lgkmcnt(0)" ::: "memory")

struct Args { const float* in[18]; float* out; unsigned char* ws; };

__device__ __forceinline__ void p0_transpose_item(const float* W, int K, int N, bf16_t* WT, LAS float* scr, int item, int lane) {
    const int nblk = N / 32, kb = item / nblk, nb = item % nblk, k0 = 64 * kb, n0 = 32 * nb;
    float wv[32];
#pragma unroll
    for (int i = 0; i < 32; ++i) { const int kk = 2 * i + (lane >> 5); wv[i] = W[(size_t)(k0 + kk) * N + n0 + (lane & 31)]; }
    __builtin_amdgcn_sched_barrier(0);
#pragma unroll
    for (int i = 0; i < 32; ++i) { const int kk = 2 * i + (lane >> 5); scr[kk * 33 + (lane & 31)] = wv[i]; }
    LDS_WAIT();
    const int c = lane & 7;
#pragma unroll
    for (int j = 0; j < 4; ++j) { const int n = (lane >> 3) + 8 * j; const LAS float* s = scr + (8 * c) * 33 + n;
        v4u o; o.x = pk2(s[0 * 33], s[1 * 33]); o.y = pk2(s[2 * 33], s[3 * 33]); o.z = pk2(s[4 * 33], s[5 * 33]); o.w = pk2(s[6 * 33], s[7 * 33]);
        *(v4u*)(WT + (size_t)(n0 + n) * K + k0 + 8 * c) = o; }
    LDS_WAIT();
}
__device__ __forceinline__ void prep_small(int id, const float* a_re, const float* a_im, const float* log_dt, const float* b_re, const float* b_im, const float* hl, float* sm) {
    if (id < DEPTH * 16 * 64) {
        const int lg = id >> 6;
        const double dt = exp((double)log_dt[lg]), ar = a_re[id], ai = a_im[id];
        const double mag = exp(dt * ar); double sn, cs; sincos_d(dt * ai, sn, cs);
        const double are = mag * cs, aim = mag * sn, nr = are - 1.0, ni = aim, den = ar * ar + ai * ai;
        const double zr = (nr * ar + ni * ai) / den, zi = (ni * ar - nr * ai) / den;
        sm[SM_ABAR + id * 2] = (float)are; sm[SM_ABAR + id * 2 + 1] = (float)aim;
        for (int c = 0; c < 16; ++c) {
            const double br = b_re[id * 16 + c], bi = b_im[id * 16 + c];
            sm[SM_BBAR + (id * 16 + c) * 2] = (float)(zr * br - zi * bi);
            sm[SM_BBAR + (id * 16 + c) * 2 + 1] = (float)(zr * bi + zi * br);
        }
    }
    if (id < 256) {
        const float h0 = hl[id], h1 = hl[256 + id], mx = fmaxf(h0, h1), e0 = expf(h0 - mx), e1 = expf(h1 - mx);
        sm[SM_LB + id] = 0.0f; sm[SM_LB + 256 + id] = e1 / (e0 + e1);
    }
}

__device__ __forceinline__ float dot64(const float* qs, const bf16_t* krow) {
    float s = 0.f;
#pragma unroll
    for (int i = 0; i < 8; ++i) {
        const u32x4 v = *(const u32x4*)(krow + i * 8);
#pragma unroll
        for (int j = 0; j < 4; ++j) { s = fmaf(qs[i * 8 + 2 * j], __uint_as_float(v[j] << 16), s); s = fmaf(qs[i * 8 + 2 * j + 1], __uint_as_float(v[j] & 0xffff0000u), s); }
    }
    return s;
}
__device__ __forceinline__ void moba_simple(int gid, int lane, float* scr, const bf16_t* __restrict__ proj, const float* __restrict__ kmean, const float* __restrict__ rel_bias, bf16_t* __restrict__ Y) {
    const int s = gid % SEQ, h = (gid / SEQ) & 3, b = gid / (SEQ * 4);
    float* qs = scr; float* ps = scr + 64;
    const size_t row = (size_t)b * SEQ + s;
    WSYNC();
    qs[lane] = bf2f(proj[row * NIN + COL_QA + h * 64 + lane]);
    WSYNC();
    const int own = s >> 8;
    float g = -INFINITY;
    if (lane < own) { const float* km = kmean + ((b * 4 + h) * 32 + lane) * 64; float a = 0.f; for (int d = 0; d < 64; ++d) a = fmaf(qs[d], km[d], a); g = a; }
    int blk[4]; bool val[4];
#pragma unroll
    for (int t = 0; t < 3; ++t) {
        const float mx = wave_max(g);
        val[t] = mx > -INFINITY;
        const unsigned long long mk = __ballot(g == mx);
        const int idx = val[t] ? (__ffsll((long long)mk) - 1) : own;
        blk[t] = idx;
        if (val[t] && lane == idx) g = -INFINITY;
    }
    blk[3] = own; val[3] = true;
    float lmax = NEGF;
#pragma unroll
    for (int t = 0; t < 4; ++t) {
        for (int i = 0; i < 4; ++i) {
            const int kk = lane + 64 * i, kpos = blk[t] * 256 + kk;
            const bool ok = (t < 3) ? val[t] : (kpos <= s);
            float lg = NEGF;
            if (ok) lg = dot64(qs, proj + ((size_t)b * SEQ + kpos) * NIN + COL_KA + h * 64) * 0.125f + rel_bias[t5_bucket(s - kpos) * 8 + h];
            ps[t * 256 + kk] = lg; lmax = fmaxf(lmax, lg);
        }
    }
    const float mx = wave_max(lmax);
    float lsum = 0.f;
    for (int i = 0; i < 16; ++i) { const float p = expf(ps[lane + 64 * i] - mx); ps[lane + 64 * i] = p; lsum += p; }
    const float tot = wave_sum(lsum);
    WSYNC();
    float acc = 0.f;
#pragma unroll
    for (int t = 0; t < 4; ++t) {
        if (!val[t]) continue;
        const bf16_t* vp = proj + ((size_t)b * SEQ + blk[t] * 256) * NIN + COL_VA + h * 64 + lane;
        const int nk = (t < 3) ? 256 : (s - own * 256 + 1);
        for (int kk = 0; kk < nk; ++kk) acc = fmaf(ps[t * 256 + kk], bf2f(vp[(size_t)kk * NIN]), acc);
    }
    Y[row * DM + h * 64 + lane] = f2bf(acc / tot);
}
__device__ __forceinline__ void dilated_simple(int gid, int lane, float* scr, const bf16_t* __restrict__ proj, const float* __restrict__ rel_bias, bf16_t* __restrict__ Y) {
    const int s = gid % SEQ, h = (gid / SEQ) & 3, b = gid / (SEQ * 4);
    float* qs = scr; float* ps = scr + 64;
    const size_t row = (size_t)b * SEQ + s;
    WSYNC();
    qs[lane] = bf2f(proj[row * NIN + COL_QD + h * 64 + lane]);
    WSYNC();
    float lse[3], ssum[3];
#pragma unroll
    for (int pi = 0; pi < 3; ++pi) {
        const int dil = (pi == 0) ? 1 : (pi == 1) ? 4 : 16;
        float lmax = NEGF;
        for (int i = 0; i < 3; ++i) {
            const int j = lane + 64 * i, kpos = s - j * dil;
            float lg = NEGF;
            if (j <= 128 && kpos >= 0) lg = dot64(qs, proj + ((size_t)b * SEQ + kpos) * NIN + COL_KD + h * 64) * 0.125f + rel_bias[t5_bucket(j * dil) * 8 + 4 + h];
            ps[pi * 192 + j] = lg; lmax = fmaxf(lmax, lg);
        }
        const float mx = wave_max(lmax);
        float lsum = 0.f;
        for (int i = 0; i < 3; ++i) { const int j = lane + 64 * i; const float p = expf(ps[pi * 192 + j] - mx); ps[pi * 192 + j] = p; lsum += p; }
        ssum[pi] = wave_sum(lsum);
        lse[pi] = mx + logf(ssum[pi]);
    }
    WSYNC();
    const float lm = fmaxf(lse[0], fmaxf(lse[1], lse[2]));
    const float w0 = expf(lse[0] - lm), w1 = expf(lse[1] - lm), w2 = expf(lse[2] - lm), wt = w0 + w1 + w2;
    const float wgt[3] = {w0 / wt, w1 / wt, w2 / wt};
    float out = 0.f;
#pragma unroll
    for (int pi = 0; pi < 3; ++pi) {
        const int dil = (pi == 0) ? 1 : (pi == 1) ? 4 : 16;
        float acc = 0.f;
        for (int j = 0; j <= 128; ++j) {
            const int kpos = s - j * dil; if (kpos < 0) break;
            acc = fmaf(ps[pi * 192 + j], bf2f(proj[((size_t)b * SEQ + kpos) * NIN + COL_VD + h * 64 + lane]), acc);
        }
        out += wgt[pi] * acc / ssum[pi];
    }
    Y[row * DM + 768 + h * 64 + lane] = f2bf(out);
}
__device__ __forceinline__ void s5_simple(int b, int g, int lane, float* scr, const bf16_t* __restrict__ proj, const float* __restrict__ sm, const float* __restrict__ c_re, const float* __restrict__ c_im,
                                          const float* __restrict__ dskip, bf16_t* __restrict__ ybpre, int layer) {
    float* hs = scr; float* us = scr + 8192; float* cs = scr + 8192 + 1024;
    const int pid = (layer * 16 + g) * 64 + lane;
    const float are = sm[SM_ABAR + pid * 2], aim = sm[SM_ABAR + pid * 2 + 1];
    float bbr[16], bbi[16];
#pragma unroll
    for (int c = 0; c < 16; ++c) { bbr[c] = sm[SM_BBAR + (pid * 16 + c) * 2]; bbi[c] = sm[SM_BBAR + (pid * 16 + c) * 2 + 1]; }
    for (int c = 0; c < 16; ++c) { cs[(c * 65 + lane) * 2] = c_re[((layer * 16 + g) * 16 + c) * 64 + lane]; cs[(c * 65 + lane) * 2 + 1] = c_im[((layer * 16 + g) * 16 + c) * 64 + lane]; }
    const int oc = lane & 15, otq = lane >> 4;
    const float dsk = dskip[layer * 256 + g * 16 + oc];
    float hr = 0.f, hi = 0.f;
#pragma unroll 1
    for (int t0 = 0; t0 < SEQ; t0 += 64) {
        WSYNC();
#pragma unroll 1
        for (int e = lane; e < 1024; e += 64) { const int t = e >> 4, c = e & 15; us[t * 16 + c] = bf2f(proj[((size_t)b * SEQ + t0 + t) * NIN + COL_U + g * 16 + c]); }
        WSYNC();
#pragma unroll 1
        for (int t = 0; t < 64; ++t) {
            float xr = 0.f, xi = 0.f;
#pragma unroll
            for (int c = 0; c < 16; ++c) { const float u = us[t * 16 + c]; xr = fmaf(bbr[c], u, xr); xi = fmaf(bbi[c], u, xi); }
            const float nr = are * hr - aim * hi + xr, ni = are * hi + aim * hr + xi;
            hr = nr; hi = ni;
            hs[(t * 64 + lane) * 2] = hr; hs[(t * 64 + lane) * 2 + 1] = hi;
        }
        WSYNC();
#pragma unroll 1
        for (int i = 0; i < 16; ++i) {
            const int t = otq + 4 * i;
            float y = 0.f;
#pragma unroll 4
            for (int p = 0; p < 64; ++p) y += hs[(t * 64 + p) * 2] * cs[(oc * 65 + p) * 2] - hs[(t * 64 + p) * 2 + 1] * cs[(oc * 65 + p) * 2 + 1];
            y += dsk * us[t * 16 + oc];
            ybpre[((size_t)b * SEQ + t0 + t) * 256 + g * 16 + oc] = f2bf(gelu_tanh(y));
        }
    }
}
__device__ __forceinline__ void hgrn_simple(int b, int h, int lane, float* scr, const bf16_t* __restrict__ proj, const float* __restrict__ sm, bf16_t* __restrict__ Y, int layer) {
    float* fs = scr; float* qs = scr + 4096; float* is = scr + 8192;
    const float lb = sm[SM_LB + layer * 256 + h * 64 + lane];
    float S[64];
#pragma unroll
    for (int d = 0; d < 64; ++d) S[d] = 0.f;
    for (int t0 = 0; t0 < SEQ; t0 += 64) {
        WSYNC();
        for (int t = 0; t < 64; ++t) {
            const bf16_t* r = proj + ((size_t)b * SEQ + t0 + t) * NIN + h * 64 + lane;
            const float qv = bf2f(r[COL_QC]), fv = bf2f(r[COL_FC]), iv = bf2f(r[COL_IC]);
            fs[t * 64 + lane] = lb + (1.0f - lb) * sigmoidf_(fv); qs[t * 64 + lane] = siluf_(qv) * 0.125f; is[t * 64 + lane] = iv;
        }
        WSYNC();
        for (int t = 0; t < 64; ++t) {
            const float iv = is[t * 64 + lane];
            float o = 0.f;
#pragma unroll
            for (int d = 0; d < 64; ++d) { const float f = fs[t * 64 + d]; S[d] = fmaf(f, S[d] - iv, iv); o = fmaf(qs[t * 64 + d], S[d], o); }
            Y[((size_t)b * SEQ + t0 + t) * DM + 512 + h * 64 + lane] = f2bf(o);
        }
    }
}
__device__ __forceinline__ void unpack16(const bf16_t* p, float* v) {
    const u32x4 y0 = *(const u32x4*)p, y1 = *(const u32x4*)(p + 8);
#pragma unroll
    for (int j = 0; j < 4; ++j) { v[2 * j] = __uint_as_float(y0[j] << 16); v[2 * j + 1] = __uint_as_float(y0[j] & 0xffff0000u); v[8 + 2 * j] = __uint_as_float(y1[j] << 16); v[8 + 2 * j + 1] = __uint_as_float(y1[j] & 0xffff0000u); }
}
__device__ __forceinline__ void combine_row(size_t row, int lane, bf16_t* __restrict__ Y, const bf16_t* __restrict__ proj, const float* __restrict__ gain, const bf16_t* __restrict__ PO, const float* __restrict__ PL, const bf16_t* __restrict__ PARTO, const float* __restrict__ PARTML, const bf16_t* __restrict__ ybpre, const float* __restrict__ glub) {
    bf16_t* yp = Y + row * DM + lane * 16; const bf16_t* gp = proj + row * NIN + COL_G + lane * 16;
    const bool is_m = lane < 16, is_d = lane >= 48, is_s = (lane >= 16) && (lane < 32);
    const int hm = (lane >> 2) & 3;
    const bf16_t* s0 = yp; const bf16_t* s1 = yp; const bf16_t* s2 = yp; const bf16_t* s3 = yp;
    if (is_m) { const bf16_t* pb = PARTO + ((row * 4 + hm) * 3) * 64 + (lane & 3) * 16; s1 = pb; s2 = pb + 64; s3 = pb + 128; }
    if (is_d) { const bf16_t* pb = PO + row * 256 + (lane - 48) * 16; s0 = pb; s1 = pb + (size_t)M * 256; s2 = pb + 2 * (size_t)M * 256; s3 = pb; }
    const float* wp = is_m ? PARTML + ((row * 4 + hm) * 4) * 2 : PL + row * 4 + hm;
    const u32x4 g0 = *(const u32x4*)gp, g1 = *(const u32x4*)(gp + 8);
    const u32x4 a0 = *(const u32x4*)s0, a1 = *(const u32x4*)(s0 + 8), b0 = *(const u32x4*)s1, b1 = *(const u32x4*)(s1 + 8);
    const u32x4 c0 = *(const u32x4*)s2, c1 = *(const u32x4*)(s2 + 8), d0 = *(const u32x4*)s3, d1 = *(const u32x4*)(s3 + 8);
    float4 w01 = {0.f, 0.f, 0.f, 0.f}, w23 = {0.f, 0.f, 0.f, 0.f}; float p1 = 0.f, p2 = 0.f;
    if (is_m) { w01 = *(const float4*)wp; w23 = *(const float4*)(wp + 4); }
    if (is_d) { w01.x = wp[0]; p1 = wp[(size_t)M * 4]; p2 = wp[2 * (size_t)M * 4]; }
    __builtin_amdgcn_sched_barrier(0);
    float wa = 1.f, wb = 0.f, wc = 0.f, wd = 0.f;
    if (is_m) {
        const int own = (int)((row % SEQ) >> 8);
        const float m3 = w23.z, l3 = w23.w;
        const float m0 = own > 0 ? w01.x : NEGF, m1 = own > 1 ? w01.z : NEGF, m2 = own > 2 ? w23.x : NEGF;
        const float mx = fmaxf(fmaxf(m3, m0), fmaxf(m1, m2));
        wa = l3 * __builtin_amdgcn_exp2f(m3 - mx); wb = own > 0 ? w01.y * __builtin_amdgcn_exp2f(m0 - mx) : 0.f; wc = own > 1 ? w01.w * __builtin_amdgcn_exp2f(m1 - mx) : 0.f; wd = own > 2 ? w23.y * __builtin_amdgcn_exp2f(m2 - mx) : 0.f;
        const float wi = 1.0f / (wa + wb + wc + wd); wa *= wi; wb *= wi; wc *= wi; wd *= wi;
    }
    if (is_d) { const float mx = fmaxf(w01.x, fmaxf(p1, p2)); wa = __expf(w01.x - mx); wb = __expf(p1 - mx); wc = __expf(p2 - mx); const float wi = 1.0f / (wa + wb + wc); wa *= wi; wb *= wi; wc *= wi; wd = 0.f; }
    float v[16], gt[16];
#define CB_LO(x) __uint_as_float((x) << 16)
#define CB_HI(x) __uint_as_float((x) & 0xffff0000u)
#pragma unroll
    for (int j = 0; j < 4; ++j) {
        v[2 * j] = wa * CB_LO(a0[j]) + wb * CB_LO(b0[j]) + wc * CB_LO(c0[j]) + wd * CB_LO(d0[j]);         v[2 * j + 1] = wa * CB_HI(a0[j]) + wb * CB_HI(b0[j]) + wc * CB_HI(c0[j]) + wd * CB_HI(d0[j]);
        v[8 + 2 * j] = wa * CB_LO(a1[j]) + wb * CB_LO(b1[j]) + wc * CB_LO(c1[j]) + wd * CB_LO(d1[j]);     v[9 + 2 * j] = wa * CB_HI(a1[j]) + wb * CB_HI(b1[j]) + wc * CB_HI(c1[j]) + wd * CB_HI(d1[j]);
        gt[2 * j] = CB_LO(g0[j]); gt[2 * j + 1] = CB_HI(g0[j]); gt[8 + 2 * j] = CB_LO(g1[j]); gt[9 + 2 * j] = CB_HI(g1[j]);
    }
#undef CB_LO
#undef CB_HI
    float ss = 0.f;
#pragma unroll
    for (int i = 0; i < 16; ++i) ss = fmaf(v[i], v[i], ss);
    ss += __shfl_xor(ss, 1); ss += __shfl_xor(ss, 2);
    const float r = rsqrtf(ss * (1.0f / 64.0f) + RMS_EPS);
    float o[16];
#pragma unroll
    for (int i = 0; i < 16; ++i) o[i] = v[i] * r * gain[lane * 16 + i] * (gt[i] / (1.0f + __expf(-gt[i])));
    u32x4 q0, q1;
    q0.x = cvtpk_s(o[0], o[1]); q0.y = cvtpk_s(o[2], o[3]); q0.z = cvtpk_s(o[4], o[5]); q0.w = cvtpk_s(o[6], o[7]);
    q1.x = cvtpk_s(o[8], o[9]); q1.y = cvtpk_s(o[10], o[11]); q1.z = cvtpk_s(o[12], o[13]); q1.w = cvtpk_s(o[14], o[15]);
    if (!is_s) { *(u32x4*)yp = q0; *(u32x4*)(yp + 8) = q1; }
}
__device__ __forceinline__ void layernorm_row(size_t row, int lane, float* __restrict__ z, bf16_t* __restrict__ xb, const float* __restrict__ lg, const float* __restrict__ lbias) {
    float4* zp = (float4*)(z + row * DM) + lane;
    float4 v[4]; float s = 0.f;
#pragma unroll
    for (int j = 0; j < 4; ++j) { v[j] = zp[64 * j]; s += (v[j].x + v[j].y) + (v[j].z + v[j].w); }
    const float mean = wave_sum(s) * (1.0f / DM); float q = 0.f;
#pragma unroll
    for (int j = 0; j < 4; ++j) { v[j].x -= mean; v[j].y -= mean; v[j].z -= mean; v[j].w -= mean; q += (v[j].x * v[j].x + v[j].y * v[j].y) + (v[j].z * v[j].z + v[j].w * v[j].w); }
    const float rstd = rsqrtf(wave_sum(q) * (1.0f / DM) + LN_EPS);
#pragma unroll
    for (int j = 0; j < 4; ++j) {
        const float4 gg = ((const float4*)lg)[lane + 64 * j], bb = ((const float4*)lbias)[lane + 64 * j];
        float4 o; o.x = v[j].x * rstd * gg.x + bb.x; o.y = v[j].y * rstd * gg.y + bb.y; o.z = v[j].z * rstd * gg.z + bb.z; o.w = v[j].w * rstd * gg.w + bb.w;
        zp[64 * j] = o;
        uint2 ob; ob.x = pk2(o.x, o.y); ob.y = pk2(o.z, o.w);
        ((uint2*)(xb + row * DM))[lane + 64 * j] = ob;
    }
}

struct PrepPtrs { const float *w_in, *w_out, *glu_w, *a_re, *a_im, *log_dt, *b_re, *b_im, *c_re, *c_im, *dskip; unsigned char* ws; };
__device__ __forceinline__ void prep_layer(LAS unsigned char* ldsl, PrepPtrs p, int l, int bxr, int nbr) {
    const int lane = lane_id_opaque(), wave = __builtin_amdgcn_readfirstlane((int)threadIdx.x >> 6), tid = wave * 64 + lane;
    LAS float* scr = (LAS float*)(ldsl + wave * 16384);
    constexpr int I_IN = (DM / 64) * (NIN / 32), I_OUT = (DM / 64) * (DM / 32), I_GLU = (BW / 64) * (BW / 32), I_L = I_IN + I_OUT + I_GLU;
    for (int it = bxr * NWAVES + wave; it < I_L; it += nbr * NWAVES) { int r = it;
        if (r < I_IN) { p0_transpose_item(p.w_in + (size_t)l * DM * NIN, DM, NIN, (bf16_t*)(p.ws + WS_WTIN) + (size_t)l * NIN * DM, scr, r, lane); continue; } r -= I_IN;
        if (r < I_OUT) { p0_transpose_item(p.w_out + (size_t)l * DM * DM, DM, DM, (bf16_t*)(p.ws + WS_WTOUT) + (size_t)l * DM * DM, scr, r, lane); continue; } r -= I_OUT;
        p0_transpose_item(p.glu_w + (size_t)l * BW * BW, BW, BW, (bf16_t*)(p.ws + WS_GLUWT) + (size_t)l * BW * BW, scr, r, lane); }
    for (int e = l * 65536 + bxr * 512 + tid; e < (l + 1) * 65536; e += nbr * 512)
        s5::tables_thread(e, p.a_re, p.a_im, p.log_dt, p.b_re, p.b_im, p.c_re, p.c_im, (bf16_t*)(p.ws + WS_W1), (bf16_t*)(p.ws + WS_W3), (float*)(p.ws + WS_SMALL) + SM_A64);
    for (int it = l * 1024 + bxr; it < (l + 1) * 1024; it += nbr)
        s5::kmat_item((LAS float*)ldsl, tid, it, p.a_re, p.a_im, p.log_dt, p.b_re, p.b_im, p.c_re, p.c_im, p.dskip, (bf16_t*)(p.ws + WS_KM));
}

#define OPQS(x) asm volatile("" : "+s"(x))
#define OPQ(x) asm volatile("" : "+v"(x))
__global__ void __launch_bounds__(NWAVES * 64, 2) mega_fwd(Args args) {
    extern __shared__ __attribute__((aligned(16))) unsigned char lds[];
#define LANE_ID() ({ unsigned z_ = 0u; asm volatile("" : "+v"(z_)); (int)__builtin_amdgcn_mbcnt_hi(~0u, __builtin_amdgcn_mbcnt_lo(~0u, z_)); })
#define TID_() (wave * 64 + LANE_ID())
#define tid_ TID_()
#define lane_ LANE_ID()
    const int wave = __builtin_amdgcn_readfirstlane((int)threadIdx.x >> 6);
    const int G = gridDim.x, bx = blockIdx.x, bx_ = bx;
    LAS unsigned char* ldsl = (LAS unsigned char*)lds;
    volatile LAS unsigned* MISC = (volatile LAS unsigned*)(ldsl + MISC_OFF);
    for (int u = tid_; u < (LDS_BYTES - RING_BYTES) / 4; u += NWAVES * 64) ((LAS unsigned*)(ldsl + RING_BYTES))[u] = 0u;
    __syncthreads();
    const XcdBarrier bar = xcd_barrier_post((unsigned*)(args.ws + WS_CTL) + CW_BAR, MISC + 8);
    const int gw = bx * NWAVES + wave, NGW = G * NWAVES;
#ifdef PROBE_A
#define STAMP(k) do { if (bx_ == 0 && threadIdx.x == 0) MISC[16 + (k)] = (unsigned)__builtin_amdgcn_s_memrealtime(); } while (0)
#else
#define STAMP(k) do { } while (0)
#endif
#define SUBSTAMP(k) STAMP(32 + (k))
    int stamp_i = 0;
#define GRID_BAR() do { GRID_BAR0(); ++stamp_i; STAMP(stamp_i); } while (0)
    constexpr int DIL_QA = 384, DIL_QB = 1024;
#define DIL_UNIT(park_, tidq_, ug_, ws_) do { const int ug__ = (ug_); fa2::dilated_unit(park_, ldsl, tidq_, 2 - ug__ / 512, (ug__ >> 5) & 15, ug__ & 31, (const bf16_t*)((ws_) + WS_PROJ), (const float*)((ws_) + WS_SMALL) + SM_LUTD, (bf16_t*)((ws_) + WS_PO), (float*)((ws_) + WS_PL)); } while (0)
#define DIL_FILL(wqp_, lo_, hi_, ws_) do { unsigned* wq__ = (wqp_); const int tid__ = wave * 64 + LANE_ID(); __syncthreads(); \
        if (tid__ == 0) MISC[4] = __hip_atomic_fetch_add(wq__, 1u, __ATOMIC_RELAXED, __HIP_MEMORY_SCOPE_AGENT); \
        for (;;) { __syncthreads(); const int it__ = (int)MISC[4]; if (it__ >= (hi_) - (lo_)) break; unsigned nxt__ = 0u; int tidq__ = tid__; OPQ(tidq__); \
            if (tidq__ == 0) nxt__ = __hip_atomic_fetch_add(wq__, 1u, __ATOMIC_RELAXED, __HIP_MEMORY_SCOPE_AGENT); \
            auto park__ = [&]() { if (tidq__ == 0) MISC[4] = nxt__; }; DIL_UNIT(park__, tidq__, (lo_) + it__, ws_); } } while (0)
#define GRID_BAR0() do { XcdBarrier b_ = bar; unsigned x_ = b_.x; unsigned* p_ = b_.bar; asm volatile("" : "+s"(x_), "+s"(p_)); b_.x = x_; b_.bar = p_; xcd_barrier(b_); } while (0)

    STAMP(0);
    {
        const Args* A = &args; unsigned char* ws = launder_g(args.ws);
        int lane = lane_, tid = tid_; OPQ(lane); OPQ(tid);
        const float* x = A->in[0]; const float* w_in = A->in[1]; const float* glu_w = A->in[11]; const float* w_out = A->in[15];
        bf16_t* wtin = (bf16_t*)(ws + WS_WTIN); bf16_t* wtout = (bf16_t*)(ws + WS_WTOUT); bf16_t* gluwt = (bf16_t*)(ws + WS_GLUWT); bf16_t* xb = (bf16_t*)(ws + WS_XB);
        { PrepPtrs pp{A->in[1], A->in[15], A->in[11], A->in[3], A->in[4], A->in[5], A->in[6], A->in[7], A->in[8], A->in[9], A->in[10], ws}; prep_layer(ldsl, pp, 0, bx, G); prep_layer(ldsl, pp, 1, bx, G); }
        SUBSTAMP(8);
        for (size_t i = (size_t)bx * 512 + tid; i < (size_t)M * DM / 4; i += (size_t)G * 512 * 8) {
            float4 v[8];
#pragma unroll
            for (int j = 0; j < 8; ++j) v[j] = ((const float4*)x)[i + (size_t)j * G * 512];
            __builtin_amdgcn_sched_barrier(0);
#pragma unroll
            for (int j = 0; j < 8; ++j) { uint2 o; o.x = cvtpk_s(v[j].x, v[j].y); o.y = cvtpk_s(v[j].z, v[j].w); ((uint2*)xb)[i + (size_t)j * G * 512] = o; }
        }
        SUBSTAMP(9);
        if (bx < 8 && tid < 256) prep_small(bx * 256 + tid, A->in[3], A->in[4], A->in[5], A->in[6], A->in[7], A->in[13], (float*)(ws + WS_SMALL));
        if (bx == 8) { float* smc = (float*)(ws + WS_SMALL);
            for (int i = tid; i < 256; i += 512) smc[SM_RELB + i] = A->in[2][i];
            for (int i = tid; i < 512; i += 512) smc[SM_GLUB + i] = A->in[12][i];
            for (int i = tid; i < 2048; i += 512) { smc[SM_GAIN + i] = A->in[14][i]; smc[SM_LNG + i] = A->in[16][i]; smc[SM_LNB + i] = A->in[17][i]; } }
        if (bx == 9) { float* smc = (float*)(ws + WS_SMALL); const float* rb = A->in[2];
            for (int i = tid; i < 4 * 1888; i += 512) { const int h = i / 1888, dd = i % 1888 - 96; smc[SM_LUTM + i] = dd >= 0 ? rb[t5_bucket(dd) * 8 + h] * 1.4426950408889634f : NEGF; }
            for (int i = tid; i < 3 * 4 * 256; i += 512) { const int pi = i >> 10, h = (i >> 8) & 3, dd = (i & 255) - 64, dil = (pi == 0) ? 1 : (pi == 1) ? 4 : 16;
                smc[SM_LUTD + i] = (dd >= 0 && dd <= 128) ? rb[t5_bucket(dd * dil) * 8 + 4 + h] * 1.4426950408889634f : NEGF; } }
    }
    GRID_BAR();

    auto layer_body = [&](auto LC) __attribute__((always_inline)) { constexpr int l = decltype(LC)::value;
        {
            const Args* A = &args; unsigned char* ws = launder_g(args.ws);
            pg8::Gemm g{(const bf16_t*)(ws + WS_XB), (const bf16_t*)(ws + WS_WTIN) + (size_t)l * NIN * DM, M, NIN, DM}; int tidg = tid_, bxg = bx; OPQ(tidg); OPQS(bxg); pg8::StaticOrder S; S.init(M, NIN, G, bxg);
            pg8::EpiStoreBf16 E{(bf16_t*)(ws + WS_PROJ), NIN, (float*)(ws + WS_KP)};
            pg8::gemm_phase<pg8::EpiStoreBf16, pg8::StaticOrder, true, true>(ldsl, g, S, E, tidg);
        }
        GRID_BAR();
        {
            const Args* A = &args; unsigned char* ws = launder_g(args.ws);
            const bf16_t* proj = (const bf16_t*)(ws + WS_PROJ);
            int lane = lane_; OPQ(lane); const int tid = wave * 64 + lane;
            const float* lbp = (const float*)(ws + WS_SMALL) + SM_LB + l * 256;
            unsigned* wq = (unsigned*)(ws + WS_CTL) + CW_WQ + 64 * l;
            for (int it = gw; it < 2048; it += NGW) hw::x1_wave(ldsl + wave * 16384, lane, it, proj, lbp, (float*)(ws + WS_DS), (float*)(ws + WS_DEC));
            SUBSTAMP(0);
            for (int wi = gw; wi < 512; wi += NGW) s5::x1_wave(lane, wi & 15, wi >> 4, l * 16 + (wi & 15), proj, (const bf16_t*)(ws + WS_W1), (float*)(ws + WS_HEND));
            SUBSTAMP(1);
            constexpr int N_GATE = 512;
            __syncthreads();
            if (tid == 0) MISC[4] = __hip_atomic_fetch_add(wq, 1u, __ATOMIC_RELAXED, __HIP_MEMORY_SCOPE_AGENT);
            for (;;) {
                __syncthreads();
                const int it = (int)MISC[4];
                if (it >= N_GATE) break;
                int tidq = tid; OPQ(tidq);
                __syncthreads();
                if (tidq == 0) MISC[4] = __hip_atomic_fetch_add(wq, 1u, __ATOMIC_RELAXED, __HIP_MEMORY_SCOPE_AGENT);
                fa2::gate_item(ldsl, tidq, it & 15, 31 - (it >> 4), proj, (const float*)(ws + WS_KP), (unsigned short*)(ws + WS_LIST), (int*)(ws + WS_CNT));
            }
            SUBSTAMP(2);
            DIL_FILL((unsigned*)(ws + WS_CTL) + CW_WQ + 64 * (4 + l), 0, DIL_QA, ws);
            SUBSTAMP(7);
        }
        GRID_BAR();
        {
            const Args* A = &args; unsigned char* ws = launder_g(args.ws);
            const bf16_t* proj = (const bf16_t*)(ws + WS_PROJ); const float* sm = (const float*)(ws + WS_SMALL);
            int lane = lane_; OPQ(lane);
            int bx = bx_; OPQS(bx);
            const int tid = wave * 64 + lane;
            if (bx < 32) hg::x2_scan(bx * 512 + tid, 32 * 512, (const float*)(ws + WS_DS), (const float*)(ws + WS_DEC), (bf16_t*)(ws + WS_ST));
            else if (bx < 40) s5::x2_scan((bx - 32) * 512 + tid, (const float*)(ws + WS_HEND), sm + SM_A64, (bf16_t*)(ws + WS_HST), l);
            unsigned* wq = (unsigned*)(ws + WS_CTL) + CW_WQ + 64 * (2 + l);
            const float* lutm = sm + SM_LUTM; const float* lutd = sm + SM_LUTD;
            __syncthreads();
            if (tid == 0) MISC[4] = __hip_atomic_fetch_add(wq, 1u, __ATOMIC_RELAXED, __HIP_MEMORY_SCOPE_AGENT);
            for (;;) {
                __syncthreads();
                int it = (int)MISC[4];
                constexpr int N_MOBA = 8 * 64 + 12 * 32 + 12 * 16, N_DIL = DIL_QB - DIL_QA;
                if (it >= N_MOBA + N_DIL) break;
                unsigned nxt = 0u;
                if (tid == 0) nxt = __hip_atomic_fetch_add(wq, 1u, __ATOMIC_RELAXED, __HIP_MEMORY_SCOPE_AGENT);
                int tidq = tid; OPQ(tidq);
                auto park = [&]() { if (tidq == 0) MISC[4] = nxt; };
                if (it < N_MOBA) {
                    int n, part, np;
                    if (it < 512) { n = it >> 6; part = (it >> 4) & 3; np = 4; } else if (it < 896) { const int j = it - 512; n = 8 + (j >> 5); part = (j >> 4) & 1; np = 2; } else { n = 20 + ((it - 896) >> 4); part = 0; np = 1; }
                    fa2::moba_item(park, ldsl, tidq, it & 15, n, part, np, proj, sm + SM_RELB, lutm, (const unsigned short*)(ws + WS_LIST), (const int*)(ws + WS_CNT), (bf16_t*)(ws + WS_PARTO), (float*)(ws + WS_PARTML), (bf16_t*)(ws + WS_Y));
                } else DIL_UNIT(park, tidq, DIL_QA + it - N_MOBA, ws);
            }
            SUBSTAMP(5);
        }
        GRID_BAR();
        {
            const Args* A = &args; unsigned char* ws = launder_g(args.ws);
            int lane = lane_; OPQ(lane);
            const float* lbp = (const float*)(ws + WS_SMALL) + SM_LB + l * 256;
            for (int it = bx; it < 512; it += G) s5::x3_item(ldsl, wave, lane, it, l, (const bf16_t*)(ws + WS_PROJ), (const bf16_t*)(ws + WS_KM), (const bf16_t*)(ws + WS_W3), (const bf16_t*)(ws + WS_HST), (bf16_t*)(ws + WS_YBPRE));
            __syncthreads(); SUBSTAMP(3);
            for (int it = gw; it < 2048; it += NGW) hw::x3_wave(ldsl + wave * 16384, lane, it, (const bf16_t*)(ws + WS_PROJ), lbp, (const bf16_t*)(ws + WS_ST), (bf16_t*)(ws + WS_Y));
            SUBSTAMP(4);
            DIL_FILL((unsigned*)(ws + WS_CTL) + CW_WQ + 64 * (6 + l), DIL_QB, 1536, ws);
            SUBSTAMP(6);
        }
        GRID_BAR();
        {
            const Args* A = &args; unsigned char* ws = launder_g(args.ws);
            {
                const bf16_t* ybpre = (const bf16_t*)(ws + WS_YBPRE);
                pg8::Gemm g{ybpre, (const bf16_t*)(ws + WS_GLUWT) + (size_t)l * BW * BW, M, BW, BW}; int tidg = tid_, bxg = bx; OPQ(tidg); OPQS(bxg); pg8::StaticOrder S; S.init(M, BW, G, bxg);
                const float* smp = (const float*)(ws + WS_SMALL);
                pg8::EpiGluNorm E{(bf16_t*)(ws + WS_Y), ybpre, (const bf16_t*)(ws + WS_PROJ), smp + SM_GLUB + l * BW, smp + SM_GAIN + l * DM, ldsl + RING_BYTES + 1024};
                pg8::gemm_phase<pg8::EpiGluNorm, pg8::StaticOrder, true, false>(ldsl, g, S, E, tidg);
            }
            {
                int lane = lane_; OPQ(lane);
                unsigned* wq = (unsigned*)(ws + WS_CTL) + CW_WQ + 64 * (8 + l);
                for (;;) {
                    __syncthreads();
                    if (wave == 0 && lane == 0) MISC[4] = __hip_atomic_fetch_add(wq, 1u, __ATOMIC_RELAXED, __HIP_MEMORY_SCOPE_AGENT);
                    __syncthreads();
                    const int ch = (int)MISC[4];
                    if (ch >= M / 64) break;
                    for (int r = 0; r < 8; ++r) combine_row((size_t)ch * 64 + wave * 8 + r, lane, (bf16_t*)(ws + WS_Y), (const bf16_t*)(ws + WS_PROJ), (const float*)(ws + WS_SMALL) + SM_GAIN + l * DM, (const bf16_t*)(ws + WS_PO), (const float*)(ws + WS_PL), (const bf16_t*)(ws + WS_PARTO), (const float*)(ws + WS_PARTML), (const bf16_t*)(ws + WS_YBPRE), (const float*)(ws + WS_SMALL) + SM_GLUB + l * BW);
                }
            }
        }
        GRID_BAR();
        {
            const Args* A = &args; unsigned char* ws = launder_g(args.ws);
            pg8::Gemm g{(const bf16_t*)(ws + WS_Y), (const bf16_t*)(ws + WS_WTOUT) + (size_t)l * DM * DM, M, DM, DM}; int tidg = tid_, bxg = bx; OPQ(tidg); OPQS(bxg); pg8::StaticOrder S; S.init(M, DM, G, bxg);
            const float* smp = (const float*)(ws + WS_SMALL);
            float* outp = launder_g(args.out); const float* resp = launder_g(args.in[0]);
            pg8::EpiResLn E{l == 0 ? resp : outp, outp, (bf16_t*)(ws + WS_XB), smp + SM_LNG + l * DM, smp + SM_LNB + l * DM, (unsigned long long*)(ws + WS_YBPRE), (unsigned*)(ws + WS_CTL) + CW_SEAM + l * 128 * 64, ldsl + RING_BYTES + 1024};
            pg8::gemm_phase<pg8::EpiResLn, pg8::StaticOrder, true, true>(ldsl, g, S, E, tidg);
        }
        if (l + 1 < DEPTH) GRID_BAR();
    };
    layer_body(std::integral_constant<int, 0>{});
    layer_body(std::integral_constant<int, 1>{});
#ifdef PROBE_A
    ++stamp_i; STAMP(stamp_i);
    if (bx_ == 0 && threadIdx.x == 0) { asm volatile("s_waitcnt vmcnt(0) lgkmcnt(0)" ::: "memory"); args.out[0] += (float)(MISC[16 + PROBE_B] - MISC[16 + PROBE_A]) * 1e-3f; }
#endif
}

extern "C" void kernel_launch(void* const* d_in, const int* in_sizes, int n_in, void* d_out, int out_size, void* d_ws, size_t ws_size, hipStream_t stream) {
    static int grid = 0;
    if (grid == 0) {
        if (n_in != 18 || in_sizes[0] != M * DM || out_size != M * DM || ws_size < WS_END) { fprintf(stderr, "kernel_launch: unexpected shapes (n_in %d, in0 %d, out %d, ws %zu)\n", n_in, n_in > 0 ? in_sizes[0] : -1, out_size, ws_size); grid = -1; return; }
        int dev = 0, cus = 0, per_cu = 0;
        if (hipGetDevice(&dev) != hipSuccess || hipDeviceGetAttribute(&cus, hipDeviceAttributeMultiprocessorCount, dev) != hipSuccess) { grid = -1; return; }
        if (hipFuncSetAttribute((const void*)mega_fwd, hipFuncAttributeMaxDynamicSharedMemorySize, LDS_BYTES) != hipSuccess) { fprintf(stderr, "kernel_launch: hipFuncSetAttribute failed\n"); grid = -1; return; }
        if (hipOccupancyMaxActiveBlocksPerMultiprocessor(&per_cu, (const void*)mega_fwd, NWAVES * 64, LDS_BYTES) != hipSuccess || per_cu < 1) { fprintf(stderr, "kernel_launch: occupancy query says %d\n", per_cu); }
        (void)hipGetLastError();
        grid = cus;
    }
    if (grid < 0) return;
    if (hipMemsetAsync((char*)d_ws + WS_CTL, 0, CTL_ZERO_BYTES, stream) != hipSuccess) return;
    Args a{};
    for (int i = 0; i < 18; ++i) a.in[i] = (const float*)d_in[i];
    a.out = (float*)d_out; a.ws = (unsigned char*)d_ws;
    hipLaunchKernelGGL(mega_fwd, dim3(grid), dim3(NWAVES * 64), LDS_BYTES, stream, a);
}
```

```cpp
#include <hip/hip_runtime.h>
#include <stdint.h>
#include <cstdio>
#include <type_traits>

typedef unsigned short bf16_t;
typedef unsigned u32x4 __attribute__((ext_vector_type(4)));
#define LAS __attribute__((address_space(3)))
#define GAS __attribute__((address_space(1)))

constexpr int BATCH = 4, SEQ = 8192, DM = 1024, M = BATCH * SEQ, BW = 256, NIN = 3584, HD = 64, DEPTH = 2;
constexpr int COL_QA = 0, COL_KA = 256, COL_VA = 512, COL_U = 768, COL_QC = 1024, COL_FC = 1280, COL_IC = 1536, COL_QD = 1792, COL_KD = 2048, COL_VD = 2304, COL_G = 2560;
constexpr float ALPHA = 1.4142135623730951f;
constexpr float LN_EPS = 1e-5f, RMS_EPS = 1e-6f, NEGF = -1e30f;

constexpr size_t MiB = 1u << 20;
constexpr size_t WS_CTL = 0, CTL_ZERO_BYTES = 1 * MiB;
constexpr size_t WS_SMALL = 1 * MiB;
constexpr size_t WS_WTIN = 2 * MiB;
constexpr size_t WS_WTOUT = 16 * MiB;
constexpr size_t WS_GLUWT = 20 * MiB;
constexpr size_t WS_KP = 21 * MiB;
constexpr size_t WS_XB = 22 * MiB;
constexpr size_t WS_PARTO = WS_XB;
constexpr size_t WS_PARTML = WS_XB + 48 * MiB;
constexpr size_t WS_LIST = WS_XB + 52 * MiB;
constexpr size_t WS_CNT = WS_XB + 60 * MiB;
constexpr size_t WS_PROJ = 86 * MiB;
constexpr size_t WS_Y = 310 * MiB;
constexpr size_t WS_YBPRE = 374 * MiB;
constexpr size_t WS_PO = 390 * MiB;
constexpr size_t WS_PL = 438 * MiB;
constexpr size_t WS_DS = 440 * MiB;
constexpr size_t WS_ST = 472 * MiB;
constexpr size_t WS_DEC = 488 * MiB;
constexpr size_t WS_KM = 489 * MiB;
constexpr size_t WS_W1 = 490 * MiB;
constexpr size_t WS_W3 = 498 * MiB;
constexpr size_t WS_HEND = 506 * MiB;
constexpr size_t WS_HST = 510 * MiB;
constexpr size_t WS_END = 512 * MiB;
constexpr int SM_LB = 0;
constexpr int SM_ABAR = 512;
constexpr int SM_BBAR = SM_ABAR + 2 * 16 * 64 * 2;
constexpr int SM_A64 = SM_BBAR + 2 * 16 * 64 * 16 * 2;
constexpr int SM_RELB = SM_A64 + 2 * 16 * 64 * 2, SM_GLUB = SM_RELB + 256, SM_GAIN = SM_GLUB + 512, SM_LNG = SM_GAIN + 2048, SM_LNB = SM_LNG + 2048, SM_END = SM_LNB + 2048;
constexpr int SM_LUTM = SM_END, SM_LUTD = SM_LUTM + 4 * 1888, SM_END2 = SM_LUTD + 3 * 4 * 256;
constexpr int CW_BAR = 4096;
constexpr int CW_SEAM = 32768;
constexpr int CW_WQ = 16384;

__device__ __forceinline__ float bf2f(bf16_t v) { return __uint_as_float(((unsigned)v) << 16); }

__device__ __forceinline__ float wave_max(float v) {
#pragma unroll
    for (int o = 1; o < 64; o <<= 1) v = fmaxf(v, __shfl_xor(v, o));
    return v;
}
__device__ __forceinline__ float wave_sum(float v) {
#pragma unroll
    for (int o = 1; o < 64; o <<= 1) v += __shfl_xor(v, o);
    return v;
}
__device__ __forceinline__ int t5_bucket(int d) {
    if (d < 16) return d;
    int b = 16;
    b += (d >= 22); b += (d >= 30); b += (d >= 40); b += (d >= 54); b += (d >= 73); b += (d >= 99); b += (d >= 134); b += (d >= 182);
    b += (d >= 246); b += (d >= 332); b += (d >= 450); b += (d >= 609); b += (d >= 825); b += (d >= 1117); b += (d >= 1513);
    return b;
}
__device__ __forceinline__ float sigmoidf_(float x) { return 1.0f / (1.0f + expf(-x)); }
__device__ __forceinline__ float siluf_(float x) { return x / (1.0f + expf(-x)); }
__device__ __forceinline__ float gelu_tanh(float x) { const float u = 0.7978845608028654f * (x + 0.044715f * x * x * x); return 0.5f * x * (1.0f + tanhf(u)); }
typedef float f32x2_t __attribute__((ext_vector_type(2))); typedef __bf16 bf16x2_t __attribute__((ext_vector_type(2)));
__device__ __forceinline__ unsigned cvtpk_s(float lo, float hi) { f32x2_t v = {lo, hi}; bf16x2_t b = __builtin_convertvector(v, bf16x2_t); return __builtin_bit_cast(unsigned, b); }
__device__ __forceinline__ bf16_t f2bf(float f) { return (bf16_t)(cvtpk_s(f, f) & 0xffffu); }
__device__ __forceinline__ unsigned pk2(float lo, float hi) { return cvtpk_s(lo, hi); }
__device__ __forceinline__ int lane_id_opaque() { unsigned z = 0u; asm volatile("" : "+v"(z)); return (int)__builtin_amdgcn_mbcnt_hi(~0u, __builtin_amdgcn_mbcnt_lo(~0u, z)); }
template <class T> __device__ __forceinline__ T* launder_g(T* p) { unsigned long long v = (unsigned long long)p; asm volatile("" : "+s"(v)); return (T*)(__attribute__((address_space(1))) T*)v; }
#define WSYNC() asm volatile("s_waitcnt lgkmcnt(0)" ::: "memory")

__device__ __forceinline__ void sincos_d(double th, double& s, double& c) {
    const double k = rint(th * 0.63661977236758134308);
    double r = fma(-k, 1.57079632679489655800, th); r = fma(-k, 6.12323399573676603587e-17, r);
    const long q = ((long)k) & 3;
    const double r2 = r * r;
    const double sp = r * (1.0 + r2 * (-1.0 / 6 + r2 * (1.0 / 120 + r2 * (-1.0 / 5040 + r2 * (1.0 / 362880 + r2 * (-1.0 / 39916800 + r2 * (1.0 / 6227020800.0 + r2 * (-1.0 / 1307674368000.0))))))));
    const double cp = 1.0 + r2 * (-0.5 + r2 * (1.0 / 24 + r2 * (-1.0 / 720 + r2 * (1.0 / 40320 + r2 * (-1.0 / 3628800 + r2 * (1.0 / 479001600.0 + r2 * (-1.0 / 87178291200.0 + r2 * (1.0 / 20922789888000.0))))))));
    if (q == 0) { s = sp; c = cp; } else if (q == 1) { s = cp; c = -sp; } else if (q == 2) { s = -sp; c = -cp; } else { s = -cp; c = sp; }
}

namespace pg8 {
#define PG8_LAS __attribute__((address_space(3)))
typedef unsigned short bf16_t;
typedef short bf16x8 __attribute__((ext_vector_type(8)));
typedef float f32x4 __attribute__((ext_vector_type(4)));
typedef unsigned u32x4 __attribute__((ext_vector_type(4)));
constexpr int BM = 256, BK = 64, HALF = 128, HTB = HALF * BK * 2  , STAGE_BYTES = 8 * HTB, NXCD = 8, WGM = 8;

__host__ __device__ __forceinline__ int lds_byte(int r, int c) { const int st = (r >> 4) * 2 + (c >> 5), rr = r & 15, cc = c & 31, ob = rr * 64 + cc * 2; return st * 1024 + (ob ^ (((ob >> 9) & 1) << 5)); }
__host__ __device__ __forceinline__ void stage_rc(int b, int& R, int& C) { const int st = b / 1024, sb = b % 1024, swz = sb ^ (((sb >> 9) & 1) << 5); R = (st >> 1) * 16 + swz / 64; C = (st & 1) * 32 + (swz % 64) / 2; }
__host__ __device__ __forceinline__ int perm32(int rho) { const int n = rho >> 4, i = rho & 15; return 8 * (i >> 2) + 4 * n + (i & 3); }

struct Unit { int pm, pn; };
struct Gemm { const bf16_t* A; const bf16_t* Bt; int M, N, K; };

struct StaticOrder {
    int nM, nN, nwg, G, c;
    __host__ __device__ void init(int M, int N, int G_, int c_) { nM = M / BM; nN = N / BM; nwg = nM * nN; G = G_; c = c_; }
    __host__ __device__ bool next(int i, Unit& u) const {
        const long L = (long)i * G + c; if (L >= nwg) return false;
        int wgid = (int)L; { const int q = nwg / NXCD, r = nwg % NXCD, xcd = wgid % NXCD, off = wgid / NXCD; wgid = (xcd < r ? xcd * (q + 1) : r * (q + 1) + (xcd - r) * q) + off; }
        const int nig = WGM * nN, gid = wgid / nig, fm = gid * WGM, gsz = (nM - fm) < WGM ? (nM - fm) : WGM;
        u.pm = fm + ((wgid % nig) % gsz); u.pn = (wgid % nig) / gsz; return true;
    }
    __device__ __forceinline__ void a_ready(const Unit&) const {}
    __device__ __forceinline__ void done(const Unit&) const {}
};

__device__ __forceinline__ unsigned cvt_pk_bf16(float lo, float hi) { unsigned r; asm volatile("v_cvt_pk_bf16_f32 %0, %1, %2" : "=v"(r) : "v"(lo), "v"(hi)); return r; }
struct EpiStoreBf16 {
    static constexpr bool PERM = true, AFTER_DRAIN = false;
    bf16_t* O; int ldc; float* kp;
    __device__ __forceinline__ void operator()(const f32x4 (&acc)[2][2][4][2], const Unit& u, int wr, int wc, int fr_, int fq_) const {
        const int ln_ = lane_id_opaque(), fr = ln_ & 15, fq = ln_ >> 4; (void)fr_; (void)fq_;
        const int row0 = u.pm * BM + wr * 64 + fr, col0 = u.pn * BM + wc * 32 + 8 * fq;
#pragma unroll
        for (int ai = 0; ai < 2; ++ai)
#pragma unroll
            for (int m = 0; m < 4; ++m) { bf16_t* rowp = O + (size_t)(row0 + ai * HALF + m * 16) * ldc + col0;
#pragma unroll
                for (int bj = 0; bj < 2; ++bj) { const f32x4 v0 = acc[ai][bj][m][0], v1 = acc[ai][bj][m][1];
                    u32x4 w; w.x = cvtpk_s(v0[0], v0[1]); w.y = cvtpk_s(v0[2], v0[3]); w.z = cvtpk_s(v1[0], v1[1]); w.w = cvtpk_s(v1[2], v1[3]);
                    *(u32x4*)(rowp + bj * HALF) = w; } }
        if (kp && u.pn == 1) {
#pragma unroll
            for (int bj = 0; bj < 2; ++bj)
#pragma unroll
                for (int n = 0; n < 2; ++n) { f32x4 s = {0.f, 0.f, 0.f, 0.f};
#pragma unroll
                    for (int ai = 0; ai < 2; ++ai)
#pragma unroll
                        for (int m = 0; m < 4; ++m) s += acc[ai][bj][m][n];
#pragma unroll
                    for (int o = 1; o < 16; o <<= 1) { s[0] += __shfl_xor(s[0], o); s[1] += __shfl_xor(s[1], o); s[2] += __shfl_xor(s[2], o); s[3] += __shfl_xor(s[3], o); }
                    if (fr == 0) *(f32x4*)(kp + (size_t)(u.pm * 2 + wr) * 256 + bj * HALF + wc * 32 + 8 * fq + 4 * n) = s; }
        }
    }
};
struct EpiGlu {
    static constexpr bool PERM = true, AFTER_DRAIN = false;
    bf16_t* O; int ldc; const bf16_t* Ain; int lda; const float* bias;
    __device__ __forceinline__ void operator()(const f32x4 (&acc)[2][2][4][2], const Unit& u, int wr, int wc, int fr_, int fq_) const {
        const int ln_ = lane_id_opaque(), fr = ln_ & 15, fq = ln_ >> 4; (void)fr_; (void)fq_;
        const int row0 = u.pm * BM + wr * 64 + fr, col0 = u.pn * BM + wc * 32 + 8 * fq;
        bf16_t* O = launder_g(this->O); const bf16_t* Ain = launder_g(this->Ain); const float* bias = launder_g(this->bias);
#pragma unroll
        for (int ai = 0; ai < 2; ++ai)
#pragma unroll
            for (int m = 0; m < 4; ++m) { const size_t r = (size_t)(row0 + ai * HALF + m * 16);
#pragma unroll
                for (int bj = 0; bj < 2; ++bj) { const int c = col0 + bj * HALF;
                    const u32x4 av = *(const u32x4*)(Ain + r * lda + c);
                    const f32x4 b0 = *(const f32x4*)(bias + c), b1 = *(const f32x4*)(bias + c + 4);
                    const f32x4 v0 = acc[ai][bj][m][0] + b0, v1 = acc[ai][bj][m][1] + b1;
                    float o[8];
#pragma unroll
                    for (int j = 0; j < 4; ++j) { const float alo = __uint_as_float(av[j] << 16), ahi = __uint_as_float(av[j] & 0xffff0000u);
                        const float s0 = (j < 2) ? v0[2 * j] : v1[2 * j - 4], s1 = (j < 2) ? v0[2 * j + 1] : v1[2 * j - 3];
                        o[2 * j] = alo * __builtin_amdgcn_rcpf(1.0f + __expf(-s0)); o[2 * j + 1] = ahi * __builtin_amdgcn_rcpf(1.0f + __expf(-s1)); }
                    u32x4 w; w.x = cvtpk_s(o[0], o[1]); w.y = cvtpk_s(o[2], o[3]); w.z = cvtpk_s(o[4], o[5]); w.w = cvtpk_s(o[6], o[7]);
                    *(u32x4*)(O + r * ldc + c) = w; } }
    }
};
struct EpiResF32 {
    static constexpr bool PERM = false, AFTER_DRAIN = false;
    const float* res; float* out;
    __device__ __forceinline__ void operator()(const f32x4 (&acc)[2][2][4][2], const Unit& u, int wr, int wc, int fr_, int fq_) const {
        const int ln_ = lane_id_opaque(), fr = ln_ & 15, fq = ln_ >> 4; (void)fr_; (void)fq_;
        const int col0 = u.pn * BM + wc * 32 + 4 * fq;
#pragma unroll
        for (int ai = 0; ai < 2; ++ai)
#pragma unroll
            for (int m = 0; m < 4; ++m) { const size_t off = (size_t)(u.pm * BM + ai * HALF + wr * 64 + m * 16 + fr) * 1024 + col0;
#pragma unroll
                for (int bj = 0; bj < 2; ++bj)
#pragma unroll
                    for (int n = 0; n < 2; ++n) { const f32x4 rv = *(const f32x4*)(res + off + bj * HALF + n * 16);
                        *(f32x4*)(out + off + bj * HALF + n * 16) = rv * 1.4142135623730951f + acc[ai][bj][m][n]; } }
    }
};

struct EpiResLn {
    static constexpr bool PERM = false, AFTER_DRAIN = false;
    const float* res; float* out; bf16_t* xb; const float* gam; const float* bet; unsigned long long* xbuf; unsigned* cnt; PG8_LAS unsigned char* tbl;
    __device__ __forceinline__ void operator()(f32x4 (&acc)[2][2][4][2], const Unit& u, int wr, int wc, int fr_, int fq_) const {
        typedef float f32x2v __attribute__((ext_vector_type(2)));
        const int lane = lane_id_opaque(), fr = lane & 15, fq = lane >> 4; (void)fr_; (void)fq_;
        const int wid = wr * 4 + wc;
        const int col0 = u.pn * BM + wc * 32 + 4 * fq;
        PG8_LAS f32x2v* Pt = (PG8_LAS f32x2v*)tbl;
        PG8_LAS f32x2v* St = (PG8_LAS f32x2v*)(tbl + 8192);
#pragma unroll
        for (int ai = 0; ai < 2; ++ai)
#pragma unroll
            for (int m = 0; m < 4; ++m) {
                const size_t off = (size_t)(u.pm * BM + ai * HALF + wr * 64 + m * 16 + fr) * 1024 + col0;
                f32x4 rv[2][2];
#pragma unroll
                for (int bj = 0; bj < 2; ++bj)
#pragma unroll
                    for (int n = 0; n < 2; ++n) rv[bj][n] = *(const f32x4*)(res + off + bj * HALF + n * 16);
                float s = 0.f;
#pragma unroll
                for (int bj = 0; bj < 2; ++bj)
#pragma unroll
                    for (int n = 0; n < 2; ++n) { acc[ai][bj][m][n] = rv[bj][n] * 1.4142135623730951f + acc[ai][bj][m][n]; const f32x4 x = acc[ai][bj][m][n]; s += (x[0] + x[1]) + (x[2] + x[3]); }
                s += __shfl_xor(s, 16); s += __shfl_xor(s, 32);
                const float mw = s * (1.0f / 64.0f); float q = 0.f;
#pragma unroll
                for (int bj = 0; bj < 2; ++bj)
#pragma unroll
                    for (int n = 0; n < 2; ++n) { const f32x4 d = acc[ai][bj][m][n] - mw; q += (d[0] * d[0] + d[1] * d[1]) + (d[2] * d[2] + d[3] * d[3]); }
                q += __shfl_xor(q, 16); q += __shfl_xor(q, 32);
                if (fq == 0) Pt[(ai * HALF + wr * 64 + m * 16 + fr) * 4 + wc] = (f32x2v){mw, q};
            }
        asm volatile("s_waitcnt lgkmcnt(0)" ::: "memory"); __builtin_amdgcn_s_barrier(); asm volatile("" ::: "memory");
        const int row = wid * 32 + (lane & 31);
        unsigned* cw = cnt + 64 * u.pm;
        if (lane < 32) {
            const f32x2v a = Pt[row * 4 + 0], b2 = Pt[row * 4 + 1], c = Pt[row * 4 + 2], d = Pt[row * 4 + 3];
            const float mt = (a.x + b2.x + c.x + d.x) * 0.25f;
            const float da = a.x - mt, db = b2.x - mt, dc = c.x - mt, dd = d.x - mt;
            const float m2 = (a.y + b2.y) + (c.y + d.y) + 64.0f * ((da * da + db * db) + (dc * dc + dd * dd));
            __hip_atomic_store(xbuf + ((size_t)(u.pm * BM + row) * 4 + u.pn), ((unsigned long long)__float_as_uint(m2) << 32) | __float_as_uint(mt), __ATOMIC_RELAXED, __HIP_MEMORY_SCOPE_AGENT);
        }
        asm volatile("s_waitcnt vmcnt(0)" ::: "memory");
        if (lane == 0) __hip_atomic_fetch_add(cw, 1u, __ATOMIC_RELAXED, __HIP_MEMORY_SCOPE_AGENT);
        if (wid == 0) {
            unsigned sp = 0;
            while ((unsigned)__builtin_amdgcn_readfirstlane(__hip_atomic_load(cw, __ATOMIC_RELAXED, __HIP_MEMORY_SCOPE_AGENT)) < 32u) { __builtin_amdgcn_s_sleep(2); if (++sp > (1u << 22)) break; }
            __builtin_amdgcn_fence(__ATOMIC_ACQUIRE, "agent");
        }
        asm volatile("s_waitcnt vmcnt(0) lgkmcnt(0)" ::: "memory"); __builtin_amdgcn_s_barrier(); asm volatile("" ::: "memory");
        if (lane < 32) {
            const unsigned long long* slot = xbuf + (size_t)(u.pm * BM + row) * 4; float mt[4], m2[4]; float ms = 0.f;
#pragma unroll
            for (int t = 0; t < 4; ++t) { const unsigned long long w = __hip_atomic_load(slot + t, __ATOMIC_RELAXED, __HIP_MEMORY_SCOPE_AGENT); mt[t] = __uint_as_float((unsigned)w); m2[t] = __uint_as_float((unsigned)(w >> 32)); ms += mt[t]; }
            const float mean = ms * 0.25f; float q = 0.f;
#pragma unroll
            for (int t = 0; t < 4; ++t) { const float dm = mt[t] - mean; q += m2[t] + 256.0f * dm * dm; }
            St[row] = (f32x2v){mean, 1.0f / sqrtf(q * (1.0f / 1024.0f) + 1e-5f)};
        }
        asm volatile("s_waitcnt lgkmcnt(0)" ::: "memory"); __builtin_amdgcn_s_barrier(); asm volatile("" ::: "memory");
#pragma unroll
        for (int bj = 0; bj < 2; ++bj)
#pragma unroll
            for (int n = 0; n < 2; ++n) {
                const f32x4 gv = *(const f32x4*)(gam + col0 + bj * HALF + n * 16), bv = *(const f32x4*)(bet + col0 + bj * HALF + n * 16);
#pragma unroll
                for (int ai = 0; ai < 2; ++ai)
#pragma unroll
                    for (int m = 0; m < 4; ++m) { const int r = ai * HALF + wr * 64 + m * 16 + fr; const f32x2v sr = St[r]; const size_t off = (size_t)(u.pm * BM + r) * 1024 + col0 + bj * HALF + n * 16;
                        const f32x4 o = (acc[ai][bj][m][n] - sr.x) * sr.y * gv + bv;
                        *(f32x4*)(out + off) = o;
                        uint2 w; w.x = cvtpk_s(o[0], o[1]); w.y = cvtpk_s(o[2], o[3]); *(uint2*)(xb + off) = w; }
            }
    }
};

struct EpiGluNorm {
    static constexpr bool PERM = true, AFTER_DRAIN = false;
    bf16_t* Yo; const bf16_t* ybp; const bf16_t* proj; const float* bias; const float* gain; PG8_LAS unsigned char* tbl;
    __device__ __forceinline__ void operator()(f32x4 (&acc)[2][2][4][2], const Unit& u, int wr, int wc, int fr_, int fq_) const {
        const int lane = lane_id_opaque(), fr = lane & 15, fq = lane >> 4; (void)fr_; (void)fq_;
        bf16_t* Yo_ = launder_g(Yo); const bf16_t* ybp_ = launder_g(ybp); const bf16_t* proj_ = launder_g(proj); const float* bias_ = launder_g(bias); const float* gain_ = launder_g(gain);
        const int row0 = u.pm * BM + wr * 64 + fr, cw = wc * 32 + 8 * fq;
        PG8_LAS float* Pt = (PG8_LAS float*)tbl;
#pragma unroll
        for (int bj = 0; bj < 2; ++bj) {
            const int c = cw + bj * HALF;
            const f32x4 b0 = *(const f32x4*)(bias_ + c), b1 = *(const f32x4*)(bias_ + c + 4);
#pragma unroll
            for (int ai = 0; ai < 2; ++ai)
#pragma unroll
                for (int m = 0; m < 4; ++m) {
                    const size_t r = (size_t)(row0 + ai * HALF + m * 16);
                    const u32x4 av = *(const u32x4*)(ybp_ + r * 256 + c);
                    f32x4 v0 = acc[ai][bj][m][0] + b0, v1 = acc[ai][bj][m][1] + b1; float ss = 0.f;
#pragma unroll
                    for (int j = 0; j < 4; ++j) { const float alo = __uint_as_float(av[j] << 16), ahi = __uint_as_float(av[j] & 0xffff0000u);
                        if (j < 2) { const float s0 = alo * __builtin_amdgcn_rcpf(1.0f + __expf(-v0[2 * j])), s1 = ahi * __builtin_amdgcn_rcpf(1.0f + __expf(-v0[2 * j + 1])); v0[2 * j] = s0; v0[2 * j + 1] = s1; ss += s0 * s0 + s1 * s1; }
                        else { const float s0 = alo * __builtin_amdgcn_rcpf(1.0f + __expf(-v1[2 * j - 4])), s1 = ahi * __builtin_amdgcn_rcpf(1.0f + __expf(-v1[2 * j - 3])); v1[2 * j - 4] = s0; v1[2 * j - 3] = s1; ss += s0 * s0 + s1 * s1; } }
                    acc[ai][bj][m][0] = v0; acc[ai][bj][m][1] = v1;
                    ss += __shfl_xor(ss, 16); ss += __shfl_xor(ss, 32);
                    if (fq == 0) Pt[((ai * HALF + wr * 64 + m * 16 + fr) * 2 + bj) * 4 + wc] = ss;
                }
        }
        asm volatile("s_waitcnt lgkmcnt(0)" ::: "memory"); __builtin_amdgcn_s_barrier(); asm volatile("" ::: "memory");
#pragma unroll
        for (int bj = 0; bj < 2; ++bj) {
            const int c = cw + bj * HALF;
            const f32x4 g0 = *(const f32x4*)(gain_ + 256 + c), g1 = *(const f32x4*)(gain_ + 256 + c + 4);
#pragma unroll
            for (int ai = 0; ai < 2; ++ai)
#pragma unroll
                for (int m = 0; m < 4; ++m) {
                    const int rl = ai * HALF + wr * 64 + m * 16 + fr; const size_t r = (size_t)(u.pm * BM + rl);
                    const float rs = rsqrtf((Pt[(rl * 2 + bj) * 4 + (wc & 2)] + Pt[(rl * 2 + bj) * 4 + (wc | 1)]) * (1.0f / 64.0f) + 1e-6f);
                    const u32x4 gv = *(const u32x4*)(proj_ + r * 3584 + 2560 + 256 + c);
                    const f32x4 v0 = acc[ai][bj][m][0] * rs * g0, v1 = acc[ai][bj][m][1] * rs * g1;
                    float o[8];
#pragma unroll
                    for (int j = 0; j < 4; ++j) { const float tl = __uint_as_float(gv[j] << 16), th = __uint_as_float(gv[j] & 0xffff0000u);
                        const float x0 = (j < 2) ? v0[2 * j] : v1[2 * j - 4], x1 = (j < 2) ? v0[2 * j + 1] : v1[2 * j - 3];
                        o[2 * j] = x0 * (tl * __builtin_amdgcn_rcpf(1.0f + __expf(-tl))); o[2 * j + 1] = x1 * (th * __builtin_amdgcn_rcpf(1.0f + __expf(-th))); }
                    u32x4 w; w.x = cvtpk_s(o[0], o[1]); w.y = cvtpk_s(o[2], o[3]); w.z = cvtpk_s(o[4], o[5]); w.w = cvtpk_s(o[6], o[7]);
                    *(u32x4*)(Yo_ + r * 1024 + 256 + c) = w;
                }
        }
        asm volatile("s_waitcnt lgkmcnt(0)" ::: "memory"); __builtin_amdgcn_s_barrier(); asm volatile("" ::: "memory");
    }
};

template <class Epi, class Sched, bool ALIGN_EPI = false, bool SP2 = false>
__device__ __forceinline__ void gemm_phase(PG8_LAS unsigned char* lds, const Gemm g, const Sched& S, const Epi& E, const int tid_in  ) {
    const int tid = tid_in, wid = __builtin_amdgcn_readfirstlane(tid >> 6), lane = tid & 63, wr = wid >> 2, wc = wid & 3, fr = lane & 15, fq = lane >> 4;
    const int K = g.K, nt = K / BK;
    unsigned voffA[2], voffB[2];
#pragma unroll
    for (int i = 0; i < 2; ++i) { int R, C; stage_rc(tid * 16 + i * 8192, R, C); const int Rb = Epi::PERM ? ((R & ~31) + perm32(R & 31)) : R;
        voffA[i] = (unsigned)(R * K + C) * 2u; voffB[i] = (unsigned)(Rb * K + C) * 2u; }
    const size_t kstep = (size_t)(BK * 2);
    const size_t hstep = (size_t)HALF * K * 2;
    const size_t tstep = 2 * hstep;
    const unsigned ldsw = (unsigned)wid * 1024u;
    const int aoff = lds_byte(wr * 64 + fr, fq * 8), boff = lds_byte(wc * 32 + fr, fq * 8);
#define PG8_SA(b, h) (((b) * 2 + (h)) * HTB)
#define PG8_SB(b, h) ((4 + (b) * 2 + (h)) * HTB)
#define PG8_STAGE(bufoff, gbase, voff) do { _Pragma("unroll") for (int _i = 0; _i < 2; ++_i) \
        __builtin_amdgcn_global_load_lds((const unsigned*)((const char*)(gbase) + (voff)[_i]), (PG8_LAS unsigned*)(lds + (bufoff) + ldsw + _i * 8192), 16, 0, 0); } while (0)
#define PG8_LDA(dst, b, h) do { _Pragma("unroll") for (int m = 0; m < 4; ++m) _Pragma("unroll") for (int k = 0; k < 2; ++k) dst[m][k] = *(const PG8_LAS bf16x8*)(lds + PG8_SA(b, h) + aoff + m * 2048 + k * 1024); } while (0)
#define PG8_LDB(dst, b, h) do { _Pragma("unroll") for (int n = 0; n < 2; ++n) _Pragma("unroll") for (int k = 0; k < 2; ++k) dst[n][k] = *(const PG8_LAS bf16x8*)(lds + PG8_SB(b, h) + boff + n * 2048 + k * 1024); } while (0)
#define PG8_MMA(ai, bj, At, Bt) do { __builtin_amdgcn_s_setprio(1); _Pragma("unroll") for (int m = 0; m < 4; ++m) _Pragma("unroll") for (int n = 0; n < 2; ++n) _Pragma("unroll") for (int k = 0; k < 2; ++k) \
        acc[ai][bj][m][n] = __builtin_amdgcn_mfma_f32_16x16x32_bf16(Bt[n][k], At[m][k], acc[ai][bj][m][n], 0, 0, 0); __builtin_amdgcn_s_setprio(0); } while (0)
#define PG8_WAIT_V(n) asm volatile("s_waitcnt vmcnt(" #n ")" ::: "memory")
#define PG8_WAIT_L(n) asm volatile("s_waitcnt lgkmcnt(" #n ")" ::: "memory")
#define PG8_BAR __builtin_amdgcn_s_barrier()
#define PG8_SCHED __builtin_amdgcn_sched_barrier(0)
    Unit cur, nxt; int ui = 0;
    if (!S.next(0, cur)) return;
    f32x4 acc[2][2][4][2];
#pragma unroll
    for (int a = 0; a < 2; ++a)
#pragma unroll
        for (int b = 0; b < 2; ++b)
#pragma unroll
            for (int m = 0; m < 4; ++m)
#pragma unroll
                for (int n = 0; n < 2; ++n) acc[a][b][m][n] = (f32x4){0.f, 0.f, 0.f, 0.f};
    bf16x8 At[4][2], B0[2][2], B1[2][2];
    const char* cA = (const char*)g.A + (size_t)cur.pm * tstep; const char* cB = (const char*)g.Bt + (size_t)cur.pn * tstep;
    S.a_ready(cur);
    if constexpr (SP2) {
        PG8_STAGE(PG8_SB(0, 0), cB, voffB); PG8_STAGE(PG8_SB(0, 1), cB + hstep, voffB); PG8_STAGE(PG8_SA(0, 0), cA, voffA); PG8_STAGE(PG8_SA(0, 1), cA + hstep, voffA);
        if (wr == 1) PG8_BAR;
        PG8_WAIT_V(2); PG8_BAR;
        PG8_STAGE(PG8_SB(1, 0), cB + kstep, voffB); PG8_STAGE(PG8_SA(1, 0), cA + kstep, voffA); PG8_STAGE(PG8_SB(1, 1), cB + hstep + kstep, voffB);
        PG8_WAIT_V(6); PG8_BAR;
    } else {
        PG8_STAGE(PG8_SB(0, 0), cB, voffB); PG8_STAGE(PG8_SA(0, 0), cA, voffA); PG8_STAGE(PG8_SB(0, 1), cB + hstep, voffB); PG8_STAGE(PG8_SA(0, 1), cA + hstep, voffA);
        if (wr == 1) PG8_BAR;
        PG8_WAIT_V(4); PG8_BAR;
        PG8_STAGE(PG8_SB(1, 0), cB + kstep, voffB); PG8_STAGE(PG8_SA(1, 0), cA + kstep, voffA); PG8_STAGE(PG8_SB(1, 1), cB + hstep + kstep, voffB);
        PG8_WAIT_V(6); PG8_BAR;
    }
    for (;;) {
        const bool has_next = S.next(ui + 1, nxt);
        const char* nA = has_next ? (const char*)g.A + (size_t)nxt.pm * tstep : cA; const char* nB = has_next ? (const char*)g.Bt + (size_t)nxt.pn * tstep : cB;
        for (int t = 0; t < nt; t += 2) {
            const bool last = (t == nt - 2);
            const char* a1 = cA + (size_t)(t + 1) * kstep;
            const char* a2 = last ? nA : cA + (size_t)(t + 2) * kstep; const char* b2 = last ? nB : cB + (size_t)(t + 2) * kstep;
            const char* a3 = a2 + kstep; const char* b3 = b2 + kstep;
            if (last && has_next) S.a_ready(nxt);
            if constexpr (SP2) {
            PG8_LDB(B0, 0, 0); PG8_LDB(B1, 0, 1); PG8_SCHED; PG8_LDA(At, 0, 0); PG8_STAGE(PG8_SA(1, 1), a1 + hstep, voffA);
            PG8_WAIT_V(8); PG8_WAIT_L(0); PG8_BAR; PG8_MMA(0, 0, At, B0); PG8_MMA(0, 1, At, B1); PG8_BAR; PG8_SCHED;
            PG8_LDA(At, 0, 1); PG8_STAGE(PG8_SB(0, 0), b2, voffB); PG8_STAGE(PG8_SB(0, 1), b2 + hstep, voffB); PG8_STAGE(PG8_SA(0, 0), a2, voffA);
            PG8_WAIT_V(8); PG8_WAIT_L(0); PG8_BAR; PG8_MMA(1, 0, At, B0); PG8_MMA(1, 1, At, B1); PG8_BAR; PG8_SCHED;
            PG8_LDB(B0, 1, 0); PG8_LDB(B1, 1, 1); PG8_SCHED; PG8_LDA(At, 1, 0); PG8_STAGE(PG8_SA(0, 1), a2 + hstep, voffA);
            PG8_WAIT_V(8); PG8_WAIT_L(0); PG8_BAR; PG8_MMA(0, 0, At, B0); PG8_MMA(0, 1, At, B1); PG8_BAR; PG8_SCHED;
            PG8_LDA(At, 1, 1); PG8_STAGE(PG8_SB(1, 0), b3, voffB); PG8_STAGE(PG8_SB(1, 1), b3 + hstep, voffB); PG8_STAGE(PG8_SA(1, 0), a3, voffA);
            PG8_WAIT_V(8); PG8_WAIT_L(0); PG8_BAR; PG8_MMA(1, 0, At, B0); PG8_MMA(1, 1, At, B1); PG8_BAR; PG8_SCHED;
            } else {
            PG8_LDB(B0, 0, 0); PG8_SCHED; PG8_LDA(At, 0, 0); PG8_STAGE(PG8_SA(1, 1), a1 + hstep, voffA);
            PG8_WAIT_L(8); PG8_BAR; PG8_WAIT_L(0); PG8_MMA(0, 0, At, B0); PG8_BAR; PG8_SCHED;
            PG8_LDB(B1, 0, 1); PG8_STAGE(PG8_SB(0, 0), b2, voffB);
            PG8_BAR; PG8_WAIT_L(0); PG8_MMA(0, 1, At, B1); PG8_BAR;
            PG8_LDA(At, 0, 1); PG8_STAGE(PG8_SA(0, 0), a2, voffA);
            PG8_BAR; PG8_WAIT_L(0); PG8_MMA(1, 0, At, B0); PG8_BAR; PG8_SCHED;
            PG8_STAGE(PG8_SB(0, 1), b2 + hstep, voffB);
            PG8_WAIT_V(6); PG8_BAR; PG8_MMA(1, 1, At, B1); PG8_BAR;
            PG8_LDB(B0, 1, 0); PG8_SCHED; PG8_LDA(At, 1, 0); PG8_STAGE(PG8_SA(0, 1), a2 + hstep, voffA);
            PG8_WAIT_L(8); PG8_BAR; PG8_WAIT_L(0); PG8_MMA(0, 0, At, B0); PG8_BAR; PG8_SCHED;
            PG8_LDB(B1, 1, 1); PG8_STAGE(PG8_SB(1, 0), b3, voffB);
            PG8_BAR; PG8_WAIT_L(0); PG8_MMA(0, 1, At, B1); PG8_BAR;
            PG8_LDA(At, 1, 1); PG8_STAGE(PG8_SA(1, 0), a3, voffA);
            PG8_BAR; PG8_WAIT_L(0); PG8_MMA(1, 0, At, B0); PG8_BAR; PG8_SCHED;
            PG8_STAGE(PG8_SB(1, 1), b3 + hstep, voffB);
            PG8_WAIT_V(6); PG8_BAR; PG8_MMA(1, 1, At, B1); PG8_BAR;
            }
        }
        if constexpr (ALIGN_EPI) { if (wr == 0) PG8_BAR; }
        if constexpr (!Epi::AFTER_DRAIN) { E(acc, cur, wr, wc, fr, fq); S.done(cur); }
        if (!has_next) break;
#pragma unroll
        for (int a = 0; a < 2; ++a)
#pragma unroll
            for (int b = 0; b < 2; ++b)
#pragma unroll
                for (int m = 0; m < 4; ++m)
#pragma unroll
                    for (int n = 0; n < 2; ++n) acc[a][b][m][n] = (f32x4){0.f, 0.f, 0.f, 0.f};
        cur = nxt; cA = nA; cB = nB; ++ui;
        if constexpr (ALIGN_EPI) { if (wr == 1) PG8_BAR; }
    }
    PG8_WAIT_V(0);
    if constexpr (!ALIGN_EPI) { if (wr == 0) PG8_BAR; }
    PG8_BAR;
    if constexpr (Epi::AFTER_DRAIN) { E.fused(acc, cur, wr, wc, fr, fq, lds, wid, lane); S.done(cur); }
#undef PG8_SA
#undef PG8_SB
#undef PG8_STAGE
#undef PG8_LDA
#undef PG8_LDB
#undef PG8_MMA
#undef PG8_WAIT_V
#undef PG8_WAIT_L
#undef PG8_BAR
#undef PG8_SCHED
}
}
#define XB_TMO      128
#define XB_XCNT(j)  (256  + 64 * (j))
#define XB_XSUB(j)  (1280 + 64 * (j))
#define XB_XGEN(j)  (2304 + 64 * (j))
#define XB_TOP      3328
#define XB_TOPGEN   3392
#define XCD_BAR_WORDS 3456
#define XB_SPIN_CAP (1u << 18)

__device__ __forceinline__ unsigned xb_ld(unsigned* p)              { return __hip_atomic_load((__attribute__((address_space(1))) unsigned*)p, __ATOMIC_RELAXED, __HIP_MEMORY_SCOPE_AGENT); }
__device__ __forceinline__ unsigned xb_add(unsigned* p, unsigned v) { return __hip_atomic_fetch_add((__attribute__((address_space(1))) unsigned*)p, v, __ATOMIC_RELAXED, __HIP_MEMORY_SCOPE_AGENT); }
__device__ __forceinline__ unsigned xb_xcc_id() { return (unsigned)__builtin_amdgcn_s_getreg((3 << 11) | 20) & 0xFu; }
#define XB_SPIN(cond, bar) do { unsigned _sp = 0; while (cond) { __builtin_amdgcn_s_sleep(1); \
    if ((++_sp & 255u) == 0u) { if (xb_ld(&(bar)[XB_TMO])) break; if (_sp > XB_SPIN_CAP) { atomicAdd(&(bar)[XB_TMO], 1u); break; } } } } while (0)

struct XcdBarrier {
    unsigned* bar; unsigned x;
    volatile LAS unsigned* st;
};

__device__ __forceinline__ XcdBarrier xcd_barrier_post(unsigned* bar, volatile LAS unsigned* st) {
    XcdBarrier b; b.bar = bar; b.x = xb_xcc_id(); b.st = st;
    if (threadIdx.x == 0) (void)xb_add(&bar[XB_XCNT(b.x)], 1u);
    return b;
}
__device__ __forceinline__ void xcd_barrier_complete(unsigned* bar, unsigned x, unsigned& nloc, unsigned& nx) {
    const unsigned G = gridDim.x * gridDim.y * gridDim.z;
    unsigned sum, cnt, mine, sp = 0u;
    for (;;) {
        sum = 0u; cnt = 0u; mine = 0u;
#pragma unroll
        for (unsigned j = 0; j < 16; ++j) { const unsigned c = xb_ld(&bar[XB_XCNT(j)]); sum += c; cnt += (c > 0u) ? 1u : 0u; mine = (j == x) ? c : mine; }
        if (sum == G) break;
        __builtin_amdgcn_s_sleep(1);
        if ((++sp & 255u) == 0u) { if (xb_ld(&bar[XB_TMO])) break; if (sp > XB_SPIN_CAP) { atomicAdd(&bar[XB_TMO], 1u); break; } }
    }
    nloc = mine > 0u ? mine : 1u; nx = cnt > 0u ? cnt : 1u;
}

__device__ __forceinline__ void xcd_barrier(const XcdBarrier& b) {
    asm volatile("s_waitcnt vmcnt(0)" ::: "memory");
    __syncthreads();
    if (threadIdx.x == 0) {
        unsigned* bar = b.bar;
        __builtin_amdgcn_s_waitcnt(0);
        unsigned nloc = b.st[0], nx = b.st[1];
        if (nloc == 0u) { xcd_barrier_complete(bar, b.x, nloc, nx); b.st[0] = nloc; b.st[1] = nx; }
        const unsigned old = xb_add(&bar[XB_XSUB(b.x)], 1u);
        const unsigned gen = old / nloc;
        if (old + 1u == (gen + 1u) * nloc) {
            __builtin_amdgcn_fence(__ATOMIC_RELEASE, "agent");
            asm volatile("s_waitcnt vmcnt(0)" ::: "memory");
            const unsigned og = xb_add(&bar[XB_TOP], 1u);
            const unsigned tg = og / nx;
            if (og + 1u == (tg + 1u) * nx) xb_add(&bar[XB_TOPGEN], 1u);
            else XB_SPIN(xb_ld(&bar[XB_TOPGEN]) == tg, bar);
            __builtin_amdgcn_fence(__ATOMIC_ACQUIRE, "agent");
            xb_add(&bar[XB_XGEN(b.x)], 1u);
            asm volatile("s_waitcnt vmcnt(0)" ::: "memory");
        } else {
            XB_SPIN(xb_ld(&bar[XB_XGEN(b.x)]) == gen, bar);
            __builtin_amdgcn_fence(__ATOMIC_ACQUIRE, "agent");
            asm volatile("s_waitcnt vmcnt(0)" ::: "memory");
        }
    }
    __syncthreads();
}
namespace fa {
typedef short bf16x8 __attribute__((ext_vector_type(8)));
typedef float f32x16 __attribute__((ext_vector_type(16)));
typedef short v4i16_t __attribute__((ext_vector_type(4)));
constexpr int KT_OFF = 0, VT_OFF = 8192, LUT_OFF = 16384, OST_OFF = 24576, FA_LDS = OST_OFF + 8 * 4096;
__device__ __forceinline__ int crow(int r, int hi) { return (r & 3) + 8 * (r >> 2) + 4 * hi; }
__device__ __forceinline__ unsigned cvtpk(float lo, float hi) { return cvtpk_s(lo, hi); }
template <int B> __device__ __forceinline__ bf16x8 pack8(const f32x16& p) {
    u32x4 w; w.x = cvtpk(p[B], p[B + 1]); w.y = cvtpk(p[B + 2], p[B + 3]); w.z = cvtpk(p[B + 4], p[B + 5]); w.w = cvtpk(p[B + 6], p[B + 7]);
    return __builtin_bit_cast(bf16x8, w);
}
__device__ __forceinline__ v4i16_t trd(LAS const unsigned char* p) { return __builtin_amdgcn_ds_read_tr16_b64_v4i16((LAS v4i16_t*)p); }
__device__ __forceinline__ void stage_tile(LAS unsigned char* lds, int tid, const bf16_t* krow, const bf16_t* vrow) {
    const int row = tid >> 3, ch = tid & 7;
    u32x4 kv = {0u, 0u, 0u, 0u}, vv = {0u, 0u, 0u, 0u};
    if (krow) { kv = *(const u32x4*)(krow + ch * 8); vv = *(const u32x4*)(vrow + ch * 8); }
    *(LAS u32x4*)(lds + KT_OFF + row * 128 + ((ch ^ (row & 7)) * 16)) = kv;
    *(LAS u32x4*)(lds + VT_OFF + row * 128 + ch * 16) = vv;
}
template <class Fn> __device__ __forceinline__ void tile_step(LAS const unsigned char* lds, const bf16x8 (&qf)[4], f32x16& o0, f32x16& o1, float& m, float& l, int lane, const Fn& fn) {
    const int r32 = lane & 31, hi = lane >> 5;
    f32x16 p0, p1;
#pragma unroll
    for (int r = 0; r < 16; ++r) { p0[r] = 0.f; p1[r] = 0.f; }
#pragma unroll
    for (int s = 0; s < 4; ++s) {
        const int ch = ((2 * s + hi) ^ (r32 & 7)) * 16;
        const bf16x8 k0 = *(const LAS bf16x8*)(lds + KT_OFF + r32 * 128 + ch);
        const bf16x8 k1 = *(const LAS bf16x8*)(lds + KT_OFF + (32 + r32) * 128 + ch);
        p0 = __builtin_amdgcn_mfma_f32_32x32x16_bf16(k0, qf[s], p0, 0, 0, 0);
        p1 = __builtin_amdgcn_mfma_f32_32x32x16_bf16(k1, qf[s], p1, 0, 0, 0);
    }
    float mx = NEGF;
#pragma unroll
    for (int r = 0; r < 16; ++r) { p0[r] = fn(crow(r, hi), p0[r]); p1[r] = fn(32 + crow(r, hi), p1[r]); mx = fmaxf(mx, fmaxf(p0[r], p1[r])); }
    mx = fmaxf(mx, __shfl_xor(mx, 32));
    const float mn = fmaxf(m, mx), alpha = __expf(m - mn);
    m = mn;
    float ps = 0.f;
#pragma unroll
    for (int r = 0; r < 16; ++r) { p0[r] = __expf(p0[r] - mn); p1[r] = __expf(p1[r] - mn); ps += p0[r] + p1[r]; }
    l = l * alpha + ps;
#pragma unroll
    for (int r = 0; r < 16; ++r) { o0[r] *= alpha; o1[r] *= alpha; }
    const int q4 = (lane & 15) >> 2, p4 = lane & 3, dgrp = (lane >> 4) & 1;
    const int vb = VT_OFF + (4 * hi + q4) * 128 + (16 * dgrp + 4 * p4) * 2;
#define FA_PV(P, KH, S2) do { const bf16x8 pb = pack8<8 * (S2)>(P); \
        _Pragma("unroll") for (int blk = 0; blk < 2; ++blk) { const int a = vb + (32 * (KH) + 16 * (S2)) * 128 + blk * 64; \
            const v4i16_t lo = trd(lds + a), hh = trd(lds + a + 8 * 128); \
            const bf16x8 va = {lo[0], lo[1], lo[2], lo[3], hh[0], hh[1], hh[2], hh[3]}; \
            if (blk == 0) o0 = __builtin_amdgcn_mfma_f32_32x32x16_bf16(va, pb, o0, 0, 0, 0); else o1 = __builtin_amdgcn_mfma_f32_32x32x16_bf16(va, pb, o1, 0, 0, 0); } } while (0)
    FA_PV(p0, 0, 0); FA_PV(p0, 0, 1); FA_PV(p1, 1, 0); FA_PV(p1, 1, 1);
#undef FA_PV
}
template <class RowFn> __device__ __forceinline__ float store_o(LAS unsigned char* lds, int wave, int lane, const f32x16& o0, const f32x16& o1, float l, const RowFn& orow) {
    const int r32 = lane & 31, hi = lane >> 5;
    l += __shfl_xor(l, 32);
    const float inv = 1.0f / l;
    LAS bf16_t* stg = (LAS bf16_t*)(lds + OST_OFF + wave * 4096);
#pragma unroll
    for (int r = 0; r < 16; ++r) { const int d = crow(r, hi); stg[r32 * 64 + d] = f2bf(o0[r] * inv); stg[r32 * 64 + 32 + d] = f2bf(o1[r] * inv); }
    asm volatile("s_waitcnt lgkmcnt(0)" ::: "memory");
#pragma unroll
    for (int i = 0; i < 4; ++i) { const int row = i * 8 + (lane >> 3), ch = lane & 7; const u32x4 v = *(const LAS u32x4*)(stg + row * 64 + ch * 8); *(u32x4*)(orow(row) + ch * 8) = v; }
    asm volatile("s_waitcnt lgkmcnt(0)" ::: "memory");
    return l;
}
}

namespace fa2 {
using fa::bf16x8; using fa::f32x16; using fa::v4i16_t; using fa::crow; using fa::pack8; using fa::trd;
constexpr float C2LOG = 0.125f * 1.4426950408889634f;
struct KCh { int c0, c1, c2, c3; };
__device__ __forceinline__ KCh make_kch(int lane) { const int r32 = lane & 31, hi = lane >> 5, x = r32 & 7; return KCh{((0 + hi) ^ x) * 16, ((2 + hi) ^ x) * 16, ((4 + hi) ^ x) * 16, ((6 + hi) ^ x) * 16}; }
template <class Fn> __device__ __forceinline__ void step64(LAS const unsigned char* lds, int koff, int voff, const bf16x8 (&qf)[4], f32x16& o0, f32x16& o1, float& m, float& l, int lane, const Fn& fn, const KCh& kc4) {
    const int r32 = lane & 31, hi = lane >> 5;
    f32x16 p0, p1;
    const f32x16 zero16 = {0.f, 0.f, 0.f, 0.f, 0.f, 0.f, 0.f, 0.f, 0.f, 0.f, 0.f, 0.f, 0.f, 0.f, 0.f, 0.f};
    LAS const unsigned char* kp = lds + koff + r32 * 128;
#pragma unroll
    for (int s = 0; s < 4; ++s) {
        const int ch = s == 0 ? kc4.c0 : s == 1 ? kc4.c1 : s == 2 ? kc4.c2 : kc4.c3;
        const bf16x8 k0 = *(const LAS bf16x8*)(kp + ch);
        const bf16x8 k1 = *(const LAS bf16x8*)(kp + ch + 32 * 128);
        p0 = __builtin_amdgcn_mfma_f32_32x32x16_bf16(k0, qf[s], s == 0 ? zero16 : p0, 0, 0, 0);
        p1 = __builtin_amdgcn_mfma_f32_32x32x16_bf16(k1, qf[s], s == 0 ? zero16 : p1, 0, 0, 0);
    }
    float mx = NEGF;
#pragma unroll
    for (int r = 0; r < 16; ++r) { const int kc = (r & 3) + 8 * (r >> 2); p0[r] = fn(kc, p0[r]); p1[r] = fn(32 + kc, p1[r]); mx = fmaxf(mx, fmaxf(p0[r], p1[r])); }
    mx = fmaxf(mx, __shfl_xor(mx, 32));
    const float mn = fmaxf(m, mx), alpha = __builtin_amdgcn_exp2f(m - mn);
    m = mn;
    float ps = 0.f;
#pragma unroll
    for (int r = 0; r < 16; ++r) { p0[r] = __builtin_amdgcn_exp2f(p0[r] - mn); p1[r] = __builtin_amdgcn_exp2f(p1[r] - mn); ps += p0[r] + p1[r]; }
    l = l * alpha + ps;
    o0 *= alpha; o1 *= alpha;
    const int q4 = (lane & 15) >> 2, p4 = lane & 3, dgrp = (lane >> 4) & 1;
    LAS const unsigned char* vp = lds + voff + (4 * hi + q4) * 128 + (16 * dgrp + 4 * p4) * 2;
#define FA_PV(P, KH, S2) do { const bf16x8 pb = pack8<8 * (S2)>(P); \
        _Pragma("unroll") for (int blk = 0; blk < 2; ++blk) { \
            const v4i16_t lo = trd(vp + ((32 * (KH) + 16 * (S2)) * 128 + blk * 64)), hh = trd(vp + ((32 * (KH) + 16 * (S2) + 8) * 128 + blk * 64)); \
            const bf16x8 va = {lo[0], lo[1], lo[2], lo[3], hh[0], hh[1], hh[2], hh[3]}; \
            if (blk == 0) o0 = __builtin_amdgcn_mfma_f32_32x32x16_bf16(va, pb, o0, 0, 0, 0); else o1 = __builtin_amdgcn_mfma_f32_32x32x16_bf16(va, pb, o1, 0, 0, 0); } } while (0)
    FA_PV(p0, 0, 0); FA_PV(p0, 0, 1); FA_PV(p1, 1, 0); FA_PV(p1, 1, 1);
#undef FA_PV
}
struct TabFn { LAS const float* base;
    __device__ __forceinline__ float operator()(int kc, float s) const { return fmaf(s, C2LOG, base[59 - kc]); } };
struct TabLoFn { LAS const float* base; int klo4;
    __device__ __forceinline__ float operator()(int kc, float s) const { return kc >= klo4 ? fmaf(s, C2LOG, base[59 - kc]) : NEGF; } };
struct ConstFn { float b2;
    __device__ __forceinline__ float operator()(int, float s) const { return fmaf(s, C2LOG, b2); } };
template <int NIT, class RowFn> __device__ __forceinline__ void stage_rows(LAS unsigned char* lds, int koff, int voff, int tid, int kcol, int vcol, const RowFn& rowfn) {
    u32x4 kv[NIT], vv[NIT];
#pragma unroll
    for (int i = 0; i < NIT; ++i) { const int e = tid + 512 * i, row = e >> 3, ch = e & 7; bool ok; const bf16_t* rp = rowfn(row, ok);
        kv[i] = *(const u32x4*)(rp + kcol + ch * 8); vv[i] = *(const u32x4*)(rp + vcol + ch * 8);
        if (!ok) { kv[i] = (u32x4){0u, 0u, 0u, 0u}; vv[i] = (u32x4){0u, 0u, 0u, 0u}; } }
    __builtin_amdgcn_sched_barrier(0);
#pragma unroll
    for (int i = 0; i < NIT; ++i) { const int e = tid + 512 * i, row = e >> 3, ch = e & 7;
        *(LAS u32x4*)(lds + koff + row * 128 + ((ch ^ (row & 7)) * 16)) = kv[i];
        *(LAS u32x4*)(lds + voff + row * 128 + ch * 16) = vv[i]; }
}
template <class DstFn> __device__ __forceinline__ void store_rows(LAS unsigned char* lds, int ostoff, int lane, const f32x16& o0, const f32x16& o1, float linv, const DstFn& dst) {
    const int r32 = lane & 31, hi = lane >> 5;
    LAS unsigned char* stg = lds + ostoff;
#pragma unroll
    for (int r = 0; r < 16; r += 2) { const int d = crow(r, hi);
        *(LAS unsigned*)(stg + r32 * 128 + ((((d >> 3)) ^ (r32 & 7)) << 4) + (d & 7) * 2) = cvtpk_s(o0[r] * linv, o0[r + 1] * linv);
        *(LAS unsigned*)(stg + r32 * 128 + ((((d >> 3) + 4) ^ (r32 & 7)) << 4) + (d & 7) * 2) = cvtpk_s(o1[r] * linv, o1[r + 1] * linv); }
    asm volatile("s_waitcnt lgkmcnt(0)" ::: "memory");
#pragma unroll
    for (int i = 0; i < 4; ++i) { const int row = i * 8 + (lane >> 3), ch = lane & 7; const u32x4 v = *(const LAS u32x4*)(stg + row * 128 + ((ch ^ (row & 7)) << 4)); bf16_t* p = dst(row); if (p) *(u32x4*)(p + ch * 8) = v; }
    asm volatile("s_waitcnt lgkmcnt(0)" ::: "memory");
}
constexpr int D_K = 0, D_V = 49152, D_LUT = 98304, D_OST = 0;
template <class Hook> __device__ __forceinline__ void dilated_unit(const Hook& after_stage, LAS unsigned char* lds, int tid, int pi, int bh, int u, const bf16_t* __restrict__ proj, const float* __restrict__ lutd, bf16_t* __restrict__ PO, float* __restrict__ PL) {
    const int lane = tid & 63, wave = __builtin_amdgcn_readfirstlane(tid >> 6), r32 = lane & 31, hi = lane >> 5;
    const int dil = (pi == 0) ? 1 : (pi == 1) ? 4 : 16, b = bh >> 2, h = bh & 3;
    const int r = u % dil, sb = u / dil;
    __syncthreads();
    LAS float* lut = (LAS float*)(lds + D_LUT);
    if (tid < 64) ((LAS u32x4*)lut)[tid] = ((const u32x4*)(lutd + (pi * 4 + h) * 256))[tid];
    const int ks0 = 256 * sb - 128;
    stage_rows<6>(lds, D_K, D_V, tid, COL_KD + h * 64, COL_VD + h * 64, [&](int row, bool& ok) -> const bf16_t* { const int ks = ks0 + row; ok = ks >= 0; return proj + ((size_t)b * SEQ + (size_t)max(ks, 0) * dil + r) * NIN; });
    after_stage();
    const int qsub = 256 * sb + 32 * wave + r32;
    const size_t qrow = (size_t)b * SEQ + (size_t)qsub * dil + r;
    bf16x8 qf[4];
#pragma unroll
    for (int s = 0; s < 4; ++s) qf[s] = *(const bf16x8*)(proj + qrow * NIN + COL_QD + h * 64 + 16 * s + 8 * hi);
    f32x16 o0, o1;
#pragma unroll
    for (int i = 0; i < 16; ++i) { o0[i] = 0.f; o1[i] = 0.f; }
    float m = NEGF, l = 0.f;
    const KCh kc4 = make_kch(lane);
    __syncthreads();
    const int j0 = wave >> 1;
#pragma unroll 1
    for (int j = j0; j < j0 + 3; ++j) {
        if (ks0 + 64 * j + 63 < 0) continue;
        const int qrel = 32 * wave + r32 + 128 - 64 * j, klo = -(ks0 + 64 * j);
        if (klo > 0) { TabLoFn fn{lut + (qrel - 4 * hi + 64 - 59), klo - 4 * hi}; step64(lds, D_K + j * 8192, D_V + j * 8192, qf, o0, o1, m, l, lane, fn, kc4); }
        else { TabFn fn{lut + (qrel - 4 * hi + 64 - 59)}; step64(lds, D_K + j * 8192, D_V + j * 8192, qf, o0, o1, m, l, lane, fn, kc4); }
    }
    __syncthreads();
    l += __shfl_xor(l, 32);
    const size_t rbase = (size_t)b * SEQ + (size_t)(256 * sb + 32 * wave) * dil + r;
    bf16_t* po = PO + (size_t)pi * M * 256 + h * 64;
    store_rows(lds, D_OST + wave * 4096, lane, o0, o1, 1.0f / l, [&](int q) { return po + (rbase + (size_t)q * dil) * 256; });
    if (hi == 0) PL[((size_t)pi * M + qrow) * 4 + h] = m * 0.6931471805599453f + __logf(l);
}
__device__ __forceinline__ void gate_item(LAS unsigned char* lds, int tid, int bh, int own, const bf16_t* __restrict__ proj, const float* __restrict__ kp, unsigned short* __restrict__ LIST, int* __restrict__ CNT) {
    const int lane = tid & 63, wave = __builtin_amdgcn_readfirstlane(tid >> 6), r32 = lane & 31, hi = lane >> 5;
    const int b = bh >> 2, h = bh & 3;
    LAS int* cnt = (LAS int*)lds;
    __syncthreads();
    if (tid < 32) cnt[tid] = 0;
    __syncthreads();
    const int qib = 32 * wave + r32;
    const size_t qrow = (size_t)b * SEQ + 256 * own + qib;
    bf16x8 qf[4];
#pragma unroll
    for (int s = 0; s < 4; ++s) qf[s] = *(const bf16x8*)(proj + qrow * NIN + COL_QA + h * 64 + 16 * s + 8 * hi);
    f32x16 g;
#pragma unroll
    for (int i = 0; i < 16; ++i) g[i] = 0.f;
    const float* k0 = kp + (size_t)((b * 32 + r32) * 2) * 256 + h * 64;
#pragma unroll
    for (int s = 0; s < 4; ++s) {
        float kv[8];
#pragma unroll
        for (int j = 0; j < 8; j += 4) { const float4 a = *(const float4*)(k0 + 16 * s + 8 * hi + j), c = *(const float4*)(k0 + 256 + 16 * s + 8 * hi + j);
            kv[j] = (a.x + c.x) * (1.0f / 256.0f); kv[j + 1] = (a.y + c.y) * (1.0f / 256.0f); kv[j + 2] = (a.z + c.z) * (1.0f / 256.0f); kv[j + 3] = (a.w + c.w) * (1.0f / 256.0f); }
        u32x4 wh, wl;
#pragma unroll
        for (int j = 0; j < 4; ++j) {
            const bf16_t h0 = f2bf(kv[2 * j]), h1 = f2bf(kv[2 * j + 1]);
            const bf16_t l0 = f2bf(kv[2 * j] - bf2f(h0)), l1 = f2bf(kv[2 * j + 1] - bf2f(h1));
            wh[j] = (unsigned)h0 | ((unsigned)h1 << 16); wl[j] = (unsigned)l0 | ((unsigned)l1 << 16);
        }
        g = __builtin_amdgcn_mfma_f32_32x32x16_bf16(__builtin_bit_cast(bf16x8, wh), qf[s], g, 0, 0, 0);
        g = __builtin_amdgcn_mfma_f32_32x32x16_bf16(__builtin_bit_cast(bf16x8, wl), qf[s], g, 0, 0, 0);
    }
#pragma unroll
    for (int i = 0; i < 16; ++i) if (crow(i, hi) >= own) g[i] = -INFINITY;
#pragma unroll
    for (int t = 0; t < 3; ++t) {
        float lm = -INFINITY;
#pragma unroll
        for (int i = 0; i < 16; ++i) lm = fmaxf(lm, g[i]);
        const float gm = fmaxf(lm, __shfl_xor(lm, 32));
        int cand = 99;
#pragma unroll
        for (int i = 15; i >= 0; --i) if (g[i] == gm) cand = crow(i, hi);
        cand = min(cand, __shfl_xor(cand, 32));
        if (gm > -INFINITY) {
#pragma unroll
            for (int i = 0; i < 16; ++i) if (crow(i, hi) == cand) g[i] = -INFINITY;
            if (hi == 0) { const int pos = atomicAdd((int*)&cnt[cand], 1); LIST[(((size_t)bh * 32 + cand) * 32 + own) * 256 + pos] = (unsigned short)((t << 8) | qib); }
        }
    }
    __syncthreads();
    if (tid < 32) CNT[((size_t)bh * 32 + tid) * 32 + own] = (tid < own) ? cnt[tid] : 0;
}
constexpr int M_K = 0, M_V = 32768, M_LUT = 65536, M_OST = 73728;
template <class Hook> __device__ __forceinline__ void moba_item(const Hook& after_stage, LAS unsigned char* lds, int tid, int bh, int n, int part, int nparts, const bf16_t* __restrict__ proj, const float* __restrict__ rel_bias, const float* __restrict__ lutm, const unsigned short* __restrict__ LIST, const int* __restrict__ CNT,
                                          bf16_t* __restrict__ PARTO, float* __restrict__ PARTML, bf16_t* __restrict__ Y) {
    const int lane = tid & 63, wave = __builtin_amdgcn_readfirstlane(tid >> 6), r32 = lane & 31, hi = lane >> 5;
    const int b = bh >> 2, h = bh & 3;
    __syncthreads();
    LAS float* lut = (LAS float*)(lds + M_LUT);
    if (tid < 472) ((LAS u32x4*)lut)[tid] = ((const u32x4*)(lutm + h * 1888))[tid];
    const bf16_t* kvb = proj + ((size_t)b * SEQ + 256 * n) * NIN;
    stage_rows<4>(lds, M_K, M_V, tid, COL_KA + h * 64, COL_VA + h * 64, [&](int row, bool& ok) -> const bf16_t* { ok = true; return kvb + (size_t)row * NIN; });
    after_stage();
    int cj = 0, nt = 0;
    if (lane < 32) { if (lane == n) nt = 8; else if (lane > n) { cj = CNT[((size_t)bh * 32 + n) * 32 + lane]; nt = (cj + 31) >> 5; } }
    int st = nt;
#pragma unroll
    for (int o = 1; o < 32; o <<= 1) { const int v = __shfl_up(st, o); if ((lane & 31) >= o) st += v; }
    st -= nt;
    const int T = __shfl(st + nt, 31);
    const float b31 = rel_bias[31 * 8 + h] * 1.4426950408889634f;
    const unsigned short* lbase = LIST + (((size_t)bh * 32 + n) * 32) * 256;
    const int stride = 8 * nparts, t0 = wave + 8 * part;
    const KCh kc4 = make_kch(lane);
    struct EA { int seg, lt; unsigned short raw; bool live; };
    auto stageA = [&](int t) -> EA { EA e; const int tt = min(t, T - 1);
        e.seg = __popcll(__ballot(lane < 32 && st <= tt)) - 1; e.lt = tt - __shfl(st, e.seg); e.live = true; e.raw = 0;
        if (e.seg != n) { const int c = __shfl(cj, e.seg), idx = 32 * e.lt + r32; e.live = idx < c; e.raw = lbase[(size_t)e.seg * 256 + (e.live ? idx : 0)]; }
        return e; };
    struct EB { int seg, slot, qib; bool live; size_t qrow; };
    auto stageB = [&](const EA& e, bf16x8 (&q)[4]) -> EB { EB m; m.seg = e.seg; m.live = e.live;
        if (e.seg == n) { m.slot = 3; m.qib = 32 * e.lt + r32; } else { m.slot = e.raw >> 8; m.qib = e.raw & 255; }
        m.qrow = (size_t)b * SEQ + 256 * e.seg + m.qib;
#pragma unroll
        for (int s = 0; s < 4; ++s) q[s] = *(const bf16x8*)(proj + m.qrow * NIN + COL_QA + h * 64 + 16 * s + 8 * hi);
        return m; };
    __syncthreads();
    if (t0 < T) {
        EA ea1 = stageA(t0);
        bf16x8 q0[4], q1[4];
        EB m0 = stageB(ea1, q0);
        ea1 = stageA(t0 + stride);
#pragma unroll 1
        for (int t = t0; t < T; t += stride) {
            const EB m1 = stageB(ea1, q1);
            ea1 = stageA(t + 2 * stride);
            __builtin_amdgcn_sched_barrier(0);
            f32x16 o0, o1;
#pragma unroll
            for (int i = 0; i < 16; ++i) { o0[i] = 0.f; o1[i] = 0.f; }
            float m = NEGF, l = 0.f;
            const int seg = m0.seg, qpos = 256 * seg + m0.qib;
            if (seg == n) {
                const int nks = (m0.qib - r32 + 31) / 64 + 1;
                for (int ks = 0; ks < nks; ++ks) { TabFn fn{lut + (m0.qib - 64 * ks - 4 * hi + 96 - 59)}; step64(lds, M_K + ks * 8192, M_V + ks * 8192, q0, o0, o1, m, l, lane, fn, kc4); }
            } else if (seg - n >= 7) {
                ConstFn fn{b31};
#pragma unroll 1
                for (int ks = 0; ks < 4; ++ks) step64(lds, M_K + ks * 8192, M_V + ks * 8192, q0, o0, o1, m, l, lane, fn, kc4);
            } else {
#pragma unroll 1
                for (int ks = 0; ks < 4; ++ks) { TabFn fn{lut + (qpos - 256 * n - 64 * ks - 4 * hi + 96 - 59)}; step64(lds, M_K + ks * 8192, M_V + ks * 8192, q0, o0, o1, m, l, lane, fn, kc4); }
            }
            l += __shfl_xor(l, 32);
            bf16_t* dstp = nullptr;
            if (m0.live) dstp = (m0.slot == 3) ? Y + m0.qrow * DM + h * 64 : PARTO + ((m0.qrow * 4 + h) * 3 + m0.slot) * 64;
            const unsigned long long dl = (unsigned long long)dstp;
            store_rows(lds, M_OST + wave * 4096, lane, o0, o1, 1.0f / l, [&](int q) { return (bf16_t*)__shfl(dl, q); });
            if (m0.live && hi == 0) { float2 ml; ml.x = m; ml.y = l; *(float2*)(PARTML + ((m0.qrow * 4 + h) * 4 + m0.slot) * 2) = ml; }
            m0 = m1;
#pragma unroll
            for (int s = 0; s < 4; ++s) q0[s] = q1[s];
        }
    }
}
}

namespace hg {
typedef short bf16x8 __attribute__((ext_vector_type(8)));
typedef float f32x4 __attribute__((ext_vector_type(4)));
typedef unsigned u32x2 __attribute__((ext_vector_type(2)));
constexpr int SEG_OFF = 0, BT_OFF = 2048, VT_OFF = 18432, KT_OFF = 26624;
constexpr int QS_OFF = 26624, QD_OFF = 34816, QO_OFF = 43008, KD_OFF = 51200, KO_OFF = 59392;
__device__ __forceinline__ void img_put(LAS unsigned char* lds, int off, int row, int d, float v) { *(LAS bf16_t*)(lds + off + row * 128 + ((((d >> 3) ^ (row & 7))) << 4) + (d & 7) * 2) = f2bf(v); }
__device__ __forceinline__ bf16x8 img_frag(LAS const unsigned char* lds, int off, int row, int chunk) { return *(const LAS bf16x8*)(lds + off + row * 128 + ((chunk ^ (row & 7)) << 4)); }
__device__ __forceinline__ unsigned cvtpk(float lo, float hi) { return cvtpk_s(lo, hi); }
struct Ch { float f[8], b[8], qv[8], iv[8], blast; };
template <bool NEEDQ> __device__ __forceinline__ void stage(LAS unsigned char* lds, int wave, int lane, const bf16_t* __restrict__ rowp  , float lb, Ch& c) {
    float cs = 0.f;
#pragma unroll
    for (int i = 0; i < 8; ++i) {
        const bf16_t* r = rowp + (size_t)(8 * wave + i) * NIN + lane;
        const float fp = bf2f(r[COL_FC]); c.iv[i] = bf2f(r[COL_IC]);
        if (NEEDQ) { const float q = bf2f(r[COL_QC]); c.qv[i] = q * __builtin_amdgcn_rcpf(1.0f + __expf(-q)) * 0.125f; }
        c.f[i] = lb + (1.0f - lb) * __builtin_amdgcn_rcpf(1.0f + __expf(-fp));
        cs += __logf(c.f[i]); c.b[i] = cs;
    }
    LAS float* seg = (LAS float*)(lds + SEG_OFF);
    seg[wave * 64 + lane] = cs;
    __syncthreads();
    float off = 0.f, tot = 0.f;
#pragma unroll
    for (int w = 0; w < 8; ++w) { const float s = seg[w * 64 + lane]; tot += s; if (w < wave) off += s; }
#pragma unroll
    for (int i = 0; i < 8; ++i) c.b[i] += off;
    c.blast = tot;
}
__device__ __forceinline__ void x1_item(LAS unsigned char* lds, int wave, int lane, int item, const bf16_t* __restrict__ proj, const float* __restrict__ lbp, float* __restrict__ DS, float* __restrict__ DEC) {
    const int bh = item >> 7, ch = item & 127, b = bh >> 2, h = bh & 3;
    __syncthreads();
    Ch c; stage<false>(lds, wave, lane, proj + ((size_t)b * SEQ + ch * 64) * NIN + h * 64, lbp[h * 64 + lane], c);
    u32x4 kw, vw;
#pragma unroll
    for (int j = 0; j < 4; ++j) {
        kw[j] = cvtpk((1.0f - c.f[2 * j]) * __expf(c.blast - c.b[2 * j]), (1.0f - c.f[2 * j + 1]) * __expf(c.blast - c.b[2 * j + 1]));
        vw[j] = cvtpk(c.iv[2 * j], c.iv[2 * j + 1]);
    }
    *(LAS u32x4*)(lds + KT_OFF + lane * 128 + ((wave ^ (lane & 7)) << 4)) = kw;
    *(LAS u32x4*)(lds + VT_OFF + lane * 128 + ((wave ^ (lane & 7)) << 4)) = vw;
    if (wave == 0) DEC[(size_t)item * 64 + lane] = __expf(c.blast);
    __syncthreads();
    const int fr = lane & 15, quad = lane >> 4, mt = wave >> 1;
#pragma unroll
    for (int n2 = 0; n2 < 2; ++n2) {
        const int nt = 2 * (wave & 1) + n2;
        f32x4 acc = {0.f, 0.f, 0.f, 0.f};
#pragma unroll
        for (int kk = 0; kk < 2; ++kk)
            acc = __builtin_amdgcn_mfma_f32_16x16x32_bf16(img_frag(lds, VT_OFF, 16 * mt + fr, quad + 4 * kk), img_frag(lds, KT_OFF, 16 * nt + fr, quad + 4 * kk), acc, 0, 0, 0);
        float* o = DS + (size_t)item * 4096 + (16 * mt + 4 * quad) * 64 + 16 * nt + fr;
#pragma unroll
        for (int r = 0; r < 4; ++r) o[r * 64] = acc[r];
    }
}
__device__ __forceinline__ void x2_scan(int gtid, int nthreads, const float* __restrict__ DS, const float* __restrict__ DEC, bf16_t* __restrict__ ST) {
    for (int e = gtid; e < 16 * 1024; e += nthreads) {
        const int bh = e >> 10, q = e & 1023;
        const int d4 = q & 15;
        f32x4 s = {0.f, 0.f, 0.f, 0.f};
#pragma unroll 1
        for (int c0 = 0; c0 < 128; c0 += 8) {
            f32x4 ds[8], de[8];
#pragma unroll
            for (int i = 0; i < 8; ++i) { const size_t it = (size_t)bh * 128 + c0 + i; ds[i] = *(const f32x4*)(DS + it * 4096 + q * 4); de[i] = *(const f32x4*)(DEC + it * 64 + d4 * 4); }
#pragma unroll
            for (int i = 0; i < 8; ++i) { const size_t it = (size_t)bh * 128 + c0 + i;
                uint2 w; w.x = cvtpk(s[0], s[1]); w.y = cvtpk(s[2], s[3]); *(uint2*)(ST + it * 4096 + q * 4) = w;
                s = s * de[i] + ds[i]; }
        }
    }
}
__device__ __forceinline__ void x3_item(LAS unsigned char* lds, int wave, int lane, int item, const bf16_t* __restrict__ proj, const float* __restrict__ lbp, const bf16_t* __restrict__ ST, bf16_t* __restrict__ Y) {
    const int bh = item >> 7, ch = item & 127, b = bh >> 2, h = bh & 3;
    __syncthreads();
    Ch c; stage<true>(lds, wave, lane, proj + ((size_t)b * SEQ + ch * 64) * NIN + h * 64, lbp[h * 64 + lane], c);
    LAS float* bt = (LAS float*)(lds + BT_OFF);
#pragma unroll
    for (int i = 0; i < 8; ++i) bt[(8 * wave + i) * 64 + lane] = c.b[i];
    { u32x4 vw;
#pragma unroll
      for (int j = 0; j < 4; ++j) vw[j] = cvtpk(c.iv[2 * j], c.iv[2 * j + 1]);
      *(LAS u32x4*)(lds + VT_OFF + lane * 128 + ((wave ^ (lane & 7)) << 4)) = vw; }
    __syncthreads();
    {
        const int I = wave >> 1;
        const float cI = bt[(16 * I + 7) * 64 + lane];
        const float rI = (I > 0) ? bt[(16 * I - 1) * 64 + lane] : 0.f;
        float rN[3];
#pragma unroll
        for (int ip = 1; ip < 4; ++ip) rN[ip - 1] = bt[(16 * ip - 1) * 64 + lane];
#pragma unroll
        for (int i = 0; i < 8; ++i) {
            const int t = 8 * wave + i; const float bb = c.b[i], q = c.qv[i], k = 1.0f - c.f[i];
            img_put(lds, QS_OFF, t, lane, q * __expf(bb));
            img_put(lds, QD_OFF, t, lane, q * __expf(bb - cI));
            img_put(lds, QO_OFF, t, lane, q * __expf(bb - rI));
            img_put(lds, KD_OFF, t, lane, k * __expf(cI - bb));
#pragma unroll
            for (int ip = 1; ip < 4; ++ip) if (ip > I) img_put(lds, KO_OFF + (ip - 1) * 8192, t, lane, k * __expf(rN[ip - 1] - bb));
        }
    }
    __syncthreads();
    const int fr = lane & 15, quad = lane >> 4, I = wave >> 1, vh = wave & 1;
    unsigned sc[4][2];
#pragma unroll
    for (int J = 0; J < 4; ++J) {
        sc[J][0] = 0u; sc[J][1] = 0u;
        if (J <= I) {
            f32x4 acc = {0.f, 0.f, 0.f, 0.f};
            const int ko = (J < I) ? KO_OFF + (I - 1) * 8192 : KD_OFF, qo = (J < I) ? QO_OFF : QD_OFF;
#pragma unroll
            for (int kk = 0; kk < 2; ++kk)
                acc = __builtin_amdgcn_mfma_f32_16x16x32_bf16(img_frag(lds, ko, 16 * J + fr, quad + 4 * kk), img_frag(lds, qo, 16 * I + fr, quad + 4 * kk), acc, 0, 0, 0);
            if (J == I) {
#pragma unroll
                for (int r = 0; r < 4; ++r) if (4 * quad + r > fr) acc[r] = 0.f;
            }
            sc[J][0] = cvtpk(acc[0], acc[1]); sc[J][1] = cvtpk(acc[2], acc[3]);
        }
    }
    const bf16_t* stp = ST + (size_t)item * 4096;
    const size_t orow = (size_t)b * SEQ + ch * 64 + 16 * I + fr;
#pragma unroll
    for (int m2 = 0; m2 < 2; ++m2) {
        const int mt = 2 * vh + m2, v = 16 * mt + fr;
        f32x4 acc = {0.f, 0.f, 0.f, 0.f};
#pragma unroll
        for (int ks = 0; ks < 2; ++ks) {
            if (2 * ks <= I) {
                u32x4 bw, aw;
                bw[0] = sc[2 * ks][0]; bw[1] = sc[2 * ks][1]; bw[2] = sc[2 * ks + 1][0]; bw[3] = sc[2 * ks + 1][1];
                const LAS unsigned char* vr = lds + VT_OFF + v * 128;
                const u32x2 a0 = *(const LAS u32x2*)(vr + (((4 * ks + (quad >> 1)) ^ (v & 7)) << 4) + (quad & 1) * 8);
                u32x2 a1 = {0u, 0u};
                if (2 * ks + 1 <= I) a1 = *(const LAS u32x2*)(vr + (((4 * ks + 2 + (quad >> 1)) ^ (v & 7)) << 4) + (quad & 1) * 8);
                aw[0] = a0.x; aw[1] = a0.y; aw[2] = a1.x; aw[3] = a1.y;
                acc = __builtin_amdgcn_mfma_f32_16x16x32_bf16(__builtin_bit_cast(bf16x8, aw), __builtin_bit_cast(bf16x8, bw), acc, 0, 0, 0);
            }
        }
#pragma unroll
        for (int kk = 0; kk < 2; ++kk) {
            const bf16x8 sa = *(const bf16x8*)(stp + v * 64 + 8 * quad + 32 * kk);
            acc = __builtin_amdgcn_mfma_f32_16x16x32_bf16(sa, img_frag(lds, QS_OFF, 16 * I + fr, quad + 4 * kk), acc, 0, 0, 0);
        }
        uint2 w; w.x = cvtpk(acc[0], acc[1]); w.y = cvtpk(acc[2], acc[3]);
        *(uint2*)(Y + orow * DM + 512 + h * 64 + 16 * mt + 4 * quad) = w;
    }
}
}

namespace hw {
typedef short bf16x8 __attribute__((ext_vector_type(8)));
typedef float f32x4 __attribute__((ext_vector_type(4)));
typedef unsigned u32x2 __attribute__((ext_vector_type(2)));
#define HW_LDSW() asm volatile("s_waitcnt lgkmcnt(0)" ::: "memory")
__device__ __forceinline__ bf16x8 frag128(LAS const unsigned char* base, int row, int chunk) { return *(const LAS bf16x8*)(base + row * 128 + ((chunk ^ (row & 7)) << 4)); }
__device__ __forceinline__ void x1_wave(LAS unsigned char* wl, int lane, int item, const bf16_t* __restrict__ proj, const float* __restrict__ lbp, float* __restrict__ DS, float* __restrict__ DEC) {
    const int bh = item >> 7, ch = item & 127, b = bh >> 2, h = bh & 3;
    const bf16_t* rp = proj + ((size_t)b * SEQ + ch * 64) * NIN + h * 64 + lane;
    const float lb = lbp[h * 64 + lane];
    float f[64]; float cs = 0.f;
    HW_LDSW();
#pragma unroll
    for (int g2 = 0; g2 < 4; ++g2) {
        unsigned short rf[16], ri[16];
#pragma unroll
        for (int i = 0; i < 16; ++i) { const bf16_t* r = rp + (size_t)(16 * g2 + i) * NIN; rf[i] = r[COL_FC]; ri[i] = r[COL_IC]; }
        __builtin_amdgcn_sched_barrier(0);
#pragma unroll
        for (int i = 0; i < 16; ++i) { const float ff = lb + (1.0f - lb) * __builtin_amdgcn_rcpf(1.0f + __expf(-bf2f(rf[i]))); f[16 * g2 + i] = ff; cs += __logf(ff); }
#pragma unroll
        for (int q = 0; q < 2; ++q) { const int g = 2 * g2 + q;
            u32x4 vw; vw[0] = (unsigned)ri[8 * q] | ((unsigned)ri[8 * q + 1] << 16); vw[1] = (unsigned)ri[8 * q + 2] | ((unsigned)ri[8 * q + 3] << 16);
            vw[2] = (unsigned)ri[8 * q + 4] | ((unsigned)ri[8 * q + 5] << 16); vw[3] = (unsigned)ri[8 * q + 6] | ((unsigned)ri[8 * q + 7] << 16);
            *(LAS u32x4*)(wl + 8192 + lane * 128 + ((g ^ (lane & 7)) << 4)) = vw; }
    }
    const float blast = cs; cs = 0.f;
#pragma unroll
    for (int g = 0; g < 8; ++g) {
        float kh[8];
#pragma unroll
        for (int i = 0; i < 8; ++i) { const float ff = f[8 * g + i]; cs += __logf(ff); kh[i] = (1.0f - ff) * __expf(blast - cs); }
        u32x4 kw; kw[0] = cvtpk_s(kh[0], kh[1]); kw[1] = cvtpk_s(kh[2], kh[3]); kw[2] = cvtpk_s(kh[4], kh[5]); kw[3] = cvtpk_s(kh[6], kh[7]);
        *(LAS u32x4*)(wl + lane * 128 + ((g ^ (lane & 7)) << 4)) = kw;
    }
    DEC[(size_t)item * 64 + lane] = __expf(blast);
    HW_LDSW();
    const int fr = lane & 15, quad = lane >> 4;
    float* dsp = DS + (size_t)item * 4096;
#pragma unroll
    for (int mt = 0; mt < 4; ++mt) {
        const bf16x8 a0 = frag128(wl + 8192, 16 * mt + fr, quad), a1 = frag128(wl + 8192, 16 * mt + fr, quad + 4);
#pragma unroll
        for (int nt = 0; nt < 4; ++nt) {
            f32x4 acc = {0.f, 0.f, 0.f, 0.f};
            acc = __builtin_amdgcn_mfma_f32_16x16x32_bf16(a0, frag128(wl, 16 * nt + fr, quad), acc, 0, 0, 0);
            acc = __builtin_amdgcn_mfma_f32_16x16x32_bf16(a1, frag128(wl, 16 * nt + fr, quad + 4), acc, 0, 0, 0);
            float* o = dsp + (16 * mt + 4 * quad) * 64 + 16 * nt + fr;
#pragma unroll
            for (int r = 0; r < 4; ++r) o[r * 64] = acc[r];
        }
    }
    HW_LDSW();
}
__device__ __forceinline__ void x3_wave(LAS unsigned char* wl, int lane, int item, const bf16_t* __restrict__ proj, const float* __restrict__ lbp, const bf16_t* __restrict__ ST, bf16_t* __restrict__ Y) {
    const int bh = item >> 7, ch = item & 127, b = bh >> 2, h = bh & 3;
    const int fr = lane & 15, quad = lane >> 4;
    const bf16_t* rp = proj + ((size_t)b * SEQ + ch * 64) * NIN + h * 64 + lane;
    const float lb = lbp[h * 64 + lane];
    f32x4 S[4][4];
    { const bf16_t* sp = ST + (size_t)item * 4096;
#pragma unroll
      for (int tv = 0; tv < 4; ++tv)
#pragma unroll
          for (int td = 0; td < 4; ++td) { const uint2 w = *(const uint2*)(sp + (16 * tv + fr) * 64 + 16 * td + 4 * quad);
              S[td][tv] = (f32x4){__uint_as_float(w.x << 16), __uint_as_float(w.x & 0xffff0000u), __uint_as_float(w.y << 16), __uint_as_float(w.y & 0xffff0000u)}; } }
    LAS float* decl = (LAS float*)(wl + 10240);
    unsigned short nf[16], nq[16], ni[16];
#pragma unroll
    for (int i = 0; i < 16; ++i) { const bf16_t* r = rp + (size_t)i * NIN; nf[i] = r[COL_FC]; nq[i] = r[COL_QC]; ni[i] = r[COL_IC]; }
#pragma unroll 1
    for (int I = 0; I < 4; ++I) {
        float ff[16], qv[16], iv[16], bb[16];
#pragma unroll
        for (int i = 0; i < 16; ++i) { ff[i] = bf2f(nf[i]); qv[i] = bf2f(nq[i]); iv[i] = bf2f(ni[i]); }
        { const int In = I < 3 ? I + 1 : 3;
#pragma unroll
          for (int i = 0; i < 16; ++i) { const bf16_t* r = rp + (size_t)(16 * In + i) * NIN; nf[i] = r[COL_FC]; nq[i] = r[COL_QC]; ni[i] = r[COL_IC]; } }
        __builtin_amdgcn_sched_barrier(0);
        float cs = 0.f;
#pragma unroll
        for (int i = 0; i < 16; ++i) { ff[i] = lb + (1.0f - lb) * __builtin_amdgcn_rcpf(1.0f + __expf(-ff[i])); cs += __logf(ff[i]); bb[i] = cs; qv[i] = qv[i] * __builtin_amdgcn_rcpf(1.0f + __expf(-qv[i])) * 0.125f; }
        const float cm = bb[7], be = bb[15];
        HW_LDSW();
        { u32x4 v0, v1, k0, k1;
#pragma unroll
          for (int j = 0; j < 4; ++j) { v0[j] = cvtpk_s(iv[2 * j], iv[2 * j + 1]); v1[j] = cvtpk_s(iv[8 + 2 * j], iv[9 + 2 * j]);
              k0[j] = cvtpk_s((1.0f - ff[2 * j]) * __expf(be - bb[2 * j]), (1.0f - ff[2 * j + 1]) * __expf(be - bb[2 * j + 1]));
              k1[j] = cvtpk_s((1.0f - ff[8 + 2 * j]) * __expf(be - bb[8 + 2 * j]), (1.0f - ff[9 + 2 * j]) * __expf(be - bb[9 + 2 * j])); }
          *(LAS u32x4*)(wl + 8192 + lane * 32) = v0; *(LAS u32x4*)(wl + 8192 + lane * 32 + 16) = v1;
          *(LAS u32x4*)(wl + 6144 + lane * 32) = k0; *(LAS u32x4*)(wl + 6144 + lane * 32 + 16) = k1; }
        decl[lane] = __expf(be);
#pragma unroll
        for (int i = 0; i < 16; ++i) {
            const int off = i * 128 + ((((lane >> 3) ^ (i & 7))) << 4) + (lane & 7) * 2;
            *(LAS bf16_t*)(wl + off) = f2bf(qv[i] * __expf(bb[i]));
            *(LAS bf16_t*)(wl + 2048 + off) = f2bf(qv[i] * __expf(bb[i] - cm));
            *(LAS bf16_t*)(wl + 4096 + off) = f2bf((1.0f - ff[i]) * __expf(cm - bb[i]));
        }
        HW_LDSW();
        f32x4 sc = {0.f, 0.f, 0.f, 0.f};
        sc = __builtin_amdgcn_mfma_f32_16x16x32_bf16(frag128(wl + 4096, fr, quad), frag128(wl + 2048, fr, quad), sc, 0, 0, 0);
        sc = __builtin_amdgcn_mfma_f32_16x16x32_bf16(frag128(wl + 4096, fr, quad + 4), frag128(wl + 2048, fr, quad + 4), sc, 0, 0, 0);
#pragma unroll
        for (int r = 0; r < 4; ++r) if (4 * quad + r > fr) sc[r] = 0.f;
        u32x4 scb; scb[0] = cvtpk_s(sc[0], sc[1]); scb[1] = cvtpk_s(sc[2], sc[3]); scb[2] = 0u; scb[3] = 0u;
        u32x4 qi[2];
#pragma unroll
        for (int ks = 0; ks < 2; ++ks) {
            const u32x2 lo = *(const LAS u32x2*)(wl + fr * 128 + ((((4 * ks + (quad >> 1))) ^ (fr & 7)) << 4) + (quad & 1) * 8);
            const u32x2 hi2 = *(const LAS u32x2*)(wl + fr * 128 + ((((4 * ks + 2 + (quad >> 1))) ^ (fr & 7)) << 4) + (quad & 1) * 8);
            qi[ks] = (u32x4){lo[0], lo[1], hi2[0], hi2[1]};
        }
        const size_t orow = (size_t)b * SEQ + ch * 64 + 16 * I + fr;
#pragma unroll
        for (int tv = 0; tv < 4; ++tv) {
            const u32x2 vt = *(const LAS u32x2*)(wl + 8192 + (16 * tv + fr) * 32 + quad * 8);
            f32x4 acc = {0.f, 0.f, 0.f, 0.f};
            acc = __builtin_amdgcn_mfma_f32_16x16x32_bf16(__builtin_bit_cast(bf16x8, (u32x4){vt[0], vt[1], 0u, 0u}), __builtin_bit_cast(bf16x8, scb), acc, 0, 0, 0);
#pragma unroll
            for (int ks = 0; ks < 2; ++ks) {
                u32x4 sa; sa[0] = cvtpk_s(S[2 * ks][tv][0], S[2 * ks][tv][1]); sa[1] = cvtpk_s(S[2 * ks][tv][2], S[2 * ks][tv][3]);
                sa[2] = cvtpk_s(S[2 * ks + 1][tv][0], S[2 * ks + 1][tv][1]); sa[3] = cvtpk_s(S[2 * ks + 1][tv][2], S[2 * ks + 1][tv][3]);
                acc = __builtin_amdgcn_mfma_f32_16x16x32_bf16(__builtin_bit_cast(bf16x8, sa), __builtin_bit_cast(bf16x8, qi[ks]), acc, 0, 0, 0);
            }
            uint2 w; w.x = cvtpk_s(acc[0], acc[1]); w.y = cvtpk_s(acc[2], acc[3]);
            *(uint2*)(Y + orow * DM + 512 + h * 64 + 16 * tv + 4 * quad) = w;
        }
        if (I < 3) {
#pragma unroll
            for (int td = 0; td < 4; ++td) {
                const f32x4 dc = *(const LAS f32x4*)(wl + 10240 + (16 * td + 4 * quad) * 4);
                const u32x2 kt = *(const LAS u32x2*)(wl + 6144 + (16 * td + fr) * 32 + quad * 8);
                const bf16x8 ka = __builtin_bit_cast(bf16x8, (u32x4){kt[0], kt[1], 0u, 0u});
#pragma unroll
                for (int tv = 0; tv < 4; ++tv) {
                    const u32x2 vt = *(const LAS u32x2*)(wl + 8192 + (16 * tv + fr) * 32 + quad * 8);
                    S[td][tv] = __builtin_amdgcn_mfma_f32_16x16x32_bf16(ka, __builtin_bit_cast(bf16x8, (u32x4){vt[0], vt[1], 0u, 0u}), S[td][tv] * dc, 0, 0, 0);
                }
            }
        }
    }
    HW_LDSW();
}
}

namespace s5 {
typedef short bf16x8 __attribute__((ext_vector_type(8)));
typedef float f32x4 __attribute__((ext_vector_type(4)));
__device__ __forceinline__ void cpow(double dt, double ar, double ai, int n, double& pr, double& pi) { const double mg = exp(n * dt * ar); double sn, cs; sincos_d(n * dt * ai, sn, cs); pr = mg * cs; pi = mg * sn; }
__device__ __forceinline__ void zfac(double dt, double ar, double ai, double& zr, double& zi) {
    double are, aim; cpow(dt, ar, ai, 1, are, aim);
    const double nr = are - 1.0, ni = aim, den = ar * ar + ai * ai; zr = (nr * ar + ni * ai) / den; zi = (ni * ar - nr * ai) / den;
}
__device__ __forceinline__ void tables_thread(int e, const float* a_re, const float* a_im, const float* log_dt, const float* b_re, const float* b_im, const float* c_re, const float* c_im,
                                              bf16_t* W1, bf16_t* W3, float* a64) {
    const int st = e & 63, p = (e >> 6) & 63, lg = e >> 12;
    const int id = lg * 64 + p;
    float brv[16], biv[16], crv[16], civ[16];
#pragma unroll
    for (int c4 = 0; c4 < 4; ++c4) { const float4 x = *(const float4*)(b_re + id * 16 + 4 * c4), y = *(const float4*)(b_im + id * 16 + 4 * c4);
        brv[4 * c4] = x.x; brv[4 * c4 + 1] = x.y; brv[4 * c4 + 2] = x.z; brv[4 * c4 + 3] = x.w; biv[4 * c4] = y.x; biv[4 * c4 + 1] = y.y; biv[4 * c4 + 2] = y.z; biv[4 * c4 + 3] = y.w; }
#pragma unroll
    for (int c = 0; c < 16; ++c) { crv[c] = c_re[(lg * 16 + c) * 64 + p]; civ[c] = c_im[(lg * 16 + c) * 64 + p]; }
    const double dt = exp((double)log_dt[lg]), ar = a_re[id], ai = a_im[id];
    __builtin_amdgcn_sched_barrier(0);
    double zr, zi; zfac(dt, ar, ai, zr, zi);
    { double pr, pi; cpow(dt, ar, ai, 63 - st, pr, pi);
      unsigned wr[8], wi[8];
#pragma unroll
      for (int c2 = 0; c2 < 8; ++c2) {
          float vr[2], vi[2];
#pragma unroll
          for (int q = 0; q < 2; ++q) { const int c = 2 * c2 + q; const double br = brv[c], bi = biv[c];
              const double bbr = zr * br - zi * bi, bbi = zr * bi + zi * br; vr[q] = (float)(pr * bbr - pi * bbi); vi[q] = (float)(pr * bbi + pi * bbr); }
          wr[c2] = pk2(vr[0], vr[1]); wi[c2] = pk2(vi[0], vi[1]);
      }
      u32x4* o0 = (u32x4*)(W1 + ((size_t)(lg * 128 + 2 * p) * 1024 + st * 16)); u32x4* o1 = (u32x4*)(W1 + ((size_t)(lg * 128 + 2 * p + 1) * 1024 + st * 16));
      o0[0] = (u32x4){wr[0], wr[1], wr[2], wr[3]}; o0[1] = (u32x4){wr[4], wr[5], wr[6], wr[7]};
      o1[0] = (u32x4){wi[0], wi[1], wi[2], wi[3]}; o1[1] = (u32x4){wi[4], wi[5], wi[6], wi[7]}; }
    { double pr, pi; cpow(dt, ar, ai, st + 1, pr, pi);
#pragma unroll
      for (int c = 0; c < 16; ++c) { const double cr = crv[c], ci = civ[c];
          *(unsigned*)(W3 + ((size_t)(lg * 1024 + st * 16 + c) * 128 + 2 * p)) = pk2((float)(cr * pr - ci * pi), -(float)(cr * pi + ci * pr)); }
      if (st == 63) { a64[id * 2] = (float)pr; a64[id * 2 + 1] = (float)pi; } }
}
__device__ __forceinline__ void kmat_item(LAS float* scr, int tid, int item, const float* a_re, const float* a_im, const float* log_dt, const float* b_re, const float* b_im, const float* c_re, const float* c_im, const float* dskip, bf16_t* KM) {
    const int tau = item & 63, lg = item >> 6;
    __syncthreads();
    if (tid < 256) ((LAS f32x4*)(scr + 2048))[tid] = ((const f32x4*)(c_re + (size_t)lg * 1024))[tid];
    else ((LAS f32x4*)(scr + 3072))[tid - 256] = ((const f32x4*)(c_im + (size_t)lg * 1024))[tid - 256];
    { const int p = tid >> 3, c0 = (tid & 7) * 2, id = lg * 64 + p;
      const double dt = exp((double)log_dt[lg]), ar = a_re[id], ai = a_im[id];
      double zr, zi, pr, pi; zfac(dt, ar, ai, zr, zi); cpow(dt, ar, ai, tau, pr, pi);
#pragma unroll
      for (int q = 0; q < 2; ++q) { const int c = c0 + q; const double br = b_re[id * 16 + c], bi = b_im[id * 16 + c];
          const double bbr = zr * br - zi * bi, bbi = zr * bi + zi * br;
          scr[(p * 16 + c) * 2] = (float)(pr * bbr - pi * bbi); scr[(p * 16 + c) * 2 + 1] = (float)(pr * bbi + pi * bbr); } }
    __syncthreads();
    if (tid < 256) { const int c = tid >> 4, cp = tid & 15; float s = 0.f;
#pragma unroll 8
        for (int p = 0; p < 64; ++p) s += scr[2048 + c * 64 + p] * scr[(p * 16 + cp) * 2] - scr[3072 + c * 64 + p] * scr[(p * 16 + cp) * 2 + 1];
        if (tau == 0 && c == cp) s += dskip[lg * 16 + c];
        KM[((size_t)(lg * 64 + tau) * 16 + c) * 16 + cp] = f2bf(s); }
}
__device__ __forceinline__ size_t chunk_row(int cid) { return (size_t)(cid >> 7) * SEQ + (size_t)(cid & 127) * 64; }
__device__ __forceinline__ void x1_wave(int lane, int g, int mt, int lg, const bf16_t* __restrict__ proj, const bf16_t* __restrict__ W1, float* __restrict__ HEND) {
    const int fr = lane & 15, quad = lane >> 4;
    const bf16_t* ap = proj + (chunk_row(mt * 16 + fr) + (quad >> 1)) * NIN + COL_U + g * 16 + 8 * (quad & 1);
    const bf16_t* bp = W1 + ((size_t)(lg * 128 + fr) * 1024 + 8 * quad);
    f32x4 acc[8];
#pragma unroll
    for (int n = 0; n < 8; ++n) acc[n] = (f32x4){0.f, 0.f, 0.f, 0.f};
    bf16x8 afr[32];
#pragma unroll
    for (int kk = 0; kk < 32; ++kk) afr[kk] = *(const bf16x8*)(ap + (size_t)(2 * kk) * NIN);
#pragma unroll
    for (int kk = 0; kk < 32; ++kk) {
#pragma unroll
        for (int n = 0; n < 8; ++n) acc[n] = __builtin_amdgcn_mfma_f32_16x16x32_bf16(afr[kk], *(const bf16x8*)(bp + (size_t)n * 16 * 1024 + 32 * kk), acc[n], 0, 0, 0);
    }
#pragma unroll
    for (int n = 0; n < 8; ++n)
#pragma unroll
        for (int r = 0; r < 4; ++r) HEND[((size_t)(mt * 16 + 4 * quad + r) * 16 + g) * 128 + 16 * n + fr] = acc[n][r];
}
__device__ __forceinline__ void x2_scan(int e, const float* __restrict__ HEND, const float* __restrict__ a64, bf16_t* __restrict__ HST, int layer) {
    const int p = e & 63, g = (e >> 6) & 15, b = e >> 10;
    const float ar = a64[((layer * 16 + g) * 64 + p) * 2], ai = a64[((layer * 16 + g) * 64 + p) * 2 + 1];
    float hr = 0.f, hi = 0.f;
#pragma unroll 1
    for (int c0 = 0; c0 < 128; c0 += 16) {
        float2 he[16];
#pragma unroll
        for (int i = 0; i < 16; ++i) he[i] = *(const float2*)(HEND + ((size_t)(b * 128 + c0 + i) * 16 + g) * 128 + 2 * p);
#pragma unroll
        for (int i = 0; i < 16; ++i) {
            *(unsigned*)(HST + ((size_t)(b * 128 + c0 + i) * 16 + g) * 128 + 2 * p) = cvtpk_s(hr, hi);
            const float nr = ar * hr - ai * hi + he[i].x, ni = ar * hi + ai * hr + he[i].y; hr = nr; hi = ni;
        }
    }
}
__device__ __forceinline__ void x3_item(LAS unsigned char* lds, int wave, int lane, int item, int layer, const bf16_t* __restrict__ proj, const bf16_t* __restrict__ KM, const bf16_t* __restrict__ W3,
                                        const bf16_t* __restrict__ HST, bf16_t* __restrict__ ybpre) {
    const int g = item & 15, mt = item >> 4, lg = layer * 16 + g;
    const int tid = wave * 64 + lane;
    __syncthreads();
    { const u32x4* src = (const u32x4*)(KM + (size_t)lg * 64 * 256);
      u32x4 kv[4];
#pragma unroll
      for (int i = 0; i < 4; ++i) kv[i] = src[tid + 512 * i];
#pragma unroll
      for (int i = 0; i < 4; ++i) ((LAS u32x4*)lds)[tid + 512 * i] = kv[i];
      if (tid < 32) ((LAS u32x4*)(lds + 32768))[tid] = (u32x4){0u, 0u, 0u, 0u}; }
    __syncthreads();
    const int fr = lane & 15, quad = lane >> 4;
    const size_t crow = chunk_row(mt * 16 + fr);
    const bf16_t* ap = proj + (crow + (quad >> 1)) * NIN + COL_U + g * 16 + 8 * (quad & 1);
    f32x4 acc[8];
#pragma unroll
    for (int i = 0; i < 8; ++i) acc[i] = (f32x4){0.f, 0.f, 0.f, 0.f};
    const int tlo = 4 * wave, thi = 60 - 4 * wave;
    const int kkmax = (thi + 3) >> 1;
    const int lbase = (fr * 16 + 8 * (quad & 1)) * 2;
    const int kboth = 2 * wave + 1;
#define S5_B(t_, kk_) ({ const int tau_ = (t_) - 2 * (kk_) - (quad >> 1); *(const LAS bf16x8*)(lds + (tau_ < 0 ? 64 : tau_) * 512 + lbase); })
#pragma unroll 1
    for (int kb = 0; kb <= kkmax; kb += 8) {
        bf16x8 a8[8];
#pragma unroll
        for (int i = 0; i < 8; ++i) a8[i] = *(const bf16x8*)(ap + (size_t)(2 * (kb + i)) * NIN);
        __builtin_amdgcn_sched_barrier(0);
#pragma unroll
        for (int i = 0; i < 8; ++i) {
            const int kk = kb + i;
            if (kk <= kboth) {
#pragma unroll
                for (int ti = 0; ti < 4; ++ti) acc[ti] = __builtin_amdgcn_mfma_f32_16x16x32_bf16(a8[i], S5_B(tlo + ti, kk), acc[ti], 0, 0, 0);
            }
            if (kk <= kkmax) {
#pragma unroll
                for (int ti = 0; ti < 4; ++ti) acc[4 + ti] = __builtin_amdgcn_mfma_f32_16x16x32_bf16(a8[i], S5_B(thi + ti, kk), acc[4 + ti], 0, 0, 0);
            }
        }
    }
#undef S5_B
    {
        const bf16_t* hp = HST + ((size_t)(mt * 16 + fr) * 16 + g) * 128 + 8 * quad;
        const bf16_t* wlo = W3 + ((size_t)(lg * 1024 + tlo * 16 + fr) * 128 + 8 * quad);
        const bf16_t* whi = W3 + ((size_t)(lg * 1024 + thi * 16 + fr) * 128 + 8 * quad);
#pragma unroll 1
        for (int kk = 0; kk < 4; ++kk) {
            const bf16x8 a = *(const bf16x8*)(hp + 32 * kk);
            bf16x8 wb[8];
#pragma unroll
            for (int ti = 0; ti < 8; ++ti) wb[ti] = *(const bf16x8*)((ti < 4 ? wlo + (size_t)ti * 16 * 128 : whi + (size_t)(ti - 4) * 16 * 128) + 32 * kk);
            __builtin_amdgcn_sched_barrier(0);
#pragma unroll
            for (int ti = 0; ti < 8; ++ti) acc[ti] = __builtin_amdgcn_mfma_f32_16x16x32_bf16(a, wb[ti], acc[ti], 0, 0, 0);
        }
    }
#pragma unroll
    for (int ti = 0; ti < 8; ++ti)
#pragma unroll
        for (int r = 0; r < 4; ++r) {
            const int t = ti < 4 ? tlo + ti : thi + ti - 4;
            const size_t row = chunk_row(mt * 16 + 4 * quad + r) + t;
            const float y = acc[ti][r];
            const float uu = 1.5957691216057308f * (y + 0.044715f * y * y * y);
            ybpre[row * 256 + g * 16 + fr] = f2bf(y * __builtin_amdgcn_rcpf(1.0f + __expf(-uu)));
        }
}
}

constexpr int NWAVES = 8;
constexpr int RING_BYTES = 131072, MISC_OFF = RING_BYTES + 320, LDS_BYTES = 147456;
typedef unsigned v4u __attribute__((ext_vector_type(4)));
#define LDS_WAIT() asm volatile("s_waitcnt lgkmcnt(0)" ::: "memory")

struct Args { const float* in[18]; float* out; unsigned char* ws; };

__device__ __forceinline__ void p0_transpose_item(const float* W, int K, int N, bf16_t* WT, LAS float* scr, int item, int lane) {
    const int nblk = N / 32, kb = item / nblk, nb = item % nblk, k0 = 64 * kb, n0 = 32 * nb;
    float wv[32];
#pragma unroll
    for (int i = 0; i < 32; ++i) { const int kk = 2 * i + (lane >> 5); wv[i] = W[(size_t)(k0 + kk) * N + n0 + (lane & 31)]; }
    __builtin_amdgcn_sched_barrier(0);
#pragma unroll
    for (int i = 0; i < 32; ++i) { const int kk = 2 * i + (lane >> 5); scr[kk * 33 + (lane & 31)] = wv[i]; }
    LDS_WAIT();
    const int c = lane & 7;
#pragma unroll
    for (int j = 0; j < 4; ++j) { const int n = (lane >> 3) + 8 * j; const LAS float* s = scr + (8 * c) * 33 + n;
        v4u o; o.x = pk2(s[0 * 33], s[1 * 33]); o.y = pk2(s[2 * 33], s[3 * 33]); o.z = pk2(s[4 * 33], s[5 * 33]); o.w = pk2(s[6 * 33], s[7 * 33]);
        *(v4u*)(WT + (size_t)(n0 + n) * K + k0 + 8 * c) = o; }
    LDS_WAIT();
}
__device__ __forceinline__ void prep_small(int id, const float* a_re, const float* a_im, const float* log_dt, const float* b_re, const float* b_im, const float* hl, float* sm) {
    if (id < DEPTH * 16 * 64) {
        const int lg = id >> 6;
        const double dt = exp((double)log_dt[lg]), ar = a_re[id], ai = a_im[id];
        const double mag = exp(dt * ar); double sn, cs; sincos_d(dt * ai, sn, cs);
        const double are = mag * cs, aim = mag * sn, nr = are - 1.0, ni = aim, den = ar * ar + ai * ai;
        const double zr = (nr * ar + ni * ai) / den, zi = (ni * ar - nr * ai) / den;
        sm[SM_ABAR + id * 2] = (float)are; sm[SM_ABAR + id * 2 + 1] = (float)aim;
        for (int c = 0; c < 16; ++c) {
            const double br = b_re[id * 16 + c], bi = b_im[id * 16 + c];
            sm[SM_BBAR + (id * 16 + c) * 2] = (float)(zr * br - zi * bi);
            sm[SM_BBAR + (id * 16 + c) * 2 + 1] = (float)(zr * bi + zi * br);
        }
    }
    if (id < 256) {
        const float h0 = hl[id], h1 = hl[256 + id], mx = fmaxf(h0, h1), e0 = expf(h0 - mx), e1 = expf(h1 - mx);
        sm[SM_LB + id] = 0.0f; sm[SM_LB + 256 + id] = e1 / (e0 + e1);
    }
}

__device__ __forceinline__ float dot64(const float* qs, const bf16_t* krow) {
    float s = 0.f;
#pragma unroll
    for (int i = 0; i < 8; ++i) {
        const u32x4 v = *(const u32x4*)(krow + i * 8);
#pragma unroll
        for (int j = 0; j < 4; ++j) { s = fmaf(qs[i * 8 + 2 * j], __uint_as_float(v[j] << 16), s); s = fmaf(qs[i * 8 + 2 * j + 1], __uint_as_float(v[j] & 0xffff0000u), s); }
    }
    return s;
}
__device__ __forceinline__ void moba_simple(int gid, int lane, float* scr, const bf16_t* __restrict__ proj, const float* __restrict__ kmean, const float* __restrict__ rel_bias, bf16_t* __restrict__ Y) {
    const int s = gid % SEQ, h = (gid / SEQ) & 3, b = gid / (SEQ * 4);
    float* qs = scr; float* ps = scr + 64;
    const size_t row = (size_t)b * SEQ + s;
    WSYNC();
    qs[lane] = bf2f(proj[row * NIN + COL_QA + h * 64 + lane]);
    WSYNC();
    const int own = s >> 8;
    float g = -INFINITY;
    if (lane < own) { const float* km = kmean + ((b * 4 + h) * 32 + lane) * 64; float a = 0.f; for (int d = 0; d < 64; ++d) a = fmaf(qs[d], km[d], a); g = a; }
    int blk[4]; bool val[4];
#pragma unroll
    for (int t = 0; t < 3; ++t) {
        const float mx = wave_max(g);
        val[t] = mx > -INFINITY;
        const unsigned long long mk = __ballot(g == mx);
        const int idx = val[t] ? (__ffsll((long long)mk) - 1) : own;
        blk[t] = idx;
        if (val[t] && lane == idx) g = -INFINITY;
    }
    blk[3] = own; val[3] = true;
    float lmax = NEGF;
#pragma unroll
    for (int t = 0; t < 4; ++t) {
        for (int i = 0; i < 4; ++i) {
            const int kk = lane + 64 * i, kpos = blk[t] * 256 + kk;
            const bool ok = (t < 3) ? val[t] : (kpos <= s);
            float lg = NEGF;
            if (ok) lg = dot64(qs, proj + ((size_t)b * SEQ + kpos) * NIN + COL_KA + h * 64) * 0.125f + rel_bias[t5_bucket(s - kpos) * 8 + h];
            ps[t * 256 + kk] = lg; lmax = fmaxf(lmax, lg);
        }
    }
    const float mx = wave_max(lmax);
    float lsum = 0.f;
    for (int i = 0; i < 16; ++i) { const float p = expf(ps[lane + 64 * i] - mx); ps[lane + 64 * i] = p; lsum += p; }
    const float tot = wave_sum(lsum);
    WSYNC();
    float acc = 0.f;
#pragma unroll
    for (int t = 0; t < 4; ++t) {
        if (!val[t]) continue;
        const bf16_t* vp = proj + ((size_t)b * SEQ + blk[t] * 256) * NIN + COL_VA + h * 64 + lane;
        const int nk = (t < 3) ? 256 : (s - own * 256 + 1);
        for (int kk = 0; kk < nk; ++kk) acc = fmaf(ps[t * 256 + kk], bf2f(vp[(size_t)kk * NIN]), acc);
    }
    Y[row * DM + h * 64 + lane] = f2bf(acc / tot);
}
__device__ __forceinline__ void dilated_simple(int gid, int lane, float* scr, const bf16_t* __restrict__ proj, const float* __restrict__ rel_bias, bf16_t* __restrict__ Y) {
    const int s = gid % SEQ, h = (gid / SEQ) & 3, b = gid / (SEQ * 4);
    float* qs = scr; float* ps = scr + 64;
    const size_t row = (size_t)b * SEQ + s;
    WSYNC();
    qs[lane] = bf2f(proj[row * NIN + COL_QD + h * 64 + lane]);
    WSYNC();
    float lse[3], ssum[3];
#pragma unroll
    for (int pi = 0; pi < 3; ++pi) {
        const int dil = (pi == 0) ? 1 : (pi == 1) ? 4 : 16;
        float lmax = NEGF;
        for (int i = 0; i < 3; ++i) {
            const int j = lane + 64 * i, kpos = s - j * dil;
            float lg = NEGF;
            if (j <= 128 && kpos >= 0) lg = dot64(qs, proj + ((size_t)b * SEQ + kpos) * NIN + COL_KD + h * 64) * 0.125f + rel_bias[t5_bucket(j * dil) * 8 + 4 + h];
            ps[pi * 192 + j] = lg; lmax = fmaxf(lmax, lg);
        }
        const float mx = wave_max(lmax);
        float lsum = 0.f;
        for (int i = 0; i < 3; ++i) { const int j = lane + 64 * i; const float p = expf(ps[pi * 192 + j] - mx); ps[pi * 192 + j] = p; lsum += p; }
        ssum[pi] = wave_sum(lsum);
        lse[pi] = mx + logf(ssum[pi]);
    }
    WSYNC();
    const float lm = fmaxf(lse[0], fmaxf(lse[1], lse[2]));
    const float w0 = expf(lse[0] - lm), w1 = expf(lse[1] - lm), w2 = expf(lse[2] - lm), wt = w0 + w1 + w2;
    const float wgt[3] = {w0 / wt, w1 / wt, w2 / wt};
    float out = 0.f;
#pragma unroll
    for (int pi = 0; pi < 3; ++pi) {
        const int dil = (pi == 0) ? 1 : (pi == 1) ? 4 : 16;
        float acc = 0.f;
        for (int j = 0; j <= 128; ++j) {
            const int kpos = s - j * dil; if (kpos < 0) break;
            acc = fmaf(ps[pi * 192 + j], bf2f(proj[((size_t)b * SEQ + kpos) * NIN + COL_VD + h * 64 + lane]), acc);
        }
        out += wgt[pi] * acc / ssum[pi];
    }
    Y[row * DM + 768 + h * 64 + lane] = f2bf(out);
}
__device__ __forceinline__ void s5_simple(int b, int g, int lane, float* scr, const bf16_t* __restrict__ proj, const float* __restrict__ sm, const float* __restrict__ c_re, const float* __restrict__ c_im,
                                          const float* __restrict__ dskip, bf16_t* __restrict__ ybpre, int layer) {
    float* hs = scr; float* us = scr + 8192; float* cs = scr + 8192 + 1024;
    const int pid = (layer * 16 + g) * 64 + lane;
    const float are = sm[SM_ABAR + pid * 2], aim = sm[SM_ABAR + pid * 2 + 1];
    float bbr[16], bbi[16];
#pragma unroll
    for (int c = 0; c < 16; ++c) { bbr[c] = sm[SM_BBAR + (pid * 16 + c) * 2]; bbi[c] = sm[SM_BBAR + (pid * 16 + c) * 2 + 1]; }
    for (int c = 0; c < 16; ++c) { cs[(c * 65 + lane) * 2] = c_re[((layer * 16 + g) * 16 + c) * 64 + lane]; cs[(c * 65 + lane) * 2 + 1] = c_im[((layer * 16 + g) * 16 + c) * 64 + lane]; }
    const int oc = lane & 15, otq = lane >> 4;
    const float dsk = dskip[layer * 256 + g * 16 + oc];
    float hr = 0.f, hi = 0.f;
#pragma unroll 1
    for (int t0 = 0; t0 < SEQ; t0 += 64) {
        WSYNC();
#pragma unroll 1
        for (int e = lane; e < 1024; e += 64) { const int t = e >> 4, c = e & 15; us[t * 16 + c] = bf2f(proj[((size_t)b * SEQ + t0 + t) * NIN + COL_U + g * 16 + c]); }
        WSYNC();
#pragma unroll 1
        for (int t = 0; t < 64; ++t) {
            float xr = 0.f, xi = 0.f;
#pragma unroll
            for (int c = 0; c < 16; ++c) { const float u = us[t * 16 + c]; xr = fmaf(bbr[c], u, xr); xi = fmaf(bbi[c], u, xi); }
            const float nr = are * hr - aim * hi + xr, ni = are * hi + aim * hr + xi;
            hr = nr; hi = ni;
            hs[(t * 64 + lane) * 2] = hr; hs[(t * 64 + lane) * 2 + 1] = hi;
        }
        WSYNC();
#pragma unroll 1
        for (int i = 0; i < 16; ++i) {
            const int t = otq + 4 * i;
            float y = 0.f;
#pragma unroll 4
            for (int p = 0; p < 64; ++p) y += hs[(t * 64 + p) * 2] * cs[(oc * 65 + p) * 2] - hs[(t * 64 + p) * 2 + 1] * cs[(oc * 65 + p) * 2 + 1];
            y += dsk * us[t * 16 + oc];
            ybpre[((size_t)b * SEQ + t0 + t) * 256 + g * 16 + oc] = f2bf(gelu_tanh(y));
        }
    }
}
__device__ __forceinline__ void hgrn_simple(int b, int h, int lane, float* scr, const bf16_t* __restrict__ proj, const float* __restrict__ sm, bf16_t* __restrict__ Y, int layer) {
    float* fs = scr; float* qs = scr + 4096; float* is = scr + 8192;
    const float lb = sm[SM_LB + layer * 256 + h * 64 + lane];
    float S[64];
#pragma unroll
    for (int d = 0; d < 64; ++d) S[d] = 0.f;
    for (int t0 = 0; t0 < SEQ; t0 += 64) {
        WSYNC();
        for (int t = 0; t < 64; ++t) {
            const bf16_t* r = proj + ((size_t)b * SEQ + t0 + t) * NIN + h * 64 + lane;
            const float qv = bf2f(r[COL_QC]), fv = bf2f(r[COL_FC]), iv = bf2f(r[COL_IC]);
            fs[t * 64 + lane] = lb + (1.0f - lb) * sigmoidf_(fv); qs[t * 64 + lane] = siluf_(qv) * 0.125f; is[t * 64 + lane] = iv;
        }
        WSYNC();
        for (int t = 0; t < 64; ++t) {
            const float iv = is[t * 64 + lane];
            float o = 0.f;
#pragma unroll
            for (int d = 0; d < 64; ++d) { const float f = fs[t * 64 + d]; S[d] = fmaf(f, S[d] - iv, iv); o = fmaf(qs[t * 64 + d], S[d], o); }
            Y[((size_t)b * SEQ + t0 + t) * DM + 512 + h * 64 + lane] = f2bf(o);
        }
    }
}
__device__ __forceinline__ void unpack16(const bf16_t* p, float* v) {
    const u32x4 y0 = *(const u32x4*)p, y1 = *(const u32x4*)(p + 8);
#pragma unroll
    for (int j = 0; j < 4; ++j) { v[2 * j] = __uint_as_float(y0[j] << 16); v[2 * j + 1] = __uint_as_float(y0[j] & 0xffff0000u); v[8 + 2 * j] = __uint_as_float(y1[j] << 16); v[8 + 2 * j + 1] = __uint_as_float(y1[j] & 0xffff0000u); }
}
__device__ __forceinline__ void combine_row(size_t row, int lane, bf16_t* __restrict__ Y, const bf16_t* __restrict__ proj, const float* __restrict__ gain, const bf16_t* __restrict__ PO, const float* __restrict__ PL, const bf16_t* __restrict__ PARTO, const float* __restrict__ PARTML, const bf16_t* __restrict__ ybpre, const float* __restrict__ glub) {
    bf16_t* yp = Y + row * DM + lane * 16; const bf16_t* gp = proj + row * NIN + COL_G + lane * 16;
    const bool is_m = lane < 16, is_d = lane >= 48, is_s = (lane >= 16) && (lane < 32);
    const int hm = (lane >> 2) & 3;
    const bf16_t* s0 = yp; const bf16_t* s1 = yp; const bf16_t* s2 = yp; const bf16_t* s3 = yp;
    if (is_m) { const bf16_t* pb = PARTO + ((row * 4 + hm) * 3) * 64 + (lane & 3) * 16; s1 = pb; s2 = pb + 64; s3 = pb + 128; }
    if (is_d) { const bf16_t* pb = PO + row * 256 + (lane - 48) * 16; s0 = pb; s1 = pb + (size_t)M * 256; s2 = pb + 2 * (size_t)M * 256; s3 = pb; }
    const float* wp = is_m ? PARTML + ((row * 4 + hm) * 4) * 2 : PL + row * 4 + hm;
    const u32x4 g0 = *(const u32x4*)gp, g1 = *(const u32x4*)(gp + 8);
    const u32x4 a0 = *(const u32x4*)s0, a1 = *(const u32x4*)(s0 + 8), b0 = *(const u32x4*)s1, b1 = *(const u32x4*)(s1 + 8);
    const u32x4 c0 = *(const u32x4*)s2, c1 = *(const u32x4*)(s2 + 8), d0 = *(const u32x4*)s3, d1 = *(const u32x4*)(s3 + 8);
    float4 w01 = {0.f, 0.f, 0.f, 0.f}, w23 = {0.f, 0.f, 0.f, 0.f}; float p1 = 0.f, p2 = 0.f;
    if (is_m) { w01 = *(const float4*)wp; w23 = *(const float4*)(wp + 4); }
    if (is_d) { w01.x = wp[0]; p1 = wp[(size_t)M * 4]; p2 = wp[2 * (size_t)M * 4]; }
    __builtin_amdgcn_sched_barrier(0);
    float wa = 1.f, wb = 0.f, wc = 0.f, wd = 0.f;
    if (is_m) {
        const int own = (int)((row % SEQ) >> 8);
        const float m3 = w23.z, l3 = w23.w;
        const float m0 = own > 0 ? w01.x : NEGF, m1 = own > 1 ? w01.z : NEGF, m2 = own > 2 ? w23.x : NEGF;
        const float mx = fmaxf(fmaxf(m3, m0), fmaxf(m1, m2));
        wa = l3 * __builtin_amdgcn_exp2f(m3 - mx); wb = own > 0 ? w01.y * __builtin_amdgcn_exp2f(m0 - mx) : 0.f; wc = own > 1 ? w01.w * __builtin_amdgcn_exp2f(m1 - mx) : 0.f; wd = own > 2 ? w23.y * __builtin_amdgcn_exp2f(m2 - mx) : 0.f;
        const float wi = 1.0f / (wa + wb + wc + wd); wa *= wi; wb *= wi; wc *= wi; wd *= wi;
    }
    if (is_d) { const float mx = fmaxf(w01.x, fmaxf(p1, p2)); wa = __expf(w01.x - mx); wb = __expf(p1 - mx); wc = __expf(p2 - mx); const float wi = 1.0f / (wa + wb + wc); wa *= wi; wb *= wi; wc *= wi; wd = 0.f; }
    float v[16], gt[16];
#define CB_LO(x) __uint_as_float((x) << 16)
#define CB_HI(x) __uint_as_float((x) & 0xffff0000u)
#pragma unroll
    for (int j = 0; j < 4; ++j) {
        v[2 * j] = wa * CB_LO(a0[j]) + wb * CB_LO(b0[j]) + wc * CB_LO(c0[j]) + wd * CB_LO(d0[j]);         v[2 * j + 1] = wa * CB_HI(a0[j]) + wb * CB_HI(b0[j]) + wc * CB_HI(c0[j]) + wd * CB_HI(d0[j]);
        v[8 + 2 * j] = wa * CB_LO(a1[j]) + wb * CB_LO(b1[j]) + wc * CB_LO(c1[j]) + wd * CB_LO(d1[j]);     v[9 + 2 * j] = wa * CB_HI(a1[j]) + wb * CB_HI(b1[j]) + wc * CB_HI(c1[j]) + wd * CB_HI(d1[j]);
        gt[2 * j] = CB_LO(g0[j]); gt[2 * j + 1] = CB_HI(g0[j]); gt[8 + 2 * j] = CB_LO(g1[j]); gt[9 + 2 * j] = CB_HI(g1[j]);
    }
#undef CB_LO
#undef CB_HI
    float ss = 0.f;
#pragma unroll
    for (int i = 0; i < 16; ++i) ss = fmaf(v[i], v[i], ss);
    ss += __shfl_xor(ss, 1); ss += __shfl_xor(ss, 2);
    const float r = rsqrtf(ss * (1.0f / 64.0f) + RMS_EPS);
    float o[16];
#pragma unroll
    for (int i = 0; i < 16; ++i) o[i] = v[i] * r * gain[lane * 16 + i] * (gt[i] * __builtin_amdgcn_rcpf(1.0f + __expf(-gt[i])));
    u32x4 q0, q1;
    q0.x = cvtpk_s(o[0], o[1]); q0.y = cvtpk_s(o[2], o[3]); q0.z = cvtpk_s(o[4], o[5]); q0.w = cvtpk_s(o[6], o[7]);
    q1.x = cvtpk_s(o[8], o[9]); q1.y = cvtpk_s(o[10], o[11]); q1.z = cvtpk_s(o[12], o[13]); q1.w = cvtpk_s(o[14], o[15]);
    if (!is_s) { *(u32x4*)yp = q0; *(u32x4*)(yp + 8) = q1; }
}
__device__ __forceinline__ void layernorm_row(size_t row, int lane, float* __restrict__ z, bf16_t* __restrict__ xb, const float* __restrict__ lg, const float* __restrict__ lbias) {
    float4* zp = (float4*)(z + row * DM) + lane;
    float4 v[4]; float s = 0.f;
#pragma unroll
    for (int j = 0; j < 4; ++j) { v[j] = zp[64 * j]; s += (v[j].x + v[j].y) + (v[j].z + v[j].w); }
    const float mean = wave_sum(s) * (1.0f / DM); float q = 0.f;
#pragma unroll
    for (int j = 0; j < 4; ++j) { v[j].x -= mean; v[j].y -= mean; v[j].z -= mean; v[j].w -= mean; q += (v[j].x * v[j].x + v[j].y * v[j].y) + (v[j].z * v[j].z + v[j].w * v[j].w); }
    const float rstd = rsqrtf(wave_sum(q) * (1.0f / DM) + LN_EPS);
#pragma unroll
    for (int j = 0; j < 4; ++j) {
        const float4 gg = ((const float4*)lg)[lane + 64 * j], bb = ((const float4*)lbias)[lane + 64 * j];
        float4 o; o.x = v[j].x * rstd * gg.x + bb.x; o.y = v[j].y * rstd * gg.y + bb.y; o.z = v[j].z * rstd * gg.z + bb.z; o.w = v[j].w * rstd * gg.w + bb.w;
        zp[64 * j] = o;
        uint2 ob; ob.x = pk2(o.x, o.y); ob.y = pk2(o.z, o.w);
        ((uint2*)(xb + row * DM))[lane + 64 * j] = ob;
    }
}

struct PrepPtrs { const float *w_in, *w_out, *glu_w, *a_re, *a_im, *log_dt, *b_re, *b_im, *c_re, *c_im, *dskip; unsigned char* ws; };
__device__ __forceinline__ void prep_layer(LAS unsigned char* ldsl, PrepPtrs p, int l, int bxr, int nbr) {
    const int lane = lane_id_opaque(), wave = __builtin_amdgcn_readfirstlane((int)threadIdx.x >> 6), tid = wave * 64 + lane;
    LAS float* scr = (LAS float*)(ldsl + wave * 16384);
    constexpr int I_IN = (DM / 64) * (NIN / 32), I_OUT = (DM / 64) * (DM / 32), I_GLU = (BW / 64) * (BW / 32), I_L = I_IN + I_OUT + I_GLU;
    for (int it = bxr * NWAVES + wave; it < I_L; it += nbr * NWAVES) { int r = it;
        if (r < I_IN) { p0_transpose_item(p.w_in + (size_t)l * DM * NIN, DM, NIN, (bf16_t*)(p.ws + WS_WTIN) + (size_t)l * NIN * DM, scr, r, lane); continue; } r -= I_IN;
        if (r < I_OUT) { p0_transpose_item(p.w_out + (size_t)l * DM * DM, DM, DM, (bf16_t*)(p.ws + WS_WTOUT) + (size_t)l * DM * DM, scr, r, lane); continue; } r -= I_OUT;
        p0_transpose_item(p.glu_w + (size_t)l * BW * BW, BW, BW, (bf16_t*)(p.ws + WS_GLUWT) + (size_t)l * BW * BW, scr, r, lane); }
    for (int e = l * 65536 + bxr * 512 + tid; e < (l + 1) * 65536; e += nbr * 512)
        s5::tables_thread(e, p.a_re, p.a_im, p.log_dt, p.b_re, p.b_im, p.c_re, p.c_im, (bf16_t*)(p.ws + WS_W1), (bf16_t*)(p.ws + WS_W3), (float*)(p.ws + WS_SMALL) + SM_A64);
    for (int it = l * 1024 + bxr; it < (l + 1) * 1024; it += nbr)
        s5::kmat_item((LAS float*)ldsl, tid, it, p.a_re, p.a_im, p.log_dt, p.b_re, p.b_im, p.c_re, p.c_im, p.dskip, (bf16_t*)(p.ws + WS_KM));
}

#define OPQS(x) asm volatile("" : "+s"(x))
#define OPQ(x) asm volatile("" : "+v"(x))
__global__ void __launch_bounds__(NWAVES * 64, 2) mega_fwd(Args args) {
    extern __shared__ __attribute__((aligned(16))) unsigned char lds[];
#define LANE_ID() ({ unsigned z_ = 0u; asm volatile("" : "+v"(z_)); (int)__builtin_amdgcn_mbcnt_hi(~0u, __builtin_amdgcn_mbcnt_lo(~0u, z_)); })
#define TID_() (wave * 64 + LANE_ID())
#define tid_ TID_()
#define lane_ LANE_ID()
    const int wave = __builtin_amdgcn_readfirstlane((int)threadIdx.x >> 6);
    const int G = gridDim.x, bx = blockIdx.x, bx_ = bx;
    LAS unsigned char* ldsl = (LAS unsigned char*)lds;
    volatile LAS unsigned* MISC = (volatile LAS unsigned*)(ldsl + MISC_OFF);
    for (int u = tid_; u < (LDS_BYTES - RING_BYTES) / 4; u += NWAVES * 64) ((LAS unsigned*)(ldsl + RING_BYTES))[u] = 0u;
    __syncthreads();
    const XcdBarrier bar = xcd_barrier_post((unsigned*)(args.ws + WS_CTL) + CW_BAR, MISC + 8);
    const int gw = bx * NWAVES + wave, NGW = G * NWAVES;
#ifdef PROBE_A
#define STAMP(k) do { if (bx_ == 0 && threadIdx.x == 0) MISC[16 + (k)] = (unsigned)__builtin_amdgcn_s_memrealtime(); } while (0)
#else
#define STAMP(k) do { } while (0)
#endif
#define SUBSTAMP(k) STAMP(32 + (k))
    int stamp_i = 0;
#define GRID_BAR() do { GRID_BAR0(); ++stamp_i; STAMP(stamp_i); } while (0)
    constexpr int DIL_QA = 384, DIL_QB = 1024;
#define DIL_UNIT(park_, tidq_, ug_, ws_) do { const int ug__ = (ug_); fa2::dilated_unit(park_, ldsl, tidq_, 2 - ug__ / 512, (ug__ >> 5) & 15, ug__ & 31, (const bf16_t*)((ws_) + WS_PROJ), (const float*)((ws_) + WS_SMALL) + SM_LUTD, (bf16_t*)((ws_) + WS_PO), (float*)((ws_) + WS_PL)); } while (0)
#define DIL_FILL(wqp_, lo_, hi_, ws_) do { unsigned* wq__ = (wqp_); const int tid__ = wave * 64 + LANE_ID(); __syncthreads(); \
        if (tid__ == 0) MISC[4] = __hip_atomic_fetch_add(wq__, 1u, __ATOMIC_RELAXED, __HIP_MEMORY_SCOPE_AGENT); \
        for (;;) { __syncthreads(); const int it__ = (int)MISC[4]; if (it__ >= (hi_) - (lo_)) break; unsigned nxt__ = 0u; int tidq__ = tid__; OPQ(tidq__); \
            if (tidq__ == 0) nxt__ = __hip_atomic_fetch_add(wq__, 1u, __ATOMIC_RELAXED, __HIP_MEMORY_SCOPE_AGENT); \
            auto park__ = [&]() { if (tidq__ == 0) MISC[4] = nxt__; }; DIL_UNIT(park__, tidq__, (lo_) + it__, ws_); } } while (0)
#define GRID_BAR0() do { XcdBarrier b_ = bar; unsigned x_ = b_.x; unsigned* p_ = b_.bar; asm volatile("" : "+s"(x_), "+s"(p_)); b_.x = x_; b_.bar = p_; xcd_barrier(b_); } while (0)

    STAMP(0);
    {
        const Args* A = &args; unsigned char* ws = launder_g(args.ws);
        int lane = lane_, tid = tid_; OPQ(lane); OPQ(tid);
        const float* x = A->in[0]; const float* w_in = A->in[1]; const float* glu_w = A->in[11]; const float* w_out = A->in[15];
        bf16_t* wtin = (bf16_t*)(ws + WS_WTIN); bf16_t* wtout = (bf16_t*)(ws + WS_WTOUT); bf16_t* gluwt = (bf16_t*)(ws + WS_GLUWT); bf16_t* xb = (bf16_t*)(ws + WS_XB);
        { PrepPtrs pp{A->in[1], A->in[15], A->in[11], A->in[3], A->in[4], A->in[5], A->in[6], A->in[7], A->in[8], A->in[9], A->in[10], ws}; prep_layer(ldsl, pp, 0, bx, G); prep_layer(ldsl, pp, 1, bx, G); }
        SUBSTAMP(8);
        for (size_t i = (size_t)bx * 512 + tid; i < (size_t)M * DM / 4; i += (size_t)G * 512 * 8) {
            float4 v[8];
#pragma unroll
            for (int j = 0; j < 8; ++j) v[j] = ((const float4*)x)[i + (size_t)j * G * 512];
            __builtin_amdgcn_sched_barrier(0);
#pragma unroll
            for (int j = 0; j < 8; ++j) { uint2 o; o.x = cvtpk_s(v[j].x, v[j].y); o.y = cvtpk_s(v[j].z, v[j].w); ((uint2*)xb)[i + (size_t)j * G * 512] = o; }
        }
        SUBSTAMP(9);
        if (bx < 8 && tid < 256) prep_small(bx * 256 + tid, A->in[3], A->in[4], A->in[5], A->in[6], A->in[7], A->in[13], (float*)(ws + WS_SMALL));
        if (bx == 8) { float* smc = (float*)(ws + WS_SMALL);
            for (int i = tid; i < 256; i += 512) smc[SM_RELB + i] = A->in[2][i];
            for (int i = tid; i < 512; i += 512) smc[SM_GLUB + i] = A->in[12][i];
            for (int i = tid; i < 2048; i += 512) { smc[SM_GAIN + i] = A->in[14][i]; smc[SM_LNG + i] = A->in[16][i]; smc[SM_LNB + i] = A->in[17][i]; } }
        if (bx == 9) { float* smc = (float*)(ws + WS_SMALL); const float* rb = A->in[2];
            for (int i = tid; i < 4 * 1888; i += 512) { const int h = i / 1888, dd = i % 1888 - 96; smc[SM_LUTM + i] = dd >= 0 ? rb[t5_bucket(dd) * 8 + h] * 1.4426950408889634f : NEGF; }
            for (int i = tid; i < 3 * 4 * 256; i += 512) { const int pi = i >> 10, h = (i >> 8) & 3, dd = (i & 255) - 64, dil = (pi == 0) ? 1 : (pi == 1) ? 4 : 16;
                smc[SM_LUTD + i] = (dd >= 0 && dd <= 128) ? rb[t5_bucket(dd * dil) * 8 + 4 + h] * 1.4426950408889634f : NEGF; } }
    }
    GRID_BAR();

    auto layer_body = [&](auto LC) __attribute__((always_inline)) { constexpr int l = decltype(LC)::value;
        {
            const Args* A = &args; unsigned char* ws = launder_g(args.ws);
            pg8::Gemm g{(const bf16_t*)(ws + WS_XB), (const bf16_t*)(ws + WS_WTIN) + (size_t)l * NIN * DM, M, NIN, DM}; int tidg = tid_, bxg = bx; OPQ(tidg); OPQS(bxg); pg8::StaticOrder S; S.init(M, NIN, G, bxg);
            pg8::EpiStoreBf16 E{(bf16_t*)(ws + WS_PROJ), NIN, (float*)(ws + WS_KP)};
            pg8::gemm_phase<pg8::EpiStoreBf16, pg8::StaticOrder, true, true>(ldsl, g, S, E, tidg);
        }
        GRID_BAR();
        {
            const Args* A = &args; unsigned char* ws = launder_g(args.ws);
            const bf16_t* proj = (const bf16_t*)(ws + WS_PROJ);
            int lane = lane_; OPQ(lane); const int tid = wave * 64 + lane;
            const float* lbp = (const float*)(ws + WS_SMALL) + SM_LB + l * 256;
            unsigned* wq = (unsigned*)(ws + WS_CTL) + CW_WQ + 64 * l;
            for (int it = gw; it < 2048; it += NGW) hw::x1_wave(ldsl + wave * 16384, lane, it, proj, lbp, (float*)(ws + WS_DS), (float*)(ws + WS_DEC));
            SUBSTAMP(0);
            for (int wi = gw; wi < 512; wi += NGW) s5::x1_wave(lane, wi & 15, wi >> 4, l * 16 + (wi & 15), proj, (const bf16_t*)(ws + WS_W1), (float*)(ws + WS_HEND));
            SUBSTAMP(1);
            constexpr int N_GATE = 512;
            __syncthreads();
            if (tid == 0) MISC[4] = __hip_atomic_fetch_add(wq, 1u, __ATOMIC_RELAXED, __HIP_MEMORY_SCOPE_AGENT);
            for (;;) {
                __syncthreads();
                const int it = (int)MISC[4];
                if (it >= N_GATE) break;
                int tidq = tid; OPQ(tidq);
                __syncthreads();
                if (tidq == 0) MISC[4] = __hip_atomic_fetch_add(wq, 1u, __ATOMIC_RELAXED, __HIP_MEMORY_SCOPE_AGENT);
                fa2::gate_item(ldsl, tidq, it & 15, 31 - (it >> 4), proj, (const float*)(ws + WS_KP), (unsigned short*)(ws + WS_LIST), (int*)(ws + WS_CNT));
            }
            SUBSTAMP(2);
            DIL_FILL((unsigned*)(ws + WS_CTL) + CW_WQ + 64 * (4 + l), 0, DIL_QA, ws);
            SUBSTAMP(7);
        }
        GRID_BAR();
        {
            const Args* A = &args; unsigned char* ws = launder_g(args.ws);
            const bf16_t* proj = (const bf16_t*)(ws + WS_PROJ); const float* sm = (const float*)(ws + WS_SMALL);
            int lane = lane_; OPQ(lane);
            int bx = bx_; OPQS(bx);
            const int tid = wave * 64 + lane;
            if (bx < 32) hg::x2_scan(bx * 512 + tid, 32 * 512, (const float*)(ws + WS_DS), (const float*)(ws + WS_DEC), (bf16_t*)(ws + WS_ST));
            else if (bx < 40) s5::x2_scan((bx - 32) * 512 + tid, (const float*)(ws + WS_HEND), sm + SM_A64, (bf16_t*)(ws + WS_HST), l);
            unsigned* wq = (unsigned*)(ws + WS_CTL) + CW_WQ + 64 * (2 + l);
            unsigned* sflag = (unsigned*)(ws + WS_CTL) + CW_WQ + 64 * (10 + l);
            const float* lutm = sm + SM_LUTM; const float* lutd = sm + SM_LUTD;
            const float* lbp = sm + SM_LB + l * 256;
            if (bx < 40) {
                asm volatile("s_waitcnt vmcnt(0)" ::: "memory"); __syncthreads();
                if (tid == 0) { __builtin_amdgcn_fence(__ATOMIC_RELEASE, "agent"); asm volatile("s_waitcnt vmcnt(0)" ::: "memory"); __hip_atomic_fetch_add(sflag, 1u, __ATOMIC_RELAXED, __HIP_MEMORY_SCOPE_AGENT); }
            }
            bool scans_seen = false;
            __syncthreads();
            if (tid == 0) MISC[4] = __hip_atomic_fetch_add(wq, 1u, __ATOMIC_RELAXED, __HIP_MEMORY_SCOPE_AGENT);
            for (;;) {
                __syncthreads();
                int it = (int)MISC[4];
                constexpr int N_MOBA = 8 * 64 + 12 * 32 + 12 * 16, N_S5X = 512, N_HGX = 256, N_DIL = 1536 - DIL_QA;
                if (it >= N_MOBA + N_S5X + N_HGX + N_DIL) break;
                unsigned nxt = 0u;
                if (tid == 0) nxt = __hip_atomic_fetch_add(wq, 1u, __ATOMIC_RELAXED, __HIP_MEMORY_SCOPE_AGENT);
                int tidq = tid; OPQ(tidq);
                auto park = [&]() { if (tidq == 0) MISC[4] = nxt; };
                if (it < N_MOBA) {
                    int n, part, np;
                    if (it < 512) { n = it >> 6; part = (it >> 4) & 3; np = 4; } else if (it < 896) { const int j = it - 512; n = 8 + (j >> 5); part = (j >> 4) & 1; np = 2; } else { n = 20 + ((it - 896) >> 4); part = 0; np = 1; }
                    fa2::moba_item(park, ldsl, tidq, it & 15, n, part, np, proj, sm + SM_RELB, lutm, (const unsigned short*)(ws + WS_LIST), (const int*)(ws + WS_CNT), (bf16_t*)(ws + WS_PARTO), (float*)(ws + WS_PARTML), (bf16_t*)(ws + WS_Y));
                } else if (it < N_MOBA + N_S5X + N_HGX) {
                    if (!scans_seen) {
                        if (tidq == 0) { unsigned sp = 0; while (__hip_atomic_load(sflag, __ATOMIC_RELAXED, __HIP_MEMORY_SCOPE_AGENT) < 40u) { __builtin_amdgcn_s_sleep(4); if (++sp > (1u << 24)) break; }
                            __builtin_amdgcn_fence(__ATOMIC_ACQUIRE, "agent"); asm volatile("s_waitcnt vmcnt(0)" ::: "memory"); }
                        scans_seen = true;
                    }
                    __syncthreads();
                    park();
                    if (it < N_MOBA + N_S5X) s5::x3_item(ldsl, wave, tidq & 63, it - N_MOBA, l, proj, (const bf16_t*)(ws + WS_KM), (const bf16_t*)(ws + WS_W3), (const bf16_t*)(ws + WS_HST), (bf16_t*)(ws + WS_YBPRE));
                    else hw::x3_wave(ldsl + wave * 16384, tidq & 63, (it - N_MOBA - N_S5X) * 8 + wave, proj, lbp, (const bf16_t*)(ws + WS_ST), (bf16_t*)(ws + WS_Y));
                } else DIL_UNIT(park, tidq, DIL_QA + it - (N_MOBA + N_S5X + N_HGX), ws);
            }
            SUBSTAMP(5);
        }
        GRID_BAR();
        {
            const Args* A = &args; unsigned char* ws = launder_g(args.ws);
            {
                const bf16_t* ybpre = (const bf16_t*)(ws + WS_YBPRE);
                pg8::Gemm g{ybpre, (const bf16_t*)(ws + WS_GLUWT) + (size_t)l * BW * BW, M, BW, BW}; int tidg = tid_, bxg = bx; OPQ(tidg); OPQS(bxg); pg8::StaticOrder S; S.init(M, BW, G, bxg);
                const float* smp = (const float*)(ws + WS_SMALL);
                pg8::EpiGluNorm E{(bf16_t*)(ws + WS_Y), ybpre, (const bf16_t*)(ws + WS_PROJ), smp + SM_GLUB + l * BW, smp + SM_GAIN + l * DM, ldsl + RING_BYTES + 1024};
                pg8::gemm_phase<pg8::EpiGluNorm, pg8::StaticOrder, true, false>(ldsl, g, S, E, tidg);
            }
            {
                int lane = lane_; OPQ(lane);
                unsigned* wq = (unsigned*)(ws + WS_CTL) + CW_WQ + 64 * (8 + l);
                for (;;) {
                    __syncthreads();
                    if (wave == 0 && lane == 0) MISC[4] = __hip_atomic_fetch_add(wq, 1u, __ATOMIC_RELAXED, __HIP_MEMORY_SCOPE_AGENT);
                    __syncthreads();
                    const int ch = (int)MISC[4];
                    if (ch >= M / 64) break;
                    for (int r = 0; r < 8; ++r) combine_row((size_t)ch * 64 + wave * 8 + r, lane, (bf16_t*)(ws + WS_Y), (const bf16_t*)(ws + WS_PROJ), (const float*)(ws + WS_SMALL) + SM_GAIN + l * DM, (const bf16_t*)(ws + WS_PO), (const float*)(ws + WS_PL), (const bf16_t*)(ws + WS_PARTO), (const float*)(ws + WS_PARTML), (const bf16_t*)(ws + WS_YBPRE), (const float*)(ws + WS_SMALL) + SM_GLUB + l * BW);
                }
            }
        }
        GRID_BAR();
        {
            const Args* A = &args; unsigned char* ws = launder_g(args.ws);
            pg8::Gemm g{(const bf16_t*)(ws + WS_Y), (const bf16_t*)(ws + WS_WTOUT) + (size_t)l * DM * DM, M, DM, DM}; int tidg = tid_, bxg = bx; OPQ(tidg); OPQS(bxg); pg8::StaticOrder S; S.init(M, DM, G, bxg);
            const float* smp = (const float*)(ws + WS_SMALL);
            float* outp = launder_g(args.out); const float* resp = launder_g(args.in[0]);
            pg8::EpiResLn E{l == 0 ? resp : outp, outp, (bf16_t*)(ws + WS_XB), smp + SM_LNG + l * DM, smp + SM_LNB + l * DM, (unsigned long long*)(ws + WS_YBPRE), (unsigned*)(ws + WS_CTL) + CW_SEAM + l * 128 * 64, ldsl + RING_BYTES + 1024};
            pg8::gemm_phase<pg8::EpiResLn, pg8::StaticOrder, true, true>(ldsl, g, S, E, tidg);
        }
        if (l + 1 < DEPTH) GRID_BAR();
    };
    layer_body(std::integral_constant<int, 0>{});
    layer_body(std::integral_constant<int, 1>{});
#ifdef PROBE_A
    ++stamp_i; STAMP(stamp_i);
    if (bx_ == 0 && threadIdx.x == 0) { asm volatile("s_waitcnt vmcnt(0) lgkmcnt(0)" ::: "memory"); args.out[0] += (float)(MISC[16 + PROBE_B] - MISC[16 + PROBE_A]) * 1e-3f; }
#endif
}

extern "C" void kernel_launch(void* const* d_in, const int* in_sizes, int n_in, void* d_out, int out_size, void* d_ws, size_t ws_size, hipStream_t stream) {
    static int grid = 0;
    if (grid == 0) {
        if (n_in != 18 || in_sizes[0] != M * DM || out_size != M * DM || ws_size < WS_END) { fprintf(stderr, "kernel_launch: unexpected shapes (n_in %d, in0 %d, out %d, ws %zu)\n", n_in, n_in > 0 ? in_sizes[0] : -1, out_size, ws_size); grid = -1; return; }
        int dev = 0, cus = 0, per_cu = 0;
        if (hipGetDevice(&dev) != hipSuccess || hipDeviceGetAttribute(&cus, hipDeviceAttributeMultiprocessorCount, dev) != hipSuccess) { grid = -1; return; }
        if (hipFuncSetAttribute((const void*)mega_fwd, hipFuncAttributeMaxDynamicSharedMemorySize, LDS_BYTES) != hipSuccess) { fprintf(stderr, "kernel_launch: hipFuncSetAttribute failed\n"); grid = -1; return; }
        if (hipOccupancyMaxActiveBlocksPerMultiprocessor(&per_cu, (const void*)mega_fwd, NWAVES * 64, LDS_BYTES) != hipSuccess || per_cu < 1) { fprintf(stderr, "kernel_launch: occupancy query says %d\n", per_cu); }
        (void)hipGetLastError();
        grid = cus;
    }
    if (grid < 0) return;
    if (hipMemsetAsync((char*)d_ws + WS_CTL, 0, CTL_ZERO_BYTES, stream) != hipSuccess) return;
    Args a{};
    for (int i = 0; i < 18; ++i) a.in[i] = (const float*)d_in[i];
    a.out = (float*)d_out; a.ws = (unsigned char*)d_ws;
    hipLaunchKernelGGL(mega_fwd, dim3(grid), dim3(NWAVES * 64), LDS_BYTES, stream, a);
}
```

```cpp
#include <hip/hip_runtime.h>
#include <stdint.h>
#include <cstdio>
#include <type_traits>

typedef unsigned short bf16_t;
typedef unsigned u32x4 __attribute__((ext_vector_type(4)));
#define LAS __attribute__((address_space(3)))
#define GAS __attribute__((address_space(1)))

constexpr int BATCH = 4, SEQ = 8192, DM = 1024, M = BATCH * SEQ, BW = 256, NIN = 3584, HD = 64, DEPTH = 2;
constexpr int COL_QA = 0, COL_KA = 256, COL_VA = 512, COL_U = 768, COL_QC = 1024, COL_FC = 1280, COL_IC = 1536, COL_QD = 1792, COL_KD = 2048, COL_VD = 2304, COL_G = 2560;
constexpr float ALPHA = 1.4142135623730951f;
constexpr float LN_EPS = 1e-5f, RMS_EPS = 1e-6f, NEGF = -1e30f;

constexpr size_t MiB = 1u << 20;
constexpr size_t WS_CTL = 0, CTL_ZERO_BYTES = 1 * MiB;
constexpr size_t WS_SMALL = 1 * MiB;
constexpr size_t WS_WTIN = 2 * MiB;
constexpr size_t WS_WTOUT = 16 * MiB;
constexpr size_t WS_GLUWT = 20 * MiB;
constexpr size_t WS_KP = 21 * MiB;
constexpr size_t WS_XB = 22 * MiB;
constexpr size_t WS_PARTO = WS_XB;
constexpr size_t WS_PARTML = WS_XB + 48 * MiB;
constexpr size_t WS_LIST = WS_XB + 52 * MiB;
constexpr size_t WS_CNT = WS_XB + 60 * MiB;
constexpr size_t WS_PROJ = 86 * MiB;
constexpr size_t WS_Y = 310 * MiB;
constexpr size_t WS_YBPRE = 374 * MiB;
constexpr size_t WS_PO = 390 * MiB;
constexpr size_t WS_PL = 438 * MiB;
constexpr size_t WS_DS = 440 * MiB;
constexpr size_t WS_ST = 472 * MiB;
constexpr size_t WS_DEC = 488 * MiB;
constexpr size_t WS_KM = 489 * MiB;
constexpr size_t WS_W1 = 490 * MiB;
constexpr size_t WS_W3 = 498 * MiB;
constexpr size_t WS_HEND = 506 * MiB;
constexpr size_t WS_HST = 510 * MiB;
constexpr size_t WS_END = 512 * MiB;
constexpr int SM_LB = 0;
constexpr int SM_ABAR = 512;
constexpr int SM_BBAR = SM_ABAR + 2 * 16 * 64 * 2;
constexpr int SM_A64 = SM_BBAR + 2 * 16 * 64 * 16 * 2;
constexpr int SM_RELB = SM_A64 + 2 * 16 * 64 * 2, SM_GLUB = SM_RELB + 256, SM_GAIN = SM_GLUB + 512, SM_LNG = SM_GAIN + 2048, SM_LNB = SM_LNG + 2048, SM_END = SM_LNB + 2048;
constexpr int SM_LUTM = SM_END, SM_LUTD = SM_LUTM + 4 * 1888, SM_END2 = SM_LUTD + 3 * 4 * 256;
constexpr int CW_BAR = 4096;
constexpr int CW_SEAM = 32768;
constexpr int CW_WQ = 16384;

__device__ __forceinline__ float bf2f(bf16_t v) { return __uint_as_float(((unsigned)v) << 16); }

__device__ __forceinline__ float wave_max(float v) {
#pragma unroll
    for (int o = 1; o < 64; o <<= 1) v = fmaxf(v, __shfl_xor(v, o));
    return v;
}
__device__ __forceinline__ float wave_sum(float v) {
#pragma unroll
    for (int o = 1; o < 64; o <<= 1) v += __shfl_xor(v, o);
    return v;
}
__device__ __forceinline__ int t5_bucket(int d) {
    if (d < 16) return d;
    int b = 16;
    b += (d >= 22); b += (d >= 30); b += (d >= 40); b += (d >= 54); b += (d >= 73); b += (d >= 99); b += (d >= 134); b += (d >= 182);
    b += (d >= 246); b += (d >= 332); b += (d >= 450); b += (d >= 609); b += (d >= 825); b += (d >= 1117); b += (d >= 1513);
    return b;
}
__device__ __forceinline__ float sigmoidf_(float x) { return 1.0f / (1.0f + expf(-x)); }
__device__ __forceinline__ float siluf_(float x) { return x / (1.0f + expf(-x)); }
__device__ __forceinline__ float gelu_tanh(float x) { const float u = 0.7978845608028654f * (x + 0.044715f * x * x * x); return 0.5f * x * (1.0f + tanhf(u)); }
typedef float f32x2_t __attribute__((ext_vector_type(2))); typedef __bf16 bf16x2_t __attribute__((ext_vector_type(2)));
__device__ __forceinline__ unsigned cvtpk_s(float lo, float hi) { f32x2_t v = {lo, hi}; bf16x2_t b = __builtin_convertvector(v, bf16x2_t); return __builtin_bit_cast(unsigned, b); }
__device__ __forceinline__ bf16_t f2bf(float f) { return (bf16_t)(cvtpk_s(f, f) & 0xffffu); }
__device__ __forceinline__ unsigned pk2(float lo, float hi) { return cvtpk_s(lo, hi); }
__device__ __forceinline__ int lane_id_opaque() { unsigned z = 0u; asm volatile("" : "+v"(z)); return (int)__builtin_amdgcn_mbcnt_hi(~0u, __builtin_amdgcn_mbcnt_lo(~0u, z)); }
template <class T> __device__ __forceinline__ T* launder_g(T* p) { unsigned long long v = (unsigned long long)p; asm volatile("" : "+s"(v)); return (T*)(__attribute__((address_space(1))) T*)v; }
#define WSYNC() asm volatile("s_waitcnt lgkmcnt(0)" ::: "memory")

__device__ __forceinline__ void sincos_d(double th, double& s, double& c) {
    const double k = rint(th * 0.63661977236758134308);
    double r = fma(-k, 1.57079632679489655800, th); r = fma(-k, 6.12323399573676603587e-17, r);
    const long q = ((long)k) & 3;
    const double r2 = r * r;
    const double sp = r * (1.0 + r2 * (-1.0 / 6 + r2 * (1.0 / 120 + r2 * (-1.0 / 5040 + r2 * (1.0 / 362880 + r2 * (-1.0 / 39916800 + r2 * (1.0 / 6227020800.0 + r2 * (-1.0 / 1307674368000.0))))))));
    const double cp = 1.0 + r2 * (-0.5 + r2 * (1.0 / 24 + r2 * (-1.0 / 720 + r2 * (1.0 / 40320 + r2 * (-1.0 / 3628800 + r2 * (1.0 / 479001600.0 + r2 * (-1.0 / 87178291200.0 + r2 * (1.0 / 20922789888000.0))))))));
    if (q == 0) { s = sp; c = cp; } else if (q == 1) { s = cp; c = -sp; } else if (q == 2) { s = -sp; c = -cp; } else { s = -cp; c = sp; }
}

namespace pg8 {
#define PG8_LAS __attribute__((address_space(3)))
typedef unsigned short bf16_t;
typedef short bf16x8 __attribute__((ext_vector_type(8)));
typedef float f32x4 __attribute__((ext_vector_type(4)));
typedef unsigned u32x4 __attribute__((ext_vector_type(4)));
constexpr int BM = 256, BK = 64, HALF = 128, HTB = HALF * BK * 2  , STAGE_BYTES = 8 * HTB, NXCD = 8, WGM = 8;

__host__ __device__ __forceinline__ int lds_byte(int r, int c) { const int st = (r >> 4) * 2 + (c >> 5), rr = r & 15, cc = c & 31, ob = rr * 64 + cc * 2; return st * 1024 + (ob ^ (((ob >> 9) & 1) << 5)); }
__host__ __device__ __forceinline__ void stage_rc(int b, int& R, int& C) { const int st = b / 1024, sb = b % 1024, swz = sb ^ (((sb >> 9) & 1) << 5); R = (st >> 1) * 16 + swz / 64; C = (st & 1) * 32 + (swz % 64) / 2; }
__host__ __device__ __forceinline__ int perm32(int rho) { const int n = rho >> 4, i = rho & 15; return 8 * (i >> 2) + 4 * n + (i & 3); }

struct Unit { int pm, pn; };
struct Gemm { const bf16_t* A; const bf16_t* Bt; int M, N, K; };

struct StaticOrder {
    int nM, nN, nwg, G, c;
    __host__ __device__ void init(int M, int N, int G_, int c_) { nM = M / BM; nN = N / BM; nwg = nM * nN; G = G_; c = c_; }
    __host__ __device__ bool next(int i, Unit& u) const {
        const long L = (long)i * G + c; if (L >= nwg) return false;
        int wgid = (int)L; { const int q = nwg / NXCD, r = nwg % NXCD, xcd = wgid % NXCD, off = wgid / NXCD; wgid = (xcd < r ? xcd * (q + 1) : r * (q + 1) + (xcd - r) * q) + off; }
        const int nig = WGM * nN, gid = wgid / nig, fm = gid * WGM, gsz = (nM - fm) < WGM ? (nM - fm) : WGM;
        u.pm = fm + ((wgid % nig) % gsz); u.pn = (wgid % nig) / gsz; return true;
    }
    __device__ __forceinline__ void a_ready(const Unit&) const {}
    __device__ __forceinline__ void done(const Unit&) const {}
};

__device__ __forceinline__ unsigned cvt_pk_bf16(float lo, float hi) { unsigned r; asm volatile("v_cvt_pk_bf16_f32 %0, %1, %2" : "=v"(r) : "v"(lo), "v"(hi)); return r; }
struct EpiStoreBf16 {
    static constexpr bool PERM = true, AFTER_DRAIN = false;
    bf16_t* O; int ldc; float* kp;
    __device__ __forceinline__ void operator()(const f32x4 (&acc)[2][2][4][2], const Unit& u, int wr, int wc, int fr_, int fq_) const {
        const int ln_ = lane_id_opaque(), fr = ln_ & 15, fq = ln_ >> 4; (void)fr_; (void)fq_;
        const int row0 = u.pm * BM + wr * 64 + fr, col0 = u.pn * BM + wc * 32 + 8 * fq;
#pragma unroll
        for (int ai = 0; ai < 2; ++ai)
#pragma unroll
            for (int m = 0; m < 4; ++m) { bf16_t* rowp = O + (size_t)(row0 + ai * HALF + m * 16) * ldc + col0;
#pragma unroll
                for (int bj = 0; bj < 2; ++bj) { const f32x4 v0 = acc[ai][bj][m][0], v1 = acc[ai][bj][m][1];
                    u32x4 w; w.x = cvtpk_s(v0[0], v0[1]); w.y = cvtpk_s(v0[2], v0[3]); w.z = cvtpk_s(v1[0], v1[1]); w.w = cvtpk_s(v1[2], v1[3]);
                    *(u32x4*)(rowp + bj * HALF) = w; } }
        if (kp && u.pn == 1) {
#pragma unroll
            for (int bj = 0; bj < 2; ++bj)
#pragma unroll
                for (int n = 0; n < 2; ++n) { f32x4 s = {0.f, 0.f, 0.f, 0.f};
#pragma unroll
                    for (int ai = 0; ai < 2; ++ai)
#pragma unroll
                        for (int m = 0; m < 4; ++m) s += acc[ai][bj][m][n];
#pragma unroll
                    for (int o = 1; o < 16; o <<= 1) { s[0] += __shfl_xor(s[0], o); s[1] += __shfl_xor(s[1], o); s[2] += __shfl_xor(s[2], o); s[3] += __shfl_xor(s[3], o); }
                    if (fr == 0) *(f32x4*)(kp + (size_t)(u.pm * 2 + wr) * 256 + bj * HALF + wc * 32 + 8 * fq + 4 * n) = s; }
        }
    }
};
struct EpiGlu {
    static constexpr bool PERM = true, AFTER_DRAIN = false;
    bf16_t* O; int ldc; const bf16_t* Ain; int lda; const float* bias;
    __device__ __forceinline__ void operator()(const f32x4 (&acc)[2][2][4][2], const Unit& u, int wr, int wc, int fr_, int fq_) const {
        const int ln_ = lane_id_opaque(), fr = ln_ & 15, fq = ln_ >> 4; (void)fr_; (void)fq_;
        const int row0 = u.pm * BM + wr * 64 + fr, col0 = u.pn * BM + wc * 32 + 8 * fq;
        bf16_t* O = launder_g(this->O); const bf16_t* Ain = launder_g(this->Ain); const float* bias = launder_g(this->bias);
#pragma unroll
        for (int ai = 0; ai < 2; ++ai)
#pragma unroll
            for (int m = 0; m < 4; ++m) { const size_t r = (size_t)(row0 + ai * HALF + m * 16);
#pragma unroll
                for (int bj = 0; bj < 2; ++bj) { const int c = col0 + bj * HALF;
                    const u32x4 av = *(const u32x4*)(Ain + r * lda + c);
                    const f32x4 b0 = *(const f32x4*)(bias + c), b1 = *(const f32x4*)(bias + c + 4);
                    const f32x4 v0 = acc[ai][bj][m][0] + b0, v1 = acc[ai][bj][m][1] + b1;
                    float o[8];
#pragma unroll
                    for (int j = 0; j < 4; ++j) { const float alo = __uint_as_float(av[j] << 16), ahi = __uint_as_float(av[j] & 0xffff0000u);
                        const float s0 = (j < 2) ? v0[2 * j] : v1[2 * j - 4], s1 = (j < 2) ? v0[2 * j + 1] : v1[2 * j - 3];
                        o[2 * j] = alo * __builtin_amdgcn_rcpf(1.0f + __expf(-s0)); o[2 * j + 1] = ahi * __builtin_amdgcn_rcpf(1.0f + __expf(-s1)); }
                    u32x4 w; w.x = cvtpk_s(o[0], o[1]); w.y = cvtpk_s(o[2], o[3]); w.z = cvtpk_s(o[4], o[5]); w.w = cvtpk_s(o[6], o[7]);
                    *(u32x4*)(O + r * ldc + c) = w; } }
    }
};
struct EpiResF32 {
    static constexpr bool PERM = false, AFTER_DRAIN = false;
    const float* res; float* out;
    __device__ __forceinline__ void operator()(const f32x4 (&acc)[2][2][4][2], const Unit& u, int wr, int wc, int fr_, int fq_) const {
        const int ln_ = lane_id_opaque(), fr = ln_ & 15, fq = ln_ >> 4; (void)fr_; (void)fq_;
        const int col0 = u.pn * BM + wc * 32 + 4 * fq;
#pragma unroll
        for (int ai = 0; ai < 2; ++ai)
#pragma unroll
            for (int m = 0; m < 4; ++m) { const size_t off = (size_t)(u.pm * BM + ai * HALF + wr * 64 + m * 16 + fr) * 1024 + col0;
#pragma unroll
                for (int bj = 0; bj < 2; ++bj)
#pragma unroll
                    for (int n = 0; n < 2; ++n) { const f32x4 rv = *(const f32x4*)(res + off + bj * HALF + n * 16);
                        *(f32x4*)(out + off + bj * HALF + n * 16) = rv * 1.4142135623730951f + acc[ai][bj][m][n]; } }
    }
};

struct EpiResLn {
    static constexpr bool PERM = false, AFTER_DRAIN = false;
    const float* res; float* out; bf16_t* xb; const float* gam; const float* bet; unsigned long long* xbuf; unsigned* cnt; PG8_LAS unsigned char* tbl;
    __device__ __forceinline__ void operator()(f32x4 (&acc)[2][2][4][2], const Unit& u, int wr, int wc, int fr_, int fq_) const {
        typedef float f32x2v __attribute__((ext_vector_type(2)));
        const int lane = lane_id_opaque(), fr = lane & 15, fq = lane >> 4; (void)fr_; (void)fq_;
        const int wid = wr * 4 + wc;
        const int col0 = u.pn * BM + wc * 32 + 4 * fq;
        PG8_LAS f32x2v* Pt = (PG8_LAS f32x2v*)tbl;
        PG8_LAS f32x2v* St = (PG8_LAS f32x2v*)(tbl + 8192);
#pragma unroll
        for (int ai = 0; ai < 2; ++ai)
#pragma unroll
            for (int m = 0; m < 4; ++m) {
                const size_t off = (size_t)(u.pm * BM + ai * HALF + wr * 64 + m * 16 + fr) * 1024 + col0;
                f32x4 rv[2][2];
#pragma unroll
                for (int bj = 0; bj < 2; ++bj)
#pragma unroll
                    for (int n = 0; n < 2; ++n) rv[bj][n] = *(const f32x4*)(res + off + bj * HALF + n * 16);
                float s = 0.f;
#pragma unroll
                for (int bj = 0; bj < 2; ++bj)
#pragma unroll
                    for (int n = 0; n < 2; ++n) { acc[ai][bj][m][n] = rv[bj][n] * 1.4142135623730951f + acc[ai][bj][m][n]; const f32x4 x = acc[ai][bj][m][n]; s += (x[0] + x[1]) + (x[2] + x[3]); }
                s += __shfl_xor(s, 16); s += __shfl_xor(s, 32);
                const float mw = s * (1.0f / 64.0f); float q = 0.f;
#pragma unroll
                for (int bj = 0; bj < 2; ++bj)
#pragma unroll
                    for (int n = 0; n < 2; ++n) { const f32x4 d = acc[ai][bj][m][n] - mw; q += (d[0] * d[0] + d[1] * d[1]) + (d[2] * d[2] + d[3] * d[3]); }
                q += __shfl_xor(q, 16); q += __shfl_xor(q, 32);
                if (fq == 0) Pt[(ai * HALF + wr * 64 + m * 16 + fr) * 4 + wc] = (f32x2v){mw, q};
            }
        asm volatile("s_waitcnt lgkmcnt(0)" ::: "memory"); __builtin_amdgcn_s_barrier(); asm volatile("" ::: "memory");
        const int row = wid * 32 + (lane & 31);
        unsigned* cw = cnt + 64 * u.pm;
        if (lane < 32) {
            const f32x2v a = Pt[row * 4 + 0], b2 = Pt[row * 4 + 1], c = Pt[row * 4 + 2], d = Pt[row * 4 + 3];
            const float mt = (a.x + b2.x + c.x + d.x) * 0.25f;
            const float da = a.x - mt, db = b2.x - mt, dc = c.x - mt, dd = d.x - mt;
            const float m2 = (a.y + b2.y) + (c.y + d.y) + 64.0f * ((da * da + db * db) + (dc * dc + dd * dd));
            __hip_atomic_store(xbuf + ((size_t)(u.pm * BM + row) * 4 + u.pn), ((unsigned long long)__float_as_uint(m2) << 32) | __float_as_uint(mt), __ATOMIC_RELAXED, __HIP_MEMORY_SCOPE_AGENT);
        }
        asm volatile("s_waitcnt vmcnt(0)" ::: "memory");
        if (lane == 0) __hip_atomic_fetch_add(cw, 1u, __ATOMIC_RELAXED, __HIP_MEMORY_SCOPE_AGENT);
        if (wid == 0) {
            unsigned sp = 0;
            while ((unsigned)__builtin_amdgcn_readfirstlane(__hip_atomic_load(cw, __ATOMIC_RELAXED, __HIP_MEMORY_SCOPE_AGENT)) < 32u) { __builtin_amdgcn_s_sleep(2); if (++sp > (1u << 22)) break; }
            __builtin_amdgcn_fence(__ATOMIC_ACQUIRE, "agent");
        }
        asm volatile("s_waitcnt vmcnt(0) lgkmcnt(0)" ::: "memory"); __builtin_amdgcn_s_barrier(); asm volatile("" ::: "memory");
        if (lane < 32) {
            const unsigned long long* slot = xbuf + (size_t)(u.pm * BM + row) * 4; float mt[4], m2[4]; float ms = 0.f;
#pragma unroll
            for (int t = 0; t < 4; ++t) { const unsigned long long w = __hip_atomic_load(slot + t, __ATOMIC_RELAXED, __HIP_MEMORY_SCOPE_AGENT); mt[t] = __uint_as_float((unsigned)w); m2[t] = __uint_as_float((unsigned)(w >> 32)); ms += mt[t]; }
            const float mean = ms * 0.25f; float q = 0.f;
#pragma unroll
            for (int t = 0; t < 4; ++t) { const float dm = mt[t] - mean; q += m2[t] + 256.0f * dm * dm; }
            St[row] = (f32x2v){mean, 1.0f / sqrtf(q * (1.0f / 1024.0f) + 1e-5f)};
        }
        asm volatile("s_waitcnt lgkmcnt(0)" ::: "memory"); __builtin_amdgcn_s_barrier(); asm volatile("" ::: "memory");
#pragma unroll
        for (int bj = 0; bj < 2; ++bj)
#pragma unroll
            for (int n = 0; n < 2; ++n) {
                const f32x4 gv = *(const f32x4*)(gam + col0 + bj * HALF + n * 16), bv = *(const f32x4*)(bet + col0 + bj * HALF + n * 16);
#pragma unroll
                for (int ai = 0; ai < 2; ++ai)
#pragma unroll
                    for (int m = 0; m < 4; ++m) { const int r = ai * HALF + wr * 64 + m * 16 + fr; const f32x2v sr = St[r]; const size_t off = (size_t)(u.pm * BM + r) * 1024 + col0 + bj * HALF + n * 16;
                        const f32x4 o = (acc[ai][bj][m][n] - sr.x) * sr.y * gv + bv;
                        *(f32x4*)(out + off) = o;
                        uint2 w; w.x = cvtpk_s(o[0], o[1]); w.y = cvtpk_s(o[2], o[3]); *(uint2*)(xb + off) = w; }
            }
    }
};

struct EpiGluNorm {
    static constexpr bool PERM = true, AFTER_DRAIN = false;
    bf16_t* Yo; const bf16_t* ybp; const bf16_t* proj; const float* bias; const float* gain; PG8_LAS unsigned char* tbl;
    __device__ __forceinline__ void operator()(f32x4 (&acc)[2][2][4][2], const Unit& u, int wr, int wc, int fr_, int fq_) const {
        const int lane = lane_id_opaque(), fr = lane & 15, fq = lane >> 4; (void)fr_; (void)fq_;
        bf16_t* Yo_ = launder_g(Yo); const bf16_t* ybp_ = launder_g(ybp); const bf16_t* proj_ = launder_g(proj); const float* bias_ = launder_g(bias); const float* gain_ = launder_g(gain);
        const int row0 = u.pm * BM + wr * 64 + fr, cw = wc * 32 + 8 * fq;
        PG8_LAS float* Pt = (PG8_LAS float*)tbl;
#pragma unroll
        for (int bj = 0; bj < 2; ++bj) {
            const int c = cw + bj * HALF;
            const f32x4 b0 = *(const f32x4*)(bias_ + c), b1 = *(const f32x4*)(bias_ + c + 4);
#pragma unroll
            for (int ai = 0; ai < 2; ++ai)
#pragma unroll
                for (int m = 0; m < 4; ++m) {
                    const size_t r = (size_t)(row0 + ai * HALF + m * 16);
                    const u32x4 av = *(const u32x4*)(ybp_ + r * 256 + c);
                    f32x4 v0 = acc[ai][bj][m][0] + b0, v1 = acc[ai][bj][m][1] + b1; float ss = 0.f;
#pragma unroll
                    for (int j = 0; j < 4; ++j) { const float alo = __uint_as_float(av[j] << 16), ahi = __uint_as_float(av[j] & 0xffff0000u);
                        if (j < 2) { const float s0 = alo * __builtin_amdgcn_rcpf(1.0f + __expf(-v0[2 * j])), s1 = ahi * __builtin_amdgcn_rcpf(1.0f + __expf(-v0[2 * j + 1])); v0[2 * j] = s0; v0[2 * j + 1] = s1; ss += s0 * s0 + s1 * s1; }
                        else { const float s0 = alo * __builtin_amdgcn_rcpf(1.0f + __expf(-v1[2 * j - 4])), s1 = ahi * __builtin_amdgcn_rcpf(1.0f + __expf(-v1[2 * j - 3])); v1[2 * j - 4] = s0; v1[2 * j - 3] = s1; ss += s0 * s0 + s1 * s1; } }
                    acc[ai][bj][m][0] = v0; acc[ai][bj][m][1] = v1;
                    ss += __shfl_xor(ss, 16); ss += __shfl_xor(ss, 32);
                    if (fq == 0) Pt[((ai * HALF + wr * 64 + m * 16 + fr) * 2 + bj) * 4 + wc] = ss;
                }
        }
        asm volatile("s_waitcnt lgkmcnt(0)" ::: "memory"); __builtin_amdgcn_s_barrier(); asm volatile("" ::: "memory");
#pragma unroll
        for (int bj = 0; bj < 2; ++bj) {
            const int c = cw + bj * HALF;
            const f32x4 g0 = *(const f32x4*)(gain_ + 256 + c), g1 = *(const f32x4*)(gain_ + 256 + c + 4);
#pragma unroll
            for (int ai = 0; ai < 2; ++ai)
#pragma unroll
                for (int m = 0; m < 4; ++m) {
                    const int rl = ai * HALF + wr * 64 + m * 16 + fr; const size_t r = (size_t)(u.pm * BM + rl);
                    const float rs = rsqrtf((Pt[(rl * 2 + bj) * 4 + (wc & 2)] + Pt[(rl * 2 + bj) * 4 + (wc | 1)]) * (1.0f / 64.0f) + 1e-6f);
                    const u32x4 gv = *(const u32x4*)(proj_ + r * 3584 + 2560 + 256 + c);
                    const f32x4 v0 = acc[ai][bj][m][0] * rs * g0, v1 = acc[ai][bj][m][1] * rs * g1;
                    float o[8];
#pragma unroll
                    for (int j = 0; j < 4; ++j) { const float tl = __uint_as_float(gv[j] << 16), th = __uint_as_float(gv[j] & 0xffff0000u);
                        const float x0 = (j < 2) ? v0[2 * j] : v1[2 * j - 4], x1 = (j < 2) ? v0[2 * j + 1] : v1[2 * j - 3];
                        o[2 * j] = x0 * (tl * __builtin_amdgcn_rcpf(1.0f + __expf(-tl))); o[2 * j + 1] = x1 * (th * __builtin_amdgcn_rcpf(1.0f + __expf(-th))); }
                    u32x4 w; w.x = cvtpk_s(o[0], o[1]); w.y = cvtpk_s(o[2], o[3]); w.z = cvtpk_s(o[4], o[5]); w.w = cvtpk_s(o[6], o[7]);
                    *(u32x4*)(Yo_ + r * 1024 + 256 + c) = w;
                }
        }
        asm volatile("s_waitcnt lgkmcnt(0)" ::: "memory"); __builtin_amdgcn_s_barrier(); asm volatile("" ::: "memory");
    }
};

template <class Epi, class Sched, bool ALIGN_EPI = false, bool SP2 = false>
__device__ __forceinline__ void gemm_phase(PG8_LAS unsigned char* lds, const Gemm g, const Sched& S, const Epi& E, const int tid_in  ) {
    const int tid = tid_in, wid = __builtin_amdgcn_readfirstlane(tid >> 6), lane = tid & 63, wr = wid >> 2, wc = wid & 3, fr = lane & 15, fq = lane >> 4;
    const int K = g.K, nt = K / BK;
    unsigned voffA[2], voffB[2];
#pragma unroll
    for (int i = 0; i < 2; ++i) { int R, C; stage_rc(tid * 16 + i * 8192, R, C); const int Rb = Epi::PERM ? ((R & ~31) + perm32(R & 31)) : R;
        voffA[i] = (unsigned)(R * K + C) * 2u; voffB[i] = (unsigned)(Rb * K + C) * 2u; }
    const size_t kstep = (size_t)(BK * 2);
    const size_t hstep = (size_t)HALF * K * 2;
    const size_t tstep = 2 * hstep;
    const unsigned ldsw = (unsigned)wid * 1024u;
    const int aoff = lds_byte(wr * 64 + fr, fq * 8), boff = lds_byte(wc * 32 + fr, fq * 8);
#define PG8_SA(b, h) (((b) * 2 + (h)) * HTB)
#define PG8_SB(b, h) ((4 + (b) * 2 + (h)) * HTB)
#define PG8_STAGE(bufoff, gbase, voff) do { _Pragma("unroll") for (int _i = 0; _i < 2; ++_i) \
        __builtin_amdgcn_global_load_lds((const unsigned*)((const char*)(gbase) + (voff)[_i]), (PG8_LAS unsigned*)(lds + (bufoff) + ldsw + _i * 8192), 16, 0, 0); } while (0)
#define PG8_LDA(dst, b, h) do { _Pragma("unroll") for (int m = 0; m < 4; ++m) _Pragma("unroll") for (int k = 0; k < 2; ++k) dst[m][k] = *(const PG8_LAS bf16x8*)(lds + PG8_SA(b, h) + aoff + m * 2048 + k * 1024); } while (0)
#define PG8_LDB(dst, b, h) do { _Pragma("unroll") for (int n = 0; n < 2; ++n) _Pragma("unroll") for (int k = 0; k < 2; ++k) dst[n][k] = *(const PG8_LAS bf16x8*)(lds + PG8_SB(b, h) + boff + n * 2048 + k * 1024); } while (0)
#define PG8_MMA(ai, bj, At, Bt) do { __builtin_amdgcn_s_setprio(1); _Pragma("unroll") for (int m = 0; m < 4; ++m) _Pragma("unroll") for (int n = 0; n < 2; ++n) _Pragma("unroll") for (int k = 0; k < 2; ++k) \
        acc[ai][bj][m][n] = __builtin_amdgcn_mfma_f32_16x16x32_bf16(Bt[n][k], At[m][k], acc[ai][bj][m][n], 0, 0, 0); __builtin_amdgcn_s_setprio(0); } while (0)
#define PG8_WAIT_V(n) asm volatile("s_waitcnt vmcnt(" #n ")" ::: "memory")
#define PG8_WAIT_L(n) asm volatile("s_waitcnt lgkmcnt(" #n ")" ::: "memory")
#define PG8_BAR __builtin_amdgcn_s_barrier()
#define PG8_SCHED __builtin_amdgcn_sched_barrier(0)
    Unit cur, nxt; int ui = 0;
    if (!S.next(0, cur)) return;
    f32x4 acc[2][2][4][2];
#pragma unroll
    for (int a = 0; a < 2; ++a)
#pragma unroll
        for (int b = 0; b < 2; ++b)
#pragma unroll
            for (int m = 0; m < 4; ++m)
#pragma unroll
                for (int n = 0; n < 2; ++n) acc[a][b][m][n] = (f32x4){0.f, 0.f, 0.f, 0.f};
    bf16x8 At[4][2], B0[2][2], B1[2][2];
    const char* cA = (const char*)g.A + (size_t)cur.pm * tstep; const char* cB = (const char*)g.Bt + (size_t)cur.pn * tstep;
    S.a_ready(cur);
    if constexpr (SP2) {
        PG8_STAGE(PG8_SB(0, 0), cB, voffB); PG8_STAGE(PG8_SB(0, 1), cB + hstep, voffB); PG8_STAGE(PG8_SA(0, 0), cA, voffA); PG8_STAGE(PG8_SA(0, 1), cA + hstep, voffA);
        if (wr == 1) PG8_BAR;
        PG8_WAIT_V(2); PG8_BAR;
        PG8_STAGE(PG8_SB(1, 0), cB + kstep, voffB); PG8_STAGE(PG8_SA(1, 0), cA + kstep, voffA); PG8_STAGE(PG8_SB(1, 1), cB + hstep + kstep, voffB);
        PG8_WAIT_V(6); PG8_BAR;
    } else {
        PG8_STAGE(PG8_SB(0, 0), cB, voffB); PG8_STAGE(PG8_SA(0, 0), cA, voffA); PG8_STAGE(PG8_SB(0, 1), cB + hstep, voffB); PG8_STAGE(PG8_SA(0, 1), cA + hstep, voffA);
        if (wr == 1) PG8_BAR;
        PG8_WAIT_V(4); PG8_BAR;
        PG8_STAGE(PG8_SB(1, 0), cB + kstep, voffB); PG8_STAGE(PG8_SA(1, 0), cA + kstep, voffA); PG8_STAGE(PG8_SB(1, 1), cB + hstep + kstep, voffB);
        PG8_WAIT_V(6); PG8_BAR;
    }
    for (;;) {
        const bool has_next = S.next(ui + 1, nxt);
        const char* nA = has_next ? (const char*)g.A + (size_t)nxt.pm * tstep : cA; const char* nB = has_next ? (const char*)g.Bt + (size_t)nxt.pn * tstep : cB;
        for (int t = 0; t < nt; t += 2) {
            const bool last = (t == nt - 2);
            const char* a1 = cA + (size_t)(t + 1) * kstep;
            const char* a2 = last ? nA : cA + (size_t)(t + 2) * kstep; const char* b2 = last ? nB : cB + (size_t)(t + 2) * kstep;
            const char* a3 = a2 + kstep; const char* b3 = b2 + kstep;
            if (last && has_next) S.a_ready(nxt);
            if constexpr (SP2) {
            PG8_LDB(B0, 0, 0); PG8_LDB(B1, 0, 1); PG8_SCHED; PG8_LDA(At, 0, 0); PG8_STAGE(PG8_SA(1, 1), a1 + hstep, voffA);
            PG8_WAIT_V(8); PG8_WAIT_L(0); PG8_BAR; PG8_MMA(0, 0, At, B0); PG8_MMA(0, 1, At, B1); PG8_BAR; PG8_SCHED;
            PG8_LDA(At, 0, 1); PG8_STAGE(PG8_SB(0, 0), b2, voffB); PG8_STAGE(PG8_SB(0, 1), b2 + hstep, voffB); PG8_STAGE(PG8_SA(0, 0), a2, voffA);
            PG8_WAIT_V(8); PG8_WAIT_L(0); PG8_BAR; PG8_MMA(1, 0, At, B0); PG8_MMA(1, 1, At, B1); PG8_BAR; PG8_SCHED;
            PG8_LDB(B0, 1, 0); PG8_LDB(B1, 1, 1); PG8_SCHED; PG8_LDA(At, 1, 0); PG8_STAGE(PG8_SA(0, 1), a2 + hstep, voffA);
            PG8_WAIT_V(8); PG8_WAIT_L(0); PG8_BAR; PG8_MMA(0, 0, At, B0); PG8_MMA(0, 1, At, B1); PG8_BAR; PG8_SCHED;
            PG8_LDA(At, 1, 1); PG8_STAGE(PG8_SB(1, 0), b3, voffB); PG8_STAGE(PG8_SB(1, 1), b3 + hstep, voffB); PG8_STAGE(PG8_SA(1, 0), a3, voffA);
            PG8_WAIT_V(8); PG8_WAIT_L(0); PG8_BAR; PG8_MMA(1, 0, At, B0); PG8_MMA(1, 1, At, B1); PG8_BAR; PG8_SCHED;
            } else {
            PG8_LDB(B0, 0, 0); PG8_SCHED; PG8_LDA(At, 0, 0); PG8_STAGE(PG8_SA(1, 1), a1 + hstep, voffA);
            PG8_WAIT_L(8); PG8_BAR; PG8_WAIT_L(0); PG8_MMA(0, 0, At, B0); PG8_BAR; PG8_SCHED;
            PG8_LDB(B1, 0, 1); PG8_STAGE(PG8_SB(0, 0), b2, voffB);
            PG8_BAR; PG8_WAIT_L(0); PG8_MMA(0, 1, At, B1); PG8_BAR;
            PG8_LDA(At, 0, 1); PG8_STAGE(PG8_SA(0, 0), a2, voffA);
            PG8_BAR; PG8_WAIT_L(0); PG8_MMA(1, 0, At, B0); PG8_BAR; PG8_SCHED;
            PG8_STAGE(PG8_SB(0, 1), b2 + hstep, voffB);
            PG8_WAIT_V(6); PG8_BAR; PG8_MMA(1, 1, At, B1); PG8_BAR;
            PG8_LDB(B0, 1, 0); PG8_SCHED; PG8_LDA(At, 1, 0); PG8_STAGE(PG8_SA(0, 1), a2 + hstep, voffA);
            PG8_WAIT_L(8); PG8_BAR; PG8_WAIT_L(0); PG8_MMA(0, 0, At, B0); PG8_BAR; PG8_SCHED;
            PG8_LDB(B1, 1, 1); PG8_STAGE(PG8_SB(1, 0), b3, voffB);
            PG8_BAR; PG8_WAIT_L(0); PG8_MMA(0, 1, At, B1); PG8_BAR;
            PG8_LDA(At, 1, 1); PG8_STAGE(PG8_SA(1, 0), a3, voffA);
            PG8_BAR; PG8_WAIT_L(0); PG8_MMA(1, 0, At, B0); PG8_BAR; PG8_SCHED;
            PG8_STAGE(PG8_SB(1, 1), b3 + hstep, voffB);
            PG8_WAIT_V(6); PG8_BAR; PG8_MMA(1, 1, At, B1); PG8_BAR;
            }
        }
        if constexpr (ALIGN_EPI) { if (wr == 0) PG8_BAR; }
        if constexpr (!Epi::AFTER_DRAIN) { E(acc, cur, wr, wc, fr, fq); S.done(cur); }
        if (!has_next) break;
#pragma unroll
        for (int a = 0; a < 2; ++a)
#pragma unroll
            for (int b = 0; b < 2; ++b)
#pragma unroll
                for (int m = 0; m < 4; ++m)
#pragma unroll
                    for (int n = 0; n < 2; ++n) acc[a][b][m][n] = (f32x4){0.f, 0.f, 0.f, 0.f};
        cur = nxt; cA = nA; cB = nB; ++ui;
        if constexpr (ALIGN_EPI) { if (wr == 1) PG8_BAR; }
    }
    PG8_WAIT_V(0);
    if constexpr (!ALIGN_EPI) { if (wr == 0) PG8_BAR; }
    PG8_BAR;
    if constexpr (Epi::AFTER_DRAIN) { E.fused(acc, cur, wr, wc, fr, fq, lds, wid, lane); S.done(cur); }
#undef PG8_SA
#undef PG8_SB
#undef PG8_STAGE
#undef PG8_LDA
#undef PG8_LDB
#undef PG8_MMA
#undef PG8_WAIT_V
#undef PG8_WAIT_L
#undef PG8_BAR
#undef PG8_SCHED
}
}
#define XB_TMO      128
#define XB_XCNT(j)  (256  + 64 * (j))
#define XB_XSUB(j)  (1280 + 64 * (j))
#define XB_XGEN(j)  (2304 + 64 * (j))
#define XB_TOP      3328
#define XB_TOPGEN   3392
#define XCD_BAR_WORDS 3456
#define XB_SPIN_CAP (1u << 18)

__device__ __forceinline__ unsigned xb_ld(unsigned* p)              { return __hip_atomic_load((__attribute__((address_space(1))) unsigned*)p, __ATOMIC_RELAXED, __HIP_MEMORY_SCOPE_AGENT); }
__device__ __forceinline__ unsigned xb_add(unsigned* p, unsigned v) { return __hip_atomic_fetch_add((__attribute__((address_space(1))) unsigned*)p, v, __ATOMIC_RELAXED, __HIP_MEMORY_SCOPE_AGENT); }
__device__ __forceinline__ unsigned xb_xcc_id() { return (unsigned)__builtin_amdgcn_s_getreg((3 << 11) | 20) & 0xFu; }
#define XB_SPIN(cond, bar) do { unsigned _sp = 0; while (cond) { __builtin_amdgcn_s_sleep(1); \
    if ((++_sp & 255u) == 0u) { if (xb_ld(&(bar)[XB_TMO])) break; if (_sp > XB_SPIN_CAP) { atomicAdd(&(bar)[XB_TMO], 1u); break; } } } } while (0)

struct XcdBarrier {
    unsigned* bar; unsigned x;
    volatile LAS unsigned* st;
};

__device__ __forceinline__ XcdBarrier xcd_barrier_post(unsigned* bar, volatile LAS unsigned* st) {
    XcdBarrier b; b.bar = bar; b.x = xb_xcc_id(); b.st = st;
    if (threadIdx.x == 0) (void)xb_add(&bar[XB_XCNT(b.x)], 1u);
    return b;
}
__device__ __forceinline__ void xcd_barrier_complete(unsigned* bar, unsigned x, unsigned& nloc, unsigned& nx) {
    const unsigned G = gridDim.x * gridDim.y * gridDim.z;
    unsigned sum, cnt, mine, sp = 0u;
    for (;;) {
        sum = 0u; cnt = 0u; mine = 0u;
#pragma unroll
        for (unsigned j = 0; j < 16; ++j) { const unsigned c = xb_ld(&bar[XB_XCNT(j)]); sum += c; cnt += (c > 0u) ? 1u : 0u; mine = (j == x) ? c : mine; }
        if (sum == G) break;
        __builtin_amdgcn_s_sleep(1);
        if ((++sp & 255u) == 0u) { if (xb_ld(&bar[XB_TMO])) break; if (sp > XB_SPIN_CAP) { atomicAdd(&bar[XB_TMO], 1u); break; } }
    }
    nloc = mine > 0u ? mine : 1u; nx = cnt > 0u ? cnt : 1u;
}

__device__ __forceinline__ void xcd_barrier(const XcdBarrier& b) {
    asm volatile("s_waitcnt vmcnt(0)" ::: "memory");
    __syncthreads();
    if (threadIdx.x == 0) {
        unsigned* bar = b.bar;
        __builtin_amdgcn_s_waitcnt(0);
        unsigned nloc = b.st[0], nx = b.st[1];
        if (nloc == 0u) { xcd_barrier_complete(bar, b.x, nloc, nx); b.st[0] = nloc; b.st[1] = nx; }
        const unsigned old = xb_add(&bar[XB_XSUB(b.x)], 1u);
        const unsigned gen = old / nloc;
        if (old + 1u == (gen + 1u) * nloc) {
            __builtin_amdgcn_fence(__ATOMIC_RELEASE, "agent");
            asm volatile("s_waitcnt vmcnt(0)" ::: "memory");
            const unsigned og = xb_add(&bar[XB_TOP], 1u);
            const unsigned tg = og / nx;
            if (og + 1u == (tg + 1u) * nx) xb_add(&bar[XB_TOPGEN], 1u);
            else XB_SPIN(xb_ld(&bar[XB_TOPGEN]) == tg, bar);
            __builtin_amdgcn_fence(__ATOMIC_ACQUIRE, "agent");
            xb_add(&bar[XB_XGEN(b.x)], 1u);
            asm volatile("s_waitcnt vmcnt(0)" ::: "memory");
        } else {
            XB_SPIN(xb_ld(&bar[XB_XGEN(b.x)]) == gen, bar);
            __builtin_amdgcn_fence(__ATOMIC_ACQUIRE, "agent");
            asm volatile("s_waitcnt vmcnt(0)" ::: "memory");
        }
    }
    __syncthreads();
}
namespace fa {
typedef short bf16x8 __attribute__((ext_vector_type(8)));
typedef float f32x16 __attribute__((ext_vector_type(16)));
typedef short v4i16_t __attribute__((ext_vector_type(4)));
constexpr int KT_OFF = 0, VT_OFF = 8192, LUT_OFF = 16384, OST_OFF = 24576, FA_LDS = OST_OFF + 8 * 4096;
__device__ __forceinline__ int crow(int r, int hi) { return (r & 3) + 8 * (r >> 2) + 4 * hi; }
__device__ __forceinline__ unsigned cvtpk(float lo, float hi) { return cvtpk_s(lo, hi); }
template <int B> __device__ __forceinline__ bf16x8 pack8(const f32x16& p) {
    u32x4 w; w.x = cvtpk(p[B], p[B + 1]); w.y = cvtpk(p[B + 2], p[B + 3]); w.z = cvtpk(p[B + 4], p[B + 5]); w.w = cvtpk(p[B + 6], p[B + 7]);
    return __builtin_bit_cast(bf16x8, w);
}
__device__ __forceinline__ v4i16_t trd(LAS const unsigned char* p) { return __builtin_amdgcn_ds_read_tr16_b64_v4i16((LAS v4i16_t*)p); }
__device__ __forceinline__ void stage_tile(LAS unsigned char* lds, int tid, const bf16_t* krow, const bf16_t* vrow) {
    const int row = tid >> 3, ch = tid & 7;
    u32x4 kv = {0u, 0u, 0u, 0u}, vv = {0u, 0u, 0u, 0u};
    if (krow) { kv = *(const u32x4*)(krow + ch * 8); vv = *(const u32x4*)(vrow + ch * 8); }
    *(LAS u32x4*)(lds + KT_OFF + row * 128 + ((ch ^ (row & 7)) * 16)) = kv;
    *(LAS u32x4*)(lds + VT_OFF + row * 128 + ch * 16) = vv;
}
template <class Fn> __device__ __forceinline__ void tile_step(LAS const unsigned char* lds, const bf16x8 (&qf)[4], f32x16& o0, f32x16& o1, float& m, float& l, int lane, const Fn& fn) {
    const int r32 = lane & 31, hi = lane >> 5;
    f32x16 p0, p1;
#pragma unroll
    for (int r = 0; r < 16; ++r) { p0[r] = 0.f; p1[r] = 0.f; }
#pragma unroll
    for (int s = 0; s < 4; ++s) {
        const int ch = ((2 * s + hi) ^ (r32 & 7)) * 16;
        const bf16x8 k0 = *(const LAS bf16x8*)(lds + KT_OFF + r32 * 128 + ch);
        const bf16x8 k1 = *(const LAS bf16x8*)(lds + KT_OFF + (32 + r32) * 128 + ch);
        p0 = __builtin_amdgcn_mfma_f32_32x32x16_bf16(k0, qf[s], p0, 0, 0, 0);
        p1 = __builtin_amdgcn_mfma_f32_32x32x16_bf16(k1, qf[s], p1, 0, 0, 0);
    }
    float mx = NEGF;
#pragma unroll
    for (int r = 0; r < 16; ++r) { p0[r] = fn(crow(r, hi), p0[r]); p1[r] = fn(32 + crow(r, hi), p1[r]); mx = fmaxf(mx, fmaxf(p0[r], p1[r])); }
    mx = fmaxf(mx, __shfl_xor(mx, 32));
    const float mn = fmaxf(m, mx), alpha = __expf(m - mn);
    m = mn;
    float ps = 0.f;
#pragma unroll
    for (int r = 0; r < 16; ++r) { p0[r] = __expf(p0[r] - mn); p1[r] = __expf(p1[r] - mn); ps += p0[r] + p1[r]; }
    l = l * alpha + ps;
#pragma unroll
    for (int r = 0; r < 16; ++r) { o0[r] *= alpha; o1[r] *= alpha; }
    const int q4 = (lane & 15) >> 2, p4 = lane & 3, dgrp = (lane >> 4) & 1;
    const int vb = VT_OFF + (4 * hi + q4) * 128 + (16 * dgrp + 4 * p4) * 2;
#define FA_PV(P, KH, S2) do { const bf16x8 pb = pack8<8 * (S2)>(P); \
        _Pragma("unroll") for (int blk = 0; blk < 2; ++blk) { const int a = vb + (32 * (KH) + 16 * (S2)) * 128 + blk * 64; \
            const v4i16_t lo = trd(lds + a), hh = trd(lds + a + 8 * 128); \
            const bf16x8 va = {lo[0], lo[1], lo[2], lo[3], hh[0], hh[1], hh[2], hh[3]}; \
            if (blk == 0) o0 = __builtin_amdgcn_mfma_f32_32x32x16_bf16(va, pb, o0, 0, 0, 0); else o1 = __builtin_amdgcn_mfma_f32_32x32x16_bf16(va, pb, o1, 0, 0, 0); } } while (0)
    FA_PV(p0, 0, 0); FA_PV(p0, 0, 1); FA_PV(p1, 1, 0); FA_PV(p1, 1, 1);
#undef FA_PV
}
template <class RowFn> __device__ __forceinline__ float store_o(LAS unsigned char* lds, int wave, int lane, const f32x16& o0, const f32x16& o1, float l, const RowFn& orow) {
    const int r32 = lane & 31, hi = lane >> 5;
    l += __shfl_xor(l, 32);
    const float inv = 1.0f / l;
    LAS bf16_t* stg = (LAS bf16_t*)(lds + OST_OFF + wave * 4096);
#pragma unroll
    for (int r = 0; r < 16; ++r) { const int d = crow(r, hi); stg[r32 * 64 + d] = f2bf(o0[r] * inv); stg[r32 * 64 + 32 + d] = f2bf(o1[r] * inv); }
    asm volatile("s_waitcnt lgkmcnt(0)" ::: "memory");
#pragma unroll
    for (int i = 0; i < 4; ++i) { const int row = i * 8 + (lane >> 3), ch = lane & 7; const u32x4 v = *(const LAS u32x4*)(stg + row * 64 + ch * 8); *(u32x4*)(orow(row) + ch * 8) = v; }
    asm volatile("s_waitcnt lgkmcnt(0)" ::: "memory");
    return l;
}
}

namespace fa2 {
using fa::bf16x8; using fa::f32x16; using fa::v4i16_t; using fa::crow; using fa::pack8; using fa::trd;
constexpr float C2LOG = 0.125f * 1.4426950408889634f;
struct KCh { int c0, c1, c2, c3; };
__device__ __forceinline__ KCh make_kch(int lane) { const int r32 = lane & 31, hi = lane >> 5, x = r32 & 7; return KCh{((0 + hi) ^ x) * 16, ((2 + hi) ^ x) * 16, ((4 + hi) ^ x) * 16, ((6 + hi) ^ x) * 16}; }
template <class Fn> __device__ __forceinline__ void step64(LAS const unsigned char* lds, int koff, int voff, const bf16x8 (&qf)[4], f32x16& o0, f32x16& o1, float& m, float& l, int lane, const Fn& fn, const KCh& kc4) {
    const int r32 = lane & 31, hi = lane >> 5;
    f32x16 p0, p1;
    const f32x16 zero16 = {0.f, 0.f, 0.f, 0.f, 0.f, 0.f, 0.f, 0.f, 0.f, 0.f, 0.f, 0.f, 0.f, 0.f, 0.f, 0.f};
    LAS const unsigned char* kp = lds + koff + r32 * 128;
#pragma unroll
    for (int s = 0; s < 4; ++s) {
        const int ch = s == 0 ? kc4.c0 : s == 1 ? kc4.c1 : s == 2 ? kc4.c2 : kc4.c3;
        const bf16x8 k0 = *(const LAS bf16x8*)(kp + ch);
        const bf16x8 k1 = *(const LAS bf16x8*)(kp + ch + 32 * 128);
        p0 = __builtin_amdgcn_mfma_f32_32x32x16_bf16(k0, qf[s], s == 0 ? zero16 : p0, 0, 0, 0);
        p1 = __builtin_amdgcn_mfma_f32_32x32x16_bf16(k1, qf[s], s == 0 ? zero16 : p1, 0, 0, 0);
    }
    float mx = NEGF;
#pragma unroll
    for (int r = 0; r < 16; ++r) { const int kc = (r & 3) + 8 * (r >> 2); p0[r] = fn(kc, p0[r]); p1[r] = fn(32 + kc, p1[r]); mx = fmaxf(mx, fmaxf(p0[r], p1[r])); }
    mx = fmaxf(mx, __shfl_xor(mx, 32));
    const float mn = fmaxf(m, mx), alpha = __builtin_amdgcn_exp2f(m - mn);
    m = mn;
    float ps = 0.f;
#pragma unroll
    for (int r = 0; r < 16; ++r) { p0[r] = __builtin_amdgcn_exp2f(p0[r] - mn); p1[r] = __builtin_amdgcn_exp2f(p1[r] - mn); ps += p0[r] + p1[r]; }
    l = l * alpha + ps;
    o0 *= alpha; o1 *= alpha;
    const int q4 = (lane & 15) >> 2, p4 = lane & 3, dgrp = (lane >> 4) & 1;
    LAS const unsigned char* vp = lds + voff + (4 * hi + q4) * 128 + (16 * dgrp + 4 * p4) * 2;
#define FA_PV(P, KH, S2) do { const bf16x8 pb = pack8<8 * (S2)>(P); \
        _Pragma("unroll") for (int blk = 0; blk < 2; ++blk) { \
            const v4i16_t lo = trd(vp + ((32 * (KH) + 16 * (S2)) * 128 + blk * 64)), hh = trd(vp + ((32 * (KH) + 16 * (S2) + 8) * 128 + blk * 64)); \
            const bf16x8 va = {lo[0], lo[1], lo[2], lo[3], hh[0], hh[1], hh[2], hh[3]}; \
            if (blk == 0) o0 = __builtin_amdgcn_mfma_f32_32x32x16_bf16(va, pb, o0, 0, 0, 0); else o1 = __builtin_amdgcn_mfma_f32_32x32x16_bf16(va, pb, o1, 0, 0, 0); } } while (0)
    FA_PV(p0, 0, 0); FA_PV(p0, 0, 1); FA_PV(p1, 1, 0); FA_PV(p1, 1, 1);
#undef FA_PV
}
struct TabFn { LAS const float* base;
    __device__ __forceinline__ float operator()(int kc, float s) const { return fmaf(s, C2LOG, base[59 - kc]); } };
struct TabLoFn { LAS const float* base; int klo4;
    __device__ __forceinline__ float operator()(int kc, float s) const { return kc >= klo4 ? fmaf(s, C2LOG, base[59 - kc]) : NEGF; } };
struct ConstFn { float b2;
    __device__ __forceinline__ float operator()(int, float s) const { return fmaf(s, C2LOG, b2); } };
template <int NIT, class RowFn> __device__ __forceinline__ void stage_rows(LAS unsigned char* lds, int koff, int voff, int tid, int kcol, int vcol, const RowFn& rowfn) {
    u32x4 kv[NIT], vv[NIT];
#pragma unroll
    for (int i = 0; i < NIT; ++i) { const int e = tid + 512 * i, row = e >> 3, ch = e & 7; bool ok; const bf16_t* rp = rowfn(row, ok);
        kv[i] = *(const u32x4*)(rp + kcol + ch * 8); vv[i] = *(const u32x4*)(rp + vcol + ch * 8);
        if (!ok) { kv[i] = (u32x4){0u, 0u, 0u, 0u}; vv[i] = (u32x4){0u, 0u, 0u, 0u}; } }
    __builtin_amdgcn_sched_barrier(0);
#pragma unroll
    for (int i = 0; i < NIT; ++i) { const int e = tid + 512 * i, row = e >> 3, ch = e & 7;
        *(LAS u32x4*)(lds + koff + row * 128 + ((ch ^ (row & 7)) * 16)) = kv[i];
        *(LAS u32x4*)(lds + voff + row * 128 + ch * 16) = vv[i]; }
}
template <class DstFn> __device__ __forceinline__ void store_rows(LAS unsigned char* lds, int ostoff, int lane, const f32x16& o0, const f32x16& o1, float linv, const DstFn& dst) {
    const int r32 = lane & 31, hi = lane >> 5;
    LAS unsigned char* stg = lds + ostoff;
#pragma unroll
    for (int r = 0; r < 16; r += 2) { const int d = crow(r, hi);
        *(LAS unsigned*)(stg + r32 * 128 + ((((d >> 3)) ^ (r32 & 7)) << 4) + (d & 7) * 2) = cvtpk_s(o0[r] * linv, o0[r + 1] * linv);
        *(LAS unsigned*)(stg + r32 * 128 + ((((d >> 3) + 4) ^ (r32 & 7)) << 4) + (d & 7) * 2) = cvtpk_s(o1[r] * linv, o1[r + 1] * linv); }
    asm volatile("s_waitcnt lgkmcnt(0)" ::: "memory");
#pragma unroll
    for (int i = 0; i < 4; ++i) { const int row = i * 8 + (lane >> 3), ch = lane & 7; const u32x4 v = *(const LAS u32x4*)(stg + row * 128 + ((ch ^ (row & 7)) << 4)); bf16_t* p = dst(row); if (p) *(u32x4*)(p + ch * 8) = v; }
    asm volatile("s_waitcnt lgkmcnt(0)" ::: "memory");
}
constexpr int D_K = 0, D_V = 49152, D_LUT = 98304, D_OST = 0;
template <class Hook> __device__ __forceinline__ void dilated_unit(const Hook& after_stage, LAS unsigned char* lds, int tid, int pi, int bh, int u, const bf16_t* __restrict__ proj, const float* __restrict__ lutd, bf16_t* __restrict__ PO, float* __restrict__ PL) {
    const int lane = tid & 63, wave = __builtin_amdgcn_readfirstlane(tid >> 6), r32 = lane & 31, hi = lane >> 5;
    const int dil = (pi == 0) ? 1 : (pi == 1) ? 4 : 16, b = bh >> 2, h = bh & 3;
    const int r = u % dil, sb = u / dil;
    __syncthreads();
    LAS float* lut = (LAS float*)(lds + D_LUT);
    if (tid < 64) ((LAS u32x4*)lut)[tid] = ((const u32x4*)(lutd + (pi * 4 + h) * 256))[tid];
    const int ks0 = 256 * sb - 128;
    stage_rows<6>(lds, D_K, D_V, tid, COL_KD + h * 64, COL_VD + h * 64, [&](int row, bool& ok) -> const bf16_t* { const int ks = ks0 + row; ok = ks >= 0; return proj + ((size_t)b * SEQ + (size_t)max(ks, 0) * dil + r) * NIN; });
    after_stage();
    const int qsub = 256 * sb + 32 * wave + r32;
    const size_t qrow = (size_t)b * SEQ + (size_t)qsub * dil + r;
    bf16x8 qf[4];
#pragma unroll
    for (int s = 0; s < 4; ++s) qf[s] = *(const bf16x8*)(proj + qrow * NIN + COL_QD + h * 64 + 16 * s + 8 * hi);
    f32x16 o0, o1;
#pragma unroll
    for (int i = 0; i < 16; ++i) { o0[i] = 0.f; o1[i] = 0.f; }
    float m = NEGF, l = 0.f;
    const KCh kc4 = make_kch(lane);
    __syncthreads();
    const int j0 = wave >> 1;
#pragma unroll 1
    for (int j = j0; j < j0 + 3; ++j) {
        if (ks0 + 64 * j + 63 < 0) continue;
        const int qrel = 32 * wave + r32 + 128 - 64 * j, klo = -(ks0 + 64 * j);
        if (klo > 0) { TabLoFn fn{lut + (qrel - 4 * hi + 64 - 59), klo - 4 * hi}; step64(lds, D_K + j * 8192, D_V + j * 8192, qf, o0, o1, m, l, lane, fn, kc4); }
        else { TabFn fn{lut + (qrel - 4 * hi + 64 - 59)}; step64(lds, D_K + j * 8192, D_V + j * 8192, qf, o0, o1, m, l, lane, fn, kc4); }
    }
    __syncthreads();
    l += __shfl_xor(l, 32);
    const size_t rbase = (size_t)b * SEQ + (size_t)(256 * sb + 32 * wave) * dil + r;
    bf16_t* po = PO + (size_t)pi * M * 256 + h * 64;
    store_rows(lds, D_OST + wave * 4096, lane, o0, o1, 1.0f / l, [&](int q) { return po + (rbase + (size_t)q * dil) * 256; });
    if (hi == 0) PL[((size_t)pi * M + qrow) * 4 + h] = m * 0.6931471805599453f + __logf(l);
}
__device__ __forceinline__ void gate_item(LAS unsigned char* lds, int tid, int bh, int own, const bf16_t* __restrict__ proj, const float* __restrict__ kp, unsigned short* __restrict__ LIST, int* __restrict__ CNT) {
    const int lane = tid & 63, wave = __builtin_amdgcn_readfirstlane(tid >> 6), r32 = lane & 31, hi = lane >> 5;
    const int b = bh >> 2, h = bh & 3;
    LAS int* cnt = (LAS int*)lds;
    __syncthreads();
    if (tid < 32) cnt[tid] = 0;
    __syncthreads();
    const int qib = 32 * wave + r32;
    const size_t qrow = (size_t)b * SEQ + 256 * own + qib;
    bf16x8 qf[4];
#pragma unroll
    for (int s = 0; s < 4; ++s) qf[s] = *(const bf16x8*)(proj + qrow * NIN + COL_QA + h * 64 + 16 * s + 8 * hi);
    f32x16 g;
#pragma unroll
    for (int i = 0; i < 16; ++i) g[i] = 0.f;
    const float* k0 = kp + (size_t)((b * 32 + r32) * 2) * 256 + h * 64;
#pragma unroll
    for (int s = 0; s < 4; ++s) {
        float kv[8];
#pragma unroll
        for (int j = 0; j < 8; j += 4) { const float4 a = *(const float4*)(k0 + 16 * s + 8 * hi + j), c = *(const float4*)(k0 + 256 + 16 * s + 8 * hi + j);
            kv[j] = (a.x + c.x) * (1.0f / 256.0f); kv[j + 1] = (a.y + c.y) * (1.0f / 256.0f); kv[j + 2] = (a.z + c.z) * (1.0f / 256.0f); kv[j + 3] = (a.w + c.w) * (1.0f / 256.0f); }
        u32x4 wh, wl;
#pragma unroll
        for (int j = 0; j < 4; ++j) {
            const bf16_t h0 = f2bf(kv[2 * j]), h1 = f2bf(kv[2 * j + 1]);
            const bf16_t l0 = f2bf(kv[2 * j] - bf2f(h0)), l1 = f2bf(kv[2 * j + 1] - bf2f(h1));
            wh[j] = (unsigned)h0 | ((unsigned)h1 << 16); wl[j] = (unsigned)l0 | ((unsigned)l1 << 16);
        }
        g = __builtin_amdgcn_mfma_f32_32x32x16_bf16(__builtin_bit_cast(bf16x8, wh), qf[s], g, 0, 0, 0);
        g = __builtin_amdgcn_mfma_f32_32x32x16_bf16(__builtin_bit_cast(bf16x8, wl), qf[s], g, 0, 0, 0);
    }
#pragma unroll
    for (int i = 0; i < 16; ++i) if (crow(i, hi) >= own) g[i] = -INFINITY;
#pragma unroll
    for (int t = 0; t < 3; ++t) {
        float lm = -INFINITY;
#pragma unroll
        for (int i = 0; i < 16; ++i) lm = fmaxf(lm, g[i]);
        const float gm = fmaxf(lm, __shfl_xor(lm, 32));
        int cand = 99;
#pragma unroll
        for (int i = 15; i >= 0; --i) if (g[i] == gm) cand = crow(i, hi);
        cand = min(cand, __shfl_xor(cand, 32));
        if (gm > -INFINITY) {
#pragma unroll
            for (int i = 0; i < 16; ++i) if (crow(i, hi) == cand) g[i] = -INFINITY;
            if (hi == 0) { const int pos = atomicAdd((int*)&cnt[cand], 1); LIST[(((size_t)bh * 32 + cand) * 32 + own) * 256 + pos] = (unsigned short)((t << 8) | qib); }
        }
    }
    __syncthreads();
    if (tid < 32) CNT[((size_t)bh * 32 + tid) * 32 + own] = (tid < own) ? cnt[tid] : 0;
}
constexpr int M_K = 0, M_V = 32768, M_LUT = 65536, M_OST = 73728;
template <class Hook> __device__ __forceinline__ void moba_item(const Hook& after_stage, LAS unsigned char* lds, int tid, int bh, int n, int part, int nparts, const bf16_t* __restrict__ proj, const float* __restrict__ rel_bias, const float* __restrict__ lutm, const unsigned short* __restrict__ LIST, const int* __restrict__ CNT,
                                          bf16_t* __restrict__ PARTO, float* __restrict__ PARTML, bf16_t* __restrict__ Y) {
    const int lane = tid & 63, wave = __builtin_amdgcn_readfirstlane(tid >> 6), r32 = lane & 31, hi = lane >> 5;
    const int b = bh >> 2, h = bh & 3;
    __syncthreads();
    LAS float* lut = (LAS float*)(lds + M_LUT);
    if (tid < 472) ((LAS u32x4*)lut)[tid] = ((const u32x4*)(lutm + h * 1888))[tid];
    const bf16_t* kvb = proj + ((size_t)b * SEQ + 256 * n) * NIN;
    stage_rows<4>(lds, M_K, M_V, tid, COL_KA + h * 64, COL_VA + h * 64, [&](int row, bool& ok) -> const bf16_t* { ok = true; return kvb + (size_t)row * NIN; });
    after_stage();
    int cj = 0, nt = 0;
    if (lane < 32) { if (lane == n) nt = 8; else if (lane > n) { cj = CNT[((size_t)bh * 32 + n) * 32 + lane]; nt = (cj + 31) >> 5; } }
    int st = nt;
#pragma unroll
    for (int o = 1; o < 32; o <<= 1) { const int v = __shfl_up(st, o); if ((lane & 31) >= o) st += v; }
    st -= nt;
    const int T = __shfl(st + nt, 31);
    const float b31 = rel_bias[31 * 8 + h] * 1.4426950408889634f;
    const unsigned short* lbase = LIST + (((size_t)bh * 32 + n) * 32) * 256;
    const int stride = 8 * nparts, t0 = wave + 8 * part;
    const KCh kc4 = make_kch(lane);
    struct EA { int seg, lt; unsigned short raw; bool live; };
    auto stageA = [&](int t) -> EA { EA e; const int tt = min(t, T - 1);
        e.seg = __popcll(__ballot(lane < 32 && st <= tt)) - 1; e.lt = tt - __shfl(st, e.seg); e.live = true; e.raw = 0;
        if (e.seg != n) { const int c = __shfl(cj, e.seg), idx = 32 * e.lt + r32; e.live = idx < c; e.raw = lbase[(size_t)e.seg * 256 + (e.live ? idx : 0)]; }
        return e; };
    struct EB { int seg, slot, qib; bool live; size_t qrow; };
    auto stageB = [&](const EA& e, bf16x8 (&q)[4]) -> EB { EB m; m.seg = e.seg; m.live = e.live;
        if (e.seg == n) { m.slot = 3; m.qib = 32 * e.lt + r32; } else { m.slot = e.raw >> 8; m.qib = e.raw & 255; }
        m.qrow = (size_t)b * SEQ + 256 * e.seg + m.qib;
#pragma unroll
        for (int s = 0; s < 4; ++s) q[s] = *(const bf16x8*)(proj + m.qrow * NIN + COL_QA + h * 64 + 16 * s + 8 * hi);
        return m; };
    __syncthreads();
    if (t0 < T) {
        EA ea1 = stageA(t0);
        bf16x8 q0[4], q1[4];
        EB m0 = stageB(ea1, q0);
        ea1 = stageA(t0 + stride);
#pragma unroll 1
        for (int t = t0; t < T; t += stride) {
            const EB m1 = stageB(ea1, q1);
            ea1 = stageA(t + 2 * stride);
            __builtin_amdgcn_sched_barrier(0);
            f32x16 o0, o1;
#pragma unroll
            for (int i = 0; i < 16; ++i) { o0[i] = 0.f; o1[i] = 0.f; }
            float m = NEGF, l = 0.f;
            const int seg = m0.seg, qpos = 256 * seg + m0.qib;
            if (seg == n) {
                const int nks = (m0.qib - r32 + 31) / 64 + 1;
                for (int ks = 0; ks < nks; ++ks) { TabFn fn{lut + (m0.qib - 64 * ks - 4 * hi + 96 - 59)}; step64(lds, M_K + ks * 8192, M_V + ks * 8192, q0, o0, o1, m, l, lane, fn, kc4); }
            } else if (seg - n >= 7) {
                ConstFn fn{b31};
#pragma unroll 1
                for (int ks = 0; ks < 4; ++ks) step64(lds, M_K + ks * 8192, M_V + ks * 8192, q0, o0, o1, m, l, lane, fn, kc4);
            } else {
#pragma unroll 1
                for (int ks = 0; ks < 4; ++ks) { TabFn fn{lut + (qpos - 256 * n - 64 * ks - 4 * hi + 96 - 59)}; step64(lds, M_K + ks * 8192, M_V + ks * 8192, q0, o0, o1, m, l, lane, fn, kc4); }
            }
            l += __shfl_xor(l, 32);
            bf16_t* dstp = nullptr;
            if (m0.live) dstp = (m0.slot == 3) ? Y + m0.qrow * DM + h * 64 : PARTO + ((m0.qrow * 4 + h) * 3 + m0.slot) * 64;
            const unsigned long long dl = (unsigned long long)dstp;
            store_rows(lds, M_OST + wave * 4096, lane, o0, o1, 1.0f / l, [&](int q) { return (bf16_t*)__shfl(dl, q); });
            if (m0.live && hi == 0) { float2 ml; ml.x = m; ml.y = l; *(float2*)(PARTML + ((m0.qrow * 4 + h) * 4 + m0.slot) * 2) = ml; }
            m0 = m1;
#pragma unroll
            for (int s = 0; s < 4; ++s) q0[s] = q1[s];
        }
    }
}
}

namespace hg {
typedef short bf16x8 __attribute__((ext_vector_type(8)));
typedef float f32x4 __attribute__((ext_vector_type(4)));
typedef unsigned u32x2 __attribute__((ext_vector_type(2)));
constexpr int SEG_OFF = 0, BT_OFF = 2048, VT_OFF = 18432, KT_OFF = 26624;
constexpr int QS_OFF = 26624, QD_OFF = 34816, QO_OFF = 43008, KD_OFF = 51200, KO_OFF = 59392;
__device__ __forceinline__ void img_put(LAS unsigned char* lds, int off, int row, int d, float v) { *(LAS bf16_t*)(lds + off + row * 128 + ((((d >> 3) ^ (row & 7))) << 4) + (d & 7) * 2) = f2bf(v); }
__device__ __forceinline__ bf16x8 img_frag(LAS const unsigned char* lds, int off, int row, int chunk) { return *(const LAS bf16x8*)(lds + off + row * 128 + ((chunk ^ (row & 7)) << 4)); }
__device__ __forceinline__ unsigned cvtpk(float lo, float hi) { return cvtpk_s(lo, hi); }
struct Ch { float f[8], b[8], qv[8], iv[8], blast; };
template <bool NEEDQ> __device__ __forceinline__ void stage(LAS unsigned char* lds, int wave, int lane, const bf16_t* __restrict__ rowp  , float lb, Ch& c) {
    float cs = 0.f;
#pragma unroll
    for (int i = 0; i < 8; ++i) {
        const bf16_t* r = rowp + (size_t)(8 * wave + i) * NIN + lane;
        const float fp = bf2f(r[COL_FC]); c.iv[i] = bf2f(r[COL_IC]);
        if (NEEDQ) { const float q = bf2f(r[COL_QC]); c.qv[i] = q * __builtin_amdgcn_rcpf(1.0f + __expf(-q)) * 0.125f; }
        c.f[i] = lb + (1.0f - lb) * __builtin_amdgcn_rcpf(1.0f + __expf(-fp));
        cs += __logf(c.f[i]); c.b[i] = cs;
    }
    LAS float* seg = (LAS float*)(lds + SEG_OFF);
    seg[wave * 64 + lane] = cs;
    __syncthreads();
    float off = 0.f, tot = 0.f;
#pragma unroll
    for (int w = 0; w < 8; ++w) { const float s = seg[w * 64 + lane]; tot += s; if (w < wave) off += s; }
#pragma unroll
    for (int i = 0; i < 8; ++i) c.b[i] += off;
    c.blast = tot;
}
__device__ __forceinline__ void x1_item(LAS unsigned char* lds, int wave, int lane, int item, const bf16_t* __restrict__ proj, const float* __restrict__ lbp, float* __restrict__ DS, float* __restrict__ DEC) {
    const int bh = item >> 7, ch = item & 127, b = bh >> 2, h = bh & 3;
    __syncthreads();
    Ch c; stage<false>(lds, wave, lane, proj + ((size_t)b * SEQ + ch * 64) * NIN + h * 64, lbp[h * 64 + lane], c);
    u32x4 kw, vw;
#pragma unroll
    for (int j = 0; j < 4; ++j) {
        kw[j] = cvtpk((1.0f - c.f[2 * j]) * __expf(c.blast - c.b[2 * j]), (1.0f - c.f[2 * j + 1]) * __expf(c.blast - c.b[2 * j + 1]));
        vw[j] = cvtpk(c.iv[2 * j], c.iv[2 * j + 1]);
    }
    *(LAS u32x4*)(lds + KT_OFF + lane * 128 + ((wave ^ (lane & 7)) << 4)) = kw;
    *(LAS u32x4*)(lds + VT_OFF + lane * 128 + ((wave ^ (lane & 7)) << 4)) = vw;
    if (wave == 0) DEC[(size_t)item * 64 + lane] = __expf(c.blast);
    __syncthreads();
    const int fr = lane & 15, quad = lane >> 4, mt = wave >> 1;
#pragma unroll
    for (int n2 = 0; n2 < 2; ++n2) {
        const int nt = 2 * (wave & 1) + n2;
        f32x4 acc = {0.f, 0.f, 0.f, 0.f};
#pragma unroll
        for (int kk = 0; kk < 2; ++kk)
            acc = __builtin_amdgcn_mfma_f32_16x16x32_bf16(img_frag(lds, VT_OFF, 16 * mt + fr, quad + 4 * kk), img_frag(lds, KT_OFF, 16 * nt + fr, quad + 4 * kk), acc, 0, 0, 0);
        float* o = DS + (size_t)item * 4096 + (16 * mt + 4 * quad) * 64 + 16 * nt + fr;
#pragma unroll
        for (int r = 0; r < 4; ++r) o[r * 64] = acc[r];
    }
}
__device__ __forceinline__ void x2_scan(int gtid, int nthreads, const float* __restrict__ DS, const float* __restrict__ DEC, bf16_t* __restrict__ ST) {
    for (int e = gtid; e < 16 * 1024; e += nthreads) {
        const int bh = e >> 10, q = e & 1023;
        const int d4 = q & 15;
        f32x4 s = {0.f, 0.f, 0.f, 0.f};
#pragma unroll 1
        for (int c0 = 0; c0 < 128; c0 += 8) {
            f32x4 ds[8], de[8];
#pragma unroll
            for (int i = 0; i < 8; ++i) { const size_t it = (size_t)bh * 128 + c0 + i; ds[i] = *(const f32x4*)(DS + it * 4096 + q * 4); de[i] = *(const f32x4*)(DEC + it * 64 + d4 * 4); }
#pragma unroll
            for (int i = 0; i < 8; ++i) { const size_t it = (size_t)bh * 128 + c0 + i;
                uint2 w; w.x = cvtpk(s[0], s[1]); w.y = cvtpk(s[2], s[3]); *(uint2*)(ST + it * 4096 + q * 4) = w;
                s = s * de[i] + ds[i]; }
        }
    }
}
__device__ __forceinline__ void x3_item(LAS unsigned char* lds, int wave, int lane, int item, const bf16_t* __restrict__ proj, const float* __restrict__ lbp, const bf16_t* __restrict__ ST, bf16_t* __restrict__ Y) {
    const int bh = item >> 7, ch = item & 127, b = bh >> 2, h = bh & 3;
    __syncthreads();
    Ch c; stage<true>(lds, wave, lane, proj + ((size_t)b * SEQ + ch * 64) * NIN + h * 64, lbp[h * 64 + lane], c);
    LAS float* bt = (LAS float*)(lds + BT_OFF);
#pragma unroll
    for (int i = 0; i < 8; ++i) bt[(8 * wave + i) * 64 + lane] = c.b[i];
    { u32x4 vw;
#pragma unroll
      for (int j = 0; j < 4; ++j) vw[j] = cvtpk(c.iv[2 * j], c.iv[2 * j + 1]);
      *(LAS u32x4*)(lds + VT_OFF + lane * 128 + ((wave ^ (lane & 7)) << 4)) = vw; }
    __syncthreads();
    {
        const int I = wave >> 1;
        const float cI = bt[(16 * I + 7) * 64 + lane];
        const float rI = (I > 0) ? bt[(16 * I - 1) * 64 + lane] : 0.f;
        float rN[3];
#pragma unroll
        for (int ip = 1; ip < 4; ++ip) rN[ip - 1] = bt[(16 * ip - 1) * 64 + lane];
#pragma unroll
        for (int i = 0; i < 8; ++i) {
            const int t = 8 * wave + i; const float bb = c.b[i], q = c.qv[i], k = 1.0f - c.f[i];
            img_put(lds, QS_OFF, t, lane, q * __expf(bb));
            img_put(lds, QD_OFF, t, lane, q * __expf(bb - cI));
            img_put(lds, QO_OFF, t, lane, q * __expf(bb - rI));
            img_put(lds, KD_OFF, t, lane, k * __expf(cI - bb));
#pragma unroll
            for (int ip = 1; ip < 4; ++ip) if (ip > I) img_put(lds, KO_OFF + (ip - 1) * 8192, t, lane, k * __expf(rN[ip - 1] - bb));
        }
    }
    __syncthreads();
    const int fr = lane & 15, quad = lane >> 4, I = wave >> 1, vh = wave & 1;
    unsigned sc[4][2];
#pragma unroll
    for (int J = 0; J < 4; ++J) {
        sc[J][0] = 0u; sc[J][1] = 0u;
        if (J <= I) {
            f32x4 acc = {0.f, 0.f, 0.f, 0.f};
            const int ko = (J < I) ? KO_OFF + (I - 1) * 8192 : KD_OFF, qo = (J < I) ? QO_OFF : QD_OFF;
#pragma unroll
            for (int kk = 0; kk < 2; ++kk)
                acc = __builtin_amdgcn_mfma_f32_16x16x32_bf16(img_frag(lds, ko, 16 * J + fr, quad + 4 * kk), img_frag(lds, qo, 16 * I + fr, quad + 4 * kk), acc, 0, 0, 0);
            if (J == I) {
#pragma unroll
                for (int r = 0; r < 4; ++r) if (4 * quad + r > fr) acc[r] = 0.f;
            }
            sc[J][0] = cvtpk(acc[0], acc[1]); sc[J][1] = cvtpk(acc[2], acc[3]);
        }
    }
    const bf16_t* stp = ST + (size_t)item * 4096;
    const size_t orow = (size_t)b * SEQ + ch * 64 + 16 * I + fr;
#pragma unroll
    for (int m2 = 0; m2 < 2; ++m2) {
        const int mt = 2 * vh + m2, v = 16 * mt + fr;
        f32x4 acc = {0.f, 0.f, 0.f, 0.f};
#pragma unroll
        for (int ks = 0; ks < 2; ++ks) {
            if (2 * ks <= I) {
                u32x4 bw, aw;
                bw[0] = sc[2 * ks][0]; bw[1] = sc[2 * ks][1]; bw[2] = sc[2 * ks + 1][0]; bw[3] = sc[2 * ks + 1][1];
                const LAS unsigned char* vr = lds + VT_OFF + v * 128;
                const u32x2 a0 = *(const LAS u32x2*)(vr + (((4 * ks + (quad >> 1)) ^ (v & 7)) << 4) + (quad & 1) * 8);
                u32x2 a1 = {0u, 0u};
                if (2 * ks + 1 <= I) a1 = *(const LAS u32x2*)(vr + (((4 * ks + 2 + (quad >> 1)) ^ (v & 7)) << 4) + (quad & 1) * 8);
                aw[0] = a0.x; aw[1] = a0.y; aw[2] = a1.x; aw[3] = a1.y;
                acc = __builtin_amdgcn_mfma_f32_16x16x32_bf16(__builtin_bit_cast(bf16x8, aw), __builtin_bit_cast(bf16x8, bw), acc, 0, 0, 0);
            }
        }
#pragma unroll
        for (int kk = 0; kk < 2; ++kk) {
            const bf16x8 sa = *(const bf16x8*)(stp + v * 64 + 8 * quad + 32 * kk);
            acc = __builtin_amdgcn_mfma_f32_16x16x32_bf16(sa, img_frag(lds, QS_OFF, 16 * I + fr, quad + 4 * kk), acc, 0, 0, 0);
        }
        uint2 w; w.x = cvtpk(acc[0], acc[1]); w.y = cvtpk(acc[2], acc[3]);
        *(uint2*)(Y + orow * DM + 512 + h * 64 + 16 * mt + 4 * quad) = w;
    }
}
}

namespace hw {
typedef short bf16x8 __attribute__((ext_vector_type(8)));
typedef float f32x4 __attribute__((ext_vector_type(4)));
typedef unsigned u32x2 __attribute__((ext_vector_type(2)));
#define HW_LDSW() asm volatile("s_waitcnt lgkmcnt(0)" ::: "memory")
__device__ __forceinline__ bf16x8 frag128(LAS const unsigned char* base, int row, int chunk) { return *(const LAS bf16x8*)(base + row * 128 + ((chunk ^ (row & 7)) << 4)); }
__device__ __forceinline__ void x1_wave(LAS unsigned char* wl, int lane, int item, const bf16_t* __restrict__ proj, const float* __restrict__ lbp, float* __restrict__ DS, float* __restrict__ DEC) {
    const int bh = item >> 7, ch = item & 127, b = bh >> 2, h = bh & 3;
    const bf16_t* rp = proj + ((size_t)b * SEQ + ch * 64) * NIN + h * 64 + lane;
    const float lb = lbp[h * 64 + lane];
    float f[64]; float cs = 0.f;
    HW_LDSW();
#pragma unroll
    for (int g2 = 0; g2 < 4; ++g2) {
        unsigned short rf[16], ri[16];
#pragma unroll
        for (int i = 0; i < 16; ++i) { const bf16_t* r = rp + (size_t)(16 * g2 + i) * NIN; rf[i] = r[COL_FC]; ri[i] = r[COL_IC]; }
        __builtin_amdgcn_sched_barrier(0);
#pragma unroll
        for (int i = 0; i < 16; ++i) { const float ff = lb + (1.0f - lb) * __builtin_amdgcn_rcpf(1.0f + __expf(-bf2f(rf[i]))); f[16 * g2 + i] = ff; cs += __logf(ff); }
#pragma unroll
        for (int q = 0; q < 2; ++q) { const int g = 2 * g2 + q;
            u32x4 vw; vw[0] = (unsigned)ri[8 * q] | ((unsigned)ri[8 * q + 1] << 16); vw[1] = (unsigned)ri[8 * q + 2] | ((unsigned)ri[8 * q + 3] << 16);
            vw[2] = (unsigned)ri[8 * q + 4] | ((unsigned)ri[8 * q + 5] << 16); vw[3] = (unsigned)ri[8 * q + 6] | ((unsigned)ri[8 * q + 7] << 16);
            *(LAS u32x4*)(wl + 8192 + lane * 128 + ((g ^ (lane & 7)) << 4)) = vw; }
    }
    const float blast = cs; cs = 0.f;
#pragma unroll
    for (int g = 0; g < 8; ++g) {
        float kh[8];
#pragma unroll
        for (int i = 0; i < 8; ++i) { const float ff = f[8 * g + i]; cs += __logf(ff); kh[i] = (1.0f - ff) * __expf(blast - cs); }
        u32x4 kw; kw[0] = cvtpk_s(kh[0], kh[1]); kw[1] = cvtpk_s(kh[2], kh[3]); kw[2] = cvtpk_s(kh[4], kh[5]); kw[3] = cvtpk_s(kh[6], kh[7]);
        *(LAS u32x4*)(wl + lane * 128 + ((g ^ (lane & 7)) << 4)) = kw;
    }
    DEC[(size_t)item * 64 + lane] = __expf(blast);
    HW_LDSW();
    const int fr = lane & 15, quad = lane >> 4;
    float* dsp = DS + (size_t)item * 4096;
#pragma unroll
    for (int mt = 0; mt < 4; ++mt) {
        const bf16x8 a0 = frag128(wl + 8192, 16 * mt + fr, quad), a1 = frag128(wl + 8192, 16 * mt + fr, quad + 4);
#pragma unroll
        for (int nt = 0; nt < 4; ++nt) {
            f32x4 acc = {0.f, 0.f, 0.f, 0.f};
            acc = __builtin_amdgcn_mfma_f32_16x16x32_bf16(a0, frag128(wl, 16 * nt + fr, quad), acc, 0, 0, 0);
            acc = __builtin_amdgcn_mfma_f32_16x16x32_bf16(a1, frag128(wl, 16 * nt + fr, quad + 4), acc, 0, 0, 0);
            float* o = dsp + (16 * mt + 4 * quad) * 64 + 16 * nt + fr;
#pragma unroll
            for (int r = 0; r < 4; ++r) o[r * 64] = acc[r];
        }
    }
    HW_LDSW();
}
__device__ __forceinline__ void x3_wave(LAS unsigned char* wl, int lane, int item, const bf16_t* __restrict__ proj, const float* __restrict__ lbp, const bf16_t* __restrict__ ST, bf16_t* __restrict__ Y) {
    const int bh = item >> 7, ch = item & 127, b = bh >> 2, h = bh & 3;
    const int fr = lane & 15, quad = lane >> 4;
    const bf16_t* rp = proj + ((size_t)b * SEQ + ch * 64) * NIN + h * 64 + lane;
    const float lb = lbp[h * 64 + lane];
    f32x4 S[4][4];
    { const bf16_t* sp = ST + (size_t)item * 4096;
#pragma unroll
      for (int tv = 0; tv < 4; ++tv)
#pragma unroll
          for (int td = 0; td < 4; ++td) { const uint2 w = *(const uint2*)(sp + (16 * tv + fr) * 64 + 16 * td + 4 * quad);
              S[td][tv] = (f32x4){__uint_as_float(w.x << 16), __uint_as_float(w.x & 0xffff0000u), __uint_as_float(w.y << 16), __uint_as_float(w.y & 0xffff0000u)}; } }
    LAS float* decl = (LAS float*)(wl + 10240);
    unsigned short nf[16], nq[16], ni[16];
#pragma unroll
    for (int i = 0; i < 16; ++i) { const bf16_t* r = rp + (size_t)i * NIN; nf[i] = r[COL_FC]; nq[i] = r[COL_QC]; ni[i] = r[COL_IC]; }
#pragma unroll 1
    for (int I = 0; I < 4; ++I) {
        float ff[16], qv[16], iv[16], bb[16];
#pragma unroll
        for (int i = 0; i < 16; ++i) { ff[i] = bf2f(nf[i]); qv[i] = bf2f(nq[i]); iv[i] = bf2f(ni[i]); }
        { const int In = I < 3 ? I + 1 : 3;
#pragma unroll
          for (int i = 0; i < 16; ++i) { const bf16_t* r = rp + (size_t)(16 * In + i) * NIN; nf[i] = r[COL_FC]; nq[i] = r[COL_QC]; ni[i] = r[COL_IC]; } }
        __builtin_amdgcn_sched_barrier(0);
        float cs = 0.f;
#pragma unroll
        for (int i = 0; i < 16; ++i) { ff[i] = lb + (1.0f - lb) * __builtin_amdgcn_rcpf(1.0f + __expf(-ff[i])); cs += __logf(ff[i]); bb[i] = cs; qv[i] = qv[i] * __builtin_amdgcn_rcpf(1.0f + __expf(-qv[i])) * 0.125f; }
        const float cm = bb[7], be = bb[15];
        HW_LDSW();
        { u32x4 v0, v1, k0, k1;
#pragma unroll
          for (int j = 0; j < 4; ++j) { v0[j] = cvtpk_s(iv[2 * j], iv[2 * j + 1]); v1[j] = cvtpk_s(iv[8 + 2 * j], iv[9 + 2 * j]);
              k0[j] = cvtpk_s((1.0f - ff[2 * j]) * __expf(be - bb[2 * j]), (1.0f - ff[2 * j + 1]) * __expf(be - bb[2 * j + 1]));
              k1[j] = cvtpk_s((1.0f - ff[8 + 2 * j]) * __expf(be - bb[8 + 2 * j]), (1.0f - ff[9 + 2 * j]) * __expf(be - bb[9 + 2 * j])); }
          *(LAS u32x4*)(wl + 8192 + lane * 32) = v0; *(LAS u32x4*)(wl + 8192 + lane * 32 + 16) = v1;
          *(LAS u32x4*)(wl + 6144 + lane * 32) = k0; *(LAS u32x4*)(wl + 6144 + lane * 32 + 16) = k1; }
        decl[lane] = __expf(be);
#pragma unroll
        for (int i = 0; i < 16; ++i) {
            const int off = i * 128 + ((((lane >> 3) ^ (i & 7))) << 4) + (lane & 7) * 2;
            *(LAS bf16_t*)(wl + off) = f2bf(qv[i] * __expf(bb[i]));
            *(LAS bf16_t*)(wl + 2048 + off) = f2bf(qv[i] * __expf(bb[i] - cm));
            *(LAS bf16_t*)(wl + 4096 + off) = f2bf((1.0f - ff[i]) * __expf(cm - bb[i]));
        }
        HW_LDSW();
        f32x4 sc = {0.f, 0.f, 0.f, 0.f};
        sc = __builtin_amdgcn_mfma_f32_16x16x32_bf16(frag128(wl + 4096, fr, quad), frag128(wl + 2048, fr, quad), sc, 0, 0, 0);
        sc = __builtin_amdgcn_mfma_f32_16x16x32_bf16(frag128(wl + 4096, fr, quad + 4), frag128(wl + 2048, fr, quad + 4), sc, 0, 0, 0);
#pragma unroll
        for (int r = 0; r < 4; ++r) if (4 * quad + r > fr) sc[r] = 0.f;
        u32x4 scb; scb[0] = cvtpk_s(sc[0], sc[1]); scb[1] = cvtpk_s(sc[2], sc[3]); scb[2] = 0u; scb[3] = 0u;
        u32x4 qi[2];
#pragma unroll
        for (int ks = 0; ks < 2; ++ks) {
            const u32x2 lo = *(const LAS u32x2*)(wl + fr * 128 + ((((4 * ks + (quad >> 1))) ^ (fr & 7)) << 4) + (quad & 1) * 8);
            const u32x2 hi2 = *(const LAS u32x2*)(wl + fr * 128 + ((((4 * ks + 2 + (quad >> 1))) ^ (fr & 7)) << 4) + (quad & 1) * 8);
            qi[ks] = (u32x4){lo[0], lo[1], hi2[0], hi2[1]};
        }
        const size_t orow = (size_t)b * SEQ + ch * 64 + 16 * I + fr;
#pragma unroll
        for (int tv = 0; tv < 4; ++tv) {
            const u32x2 vt = *(const LAS u32x2*)(wl + 8192 + (16 * tv + fr) * 32 + quad * 8);
            f32x4 acc = {0.f, 0.f, 0.f, 0.f};
            acc = __builtin_amdgcn_mfma_f32_16x16x32_bf16(__builtin_bit_cast(bf16x8, (u32x4){vt[0], vt[1], 0u, 0u}), __builtin_bit_cast(bf16x8, scb), acc, 0, 0, 0);
#pragma unroll
            for (int ks = 0; ks < 2; ++ks) {
                u32x4 sa; sa[0] = cvtpk_s(S[2 * ks][tv][0], S[2 * ks][tv][1]); sa[1] = cvtpk_s(S[2 * ks][tv][2], S[2 * ks][tv][3]);
                sa[2] = cvtpk_s(S[2 * ks + 1][tv][0], S[2 * ks + 1][tv][1]); sa[3] = cvtpk_s(S[2 * ks + 1][tv][2], S[2 * ks + 1][tv][3]);
                acc = __builtin_amdgcn_mfma_f32_16x16x32_bf16(__builtin_bit_cast(bf16x8, sa), __builtin_bit_cast(bf16x8, qi[ks]), acc, 0, 0, 0);
            }
            uint2 w; w.x = cvtpk_s(acc[0], acc[1]); w.y = cvtpk_s(acc[2], acc[3]);
            *(uint2*)(Y + orow * DM + 512 + h * 64 + 16 * tv + 4 * quad) = w;
        }
        if (I < 3) {
#pragma unroll
            for (int td = 0; td < 4; ++td) {
                const f32x4 dc = *(const LAS f32x4*)(wl + 10240 + (16 * td + 4 * quad) * 4);
                const u32x2 kt = *(const LAS u32x2*)(wl + 6144 + (16 * td + fr) * 32 + quad * 8);
                const bf16x8 ka = __builtin_bit_cast(bf16x8, (u32x4){kt[0], kt[1], 0u, 0u});
#pragma unroll
                for (int tv = 0; tv < 4; ++tv) {
                    const u32x2 vt = *(const LAS u32x2*)(wl + 8192 + (16 * tv + fr) * 32 + quad * 8);
                    S[td][tv] = __builtin_amdgcn_mfma_f32_16x16x32_bf16(ka, __builtin_bit_cast(bf16x8, (u32x4){vt[0], vt[1], 0u, 0u}), S[td][tv] * dc, 0, 0, 0);
                }
            }
        }
    }
    HW_LDSW();
}
}

namespace s5 {
typedef short bf16x8 __attribute__((ext_vector_type(8)));
typedef float f32x4 __attribute__((ext_vector_type(4)));
__device__ __forceinline__ void cpow(double dt, double ar, double ai, int n, double& pr, double& pi) { const double mg = exp(n * dt * ar); double sn, cs; sincos_d(n * dt * ai, sn, cs); pr = mg * cs; pi = mg * sn; }
__device__ __forceinline__ void cpow_f(double dt, double ar, double ai, int n, double& pr, double& pi) {
    const float mg = __expf((float)(n * dt * ar)); const double th = n * dt * ai, k = rint(th * 0.15915494309189535); const float r = (float)fma(-k, 6.283185307179586, th);
    pr = (double)(mg * __cosf(r)); pi = (double)(mg * __sinf(r));
}
__device__ __forceinline__ void zfac(double dt, double ar, double ai, double& zr, double& zi) {
    double are, aim; cpow(dt, ar, ai, 1, are, aim);
    const double nr = are - 1.0, ni = aim, den = ar * ar + ai * ai; zr = (nr * ar + ni * ai) / den; zi = (ni * ar - nr * ai) / den;
}
__device__ __forceinline__ void tables_thread(int e, const float* a_re, const float* a_im, const float* log_dt, const float* b_re, const float* b_im, const float* c_re, const float* c_im,
                                              bf16_t* W1, bf16_t* W3, float* a64) {
    const int st = e & 63, p = (e >> 6) & 63, lg = e >> 12;
    const int id = lg * 64 + p;
    float brv[16], biv[16], crv[16], civ[16];
#pragma unroll
    for (int c4 = 0; c4 < 4; ++c4) { const float4 x = *(const float4*)(b_re + id * 16 + 4 * c4), y = *(const float4*)(b_im + id * 16 + 4 * c4);
        brv[4 * c4] = x.x; brv[4 * c4 + 1] = x.y; brv[4 * c4 + 2] = x.z; brv[4 * c4 + 3] = x.w; biv[4 * c4] = y.x; biv[4 * c4 + 1] = y.y; biv[4 * c4 + 2] = y.z; biv[4 * c4 + 3] = y.w; }
#pragma unroll
    for (int c = 0; c < 16; ++c) { crv[c] = c_re[(lg * 16 + c) * 64 + p]; civ[c] = c_im[(lg * 16 + c) * 64 + p]; }
    const double dt = exp((double)log_dt[lg]), ar = a_re[id], ai = a_im[id];
    __builtin_amdgcn_sched_barrier(0);
    double zr, zi; zfac(dt, ar, ai, zr, zi);
    { double pr, pi; cpow_f(dt, ar, ai, 63 - st, pr, pi);
      unsigned wr[8], wi[8];
#pragma unroll
      for (int c2 = 0; c2 < 8; ++c2) {
          float vr[2], vi[2];
#pragma unroll
          for (int q = 0; q < 2; ++q) { const int c = 2 * c2 + q; const double br = brv[c], bi = biv[c];
              const double bbr = zr * br - zi * bi, bbi = zr * bi + zi * br; vr[q] = (float)(pr * bbr - pi * bbi); vi[q] = (float)(pr * bbi + pi * bbr); }
          wr[c2] = pk2(vr[0], vr[1]); wi[c2] = pk2(vi[0], vi[1]);
      }
      u32x4* o0 = (u32x4*)(W1 + ((size_t)(lg * 128 + 2 * p) * 1024 + st * 16)); u32x4* o1 = (u32x4*)(W1 + ((size_t)(lg * 128 + 2 * p + 1) * 1024 + st * 16));
      o0[0] = (u32x4){wr[0], wr[1], wr[2], wr[3]}; o0[1] = (u32x4){wr[4], wr[5], wr[6], wr[7]};
      o1[0] = (u32x4){wi[0], wi[1], wi[2], wi[3]}; o1[1] = (u32x4){wi[4], wi[5], wi[6], wi[7]}; }
    { double pr, pi; cpow_f(dt, ar, ai, st + 1, pr, pi);
#pragma unroll
      for (int c = 0; c < 16; ++c) { const double cr = crv[c], ci = civ[c];
          *(unsigned*)(W3 + ((size_t)(lg * 1024 + st * 16 + c) * 128 + 2 * p)) = pk2((float)(cr * pr - ci * pi), -(float)(cr * pi + ci * pr)); }
      if (st == 63) { double qr, qi; cpow(dt, ar, ai, 64, qr, qi); a64[id * 2] = (float)qr; a64[id * 2 + 1] = (float)qi; } }
}
__device__ __forceinline__ void kmat_item(LAS float* scr, int tid, int item, const float* a_re, const float* a_im, const float* log_dt, const float* b_re, const float* b_im, const float* c_re, const float* c_im, const float* dskip, bf16_t* KM) {
    const int tau = item & 63, lg = item >> 6;
    __syncthreads();
    if (tid < 256) ((LAS f32x4*)(scr + 2048))[tid] = ((const f32x4*)(c_re + (size_t)lg * 1024))[tid];
    else ((LAS f32x4*)(scr + 3072))[tid - 256] = ((const f32x4*)(c_im + (size_t)lg * 1024))[tid - 256];
    { const int p = tid >> 3, c0 = (tid & 7) * 2, id = lg * 64 + p;
      const double dt = exp((double)log_dt[lg]), ar = a_re[id], ai = a_im[id];
      double zr, zi, pr, pi; zfac(dt, ar, ai, zr, zi); cpow_f(dt, ar, ai, tau, pr, pi);
#pragma unroll
      for (int q = 0; q < 2; ++q) { const int c = c0 + q; const double br = b_re[id * 16 + c], bi = b_im[id * 16 + c];
          const double bbr = zr * br - zi * bi, bbi = zr * bi + zi * br;
          scr[(p * 16 + c) * 2] = (float)(pr * bbr - pi * bbi); scr[(p * 16 + c) * 2 + 1] = (float)(pr * bbi + pi * bbr); } }
    __syncthreads();
    if (tid < 256) { const int c = tid >> 4, cp = tid & 15; float s = 0.f;
#pragma unroll 8
        for (int p = 0; p < 64; ++p) s += scr[2048 + c * 64 + p] * scr[(p * 16 + cp) * 2] - scr[3072 + c * 64 + p] * scr[(p * 16 + cp) * 2 + 1];
        if (tau == 0 && c == cp) s += dskip[lg * 16 + c];
        KM[((size_t)(lg * 64 + tau) * 16 + c) * 16 + cp] = f2bf(s); }
}
__device__ __forceinline__ size_t chunk_row(int cid) { return (size_t)(cid >> 7) * SEQ + (size_t)(cid & 127) * 64; }
__device__ __forceinline__ void x1_wave(int lane, int g, int mt, int nq, int lg, const bf16_t* __restrict__ proj, const bf16_t* __restrict__ W1, float* __restrict__ HEND) {
    const int fr = lane & 15, quad = lane >> 4;
    const bf16_t* ap = proj + (chunk_row(mt * 16 + fr) + (quad >> 1)) * NIN + COL_U + g * 16 + 8 * (quad & 1);
    const bf16_t* bp = W1 + ((size_t)(lg * 128 + 32 * nq + fr) * 1024 + 8 * quad);
    f32x4 acc0 = {0.f, 0.f, 0.f, 0.f}, acc1 = {0.f, 0.f, 0.f, 0.f};
    bf16x8 afr[32];
#pragma unroll
    for (int kk = 0; kk < 32; ++kk) afr[kk] = *(const bf16x8*)(ap + (size_t)(2 * kk) * NIN);
    bf16x8 bq0[8], bq1[8];
#pragma unroll
    for (int i = 0; i < 8; ++i) { bq0[i] = *(const bf16x8*)(bp + 32 * i); bq1[i] = *(const bf16x8*)(bp + 16 * 1024 + 32 * i); }
#pragma unroll
    for (int kk = 0; kk < 32; ++kk) {
        const bf16x8 bc0 = bq0[kk & 7], bc1 = bq1[kk & 7];
        if (kk + 8 < 32) { bq0[kk & 7] = *(const bf16x8*)(bp + 32 * (kk + 8)); bq1[kk & 7] = *(const bf16x8*)(bp + 16 * 1024 + 32 * (kk + 8)); }
        __builtin_amdgcn_sched_barrier(0);
        acc0 = __builtin_amdgcn_mfma_f32_16x16x32_bf16(afr[kk], bc0, acc0, 0, 0, 0);
        acc1 = __builtin_amdgcn_mfma_f32_16x16x32_bf16(afr[kk], bc1, acc1, 0, 0, 0);
    }
#pragma unroll
    for (int r = 0; r < 4; ++r) { float* o = HEND + ((size_t)(mt * 16 + 4 * quad + r) * 16 + g) * 128 + 32 * nq + fr; o[0] = acc0[r]; o[16] = acc1[r]; }
}
__device__ __forceinline__ void x2_scan(int e, const float* __restrict__ HEND, const float* __restrict__ a64, bf16_t* __restrict__ HST, int layer) {
    const int p = e & 63, g = (e >> 6) & 15, b = e >> 10;
    const float ar = a64[((layer * 16 + g) * 64 + p) * 2], ai = a64[((layer * 16 + g) * 64 + p) * 2 + 1];
    float hr = 0.f, hi = 0.f;
#pragma unroll 1
    for (int c0 = 0; c0 < 128; c0 += 16) {
        float2 he[16];
#pragma unroll
        for (int i = 0; i < 16; ++i) he[i] = *(const float2*)(HEND + ((size_t)(b * 128 + c0 + i) * 16 + g) * 128 + 2 * p);
#pragma unroll
        for (int i = 0; i < 16; ++i) {
            *(unsigned*)(HST + ((size_t)(b * 128 + c0 + i) * 16 + g) * 128 + 2 * p) = cvtpk_s(hr, hi);
            const float nr = ar * hr - ai * hi + he[i].x, ni = ar * hi + ai * hr + he[i].y; hr = nr; hi = ni;
        }
    }
}
__device__ __forceinline__ void x3_item(LAS unsigned char* lds, int wave, int lane, int item, int layer, const bf16_t* __restrict__ proj, const bf16_t* __restrict__ KM, const bf16_t* __restrict__ W3,
                                        const bf16_t* __restrict__ HST, bf16_t* __restrict__ ybpre) {
    const int g = item & 15, mt = item >> 4, lg = layer * 16 + g;
    const int tid = wave * 64 + lane;
    __syncthreads();
    { const u32x4* src = (const u32x4*)(KM + (size_t)lg * 64 * 256);
      u32x4 kv[4];
#pragma unroll
      for (int i = 0; i < 4; ++i) kv[i] = src[tid + 512 * i];
#pragma unroll
      for (int i = 0; i < 4; ++i) ((LAS u32x4*)lds)[tid + 512 * i] = kv[i];
      if (tid < 32) ((LAS u32x4*)(lds + 32768))[tid] = (u32x4){0u, 0u, 0u, 0u}; }
    __syncthreads();
    const int fr = lane & 15, quad = lane >> 4;
    const size_t crow = chunk_row(mt * 16 + fr);
    const bf16_t* ap = proj + (crow + (quad >> 1)) * NIN + COL_U + g * 16 + 8 * (quad & 1);
    f32x4 acc[8];
#pragma unroll
    for (int i = 0; i < 8; ++i) acc[i] = (f32x4){0.f, 0.f, 0.f, 0.f};
    const int tlo = 4 * wave, thi = 60 - 4 * wave;
    const int kkmax = (thi + 3) >> 1;
    const int lbase = (fr * 16 + 8 * (quad & 1)) * 2;
    const int kboth = 2 * wave + 1;
#define S5_B(t_, kk_) ({ const int tau_ = (t_) - 2 * (kk_) - (quad >> 1); *(const LAS bf16x8*)(lds + (tau_ < 0 ? 64 : tau_) * 512 + lbase); })
#pragma unroll 1
    for (int kb = 0; kb <= kkmax; kb += 8) {
        bf16x8 a8[8];
#pragma unroll
        for (int i = 0; i < 8; ++i) a8[i] = *(const bf16x8*)(ap + (size_t)(2 * (kb + i)) * NIN);
        __builtin_amdgcn_sched_barrier(0);
#pragma unroll
        for (int i = 0; i < 8; ++i) {
            const int kk = kb + i;
            if (kk <= kboth) {
#pragma unroll
                for (int ti = 0; ti < 4; ++ti) acc[ti] = __builtin_amdgcn_mfma_f32_16x16x32_bf16(a8[i], S5_B(tlo + ti, kk), acc[ti], 0, 0, 0);
            }
            if (kk <= kkmax) {
#pragma unroll
                for (int ti = 0; ti < 4; ++ti) acc[4 + ti] = __builtin_amdgcn_mfma_f32_16x16x32_bf16(a8[i], S5_B(thi + ti, kk), acc[4 + ti], 0, 0, 0);
            }
        }
    }
#undef S5_B
    {
        const bf16_t* hp = HST + ((size_t)(mt * 16 + fr) * 16 + g) * 128 + 8 * quad;
        const bf16_t* wlo = W3 + ((size_t)(lg * 1024 + tlo * 16 + fr) * 128 + 8 * quad);
        const bf16_t* whi = W3 + ((size_t)(lg * 1024 + thi * 16 + fr) * 128 + 8 * quad);
#pragma unroll 1
        for (int kk = 0; kk < 4; ++kk) {
            const bf16x8 a = *(const bf16x8*)(hp + 32 * kk);
            bf16x8 wb[8];
#pragma unroll
            for (int ti = 0; ti < 8; ++ti) wb[ti] = *(const bf16x8*)((ti < 4 ? wlo + (size_t)ti * 16 * 128 : whi + (size_t)(ti - 4) * 16 * 128) + 32 * kk);
            __builtin_amdgcn_sched_barrier(0);
#pragma unroll
            for (int ti = 0; ti < 8; ++ti) acc[ti] = __builtin_amdgcn_mfma_f32_16x16x32_bf16(a, wb[ti], acc[ti], 0, 0, 0);
        }
    }
#pragma unroll
    for (int ti = 0; ti < 8; ++ti)
#pragma unroll
        for (int r = 0; r < 4; ++r) {
            const int t = ti < 4 ? tlo + ti : thi + ti - 4;
            const size_t row = chunk_row(mt * 16 + 4 * quad + r) + t;
            const float y = acc[ti][r];
            const float uu = 1.5957691216057308f * (y + 0.044715f * y * y * y);
            ybpre[row * 256 + g * 16 + fr] = f2bf(y * __builtin_amdgcn_rcpf(1.0f + __expf(-uu)));
        }
}
}

constexpr int NWAVES = 8;
constexpr int RING_BYTES = 131072, MISC_OFF = RING_BYTES + 320, LDS_BYTES = 147456;
typedef unsigned v4u __attribute__((ext_vector_type(4)));
#define LDS_WAIT() asm volatile("s_waitcnt lgkmcnt(0)" ::: "memory")

struct Args { const float* in[18]; float* out; unsigned char* ws; };

__device__ __forceinline__ void p0_transpose_item(const float* W, int K, int N, bf16_t* WT, LAS float* scr, int item, int lane) {
    const int nblk = N / 32, kb = item / nblk, nb = item % nblk, k0 = 64 * kb, n0 = 32 * nb;
    float wv[32];
#pragma unroll
    for (int i = 0; i < 32; ++i) { const int kk = 2 * i + (lane >> 5); wv[i] = W[(size_t)(k0 + kk) * N + n0 + (lane & 31)]; }
    __builtin_amdgcn_sched_barrier(0);
#pragma unroll
    for (int i = 0; i < 32; ++i) { const int kk = 2 * i + (lane >> 5); scr[kk * 33 + (lane & 31)] = wv[i]; }
    LDS_WAIT();
    const int c = lane & 7;
#pragma unroll
    for (int j = 0; j < 4; ++j) { const int n = (lane >> 3) + 8 * j; const LAS float* s = scr + (8 * c) * 33 + n;
        v4u o; o.x = pk2(s[0 * 33], s[1 * 33]); o.y = pk2(s[2 * 33], s[3 * 33]); o.z = pk2(s[4 * 33], s[5 * 33]); o.w = pk2(s[6 * 33], s[7 * 33]);
        *(v4u*)(WT + (size_t)(n0 + n) * K + k0 + 8 * c) = o; }
    LDS_WAIT();
}
__device__ __forceinline__ void prep_small(int id, const float* a_re, const float* a_im, const float* log_dt, const float* b_re, const float* b_im, const float* hl, float* sm) {
    if (id < DEPTH * 16 * 64) {
        const int lg = id >> 6;
        const double dt = exp((double)log_dt[lg]), ar = a_re[id], ai = a_im[id];
        const double mag = exp(dt * ar); double sn, cs; sincos_d(dt * ai, sn, cs);
        const double are = mag * cs, aim = mag * sn, nr = are - 1.0, ni = aim, den = ar * ar + ai * ai;
        const double zr = (nr * ar + ni * ai) / den, zi = (ni * ar - nr * ai) / den;
        sm[SM_ABAR + id * 2] = (float)are; sm[SM_ABAR + id * 2 + 1] = (float)aim;
        for (int c = 0; c < 16; ++c) {
            const double br = b_re[id * 16 + c], bi = b_im[id * 16 + c];
            sm[SM_BBAR + (id * 16 + c) * 2] = (float)(zr * br - zi * bi);
            sm[SM_BBAR + (id * 16 + c) * 2 + 1] = (float)(zr * bi + zi * br);
        }
    }
    if (id < 256) {
        const float h0 = hl[id], h1 = hl[256 + id], mx = fmaxf(h0, h1), e0 = expf(h0 - mx), e1 = expf(h1 - mx);
        sm[SM_LB + id] = 0.0f; sm[SM_LB + 256 + id] = e1 / (e0 + e1);
    }
}

__device__ __forceinline__ float dot64(const float* qs, const bf16_t* krow) {
    float s = 0.f;
#pragma unroll
    for (int i = 0; i < 8; ++i) {
        const u32x4 v = *(const u32x4*)(krow + i * 8);
#pragma unroll
        for (int j = 0; j < 4; ++j) { s = fmaf(qs[i * 8 + 2 * j], __uint_as_float(v[j] << 16), s); s = fmaf(qs[i * 8 + 2 * j + 1], __uint_as_float(v[j] & 0xffff0000u), s); }
    }
    return s;
}
__device__ __forceinline__ void moba_simple(int gid, int lane, float* scr, const bf16_t* __restrict__ proj, const float* __restrict__ kmean, const float* __restrict__ rel_bias, bf16_t* __restrict__ Y) {
    const int s = gid % SEQ, h = (gid / SEQ) & 3, b = gid / (SEQ * 4);
    float* qs = scr; float* ps = scr + 64;
    const size_t row = (size_t)b * SEQ + s;
    WSYNC();
    qs[lane] = bf2f(proj[row * NIN + COL_QA + h * 64 + lane]);
    WSYNC();
    const int own = s >> 8;
    float g = -INFINITY;
    if (lane < own) { const float* km = kmean + ((b * 4 + h) * 32 + lane) * 64; float a = 0.f; for (int d = 0; d < 64; ++d) a = fmaf(qs[d], km[d], a); g = a; }
    int blk[4]; bool val[4];
#pragma unroll
    for (int t = 0; t < 3; ++t) {
        const float mx = wave_max(g);
        val[t] = mx > -INFINITY;
        const unsigned long long mk = __ballot(g == mx);
        const int idx = val[t] ? (__ffsll((long long)mk) - 1) : own;
        blk[t] = idx;
        if (val[t] && lane == idx) g = -INFINITY;
    }
    blk[3] = own; val[3] = true;
    float lmax = NEGF;
#pragma unroll
    for (int t = 0; t < 4; ++t) {
        for (int i = 0; i < 4; ++i) {
            const int kk = lane + 64 * i, kpos = blk[t] * 256 + kk;
            const bool ok = (t < 3) ? val[t] : (kpos <= s);
            float lg = NEGF;
            if (ok) lg = dot64(qs, proj + ((size_t)b * SEQ + kpos) * NIN + COL_KA + h * 64) * 0.125f + rel_bias[t5_bucket(s - kpos) * 8 + h];
            ps[t * 256 + kk] = lg; lmax = fmaxf(lmax, lg);
        }
    }
    const float mx = wave_max(lmax);
    float lsum = 0.f;
    for (int i = 0; i < 16; ++i) { const float p = expf(ps[lane + 64 * i] - mx); ps[lane + 64 * i] = p; lsum += p; }
    const float tot = wave_sum(lsum);
    WSYNC();
    float acc = 0.f;
#pragma unroll
    for (int t = 0; t < 4; ++t) {
        if (!val[t]) continue;
        const bf16_t* vp = proj + ((size_t)b * SEQ + blk[t] * 256) * NIN + COL_VA + h * 64 + lane;
        const int nk = (t < 3) ? 256 : (s - own * 256 + 1);
        for (int kk = 0; kk < nk; ++kk) acc = fmaf(ps[t * 256 + kk], bf2f(vp[(size_t)kk * NIN]), acc);
    }
    Y[row * DM + h * 64 + lane] = f2bf(acc / tot);
}
__device__ __forceinline__ void dilated_simple(int gid, int lane, float* scr, const bf16_t* __restrict__ proj, const float* __restrict__ rel_bias, bf16_t* __restrict__ Y) {
    const int s = gid % SEQ, h = (gid / SEQ) & 3, b = gid / (SEQ * 4);
    float* qs = scr; float* ps = scr + 64;
    const size_t row = (size_t)b * SEQ + s;
    WSYNC();
    qs[lane] = bf2f(proj[row * NIN + COL_QD + h * 64 + lane]);
    WSYNC();
    float lse[3], ssum[3];
#pragma unroll
    for (int pi = 0; pi < 3; ++pi) {
        const int dil = (pi == 0) ? 1 : (pi == 1) ? 4 : 16;
        float lmax = NEGF;
        for (int i = 0; i < 3; ++i) {
            const int j = lane + 64 * i, kpos = s - j * dil;
            float lg = NEGF;
            if (j <= 128 && kpos >= 0) lg = dot64(qs, proj + ((size_t)b * SEQ + kpos) * NIN + COL_KD + h * 64) * 0.125f + rel_bias[t5_bucket(j * dil) * 8 + 4 + h];
            ps[pi * 192 + j] = lg; lmax = fmaxf(lmax, lg);
        }
        const float mx = wave_max(lmax);
        float lsum = 0.f;
        for (int i = 0; i < 3; ++i) { const int j = lane + 64 * i; const float p = expf(ps[pi * 192 + j] - mx); ps[pi * 192 + j] = p; lsum += p; }
        ssum[pi] = wave_sum(lsum);
        lse[pi] = mx + logf(ssum[pi]);
    }
    WSYNC();
    const float lm = fmaxf(lse[0], fmaxf(lse[1], lse[2]));
    const float w0 = expf(lse[0] - lm), w1 = expf(lse[1] - lm), w2 = expf(lse[2] - lm), wt = w0 + w1 + w2;
    const float wgt[3] = {w0 / wt, w1 / wt, w2 / wt};
    float out = 0.f;
#pragma unroll
    for (int pi = 0; pi < 3; ++pi) {
        const int dil = (pi == 0) ? 1 : (pi == 1) ? 4 : 16;
        float acc = 0.f;
        for (int j = 0; j <= 128; ++j) {
            const int kpos = s - j * dil; if (kpos < 0) break;
            acc = fmaf(ps[pi * 192 + j], bf2f(proj[((size_t)b * SEQ + kpos) * NIN + COL_VD + h * 64 + lane]), acc);
        }
        out += wgt[pi] * acc / ssum[pi];
    }
    Y[row * DM + 768 + h * 64 + lane] = f2bf(out);
}
__device__ __forceinline__ void s5_simple(int b, int g, int lane, float* scr, const bf16_t* __restrict__ proj, const float* __restrict__ sm, const float* __restrict__ c_re, const float* __restrict__ c_im,
                                          const float* __restrict__ dskip, bf16_t* __restrict__ ybpre, int layer) {
    float* hs = scr; float* us = scr + 8192; float* cs = scr + 8192 + 1024;
    const int pid = (layer * 16 + g) * 64 + lane;
    const float are = sm[SM_ABAR + pid * 2], aim = sm[SM_ABAR + pid * 2 + 1];
    float bbr[16], bbi[16];
#pragma unroll
    for (int c = 0; c < 16; ++c) { bbr[c] = sm[SM_BBAR + (pid * 16 + c) * 2]; bbi[c] = sm[SM_BBAR + (pid * 16 + c) * 2 + 1]; }
    for (int c = 0; c < 16; ++c) { cs[(c * 65 + lane) * 2] = c_re[((layer * 16 + g) * 16 + c) * 64 + lane]; cs[(c * 65 + lane) * 2 + 1] = c_im[((layer * 16 + g) * 16 + c) * 64 + lane]; }
    const int oc = lane & 15, otq = lane >> 4;
    const float dsk = dskip[layer * 256 + g * 16 + oc];
    float hr = 0.f, hi = 0.f;
#pragma unroll 1
    for (int t0 = 0; t0 < SEQ; t0 += 64) {
        WSYNC();
#pragma unroll 1
        for (int e = lane; e < 1024; e += 64) { const int t = e >> 4, c = e & 15; us[t * 16 + c] = bf2f(proj[((size_t)b * SEQ + t0 + t) * NIN + COL_U + g * 16 + c]); }
        WSYNC();
#pragma unroll 1
        for (int t = 0; t < 64; ++t) {
            float xr = 0.f, xi = 0.f;
#pragma unroll
            for (int c = 0; c < 16; ++c) { const float u = us[t * 16 + c]; xr = fmaf(bbr[c], u, xr); xi = fmaf(bbi[c], u, xi); }
            const float nr = are * hr - aim * hi + xr, ni = are * hi + aim * hr + xi;
            hr = nr; hi = ni;
            hs[(t * 64 + lane) * 2] = hr; hs[(t * 64 + lane) * 2 + 1] = hi;
        }
        WSYNC();
#pragma unroll 1
        for (int i = 0; i < 16; ++i) {
            const int t = otq + 4 * i;
            float y = 0.f;
#pragma unroll 4
            for (int p = 0; p < 64; ++p) y += hs[(t * 64 + p) * 2] * cs[(oc * 65 + p) * 2] - hs[(t * 64 + p) * 2 + 1] * cs[(oc * 65 + p) * 2 + 1];
            y += dsk * us[t * 16 + oc];
            ybpre[((size_t)b * SEQ + t0 + t) * 256 + g * 16 + oc] = f2bf(gelu_tanh(y));
        }
    }
}
__device__ __forceinline__ void hgrn_simple(int b, int h, int lane, float* scr, const bf16_t* __restrict__ proj, const float* __restrict__ sm, bf16_t* __restrict__ Y, int layer) {
    float* fs = scr; float* qs = scr + 4096; float* is = scr + 8192;
    const float lb = sm[SM_LB + layer * 256 + h * 64 + lane];
    float S[64];
#pragma unroll
    for (int d = 0; d < 64; ++d) S[d] = 0.f;
    for (int t0 = 0; t0 < SEQ; t0 += 64) {
        WSYNC();
        for (int t = 0; t < 64; ++t) {
            const bf16_t* r = proj + ((size_t)b * SEQ + t0 + t) * NIN + h * 64 + lane;
            const float qv = bf2f(r[COL_QC]), fv = bf2f(r[COL_FC]), iv = bf2f(r[COL_IC]);
            fs[t * 64 + lane] = lb + (1.0f - lb) * sigmoidf_(fv); qs[t * 64 + lane] = siluf_(qv) * 0.125f; is[t * 64 + lane] = iv;
        }
        WSYNC();
        for (int t = 0; t < 64; ++t) {
            const float iv = is[t * 64 + lane];
            float o = 0.f;
#pragma unroll
            for (int d = 0; d < 64; ++d) { const float f = fs[t * 64 + d]; S[d] = fmaf(f, S[d] - iv, iv); o = fmaf(qs[t * 64 + d], S[d], o); }
            Y[((size_t)b * SEQ + t0 + t) * DM + 512 + h * 64 + lane] = f2bf(o);
        }
    }
}
__device__ __forceinline__ void unpack16(const bf16_t* p, float* v) {
    const u32x4 y0 = *(const u32x4*)p, y1 = *(const u32x4*)(p + 8);
#pragma unroll
    for (int j = 0; j < 4; ++j) { v[2 * j] = __uint_as_float(y0[j] << 16); v[2 * j + 1] = __uint_as_float(y0[j] & 0xffff0000u); v[8 + 2 * j] = __uint_as_float(y1[j] << 16); v[8 + 2 * j + 1] = __uint_as_float(y1[j] & 0xffff0000u); }
}
__device__ __forceinline__ void combine_row(size_t row, int lane, bf16_t* __restrict__ Y, const bf16_t* __restrict__ proj, const float* __restrict__ gain, const bf16_t* __restrict__ PO, const float* __restrict__ PL, const bf16_t* __restrict__ PARTO, const float* __restrict__ PARTML, const bf16_t* __restrict__ ybpre, const float* __restrict__ glub) {
    bf16_t* yp = Y + row * DM + lane * 16; const bf16_t* gp = proj + row * NIN + COL_G + lane * 16;
    const bool is_m = lane < 16, is_d = lane >= 48, is_s = (lane >= 16) && (lane < 32);
    const int hm = (lane >> 2) & 3;
    const bf16_t* s0 = yp; const bf16_t* s1 = yp; const bf16_t* s2 = yp; const bf16_t* s3 = yp;
    if (is_m) { const bf16_t* pb = PARTO + ((row * 4 + hm) * 3) * 64 + (lane & 3) * 16; s1 = pb; s2 = pb + 64; s3 = pb + 128; }
    if (is_d) { const bf16_t* pb = PO + row * 256 + (lane - 48) * 16; s0 = pb; s1 = pb + (size_t)M * 256; s2 = pb + 2 * (size_t)M * 256; s3 = pb; }
    const float* wp = is_m ? PARTML + ((row * 4 + hm) * 4) * 2 : PL + row * 4 + hm;
    const u32x4 g0 = *(const u32x4*)gp, g1 = *(const u32x4*)(gp + 8);
    const u32x4 a0 = *(const u32x4*)s0, a1 = *(const u32x4*)(s0 + 8), b0 = *(const u32x4*)s1, b1 = *(const u32x4*)(s1 + 8);
    const u32x4 c0 = *(const u32x4*)s2, c1 = *(const u32x4*)(s2 + 8), d0 = *(const u32x4*)s3, d1 = *(const u32x4*)(s3 + 8);
    float4 w01 = {0.f, 0.f, 0.f, 0.f}, w23 = {0.f, 0.f, 0.f, 0.f}; float p1 = 0.f, p2 = 0.f;
    if (is_m) { w01 = *(const float4*)wp; w23 = *(const float4*)(wp + 4); }
    if (is_d) { w01.x = wp[0]; p1 = wp[(size_t)M * 4]; p2 = wp[2 * (size_t)M * 4]; }
    __builtin_amdgcn_sched_barrier(0);
    float wa = 1.f, wb = 0.f, wc = 0.f, wd = 0.f;
    if (is_m) {
        const int own = (int)((row % SEQ) >> 8);
        const float m3 = w23.z, l3 = w23.w;
        const float m0 = own > 0 ? w01.x : NEGF, m1 = own > 1 ? w01.z : NEGF, m2 = own > 2 ? w23.x : NEGF;
        const float mx = fmaxf(fmaxf(m3, m0), fmaxf(m1, m2));
        wa = l3 * __builtin_amdgcn_exp2f(m3 - mx); wb = own > 0 ? w01.y * __builtin_amdgcn_exp2f(m0 - mx) : 0.f; wc = own > 1 ? w01.w * __builtin_amdgcn_exp2f(m1 - mx) : 0.f; wd = own > 2 ? w23.y * __builtin_amdgcn_exp2f(m2 - mx) : 0.f;
        const float wi = 1.0f / (wa + wb + wc + wd); wa *= wi; wb *= wi; wc *= wi; wd *= wi;
    }
    if (is_d) { const float mx = fmaxf(w01.x, fmaxf(p1, p2)); wa = __expf(w01.x - mx); wb = __expf(p1 - mx); wc = __expf(p2 - mx); const float wi = 1.0f / (wa + wb + wc); wa *= wi; wb *= wi; wc *= wi; wd = 0.f; }
    float v[16], gt[16];
#define CB_LO(x) __uint_as_float((x) << 16)
#define CB_HI(x) __uint_as_float((x) & 0xffff0000u)
#pragma unroll
    for (int j = 0; j < 4; ++j) {
        v[2 * j] = wa * CB_LO(a0[j]) + wb * CB_LO(b0[j]) + wc * CB_LO(c0[j]) + wd * CB_LO(d0[j]);         v[2 * j + 1] = wa * CB_HI(a0[j]) + wb * CB_HI(b0[j]) + wc * CB_HI(c0[j]) + wd * CB_HI(d0[j]);
        v[8 + 2 * j] = wa * CB_LO(a1[j]) + wb * CB_LO(b1[j]) + wc * CB_LO(c1[j]) + wd * CB_LO(d1[j]);     v[9 + 2 * j] = wa * CB_HI(a1[j]) + wb * CB_HI(b1[j]) + wc * CB_HI(c1[j]) + wd * CB_HI(d1[j]);
        gt[2 * j] = CB_LO(g0[j]); gt[2 * j + 1] = CB_HI(g0[j]); gt[8 + 2 * j] = CB_LO(g1[j]); gt[9 + 2 * j] = CB_HI(g1[j]);
    }
#undef CB_LO
#undef CB_HI
    float ss = 0.f;
#pragma unroll
    for (int i = 0; i < 16; ++i) ss = fmaf(v[i], v[i], ss);
    ss += __shfl_xor(ss, 1); ss += __shfl_xor(ss, 2);
    const float r = rsqrtf(ss * (1.0f / 64.0f) + RMS_EPS);
    float o[16];
#pragma unroll
    for (int i = 0; i < 16; ++i) o[i] = v[i] * r * gain[lane * 16 + i] * (gt[i] * __builtin_amdgcn_rcpf(1.0f + __expf(-gt[i])));
    u32x4 q0, q1;
    q0.x = cvtpk_s(o[0], o[1]); q0.y = cvtpk_s(o[2], o[3]); q0.z = cvtpk_s(o[4], o[5]); q0.w = cvtpk_s(o[6], o[7]);
    q1.x = cvtpk_s(o[8], o[9]); q1.y = cvtpk_s(o[10], o[11]); q1.z = cvtpk_s(o[12], o[13]); q1.w = cvtpk_s(o[14], o[15]);
    if (!is_s) { *(u32x4*)yp = q0; *(u32x4*)(yp + 8) = q1; }
}
__device__ __forceinline__ void layernorm_row(size_t row, int lane, float* __restrict__ z, bf16_t* __restrict__ xb, const float* __restrict__ lg, const float* __restrict__ lbias) {
    float4* zp = (float4*)(z + row * DM) + lane;
    float4 v[4]; float s = 0.f;
#pragma unroll
    for (int j = 0; j < 4; ++j) { v[j] = zp[64 * j]; s += (v[j].x + v[j].y) + (v[j].z + v[j].w); }
    const float mean = wave_sum(s) * (1.0f / DM); float q = 0.f;
#pragma unroll
    for (int j = 0; j < 4; ++j) { v[j].x -= mean; v[j].y -= mean; v[j].z -= mean; v[j].w -= mean; q += (v[j].x * v[j].x + v[j].y * v[j].y) + (v[j].z * v[j].z + v[j].w * v[j].w); }
    const float rstd = rsqrtf(wave_sum(q) * (1.0f / DM) + LN_EPS);
#pragma unroll
    for (int j = 0; j < 4; ++j) {
        const float4 gg = ((const float4*)lg)[lane + 64 * j], bb = ((const float4*)lbias)[lane + 64 * j];
        float4 o; o.x = v[j].x * rstd * gg.x + bb.x; o.y = v[j].y * rstd * gg.y + bb.y; o.z = v[j].z * rstd * gg.z + bb.z; o.w = v[j].w * rstd * gg.w + bb.w;
        zp[64 * j] = o;
        uint2 ob; ob.x = pk2(o.x, o.y); ob.y = pk2(o.z, o.w);
        ((uint2*)(xb + row * DM))[lane + 64 * j] = ob;
    }
}

struct PrepPtrs { const float *w_in, *w_out, *glu_w, *a_re, *a_im, *log_dt, *b_re, *b_im, *c_re, *c_im, *dskip; unsigned char* ws; };
__device__ __forceinline__ void prep_layer(LAS unsigned char* ldsl, PrepPtrs p, int l, int bxr, int nbr) {
    const int lane = lane_id_opaque(), wave = __builtin_amdgcn_readfirstlane((int)threadIdx.x >> 6), tid = wave * 64 + lane;
    LAS float* scr = (LAS float*)(ldsl + wave * 16384);
    constexpr int I_IN = (DM / 64) * (NIN / 32), I_OUT = (DM / 64) * (DM / 32), I_GLU = (BW / 64) * (BW / 32), I_L = I_IN + I_OUT + I_GLU;
    for (int it = bxr * NWAVES + wave; it < I_L; it += nbr * NWAVES) { int r = it;
        if (r < I_IN) { p0_transpose_item(p.w_in + (size_t)l * DM * NIN, DM, NIN, (bf16_t*)(p.ws + WS_WTIN) + (size_t)l * NIN * DM, scr, r, lane); continue; } r -= I_IN;
        if (r < I_OUT) { p0_transpose_item(p.w_out + (size_t)l * DM * DM, DM, DM, (bf16_t*)(p.ws + WS_WTOUT) + (size_t)l * DM * DM, scr, r, lane); continue; } r -= I_OUT;
        p0_transpose_item(p.glu_w + (size_t)l * BW * BW, BW, BW, (bf16_t*)(p.ws + WS_GLUWT) + (size_t)l * BW * BW, scr, r, lane); }
    for (int e = l * 65536 + bxr * 512 + tid; e < (l + 1) * 65536; e += nbr * 512)
        s5::tables_thread(e, p.a_re, p.a_im, p.log_dt, p.b_re, p.b_im, p.c_re, p.c_im, (bf16_t*)(p.ws + WS_W1), (bf16_t*)(p.ws + WS_W3), (float*)(p.ws + WS_SMALL) + SM_A64);
    for (int it = l * 1024 + bxr; it < (l + 1) * 1024; it += nbr)
        s5::kmat_item((LAS float*)ldsl, tid, it, p.a_re, p.a_im, p.log_dt, p.b_re, p.b_im, p.c_re, p.c_im, p.dskip, (bf16_t*)(p.ws + WS_KM));
}

#define OPQS(x) asm volatile("" : "+s"(x))
#define OPQ(x) asm volatile("" : "+v"(x))
__global__ void __launch_bounds__(NWAVES * 64, 2) mega_fwd(Args args) {
    extern __shared__ __attribute__((aligned(16))) unsigned char lds[];
#define LANE_ID() ({ unsigned z_ = 0u; asm volatile("" : "+v"(z_)); (int)__builtin_amdgcn_mbcnt_hi(~0u, __builtin_amdgcn_mbcnt_lo(~0u, z_)); })
#define TID_() (wave * 64 + LANE_ID())
#define tid_ TID_()
#define lane_ LANE_ID()
    const int wave = __builtin_amdgcn_readfirstlane((int)threadIdx.x >> 6);
    const int G = gridDim.x, bx = blockIdx.x, bx_ = bx;
    LAS unsigned char* ldsl = (LAS unsigned char*)lds;
    volatile LAS unsigned* MISC = (volatile LAS unsigned*)(ldsl + MISC_OFF);
    for (int u = tid_; u < (LDS_BYTES - RING_BYTES) / 4; u += NWAVES * 64) ((LAS unsigned*)(ldsl + RING_BYTES))[u] = 0u;
    __syncthreads();
    const XcdBarrier bar = xcd_barrier_post((unsigned*)(args.ws + WS_CTL) + CW_BAR, MISC + 8);
    const int gw = bx * NWAVES + wave, NGW = G * NWAVES;
#ifdef PROBE_A
#define STAMP(k) do { if (bx_ == 0 && threadIdx.x == 0) MISC[16 + (k)] = (unsigned)__builtin_amdgcn_s_memrealtime(); } while (0)
#else
#define STAMP(k) do { } while (0)
#endif
#define SUBSTAMP(k) STAMP(32 + (k))
    int stamp_i = 0;
#define GRID_BAR() do { GRID_BAR0(); ++stamp_i; STAMP(stamp_i); } while (0)
    constexpr int DIL_QA = 384, DIL_QB = 1024;
#define DIL_UNIT(park_, tidq_, ug_, ws_) do { const int ug__ = (ug_); fa2::dilated_unit(park_, ldsl, tidq_, 2 - ug__ / 512, (ug__ >> 5) & 15, ug__ & 31, (const bf16_t*)((ws_) + WS_PROJ), (const float*)((ws_) + WS_SMALL) + SM_LUTD, (bf16_t*)((ws_) + WS_PO), (float*)((ws_) + WS_PL)); } while (0)
#define DIL_FILL(wqp_, lo_, hi_, ws_) do { unsigned* wq__ = (wqp_); const int tid__ = wave * 64 + LANE_ID(); __syncthreads(); \
        if (tid__ == 0) MISC[4] = __hip_atomic_fetch_add(wq__, 1u, __ATOMIC_RELAXED, __HIP_MEMORY_SCOPE_AGENT); \
        for (;;) { __syncthreads(); const int it__ = (int)MISC[4]; if (it__ >= (hi_) - (lo_)) break; unsigned nxt__ = 0u; int tidq__ = tid__; OPQ(tidq__); \
            if (tidq__ == 0) nxt__ = __hip_atomic_fetch_add(wq__, 1u, __ATOMIC_RELAXED, __HIP_MEMORY_SCOPE_AGENT); \
            auto park__ = [&]() { if (tidq__ == 0) MISC[4] = nxt__; }; DIL_UNIT(park__, tidq__, (lo_) + it__, ws_); } } while (0)
#define GRID_BAR0() do { XcdBarrier b_ = bar; unsigned x_ = b_.x; unsigned* p_ = b_.bar; asm volatile("" : "+s"(x_), "+s"(p_)); b_.x = x_; b_.bar = p_; xcd_barrier(b_); } while (0)

    STAMP(0);
    {
        const Args* A = &args; unsigned char* ws = launder_g(args.ws);
        int lane = lane_, tid = tid_; OPQ(lane); OPQ(tid);
        const float* x = A->in[0]; const float* w_in = A->in[1]; const float* glu_w = A->in[11]; const float* w_out = A->in[15];
        bf16_t* wtin = (bf16_t*)(ws + WS_WTIN); bf16_t* wtout = (bf16_t*)(ws + WS_WTOUT); bf16_t* gluwt = (bf16_t*)(ws + WS_GLUWT); bf16_t* xb = (bf16_t*)(ws + WS_XB);
        { PrepPtrs pp{A->in[1], A->in[15], A->in[11], A->in[3], A->in[4], A->in[5], A->in[6], A->in[7], A->in[8], A->in[9], A->in[10], ws}; prep_layer(ldsl, pp, 0, bx, G); prep_layer(ldsl, pp, 1, bx, G); }
        SUBSTAMP(8);
        for (size_t i = (size_t)bx * 512 + tid; i < (size_t)M * DM / 4; i += (size_t)G * 512 * 8) {
            float4 v[8];
#pragma unroll
            for (int j = 0; j < 8; ++j) v[j] = ((const float4*)x)[i + (size_t)j * G * 512];
            __builtin_amdgcn_sched_barrier(0);
#pragma unroll
            for (int j = 0; j < 8; ++j) { uint2 o; o.x = cvtpk_s(v[j].x, v[j].y); o.y = cvtpk_s(v[j].z, v[j].w); ((uint2*)xb)[i + (size_t)j * G * 512] = o; }
        }
        SUBSTAMP(9);
        if (bx < 8 && tid < 256) prep_small(bx * 256 + tid, A->in[3], A->in[4], A->in[5], A->in[6], A->in[7], A->in[13], (float*)(ws + WS_SMALL));
        if (bx == 8) { float* smc = (float*)(ws + WS_SMALL);
            for (int i = tid; i < 256; i += 512) smc[SM_RELB + i] = A->in[2][i];
            for (int i = tid; i < 512; i += 512) smc[SM_GLUB + i] = A->in[12][i];
            for (int i = tid; i < 2048; i += 512) { smc[SM_GAIN + i] = A->in[14][i]; smc[SM_LNG + i] = A->in[16][i]; smc[SM_LNB + i] = A->in[17][i]; } }
        if (bx == 9) { float* smc = (float*)(ws + WS_SMALL); const float* rb = A->in[2];
            for (int i = tid; i < 4 * 1888; i += 512) { const int h = i / 1888, dd = i % 1888 - 96; smc[SM_LUTM + i] = dd >= 0 ? rb[t5_bucket(dd) * 8 + h] * 1.4426950408889634f : NEGF; }
            for (int i = tid; i < 3 * 4 * 256; i += 512) { const int pi = i >> 10, h = (i >> 8) & 3, dd = (i & 255) - 64, dil = (pi == 0) ? 1 : (pi == 1) ? 4 : 16;
                smc[SM_LUTD + i] = (dd >= 0 && dd <= 128) ? rb[t5_bucket(dd * dil) * 8 + 4 + h] * 1.4426950408889634f : NEGF; } }
    }
    GRID_BAR();

    auto layer_body = [&](auto LC) __attribute__((always_inline)) { constexpr int l = decltype(LC)::value;
        {
            const Args* A = &args; unsigned char* ws = launder_g(args.ws);
            pg8::Gemm g{(const bf16_t*)(ws + WS_XB), (const bf16_t*)(ws + WS_WTIN) + (size_t)l * NIN * DM, M, NIN, DM}; int tidg = tid_, bxg = bx; OPQ(tidg); OPQS(bxg); pg8::StaticOrder S; S.init(M, NIN, G, bxg);
            pg8::EpiStoreBf16 E{(bf16_t*)(ws + WS_PROJ), NIN, (float*)(ws + WS_KP)};
            pg8::gemm_phase<pg8::EpiStoreBf16, pg8::StaticOrder, true, true>(ldsl, g, S, E, tidg);
        }
        GRID_BAR();
        {
            const Args* A = &args; unsigned char* ws = launder_g(args.ws);
            const bf16_t* proj = (const bf16_t*)(ws + WS_PROJ);
            int lane = lane_; OPQ(lane); const int tid = wave * 64 + lane;
            const float* lbp = (const float*)(ws + WS_SMALL) + SM_LB + l * 256;
            unsigned* wq = (unsigned*)(ws + WS_CTL) + CW_WQ + 64 * l;
            for (int it = gw; it < 2048; it += NGW) hw::x1_wave(ldsl + wave * 16384, lane, it, proj, lbp, (float*)(ws + WS_DS), (float*)(ws + WS_DEC));
            SUBSTAMP(0);
            { const int wi = gw >> 2, nq = gw & 3;
                s5::x1_wave(lane, wi & 15, wi >> 4, nq, l * 16 + (wi & 15), proj, (const bf16_t*)(ws + WS_W1), (float*)(ws + WS_HEND)); }
            SUBSTAMP(1);
            constexpr int N_GATE = 512;
            __syncthreads();
            if (tid == 0) MISC[4] = __hip_atomic_fetch_add(wq, 1u, __ATOMIC_RELAXED, __HIP_MEMORY_SCOPE_AGENT);
            for (;;) {
                __syncthreads();
                const int it = (int)MISC[4];
                if (it >= N_GATE) break;
                int tidq = tid; OPQ(tidq);
                __syncthreads();
                if (tidq == 0) MISC[4] = __hip_atomic_fetch_add(wq, 1u, __ATOMIC_RELAXED, __HIP_MEMORY_SCOPE_AGENT);
                fa2::gate_item(ldsl, tidq, it & 15, 31 - (it >> 4), proj, (const float*)(ws + WS_KP), (unsigned short*)(ws + WS_LIST), (int*)(ws + WS_CNT));
            }
            SUBSTAMP(2);
            DIL_FILL((unsigned*)(ws + WS_CTL) + CW_WQ + 64 * (4 + l), 0, DIL_QA, ws);
            SUBSTAMP(7);
        }
        GRID_BAR();
        {
            const Args* A = &args; unsigned char* ws = launder_g(args.ws);
            const bf16_t* proj = (const bf16_t*)(ws + WS_PROJ); const float* sm = (const float*)(ws + WS_SMALL);
            int lane = lane_; OPQ(lane);
            int bx = bx_; OPQS(bx);
            const int tid = wave * 64 + lane;
            if (bx < 32) hg::x2_scan(bx * 512 + tid, 32 * 512, (const float*)(ws + WS_DS), (const float*)(ws + WS_DEC), (bf16_t*)(ws + WS_ST));
            else if (bx < 40) s5::x2_scan((bx - 32) * 512 + tid, (const float*)(ws + WS_HEND), sm + SM_A64, (bf16_t*)(ws + WS_HST), l);
            unsigned* wq = (unsigned*)(ws + WS_CTL) + CW_WQ + 64 * (2 + l);
            unsigned* sflag = (unsigned*)(ws + WS_CTL) + CW_WQ + 64 * (10 + l);
            const float* lutm = sm + SM_LUTM; const float* lutd = sm + SM_LUTD;
            const float* lbp = sm + SM_LB + l * 256;
            if (bx < 40) {
                asm volatile("s_waitcnt vmcnt(0)" ::: "memory"); __syncthreads();
                if (tid == 0) { __builtin_amdgcn_fence(__ATOMIC_RELEASE, "agent"); asm volatile("s_waitcnt vmcnt(0)" ::: "memory"); __hip_atomic_fetch_add(sflag, 1u, __ATOMIC_RELAXED, __HIP_MEMORY_SCOPE_AGENT); }
            }
            bool scans_seen = false;
            __syncthreads();
            if (tid == 0) MISC[4] = __hip_atomic_fetch_add(wq, 1u, __ATOMIC_RELAXED, __HIP_MEMORY_SCOPE_AGENT);
            for (;;) {
                __syncthreads();
                int it = (int)MISC[4];
                constexpr int N_MOBA = 8 * 64 + 12 * 32 + 12 * 16, N_S5X = 512, N_HGX = 256, N_DIL = 1536 - DIL_QA;
                if (it >= N_MOBA + N_S5X + N_HGX + N_DIL) break;
                unsigned nxt = 0u;
                if (tid == 0) nxt = __hip_atomic_fetch_add(wq, 1u, __ATOMIC_RELAXED, __HIP_MEMORY_SCOPE_AGENT);
                int tidq = tid; OPQ(tidq);
                auto park = [&]() { if (tidq == 0) MISC[4] = nxt; };
                if (it < N_MOBA) {
                    int n, part, np;
                    if (it < 512) { n = it >> 6; part = (it >> 4) & 3; np = 4; } else if (it < 896) { const int j = it - 512; n = 8 + (j >> 5); part = (j >> 4) & 1; np = 2; } else { n = 20 + ((it - 896) >> 4); part = 0; np = 1; }
                    fa2::moba_item(park, ldsl, tidq, it & 15, n, part, np, proj, sm + SM_RELB, lutm, (const unsigned short*)(ws + WS_LIST), (const int*)(ws + WS_CNT), (bf16_t*)(ws + WS_PARTO), (float*)(ws + WS_PARTML), (bf16_t*)(ws + WS_Y));
                } else if (it < N_MOBA + N_S5X + N_HGX) {
                    if (!scans_seen) {
                        if (tidq == 0) { unsigned sp = 0; while (__hip_atomic_load(sflag, __ATOMIC_RELAXED, __HIP_MEMORY_SCOPE_AGENT) < 40u) { __builtin_amdgcn_s_sleep(4); if (++sp > (1u << 24)) break; }
                            __builtin_amdgcn_fence(__ATOMIC_ACQUIRE, "agent"); asm volatile("s_waitcnt vmcnt(0)" ::: "memory"); }
                        scans_seen = true;
                    }
                    __syncthreads();
                    park();
                    if (it < N_MOBA + N_S5X) s5::x3_item(ldsl, wave, tidq & 63, it - N_MOBA, l, proj, (const bf16_t*)(ws + WS_KM), (const bf16_t*)(ws + WS_W3), (const bf16_t*)(ws + WS_HST), (bf16_t*)(ws + WS_YBPRE));
                    else hw::x3_wave(ldsl + wave * 16384, tidq & 63, (it - N_MOBA - N_S5X) * 8 + wave, proj, lbp, (const bf16_t*)(ws + WS_ST), (bf16_t*)(ws + WS_Y));
                } else DIL_UNIT(park, tidq, DIL_QA + it - (N_MOBA + N_S5X + N_HGX), ws);
            }
            SUBSTAMP(5);
        }
        GRID_BAR();
        {
            const Args* A = &args; unsigned char* ws = launder_g(args.ws);
            {
                const bf16_t* ybpre = (const bf16_t*)(ws + WS_YBPRE);
                pg8::Gemm g{ybpre, (const bf16_t*)(ws + WS_GLUWT) + (size_t)l * BW * BW, M, BW, BW}; int tidg = tid_, bxg = bx; OPQ(tidg); OPQS(bxg); pg8::StaticOrder S; S.init(M, BW, G, bxg);
                const float* smp = (const float*)(ws + WS_SMALL);
                pg8::EpiGluNorm E{(bf16_t*)(ws + WS_Y), ybpre, (const bf16_t*)(ws + WS_PROJ), smp + SM_GLUB + l * BW, smp + SM_GAIN + l * DM, ldsl + RING_BYTES + 1024};
                pg8::gemm_phase<pg8::EpiGluNorm, pg8::StaticOrder, true, false>(ldsl, g, S, E, tidg);
            }
            {
                int lane = lane_; OPQ(lane);
                unsigned* wq = (unsigned*)(ws + WS_CTL) + CW_WQ + 64 * (8 + l);
                for (;;) {
                    __syncthreads();
                    if (wave == 0 && lane == 0) MISC[4] = __hip_atomic_fetch_add(wq, 1u, __ATOMIC_RELAXED, __HIP_MEMORY_SCOPE_AGENT);
                    __syncthreads();
                    const int ch = (int)MISC[4];
                    if (ch >= M / 64) break;
                    for (int r = 0; r < 8; ++r) combine_row((size_t)ch * 64 + wave * 8 + r, lane, (bf16_t*)(ws + WS_Y), (const bf16_t*)(ws + WS_PROJ), (const float*)(ws + WS_SMALL) + SM_GAIN + l * DM, (const bf16_t*)(ws + WS_PO), (const float*)(ws + WS_PL), (const bf16_t*)(ws + WS_PARTO), (const float*)(ws + WS_PARTML), (const bf16_t*)(ws + WS_YBPRE), (const float*)(ws + WS_SMALL) + SM_GLUB + l * BW);
                }
            }
        }
        GRID_BAR();
        {
            const Args* A = &args; unsigned char* ws = launder_g(args.ws);
            pg8::Gemm g{(const bf16_t*)(ws + WS_Y), (const bf16_t*)(ws + WS_WTOUT) + (size_t)l * DM * DM, M, DM, DM}; int tidg = tid_, bxg = bx; OPQ(tidg); OPQS(bxg); pg8::StaticOrder S; S.init(M, DM, G, bxg);
            const float* smp = (const float*)(ws + WS_SMALL);
            float* outp = launder_g(args.out); const float* resp = launder_g(args.in[0]);
            pg8::EpiResLn E{l == 0 ? resp : outp, outp, (bf16_t*)(ws + WS_XB), smp + SM_LNG + l * DM, smp + SM_LNB + l * DM, (unsigned long long*)(ws + WS_YBPRE), (unsigned*)(ws + WS_CTL) + CW_SEAM + l * 128 * 64, ldsl + RING_BYTES + 1024};
            pg8::gemm_phase<pg8::EpiResLn, pg8::StaticOrder, true, true>(ldsl, g, S, E, tidg);
        }
        if (l + 1 < DEPTH) GRID_BAR();
    };
    layer_body(std::integral_constant<int, 0>{});
    layer_body(std::integral_constant<int, 1>{});
#ifdef PROBE_A
    ++stamp_i; STAMP(stamp_i);
    if (bx_ == 0 && threadIdx.x == 0) { asm volatile("s_waitcnt vmcnt(0) lgkmcnt(0)" ::: "memory"); args.out[0] += (float)(MISC[16 + PROBE_B] - MISC[16 + PROBE_A]) * 1e-3f; }
#endif
}

extern "C" void kernel_launch(void* const* d_in, const int* in_sizes, int n_in, void* d_out, int out_size, void* d_ws, size_t ws_size, hipStream_t stream) {
    static int grid = 0;
    if (grid == 0) {
        if (n_in != 18 || in_sizes[0] != M * DM || out_size != M * DM || ws_size < WS_END) { fprintf(stderr, "kernel_launch: unexpected shapes (n_in %d, in0 %d, out %d, ws %zu)\n", n_in, n_in > 0 ? in_sizes[0] : -1, out_size, ws_size); grid = -1; return; }
        int dev = 0, cus = 0, per_cu = 0;
        if (hipGetDevice(&dev) != hipSuccess || hipDeviceGetAttribute(&cus, hipDeviceAttributeMultiprocessorCount, dev) != hipSuccess) { grid = -1; return; }
        if (hipFuncSetAttribute((const void*)mega_fwd, hipFuncAttributeMaxDynamicSharedMemorySize, LDS_BYTES) != hipSuccess) { fprintf(stderr, "kernel_launch: hipFuncSetAttribute failed\n"); grid = -1; return; }
        if (hipOccupancyMaxActiveBlocksPerMultiprocessor(&per_cu, (const void*)mega_fwd, NWAVES * 64, LDS_BYTES) != hipSuccess || per_cu < 1) { fprintf(stderr, "kernel_launch: occupancy query says %d\n", per_cu); }
        (void)hipGetLastError();
        grid = cus;
    }
    if (grid < 0) return;
    if (hipMemsetAsync((char*)d_ws + WS_CTL, 0, CTL_ZERO_BYTES, stream) != hipSuccess) return;
    Args a{};
    for (int i = 0; i < 18; ++i) a.in[i] = (const float*)d_in[i];
    a.out = (float*)d_out; a.ws = (unsigned char*)d_ws;
    hipLaunchKernelGGL(mega_fwd, dim3(grid), dim3(NWAVES * 64), LDS_BYTES, stream, a);
}
```

```cpp
#include <hip/hip_runtime.h>
#include <stdint.h>
#include <cstdio>
#include <type_traits>

typedef unsigned short bf16_t;
typedef unsigned u32x4 __attribute__((ext_vector_type(4)));
#define LAS __attribute__((address_space(3)))
#define GAS __attribute__((address_space(1)))

constexpr int BATCH = 4, SEQ = 8192, DM = 1024, M = BATCH * SEQ, BW = 256, NIN = 3584, HD = 64, DEPTH = 2;
constexpr int COL_QA = 0, COL_KA = 256, COL_VA = 512, COL_U = 768, COL_QC = 1024, COL_FC = 1280, COL_IC = 1536, COL_QD = 1792, COL_KD = 2048, COL_VD = 2304, COL_G = 2560;
constexpr float ALPHA = 1.4142135623730951f;
constexpr float LN_EPS = 1e-5f, RMS_EPS = 1e-6f, NEGF = -1e30f;

constexpr size_t MiB = 1u << 20;
constexpr size_t WS_CTL = 0, CTL_ZERO_BYTES = 1 * MiB;
constexpr size_t WS_SMALL = 1 * MiB;
constexpr size_t WS_WTIN = 2 * MiB;
constexpr size_t WS_WTOUT = 16 * MiB;
constexpr size_t WS_GLUWT = 20 * MiB;
constexpr size_t WS_KP = 21 * MiB;
constexpr size_t WS_XB = 22 * MiB;
constexpr size_t WS_PARTO = WS_XB;
constexpr size_t WS_PARTML = WS_XB + 48 * MiB;
constexpr size_t WS_LIST = WS_XB + 52 * MiB;
constexpr size_t WS_CNT = WS_XB + 60 * MiB;
constexpr size_t WS_PROJ = 86 * MiB;
constexpr size_t WS_Y = 310 * MiB;
constexpr size_t WS_YBPRE = 374 * MiB;
constexpr size_t WS_PO = 390 * MiB;
constexpr size_t WS_PL = 438 * MiB;
constexpr size_t WS_DS = 440 * MiB;
constexpr size_t WS_ST = 472 * MiB;
constexpr size_t WS_DEC = 488 * MiB;
constexpr size_t WS_KM = 489 * MiB;
constexpr size_t WS_W1 = 490 * MiB;
constexpr size_t WS_W3 = 498 * MiB;
constexpr size_t WS_HEND = 506 * MiB;
constexpr size_t WS_HST = 510 * MiB;
constexpr size_t WS_END = 512 * MiB;
constexpr int SM_LB = 0;
constexpr int SM_ABAR = 512;
constexpr int SM_BBAR = SM_ABAR + 2 * 16 * 64 * 2;
constexpr int SM_A64 = SM_BBAR + 2 * 16 * 64 * 16 * 2;
constexpr int SM_RELB = SM_A64 + 2 * 16 * 64 * 2, SM_GLUB = SM_RELB + 256, SM_GAIN = SM_GLUB + 512, SM_LNG = SM_GAIN + 2048, SM_LNB = SM_LNG + 2048, SM_END = SM_LNB + 2048;
constexpr int SM_LUTM = SM_END, SM_LUTD = SM_LUTM + 4 * 1888, SM_END2 = SM_LUTD + 3 * 4 * 256;
constexpr int CW_BAR = 4096;
constexpr int CW_SEAM = 32768;
constexpr int CW_WQ = 16384;
constexpr int CW_CNT = 65536;
constexpr int LIST_CAP = 8192;

__device__ __forceinline__ float bf2f(bf16_t v) { return __uint_as_float(((unsigned)v) << 16); }

__device__ __forceinline__ float wave_max(float v) {
#pragma unroll
    for (int o = 1; o < 64; o <<= 1) v = fmaxf(v, __shfl_xor(v, o));
    return v;
}
__device__ __forceinline__ float wave_sum(float v) {
#pragma unroll
    for (int o = 1; o < 64; o <<= 1) v += __shfl_xor(v, o);
    return v;
}
__device__ __forceinline__ int t5_bucket(int d) {
    if (d < 16) return d;
    int b = 16;
    b += (d >= 22); b += (d >= 30); b += (d >= 40); b += (d >= 54); b += (d >= 73); b += (d >= 99); b += (d >= 134); b += (d >= 182);
    b += (d >= 246); b += (d >= 332); b += (d >= 450); b += (d >= 609); b += (d >= 825); b += (d >= 1117); b += (d >= 1513);
    return b;
}
__device__ __forceinline__ float sigmoidf_(float x) { return 1.0f / (1.0f + expf(-x)); }
__device__ __forceinline__ float siluf_(float x) { return x / (1.0f + expf(-x)); }
__device__ __forceinline__ float gelu_tanh(float x) { const float u = 0.7978845608028654f * (x + 0.044715f * x * x * x); return 0.5f * x * (1.0f + tanhf(u)); }
typedef float f32x2_t __attribute__((ext_vector_type(2))); typedef __bf16 bf16x2_t __attribute__((ext_vector_type(2)));
__device__ __forceinline__ unsigned cvtpk_s(float lo, float hi) { f32x2_t v = {lo, hi}; bf16x2_t b = __builtin_convertvector(v, bf16x2_t); return __builtin_bit_cast(unsigned, b); }
__device__ __forceinline__ bf16_t f2bf(float f) { return (bf16_t)(cvtpk_s(f, f) & 0xffffu); }
__device__ __forceinline__ unsigned pk2(float lo, float hi) { return cvtpk_s(lo, hi); }
__device__ __forceinline__ int lane_id_opaque() { unsigned z = 0u; asm volatile("" : "+v"(z)); return (int)__builtin_amdgcn_mbcnt_hi(~0u, __builtin_amdgcn_mbcnt_lo(~0u, z)); }
template <class T> __device__ __forceinline__ T* launder_g(T* p) { unsigned long long v = (unsigned long long)p; asm volatile("" : "+s"(v)); return (T*)(__attribute__((address_space(1))) T*)v; }
#define WSYNC() asm volatile("s_waitcnt lgkmcnt(0)" ::: "memory")

__device__ __forceinline__ void sincos_d(double th, double& s, double& c) {
    const double k = rint(th * 0.63661977236758134308);
    double r = fma(-k, 1.57079632679489655800, th); r = fma(-k, 6.12323399573676603587e-17, r);
    const long q = ((long)k) & 3;
    const double r2 = r * r;
    const double sp = r * (1.0 + r2 * (-1.0 / 6 + r2 * (1.0 / 120 + r2 * (-1.0 / 5040 + r2 * (1.0 / 362880 + r2 * (-1.0 / 39916800 + r2 * (1.0 / 6227020800.0 + r2 * (-1.0 / 1307674368000.0))))))));
    const double cp = 1.0 + r2 * (-0.5 + r2 * (1.0 / 24 + r2 * (-1.0 / 720 + r2 * (1.0 / 40320 + r2 * (-1.0 / 3628800 + r2 * (1.0 / 479001600.0 + r2 * (-1.0 / 87178291200.0 + r2 * (1.0 / 20922789888000.0))))))));
    if (q == 0) { s = sp; c = cp; } else if (q == 1) { s = cp; c = -sp; } else if (q == 2) { s = -sp; c = -cp; } else { s = -cp; c = sp; }
}

namespace pg8 {
#define PG8_LAS __attribute__((address_space(3)))
typedef unsigned short bf16_t;
typedef short bf16x8 __attribute__((ext_vector_type(8)));
typedef float f32x4 __attribute__((ext_vector_type(4)));
typedef unsigned u32x4 __attribute__((ext_vector_type(4)));
constexpr int BM = 256, BK = 64, HALF = 128, HTB = HALF * BK * 2  , STAGE_BYTES = 8 * HTB, NXCD = 8, WGM = 8;

__host__ __device__ __forceinline__ int lds_byte(int r, int c) { const int st = (r >> 4) * 2 + (c >> 5), rr = r & 15, cc = c & 31, ob = rr * 64 + cc * 2; return st * 1024 + (ob ^ (((ob >> 9) & 1) << 5)); }
__host__ __device__ __forceinline__ void stage_rc(int b, int& R, int& C) { const int st = b / 1024, sb = b % 1024, swz = sb ^ (((sb >> 9) & 1) << 5); R = (st >> 1) * 16 + swz / 64; C = (st & 1) * 32 + (swz % 64) / 2; }
__host__ __device__ __forceinline__ int perm32(int rho) { const int n = rho >> 4, i = rho & 15; return 8 * (i >> 2) + 4 * n + (i & 3); }

struct Unit { int pm, pn; };
struct Gemm { const bf16_t* A; const bf16_t* Bt; int M, N, K; };

struct StaticOrder {
    int nM, nN, nwg, G, c;
    __host__ __device__ void init(int M, int N, int G_, int c_) { nM = M / BM; nN = N / BM; nwg = nM * nN; G = G_; c = c_; }
    __host__ __device__ bool next(int i, Unit& u) const {
        const long L = (long)i * G + c; if (L >= nwg) return false;
        int wgid = (int)L; { const int q = nwg / NXCD, r = nwg % NXCD, xcd = wgid % NXCD, off = wgid / NXCD; wgid = (xcd < r ? xcd * (q + 1) : r * (q + 1) + (xcd - r) * q) + off; }
        const int nig = WGM * nN, gid = wgid / nig, fm = gid * WGM, gsz = (nM - fm) < WGM ? (nM - fm) : WGM;
        u.pm = fm + ((wgid % nig) % gsz); u.pn = (wgid % nig) / gsz; return true;
    }
    __device__ __forceinline__ void a_ready(const Unit&) const {}
    __device__ __forceinline__ void done(const Unit&) const {}
};

__device__ __forceinline__ unsigned cvt_pk_bf16(float lo, float hi) { unsigned r; asm volatile("v_cvt_pk_bf16_f32 %0, %1, %2" : "=v"(r) : "v"(lo), "v"(hi)); return r; }
struct EpiStoreBf16 {
    static constexpr bool PERM = true, AFTER_DRAIN = false;
    bf16_t* O; int ldc; float* kp;
    __device__ __forceinline__ void operator()(const f32x4 (&acc)[2][2][4][2], const Unit& u, int wr, int wc, int fr_, int fq_) const {
        const int ln_ = lane_id_opaque(), fr = ln_ & 15, fq = ln_ >> 4; (void)fr_; (void)fq_;
        const int row0 = u.pm * BM + wr * 64 + fr, col0 = u.pn * BM + wc * 32 + 8 * fq;
#pragma unroll
        for (int ai = 0; ai < 2; ++ai)
#pragma unroll
            for (int m = 0; m < 4; ++m) { bf16_t* rowp = O + (size_t)(row0 + ai * HALF + m * 16) * ldc + col0;
#pragma unroll
                for (int bj = 0; bj < 2; ++bj) { const f32x4 v0 = acc[ai][bj][m][0], v1 = acc[ai][bj][m][1];
                    u32x4 w; w.x = cvtpk_s(v0[0], v0[1]); w.y = cvtpk_s(v0[2], v0[3]); w.z = cvtpk_s(v1[0], v1[1]); w.w = cvtpk_s(v1[2], v1[3]);
                    *(u32x4*)(rowp + bj * HALF) = w; } }
        if (kp && u.pn == 1) {
#pragma unroll
            for (int bj = 0; bj < 2; ++bj)
#pragma unroll
                for (int n = 0; n < 2; ++n) { f32x4 s = {0.f, 0.f, 0.f, 0.f};
#pragma unroll
                    for (int ai = 0; ai < 2; ++ai)
#pragma unroll
                        for (int m = 0; m < 4; ++m) s += acc[ai][bj][m][n];
#pragma unroll
                    for (int o = 1; o < 16; o <<= 1) { s[0] += __shfl_xor(s[0], o); s[1] += __shfl_xor(s[1], o); s[2] += __shfl_xor(s[2], o); s[3] += __shfl_xor(s[3], o); }
                    if (fr == 0) *(f32x4*)(kp + (size_t)(u.pm * 2 + wr) * 256 + bj * HALF + wc * 32 + 8 * fq + 4 * n) = s; }
        }
    }
};
struct EpiGlu {
    static constexpr bool PERM = true, AFTER_DRAIN = false;
    bf16_t* O; int ldc; const bf16_t* Ain; int lda; const float* bias;
    __device__ __forceinline__ void operator()(const f32x4 (&acc)[2][2][4][2], const Unit& u, int wr, int wc, int fr_, int fq_) const {
        const int ln_ = lane_id_opaque(), fr = ln_ & 15, fq = ln_ >> 4; (void)fr_; (void)fq_;
        const int row0 = u.pm * BM + wr * 64 + fr, col0 = u.pn * BM + wc * 32 + 8 * fq;
        bf16_t* O = launder_g(this->O); const bf16_t* Ain = launder_g(this->Ain); const float* bias = launder_g(this->bias);
#pragma unroll
        for (int ai = 0; ai < 2; ++ai)
#pragma unroll
            for (int m = 0; m < 4; ++m) { const size_t r = (size_t)(row0 + ai * HALF + m * 16);
#pragma unroll
                for (int bj = 0; bj < 2; ++bj) { const int c = col0 + bj * HALF;
                    const u32x4 av = *(const u32x4*)(Ain + r * lda + c);
                    const f32x4 b0 = *(const f32x4*)(bias + c), b1 = *(const f32x4*)(bias + c + 4);
                    const f32x4 v0 = acc[ai][bj][m][0] + b0, v1 = acc[ai][bj][m][1] + b1;
                    float o[8];
#pragma unroll
                    for (int j = 0; j < 4; ++j) { const float alo = __uint_as_float(av[j] << 16), ahi = __uint_as_float(av[j] & 0xffff0000u);
                        const float s0 = (j < 2) ? v0[2 * j] : v1[2 * j - 4], s1 = (j < 2) ? v0[2 * j + 1] : v1[2 * j - 3];
                        o[2 * j] = alo * __builtin_amdgcn_rcpf(1.0f + __expf(-s0)); o[2 * j + 1] = ahi * __builtin_amdgcn_rcpf(1.0f + __expf(-s1)); }
                    u32x4 w; w.x = cvtpk_s(o[0], o[1]); w.y = cvtpk_s(o[2], o[3]); w.z = cvtpk_s(o[4], o[5]); w.w = cvtpk_s(o[6], o[7]);
                    *(u32x4*)(O + r * ldc + c) = w; } }
    }
};
struct EpiResF32 {
    static constexpr bool PERM = false, AFTER_DRAIN = false;
    const float* res; float* out;
    __device__ __forceinline__ void operator()(const f32x4 (&acc)[2][2][4][2], const Unit& u, int wr, int wc, int fr_, int fq_) const {
        const int ln_ = lane_id_opaque(), fr = ln_ & 15, fq = ln_ >> 4; (void)fr_; (void)fq_;
        const int col0 = u.pn * BM + wc * 32 + 4 * fq;
#pragma unroll
        for (int ai = 0; ai < 2; ++ai)
#pragma unroll
            for (int m = 0; m < 4; ++m) { const size_t off = (size_t)(u.pm * BM + ai * HALF + wr * 64 + m * 16 + fr) * 1024 + col0;
#pragma unroll
                for (int bj = 0; bj < 2; ++bj)
#pragma unroll
                    for (int n = 0; n < 2; ++n) { const f32x4 rv = *(const f32x4*)(res + off + bj * HALF + n * 16);
                        *(f32x4*)(out + off + bj * HALF + n * 16) = rv * 1.4142135623730951f + acc[ai][bj][m][n]; } }
    }
};

template <int L> struct EpiResLn {
    static constexpr bool PERM = false, AFTER_DRAIN = false;
    const float* res; float* out; bf16_t* xb; const float* gam; const float* bet; unsigned long long* xbuf; unsigned* cnt; PG8_LAS unsigned char* tbl;
    __device__ __forceinline__ void operator()(f32x4 (&acc)[2][2][4][2], const Unit& u, int wr, int wc, int fr_, int fq_) const {
        typedef float f32x2v __attribute__((ext_vector_type(2)));
        const int lane = lane_id_opaque(), fr = lane & 15, fq = lane >> 4; (void)fr_; (void)fq_;
        const int wid = wr * 4 + wc;
        const int col0 = u.pn * BM + wc * 32 + 4 * fq;
        PG8_LAS f32x2v* Pt = (PG8_LAS f32x2v*)tbl;
        PG8_LAS f32x2v* St = (PG8_LAS f32x2v*)(tbl + 8192);
#pragma unroll
        for (int ai = 0; ai < 2; ++ai)
#pragma unroll
            for (int m = 0; m < 4; ++m) {
                const size_t off = (size_t)(u.pm * BM + ai * HALF + wr * 64 + m * 16 + fr) * 1024 + col0;
                f32x4 rv[2][2];
                {
#pragma unroll
                    for (int bj = 0; bj < 2; ++bj)
#pragma unroll
                        for (int n = 0; n < 2; ++n) { const uint2 w = *(const uint2*)(xb + off + bj * HALF + n * 16);
                            rv[bj][n] = (f32x4){__uint_as_float(w.x << 16), __uint_as_float(w.x & 0xffff0000u), __uint_as_float(w.y << 16), __uint_as_float(w.y & 0xffff0000u)}; }
                }
                float s = 0.f;
#pragma unroll
                for (int bj = 0; bj < 2; ++bj)
#pragma unroll
                    for (int n = 0; n < 2; ++n) { acc[ai][bj][m][n] = rv[bj][n] * 1.4142135623730951f + acc[ai][bj][m][n]; const f32x4 x = acc[ai][bj][m][n]; s += (x[0] + x[1]) + (x[2] + x[3]); }
                s += __shfl_xor(s, 16); s += __shfl_xor(s, 32);
                const float mw = s * (1.0f / 64.0f); float q = 0.f;
#pragma unroll
                for (int bj = 0; bj < 2; ++bj)
#pragma unroll
                    for (int n = 0; n < 2; ++n) { const f32x4 d = acc[ai][bj][m][n] - mw; q += (d[0] * d[0] + d[1] * d[1]) + (d[2] * d[2] + d[3] * d[3]); }
                q += __shfl_xor(q, 16); q += __shfl_xor(q, 32);
                if (fq == 0) Pt[(ai * HALF + wr * 64 + m * 16 + fr) * 4 + wc] = (f32x2v){mw, q};
            }
        asm volatile("s_waitcnt lgkmcnt(0)" ::: "memory"); __builtin_amdgcn_s_barrier(); asm volatile("" ::: "memory");
        const int row = wid * 32 + (lane & 31);
        unsigned* cw = cnt + 64 * u.pm;
        if (lane < 32) {
            const f32x2v a = Pt[row * 4 + 0], b2 = Pt[row * 4 + 1], c = Pt[row * 4 + 2], d = Pt[row * 4 + 3];
            const float mt = (a.x + b2.x + c.x + d.x) * 0.25f;
            const float da = a.x - mt, db = b2.x - mt, dc = c.x - mt, dd = d.x - mt;
            const float m2 = (a.y + b2.y) + (c.y + d.y) + 64.0f * ((da * da + db * db) + (dc * dc + dd * dd));
            __hip_atomic_store(xbuf + ((size_t)(u.pm * BM + row) * 4 + u.pn), ((unsigned long long)__float_as_uint(m2) << 32) | __float_as_uint(mt), __ATOMIC_RELAXED, __HIP_MEMORY_SCOPE_AGENT);
        }
        asm volatile("s_waitcnt vmcnt(0)" ::: "memory");
        if (lane == 0) __hip_atomic_fetch_add(cw, 1u, __ATOMIC_RELAXED, __HIP_MEMORY_SCOPE_AGENT);
        if (wid == 0) {
            unsigned sp = 0;
            while ((unsigned)__builtin_amdgcn_readfirstlane(__hip_atomic_load(cw, __ATOMIC_RELAXED, __HIP_MEMORY_SCOPE_AGENT)) < 32u) { __builtin_amdgcn_s_sleep(2); if (++sp > (1u << 22)) break; }
            __builtin_amdgcn_fence(__ATOMIC_ACQUIRE, "agent");
        }
        asm volatile("s_waitcnt vmcnt(0) lgkmcnt(0)" ::: "memory"); __builtin_amdgcn_s_barrier(); asm volatile("" ::: "memory");
        if (lane < 32) {
            const unsigned long long* slot = xbuf + (size_t)(u.pm * BM + row) * 4; float mt[4], m2[4]; float ms = 0.f;
#pragma unroll
            for (int t = 0; t < 4; ++t) { const unsigned long long w = __hip_atomic_load(slot + t, __ATOMIC_RELAXED, __HIP_MEMORY_SCOPE_AGENT); mt[t] = __uint_as_float((unsigned)w); m2[t] = __uint_as_float((unsigned)(w >> 32)); ms += mt[t]; }
            const float mean = ms * 0.25f; float q = 0.f;
#pragma unroll
            for (int t = 0; t < 4; ++t) { const float dm = mt[t] - mean; q += m2[t] + 256.0f * dm * dm; }
            St[row] = (f32x2v){mean, 1.0f / sqrtf(q * (1.0f / 1024.0f) + 1e-5f)};
        }
        asm volatile("s_waitcnt lgkmcnt(0)" ::: "memory"); __builtin_amdgcn_s_barrier(); asm volatile("" ::: "memory");
        if constexpr (L == 1) {
#pragma unroll
            for (int bj = 0; bj < 2; ++bj)
#pragma unroll
                for (int n = 0; n < 2; ++n) {
                    const f32x4 gv = *(const f32x4*)(gam + col0 + bj * HALF + n * 16), bv = *(const f32x4*)(bet + col0 + bj * HALF + n * 16);
#pragma unroll
                    for (int ai = 0; ai < 2; ++ai)
#pragma unroll
                        for (int m = 0; m < 4; ++m) { const int r = ai * HALF + wr * 64 + m * 16 + fr; const f32x2v sr = St[r]; const size_t off = (size_t)(u.pm * BM + r) * 1024 + col0 + bj * HALF + n * 16;
                            *(f32x4*)(out + off) = (acc[ai][bj][m][n] - sr.x) * sr.y * gv + bv; }
                }
        } else {
#pragma unroll
            for (int bj = 0; bj < 2; ++bj)
#pragma unroll
                for (int n = 0; n < 2; ++n) {
                    const f32x4 gv = *(const f32x4*)(gam + col0 + bj * HALF + n * 16), bv = *(const f32x4*)(bet + col0 + bj * HALF + n * 16);
#pragma unroll
                    for (int ai = 0; ai < 2; ++ai)
#pragma unroll
                        for (int m = 0; m < 4; ++m) { const int r = ai * HALF + wr * 64 + m * 16 + fr; const f32x2v sr = St[r]; const size_t off = (size_t)(u.pm * BM + r) * 1024 + col0 + bj * HALF + n * 16;
                            const f32x4 o = (acc[ai][bj][m][n] - sr.x) * sr.y * gv + bv;
                            uint2 w; w.x = cvtpk_s(o[0], o[1]); w.y = cvtpk_s(o[2], o[3]); *(uint2*)(xb + off) = w; }
                }
        }
    }
};

struct EpiGluNorm {
    static constexpr bool PERM = true, AFTER_DRAIN = false;
    bf16_t* Yo; const bf16_t* ybp; const bf16_t* proj; const float* bias; const float* gain; PG8_LAS unsigned char* tbl;
    __device__ __forceinline__ void operator()(f32x4 (&acc)[2][2][4][2], const Unit& u, int wr, int wc, int fr_, int fq_) const {
        const int lane = lane_id_opaque(), fr = lane & 15, fq = lane >> 4; (void)fr_; (void)fq_;
        bf16_t* Yo_ = launder_g(Yo); const bf16_t* ybp_ = launder_g(ybp); const bf16_t* proj_ = launder_g(proj); const float* bias_ = launder_g(bias); const float* gain_ = launder_g(gain);
        const int row0 = u.pm * BM + wr * 64 + fr, cw = wc * 32 + 8 * fq;
        PG8_LAS float* Pt = (PG8_LAS float*)tbl;
        u32x4 avb[2][2][4];
#pragma unroll
        for (int bj = 0; bj < 2; ++bj)
#pragma unroll
            for (int ai = 0; ai < 2; ++ai)
#pragma unroll
                for (int m = 0; m < 4; ++m) avb[bj][ai][m] = *(const u32x4*)(ybp_ + (size_t)(row0 + ai * HALF + m * 16) * 256 + cw + bj * HALF);
        __builtin_amdgcn_sched_barrier(0);
#pragma unroll
        for (int bj = 0; bj < 2; ++bj) {
            const int c = cw + bj * HALF;
            const f32x4 b0 = *(const f32x4*)(bias_ + c), b1 = *(const f32x4*)(bias_ + c + 4);
#pragma unroll
            for (int ai = 0; ai < 2; ++ai)
#pragma unroll
                for (int m = 0; m < 4; ++m) {
                    const u32x4 av = avb[bj][ai][m];
                    f32x4 v0 = acc[ai][bj][m][0] + b0, v1 = acc[ai][bj][m][1] + b1; float ss = 0.f;
#pragma unroll
                    for (int j = 0; j < 4; ++j) { const float alo = __uint_as_float(av[j] << 16), ahi = __uint_as_float(av[j] & 0xffff0000u);
                        if (j < 2) { const float d0 = 1.0f + __expf(-v0[2 * j]), d1 = 1.0f + __expf(-v0[2 * j + 1]), R = __builtin_amdgcn_rcpf(d0 * d1); const float s0 = alo * (d1 * R), s1 = ahi * (d0 * R); v0[2 * j] = s0; v0[2 * j + 1] = s1; ss += s0 * s0 + s1 * s1; }
                        else { const float d0 = 1.0f + __expf(-v1[2 * j - 4]), d1 = 1.0f + __expf(-v1[2 * j - 3]), R = __builtin_amdgcn_rcpf(d0 * d1); const float s0 = alo * (d1 * R), s1 = ahi * (d0 * R); v1[2 * j - 4] = s0; v1[2 * j - 3] = s1; ss += s0 * s0 + s1 * s1; } }
                    acc[ai][bj][m][0] = v0; acc[ai][bj][m][1] = v1;
                    ss += __shfl_xor(ss, 16); ss += __shfl_xor(ss, 32);
                    if (fq == 0) Pt[((ai * HALF + wr * 64 + m * 16 + fr) * 2 + bj) * 4 + wc] = ss;
                }
        }
#pragma unroll
        for (int bj = 0; bj < 2; ++bj)
#pragma unroll
            for (int ai = 0; ai < 2; ++ai)
#pragma unroll
                for (int m = 0; m < 4; ++m) avb[bj][ai][m] = *(const u32x4*)(proj_ + (size_t)(row0 + ai * HALF + m * 16) * 3584 + 2560 + 256 + cw + bj * HALF);
        __builtin_amdgcn_sched_barrier(0);
        asm volatile("s_waitcnt lgkmcnt(0)" ::: "memory"); __builtin_amdgcn_s_barrier(); asm volatile("" ::: "memory");
#pragma unroll
        for (int bj = 0; bj < 2; ++bj) {
            const int c = cw + bj * HALF;
            const f32x4 g0 = *(const f32x4*)(gain_ + 256 + c), g1 = *(const f32x4*)(gain_ + 256 + c + 4);
#pragma unroll
            for (int ai = 0; ai < 2; ++ai)
#pragma unroll
                for (int m = 0; m < 4; ++m) {
                    const int rl = ai * HALF + wr * 64 + m * 16 + fr; const size_t r = (size_t)(u.pm * BM + rl);
                    const float rs = rsqrtf((Pt[(rl * 2 + bj) * 4 + (wc & 2)] + Pt[(rl * 2 + bj) * 4 + (wc | 1)]) * (1.0f / 64.0f) + 1e-6f);
                    const u32x4 gv = avb[bj][ai][m];
                    const f32x4 v0 = acc[ai][bj][m][0] * rs * g0, v1 = acc[ai][bj][m][1] * rs * g1;
                    float o[8];
#pragma unroll
                    for (int j = 0; j < 4; ++j) { const float tl = __uint_as_float(gv[j] << 16), th = __uint_as_float(gv[j] & 0xffff0000u);
                        const float x0 = (j < 2) ? v0[2 * j] : v1[2 * j - 4], x1 = (j < 2) ? v0[2 * j + 1] : v1[2 * j - 3];
                        const float dl = 1.0f + __expf(-tl), dh = 1.0f + __expf(-th), R = __builtin_amdgcn_rcpf(dl * dh);
                        o[2 * j] = x0 * (tl * (dh * R)); o[2 * j + 1] = x1 * (th * (dl * R)); }
                    u32x4 w; w.x = cvtpk_s(o[0], o[1]); w.y = cvtpk_s(o[2], o[3]); w.z = cvtpk_s(o[4], o[5]); w.w = cvtpk_s(o[6], o[7]);
                    *(u32x4*)(Yo_ + r * 1024 + 256 + c) = w;
                }
        }
        asm volatile("s_waitcnt lgkmcnt(0)" ::: "memory"); __builtin_amdgcn_s_barrier(); asm volatile("" ::: "memory");
    }
};

template <class Epi, class Sched, bool ALIGN_EPI = false, bool SP2 = false>
__device__ __forceinline__ void gemm_phase(PG8_LAS unsigned char* lds, const Gemm g, const Sched& S, const Epi& E, const int tid_in  ) {
    const int tid = tid_in, wid = __builtin_amdgcn_readfirstlane(tid >> 6), lane = tid & 63, wr = wid >> 2, wc = wid & 3, fr = lane & 15, fq = lane >> 4;
    const int K = g.K, nt = K / BK;
    unsigned voffA[2], voffB[2];
#pragma unroll
    for (int i = 0; i < 2; ++i) { int R, C; stage_rc(tid * 16 + i * 8192, R, C); const int Rb = Epi::PERM ? ((R & ~31) + perm32(R & 31)) : R;
        voffA[i] = (unsigned)(R * K + C) * 2u; voffB[i] = (unsigned)(Rb * K + C) * 2u; }
    const size_t kstep = (size_t)(BK * 2);
    const size_t hstep = (size_t)HALF * K * 2;
    const size_t tstep = 2 * hstep;
    const unsigned ldsw = (unsigned)wid * 1024u;
    const int aoff = lds_byte(wr * 64 + fr, fq * 8), boff = lds_byte(wc * 32 + fr, fq * 8);
#define PG8_SA(b, h) (((b) * 2 + (h)) * HTB)
#define PG8_SB(b, h) ((4 + (b) * 2 + (h)) * HTB)
#define PG8_STAGE(bufoff, gbase, voff) do { _Pragma("unroll") for (int _i = 0; _i < 2; ++_i) \
        __builtin_amdgcn_global_load_lds((const unsigned*)((const char*)(gbase) + (voff)[_i]), (PG8_LAS unsigned*)(lds + (bufoff) + ldsw + _i * 8192), 16, 0, 0); } while (0)
#define PG8_LDA(dst, b, h) do { _Pragma("unroll") for (int m = 0; m < 4; ++m) _Pragma("unroll") for (int k = 0; k < 2; ++k) dst[m][k] = *(const PG8_LAS bf16x8*)(lds + PG8_SA(b, h) + aoff + m * 2048 + k * 1024); } while (0)
#define PG8_LDB(dst, b, h) do { _Pragma("unroll") for (int n = 0; n < 2; ++n) _Pragma("unroll") for (int k = 0; k < 2; ++k) dst[n][k] = *(const PG8_LAS bf16x8*)(lds + PG8_SB(b, h) + boff + n * 2048 + k * 1024); } while (0)
#define PG8_MMA(ai, bj, At, Bt) do { __builtin_amdgcn_s_setprio(1); _Pragma("unroll") for (int m = 0; m < 4; ++m) _Pragma("unroll") for (int n = 0; n < 2; ++n) _Pragma("unroll") for (int k = 0; k < 2; ++k) \
        acc[ai][bj][m][n] = __builtin_amdgcn_mfma_f32_16x16x32_bf16(Bt[n][k], At[m][k], acc[ai][bj][m][n], 0, 0, 0); __builtin_amdgcn_s_setprio(0); } while (0)
#define PG8_WAIT_V(n) asm volatile("s_waitcnt vmcnt(" #n ")" ::: "memory")
#define PG8_WAIT_L(n) asm volatile("s_waitcnt lgkmcnt(" #n ")" ::: "memory")
#define PG8_BAR __builtin_amdgcn_s_barrier()
#define PG8_SCHED __builtin_amdgcn_sched_barrier(0)
    Unit cur, nxt; int ui = 0;
    if (!S.next(0, cur)) return;
    f32x4 acc[2][2][4][2];
#pragma unroll
    for (int a = 0; a < 2; ++a)
#pragma unroll
        for (int b = 0; b < 2; ++b)
#pragma unroll
            for (int m = 0; m < 4; ++m)
#pragma unroll
                for (int n = 0; n < 2; ++n) acc[a][b][m][n] = (f32x4){0.f, 0.f, 0.f, 0.f};
    bf16x8 At[4][2], B0[2][2], B1[2][2];
    const char* cA = (const char*)g.A + (size_t)cur.pm * tstep; const char* cB = (const char*)g.Bt + (size_t)cur.pn * tstep;
    S.a_ready(cur);
    if constexpr (SP2) {
        PG8_STAGE(PG8_SB(0, 0), cB, voffB); PG8_STAGE(PG8_SB(0, 1), cB + hstep, voffB); PG8_STAGE(PG8_SA(0, 0), cA, voffA); PG8_STAGE(PG8_SA(0, 1), cA + hstep, voffA);
        if (wr == 1) PG8_BAR;
        PG8_WAIT_V(2); PG8_BAR;
        PG8_STAGE(PG8_SB(1, 0), cB + kstep, voffB); PG8_STAGE(PG8_SA(1, 0), cA + kstep, voffA); PG8_STAGE(PG8_SB(1, 1), cB + hstep + kstep, voffB);
        PG8_WAIT_V(6); PG8_BAR;
    } else {
        PG8_STAGE(PG8_SB(0, 0), cB, voffB); PG8_STAGE(PG8_SA(0, 0), cA, voffA); PG8_STAGE(PG8_SB(0, 1), cB + hstep, voffB); PG8_STAGE(PG8_SA(0, 1), cA + hstep, voffA);
        if (wr == 1) PG8_BAR;
        PG8_WAIT_V(4); PG8_BAR;
        PG8_STAGE(PG8_SB(1, 0), cB + kstep, voffB); PG8_STAGE(PG8_SA(1, 0), cA + kstep, voffA); PG8_STAGE(PG8_SB(1, 1), cB + hstep + kstep, voffB);
        PG8_WAIT_V(6); PG8_BAR;
    }
    for (;;) {
        const bool has_next = S.next(ui + 1, nxt);
        const char* nA = has_next ? (const char*)g.A + (size_t)nxt.pm * tstep : cA; const char* nB = has_next ? (const char*)g.Bt + (size_t)nxt.pn * tstep : cB;
        for (int t = 0; t < nt; t += 2) {
            const bool last = (t == nt - 2);
            const char* a1 = cA + (size_t)(t + 1) * kstep;
            const char* a2 = last ? nA : cA + (size_t)(t + 2) * kstep; const char* b2 = last ? nB : cB + (size_t)(t + 2) * kstep;
            const char* a3 = a2 + kstep; const char* b3 = b2 + kstep;
            if (last && has_next) S.a_ready(nxt);
            if constexpr (SP2) {
            PG8_LDB(B0, 0, 0); PG8_LDB(B1, 0, 1); PG8_SCHED; PG8_LDA(At, 0, 0); PG8_STAGE(PG8_SA(1, 1), a1 + hstep, voffA);
            PG8_WAIT_V(8); PG8_WAIT_L(0); PG8_BAR; PG8_MMA(0, 0, At, B0); PG8_MMA(0, 1, At, B1); PG8_BAR; PG8_SCHED;
            PG8_LDA(At, 0, 1); PG8_STAGE(PG8_SB(0, 0), b2, voffB); PG8_STAGE(PG8_SB(0, 1), b2 + hstep, voffB); PG8_STAGE(PG8_SA(0, 0), a2, voffA);
            PG8_WAIT_V(8); PG8_WAIT_L(0); PG8_BAR; PG8_MMA(1, 0, At, B0); PG8_MMA(1, 1, At, B1); PG8_BAR; PG8_SCHED;
            PG8_LDB(B0, 1, 0); PG8_LDB(B1, 1, 1); PG8_SCHED; PG8_LDA(At, 1, 0); PG8_STAGE(PG8_SA(0, 1), a2 + hstep, voffA);
            PG8_WAIT_V(8); PG8_WAIT_L(0); PG8_BAR; PG8_MMA(0, 0, At, B0); PG8_MMA(0, 1, At, B1); PG8_BAR; PG8_SCHED;
            PG8_LDA(At, 1, 1); PG8_STAGE(PG8_SB(1, 0), b3, voffB); PG8_STAGE(PG8_SB(1, 1), b3 + hstep, voffB); PG8_STAGE(PG8_SA(1, 0), a3, voffA);
            PG8_WAIT_V(8); PG8_WAIT_L(0); PG8_BAR; PG8_MMA(1, 0, At, B0); PG8_MMA(1, 1, At, B1); PG8_BAR; PG8_SCHED;
            } else {
            PG8_LDB(B0, 0, 0); PG8_SCHED; PG8_LDA(At, 0, 0); PG8_STAGE(PG8_SA(1, 1), a1 + hstep, voffA);
            PG8_WAIT_L(8); PG8_BAR; PG8_WAIT_L(0); PG8_MMA(0, 0, At, B0); PG8_BAR; PG8_SCHED;
            PG8_LDB(B1, 0, 1); PG8_STAGE(PG8_SB(0, 0), b2, voffB);
            PG8_BAR; PG8_WAIT_L(0); PG8_MMA(0, 1, At, B1); PG8_BAR;
            PG8_LDA(At, 0, 1); PG8_STAGE(PG8_SA(0, 0), a2, voffA);
            PG8_BAR; PG8_WAIT_L(0); PG8_MMA(1, 0, At, B0); PG8_BAR; PG8_SCHED;
            PG8_STAGE(PG8_SB(0, 1), b2 + hstep, voffB);
            PG8_WAIT_V(6); PG8_BAR; PG8_MMA(1, 1, At, B1); PG8_BAR;
            PG8_LDB(B0, 1, 0); PG8_SCHED; PG8_LDA(At, 1, 0); PG8_STAGE(PG8_SA(0, 1), a2 + hstep, voffA);
            PG8_WAIT_L(8); PG8_BAR; PG8_WAIT_L(0); PG8_MMA(0, 0, At, B0); PG8_BAR; PG8_SCHED;
            PG8_LDB(B1, 1, 1); PG8_STAGE(PG8_SB(1, 0), b3, voffB);
            PG8_BAR; PG8_WAIT_L(0); PG8_MMA(0, 1, At, B1); PG8_BAR;
            PG8_LDA(At, 1, 1); PG8_STAGE(PG8_SA(1, 0), a3, voffA);
            PG8_BAR; PG8_WAIT_L(0); PG8_MMA(1, 0, At, B0); PG8_BAR; PG8_SCHED;
            PG8_STAGE(PG8_SB(1, 1), b3 + hstep, voffB);
            PG8_WAIT_V(6); PG8_BAR; PG8_MMA(1, 1, At, B1); PG8_BAR;
            }
        }
        if constexpr (ALIGN_EPI) { if (wr == 0) PG8_BAR; }
        if constexpr (!Epi::AFTER_DRAIN) { E(acc, cur, wr, wc, fr, fq); S.done(cur); }
        if (!has_next) break;
#pragma unroll
        for (int a = 0; a < 2; ++a)
#pragma unroll
            for (int b = 0; b < 2; ++b)
#pragma unroll
                for (int m = 0; m < 4; ++m)
#pragma unroll
                    for (int n = 0; n < 2; ++n) acc[a][b][m][n] = (f32x4){0.f, 0.f, 0.f, 0.f};
        cur = nxt; cA = nA; cB = nB; ++ui;
        if constexpr (ALIGN_EPI) { if (wr == 1) PG8_BAR; }
    }
    PG8_WAIT_V(0);
    if constexpr (!ALIGN_EPI) { if (wr == 0) PG8_BAR; }
    PG8_BAR;
    if constexpr (Epi::AFTER_DRAIN) { E.fused(acc, cur, wr, wc, fr, fq, lds, wid, lane); S.done(cur); }
#undef PG8_SA
#undef PG8_SB
#undef PG8_STAGE
#undef PG8_LDA
#undef PG8_LDB
#undef PG8_MMA
#undef PG8_WAIT_V
#undef PG8_WAIT_L
#undef PG8_BAR
#undef PG8_SCHED
}
}
#define XB_TMO      128
#define XB_XCNT(j)  (256  + 64 * (j))
#define XB_XSUB(j)  (1280 + 64 * (j))
#define XB_XGEN(j)  (2304 + 64 * (j))
#define XB_TOP      3328
#define XB_TOPGEN   3392
#define XCD_BAR_WORDS 3456
#define XB_SPIN_CAP (1u << 18)

__device__ __forceinline__ unsigned xb_ld(unsigned* p)              { return __hip_atomic_load((__attribute__((address_space(1))) unsigned*)p, __ATOMIC_RELAXED, __HIP_MEMORY_SCOPE_AGENT); }
__device__ __forceinline__ unsigned xb_add(unsigned* p, unsigned v) { return __hip_atomic_fetch_add((__attribute__((address_space(1))) unsigned*)p, v, __ATOMIC_RELAXED, __HIP_MEMORY_SCOPE_AGENT); }
__device__ __forceinline__ unsigned xb_xcc_id() { return (unsigned)__builtin_amdgcn_s_getreg((3 << 11) | 20) & 0xFu; }
#define XB_SPIN(cond, bar) do { unsigned _sp = 0; while (cond) { __builtin_amdgcn_s_sleep(1); \
    if ((++_sp & 255u) == 0u) { if (xb_ld(&(bar)[XB_TMO])) break; if (_sp > XB_SPIN_CAP) { atomicAdd(&(bar)[XB_TMO], 1u); break; } } } } while (0)

struct XcdBarrier {
    unsigned* bar; unsigned x;
    volatile LAS unsigned* st;
};

__device__ __forceinline__ XcdBarrier xcd_barrier_post(unsigned* bar, volatile LAS unsigned* st) {
    XcdBarrier b; b.bar = bar; b.x = xb_xcc_id(); b.st = st;
    if (threadIdx.x == 0) (void)xb_add(&bar[XB_XCNT(b.x)], 1u);
    return b;
}
__device__ __forceinline__ void xcd_barrier_complete(unsigned* bar, unsigned x, unsigned& nloc, unsigned& nx) {
    const unsigned G = gridDim.x * gridDim.y * gridDim.z;
    unsigned sum, cnt, mine, sp = 0u;
    for (;;) {
        sum = 0u; cnt = 0u; mine = 0u;
#pragma unroll
        for (unsigned j = 0; j < 16; ++j) { const unsigned c = xb_ld(&bar[XB_XCNT(j)]); sum += c; cnt += (c > 0u) ? 1u : 0u; mine = (j == x) ? c : mine; }
        if (sum == G) break;
        __builtin_amdgcn_s_sleep(1);
        if ((++sp & 255u) == 0u) { if (xb_ld(&bar[XB_TMO])) break; if (sp > XB_SPIN_CAP) { atomicAdd(&bar[XB_TMO], 1u); break; } }
    }
    nloc = mine > 0u ? mine : 1u; nx = cnt > 0u ? cnt : 1u;
}

__device__ __forceinline__ void xcd_barrier(const XcdBarrier& b) {
    asm volatile("s_waitcnt vmcnt(0)" ::: "memory");
    __syncthreads();
    if (threadIdx.x == 0) {
        unsigned* bar = b.bar;
        __builtin_amdgcn_s_waitcnt(0);
        unsigned nloc = b.st[0], nx = b.st[1];
        if (nloc == 0u) { xcd_barrier_complete(bar, b.x, nloc, nx); b.st[0] = nloc; b.st[1] = nx; }
        const unsigned old = xb_add(&bar[XB_XSUB(b.x)], 1u);
        const unsigned gen = old / nloc;
        if (old + 1u == (gen + 1u) * nloc) {
            __builtin_amdgcn_fence(__ATOMIC_RELEASE, "agent");
            asm volatile("s_waitcnt vmcnt(0)" ::: "memory");
            const unsigned og = xb_add(&bar[XB_TOP], 1u);
            const unsigned tg = og / nx;
            if (og + 1u == (tg + 1u) * nx) xb_add(&bar[XB_TOPGEN], 1u);
            else XB_SPIN(xb_ld(&bar[XB_TOPGEN]) == tg, bar);
            __builtin_amdgcn_fence(__ATOMIC_ACQUIRE, "agent");
            xb_add(&bar[XB_XGEN(b.x)], 1u);
            asm volatile("s_waitcnt vmcnt(0)" ::: "memory");
        } else {
            XB_SPIN(xb_ld(&bar[XB_XGEN(b.x)]) == gen, bar);
            __builtin_amdgcn_fence(__ATOMIC_ACQUIRE, "agent");
            asm volatile("s_waitcnt vmcnt(0)" ::: "memory");
        }
    }
    __syncthreads();
}
namespace fa {
typedef short bf16x8 __attribute__((ext_vector_type(8)));
typedef float f32x16 __attribute__((ext_vector_type(16)));
typedef short v4i16_t __attribute__((ext_vector_type(4)));
constexpr int KT_OFF = 0, VT_OFF = 8192, LUT_OFF = 16384, OST_OFF = 24576, FA_LDS = OST_OFF + 8 * 4096;
__device__ __forceinline__ int crow(int r, int hi) { return (r & 3) + 8 * (r >> 2) + 4 * hi; }
__device__ __forceinline__ unsigned cvtpk(float lo, float hi) { return cvtpk_s(lo, hi); }
template <int B> __device__ __forceinline__ bf16x8 pack8(const f32x16& p) {
    u32x4 w; w.x = cvtpk(p[B], p[B + 1]); w.y = cvtpk(p[B + 2], p[B + 3]); w.z = cvtpk(p[B + 4], p[B + 5]); w.w = cvtpk(p[B + 6], p[B + 7]);
    return __builtin_bit_cast(bf16x8, w);
}
__device__ __forceinline__ v4i16_t trd(LAS const unsigned char* p) { return __builtin_amdgcn_ds_read_tr16_b64_v4i16((LAS v4i16_t*)p); }
__device__ __forceinline__ void stage_tile(LAS unsigned char* lds, int tid, const bf16_t* krow, const bf16_t* vrow) {
    const int row = tid >> 3, ch = tid & 7;
    u32x4 kv = {0u, 0u, 0u, 0u}, vv = {0u, 0u, 0u, 0u};
    if (krow) { kv = *(const u32x4*)(krow + ch * 8); vv = *(const u32x4*)(vrow + ch * 8); }
    *(LAS u32x4*)(lds + KT_OFF + row * 128 + ((ch ^ (row & 7)) * 16)) = kv;
    *(LAS u32x4*)(lds + VT_OFF + row * 128 + ch * 16) = vv;
}
template <class Fn> __device__ __forceinline__ void tile_step(LAS const unsigned char* lds, const bf16x8 (&qf)[4], f32x16& o0, f32x16& o1, float& m, float& l, int lane, const Fn& fn) {
    const int r32 = lane & 31, hi = lane >> 5;
    f32x16 p0, p1;
#pragma unroll
    for (int r = 0; r < 16; ++r) { p0[r] = 0.f; p1[r] = 0.f; }
#pragma unroll
    for (int s = 0; s < 4; ++s) {
        const int ch = ((2 * s + hi) ^ (r32 & 7)) * 16;
        const bf16x8 k0 = *(const LAS bf16x8*)(lds + KT_OFF + r32 * 128 + ch);
        const bf16x8 k1 = *(const LAS bf16x8*)(lds + KT_OFF + (32 + r32) * 128 + ch);
        p0 = __builtin_amdgcn_mfma_f32_32x32x16_bf16(k0, qf[s], p0, 0, 0, 0);
        p1 = __builtin_amdgcn_mfma_f32_32x32x16_bf16(k1, qf[s], p1, 0, 0, 0);
    }
    float mx = NEGF;
#pragma unroll
    for (int r = 0; r < 16; ++r) { p0[r] = fn(crow(r, hi), p0[r]); p1[r] = fn(32 + crow(r, hi), p1[r]); mx = fmaxf(mx, fmaxf(p0[r], p1[r])); }
    mx = fmaxf(mx, __shfl_xor(mx, 32));
    const float mn = fmaxf(m, mx), alpha = __expf(m - mn);
    m = mn;
    float ps = 0.f;
#pragma unroll
    for (int r = 0; r < 16; ++r) { p0[r] = __expf(p0[r] - mn); p1[r] = __expf(p1[r] - mn); ps += p0[r] + p1[r]; }
    l = l * alpha + ps;
#pragma unroll
    for (int r = 0; r < 16; ++r) { o0[r] *= alpha; o1[r] *= alpha; }
    const int q4 = (lane & 15) >> 2, p4 = lane & 3, dgrp = (lane >> 4) & 1;
    const int vb = VT_OFF + (4 * hi + q4) * 128 + (16 * dgrp + 4 * p4) * 2;
#define FA_PV(P, KH, S2) do { const bf16x8 pb = pack8<8 * (S2)>(P); \
        _Pragma("unroll") for (int blk = 0; blk < 2; ++blk) { const int a = vb + (32 * (KH) + 16 * (S2)) * 128 + blk * 64; \
            const v4i16_t lo = trd(lds + a), hh = trd(lds + a + 8 * 128); \
            const bf16x8 va = {lo[0], lo[1], lo[2], lo[3], hh[0], hh[1], hh[2], hh[3]}; \
            if (blk == 0) o0 = __builtin_amdgcn_mfma_f32_32x32x16_bf16(va, pb, o0, 0, 0, 0); else o1 = __builtin_amdgcn_mfma_f32_32x32x16_bf16(va, pb, o1, 0, 0, 0); } } while (0)
    FA_PV(p0, 0, 0); FA_PV(p0, 0, 1); FA_PV(p1, 1, 0); FA_PV(p1, 1, 1);
#undef FA_PV
}
template <class RowFn> __device__ __forceinline__ float store_o(LAS unsigned char* lds, int wave, int lane, const f32x16& o0, const f32x16& o1, float l, const RowFn& orow) {
    const int r32 = lane & 31, hi = lane >> 5;
    l += __shfl_xor(l, 32);
    const float inv = 1.0f / l;
    LAS bf16_t* stg = (LAS bf16_t*)(lds + OST_OFF + wave * 4096);
#pragma unroll
    for (int r = 0; r < 16; ++r) { const int d = crow(r, hi); stg[r32 * 64 + d] = f2bf(o0[r] * inv); stg[r32 * 64 + 32 + d] = f2bf(o1[r] * inv); }
    asm volatile("s_waitcnt lgkmcnt(0)" ::: "memory");
#pragma unroll
    for (int i = 0; i < 4; ++i) { const int row = i * 8 + (lane >> 3), ch = lane & 7; const u32x4 v = *(const LAS u32x4*)(stg + row * 64 + ch * 8); *(u32x4*)(orow(row) + ch * 8) = v; }
    asm volatile("s_waitcnt lgkmcnt(0)" ::: "memory");
    return l;
}
}

namespace fa2 {
using fa::bf16x8; using fa::f32x16; using fa::v4i16_t; using fa::crow; using fa::pack8; using fa::trd;
constexpr float C2LOG = 0.125f * 1.4426950408889634f;
struct KCh { int c0, c1, c2, c3; };
__device__ __forceinline__ KCh make_kch(int lane) { const int r32 = lane & 31, hi = lane >> 5, x = r32 & 7; return KCh{((0 + hi) ^ x) * 16, ((2 + hi) ^ x) * 16, ((4 + hi) ^ x) * 16, ((6 + hi) ^ x) * 16}; }
template <class Fn> __device__ __forceinline__ void step64(LAS const unsigned char* lds, int koff, int voff, const bf16x8 (&qf)[4], f32x16& o0, f32x16& o1, float& m, float& l, int lane, const Fn& fn, const KCh& kc4) {
    const int r32 = lane & 31, hi = lane >> 5;
    f32x16 p0, p1;
    const f32x16 zero16 = {0.f, 0.f, 0.f, 0.f, 0.f, 0.f, 0.f, 0.f, 0.f, 0.f, 0.f, 0.f, 0.f, 0.f, 0.f, 0.f};
    LAS const unsigned char* kp = lds + koff + r32 * 128;
#pragma unroll
    for (int s = 0; s < 4; ++s) {
        const int ch = s == 0 ? kc4.c0 : s == 1 ? kc4.c1 : s == 2 ? kc4.c2 : kc4.c3;
        const bf16x8 k0 = *(const LAS bf16x8*)(kp + ch);
        const bf16x8 k1 = *(const LAS bf16x8*)(kp + ch + 32 * 128);
        p0 = __builtin_amdgcn_mfma_f32_32x32x16_bf16(k0, qf[s], s == 0 ? zero16 : p0, 0, 0, 0);
        p1 = __builtin_amdgcn_mfma_f32_32x32x16_bf16(k1, qf[s], s == 0 ? zero16 : p1, 0, 0, 0);
    }
    float mx = NEGF;
#pragma unroll
    for (int r = 0; r < 16; ++r) { const int kc = (r & 3) + 8 * (r >> 2); p0[r] = fn(kc, p0[r]); p1[r] = fn(32 + kc, p1[r]); mx = fmaxf(mx, fmaxf(p0[r], p1[r])); }
    mx = fmaxf(mx, __shfl_xor(mx, 32));
    if (!__all(mx - m <= 8.0f)) { const float mn = fmaxf(m, mx), alpha = __builtin_amdgcn_exp2f(m - mn); m = mn; l *= alpha; o0 *= alpha; o1 *= alpha; }
    float ps = 0.f;
#pragma unroll
    for (int r = 0; r < 16; ++r) { p0[r] = __builtin_amdgcn_exp2f(p0[r] - m); p1[r] = __builtin_amdgcn_exp2f(p1[r] - m); ps += p0[r] + p1[r]; }
    l += ps;
    const int q4 = (lane & 15) >> 2, p4 = lane & 3, dgrp = (lane >> 4) & 1;
    LAS const unsigned char* vp = lds + voff + (4 * hi + q4) * 128 + (16 * dgrp + 4 * p4) * 2;
#define FA_PV(P, KH, S2) do { const bf16x8 pb = pack8<8 * (S2)>(P); \
        _Pragma("unroll") for (int blk = 0; blk < 2; ++blk) { \
            const v4i16_t lo = trd(vp + ((32 * (KH) + 16 * (S2)) * 128 + blk * 64)), hh = trd(vp + ((32 * (KH) + 16 * (S2) + 8) * 128 + blk * 64)); \
            const bf16x8 va = {lo[0], lo[1], lo[2], lo[3], hh[0], hh[1], hh[2], hh[3]}; \
            if (blk == 0) o0 = __builtin_amdgcn_mfma_f32_32x32x16_bf16(va, pb, o0, 0, 0, 0); else o1 = __builtin_amdgcn_mfma_f32_32x32x16_bf16(va, pb, o1, 0, 0, 0); } } while (0)
    FA_PV(p0, 0, 0); FA_PV(p0, 0, 1); FA_PV(p1, 1, 0); FA_PV(p1, 1, 1);
#undef FA_PV
}
__device__ __forceinline__ void qk64(LAS const unsigned char* lds, int koff, const bf16x8 (&qf)[4], int lane, const KCh& kc4, f32x16& p0, f32x16& p1) {
    const int r32 = lane & 31;
    const f32x16 zero16 = {0.f, 0.f, 0.f, 0.f, 0.f, 0.f, 0.f, 0.f, 0.f, 0.f, 0.f, 0.f, 0.f, 0.f, 0.f, 0.f};
    LAS const unsigned char* kp = lds + koff + r32 * 128;
#pragma unroll
    for (int s = 0; s < 4; ++s) {
        const int ch = s == 0 ? kc4.c0 : s == 1 ? kc4.c1 : s == 2 ? kc4.c2 : kc4.c3;
        const bf16x8 k0 = *(const LAS bf16x8*)(kp + ch);
        const bf16x8 k1 = *(const LAS bf16x8*)(kp + ch + 32 * 128);
        p0 = __builtin_amdgcn_mfma_f32_32x32x16_bf16(k0, qf[s], s == 0 ? zero16 : p0, 0, 0, 0);
        p1 = __builtin_amdgcn_mfma_f32_32x32x16_bf16(k1, qf[s], s == 0 ? zero16 : p1, 0, 0, 0);
    }
}
template <class Fn> __device__ __forceinline__ void smpv64(LAS const unsigned char* lds, int voff, f32x16& p0, f32x16& p1, f32x16& o0, f32x16& o1, float& m, float& l, int lane, const Fn& fn) {
    const int hi = lane >> 5;
    float mx = NEGF;
#pragma unroll
    for (int r = 0; r < 16; ++r) { const int kc = (r & 3) + 8 * (r >> 2); p0[r] = fn(kc, p0[r]); p1[r] = fn(32 + kc, p1[r]); mx = fmaxf(mx, fmaxf(p0[r], p1[r])); }
    mx = fmaxf(mx, __shfl_xor(mx, 32));
    if (!__all(mx - m <= 8.0f)) { const float mn = fmaxf(m, mx), alpha = __builtin_amdgcn_exp2f(m - mn); m = mn; l *= alpha; o0 *= alpha; o1 *= alpha; }
    float ps = 0.f;
#pragma unroll
    for (int r = 0; r < 16; ++r) { p0[r] = __builtin_amdgcn_exp2f(p0[r] - m); p1[r] = __builtin_amdgcn_exp2f(p1[r] - m); ps += p0[r] + p1[r]; }
    l += ps;
    const int q4 = (lane & 15) >> 2, p4 = lane & 3, dgrp = (lane >> 4) & 1;
    LAS const unsigned char* vp = lds + voff + (4 * hi + q4) * 128 + (16 * dgrp + 4 * p4) * 2;
#define FA_PV(P, KH, S2) do { const bf16x8 pb = pack8<8 * (S2)>(P); \
        _Pragma("unroll") for (int blk = 0; blk < 2; ++blk) { \
            const v4i16_t lo = trd(vp + ((32 * (KH) + 16 * (S2)) * 128 + blk * 64)), hh = trd(vp + ((32 * (KH) + 16 * (S2) + 8) * 128 + blk * 64)); \
            const bf16x8 va = {lo[0], lo[1], lo[2], lo[3], hh[0], hh[1], hh[2], hh[3]}; \
            if (blk == 0) o0 = __builtin_amdgcn_mfma_f32_32x32x16_bf16(va, pb, o0, 0, 0, 0); else o1 = __builtin_amdgcn_mfma_f32_32x32x16_bf16(va, pb, o1, 0, 0, 0); } } while (0)
    FA_PV(p0, 0, 0); FA_PV(p0, 0, 1); FA_PV(p1, 1, 0); FA_PV(p1, 1, 1);
#undef FA_PV
}
struct TabFn { LAS const float* base;
    __device__ __forceinline__ float operator()(int kc, float s) const { return fmaf(s, C2LOG, base[59 - kc]); } };
struct TabLoFn { LAS const float* base; int klo4;
    __device__ __forceinline__ float operator()(int kc, float s) const { return kc >= klo4 ? fmaf(s, C2LOG, base[59 - kc]) : NEGF; } };
struct ConstFn { float b2;
    __device__ __forceinline__ float operator()(int, float s) const { return fmaf(s, C2LOG, b2); } };
template <int NIT, class RowFn, class MidFn> __device__ __forceinline__ void stage_rows(LAS unsigned char* lds, int koff, int voff, int tid, int kcol, int vcol, const RowFn& rowfn, const MidFn& mid) {
    u32x4 kv[NIT], vv[NIT];
#pragma unroll
    for (int i = 0; i < NIT; ++i) { const int e = tid + 512 * i, row = e >> 3, ch = e & 7; bool ok; const bf16_t* rp = rowfn(row, ok);
        kv[i] = *(const u32x4*)(rp + kcol + ch * 8); vv[i] = *(const u32x4*)(rp + vcol + ch * 8);
        if (!ok) { kv[i] = (u32x4){0u, 0u, 0u, 0u}; vv[i] = (u32x4){0u, 0u, 0u, 0u}; } }
    __builtin_amdgcn_sched_barrier(0);
    mid();
    __builtin_amdgcn_sched_barrier(0);
#pragma unroll
    for (int i = 0; i < NIT; ++i) { const int e = tid + 512 * i, row = e >> 3, ch = e & 7;
        *(LAS u32x4*)(lds + koff + row * 128 + ((ch ^ (row & 7)) * 16)) = kv[i];
        *(LAS u32x4*)(lds + voff + row * 128 + ch * 16) = vv[i]; }
}
template <class DstFn> __device__ __forceinline__ void store_rows(LAS unsigned char* lds, int ostoff, int lane, const f32x16& o0, const f32x16& o1, float linv, const DstFn& dst) {
    const int r32 = lane & 31, hi = lane >> 5;
    LAS unsigned char* stg = lds + ostoff;
#pragma unroll
    for (int r = 0; r < 16; r += 2) { const int d = crow(r, hi);
        *(LAS unsigned*)(stg + r32 * 128 + ((((d >> 3)) ^ (r32 & 7)) << 4) + (d & 7) * 2) = cvtpk_s(o0[r] * linv, o0[r + 1] * linv);
        *(LAS unsigned*)(stg + r32 * 128 + ((((d >> 3) + 4) ^ (r32 & 7)) << 4) + (d & 7) * 2) = cvtpk_s(o1[r] * linv, o1[r + 1] * linv); }
    asm volatile("s_waitcnt lgkmcnt(0)" ::: "memory");
#pragma unroll
    for (int i = 0; i < 4; ++i) { const int row = i * 8 + (lane >> 3), ch = lane & 7; const u32x4 v = *(const LAS u32x4*)(stg + row * 128 + ((ch ^ (row & 7)) << 4)); bf16_t* p = dst(row); if (p) *(u32x4*)(p + ch * 8) = v; }
    asm volatile("s_waitcnt lgkmcnt(0)" ::: "memory");
}
__device__ __forceinline__ void store_direct(int hi, const f32x16& o0, const f32x16& o1, float linv, bf16_t* p) {
    unsigned w[2][4][2];
#pragma unroll
    for (int g = 0; g < 4; ++g) {
        w[0][g][0] = cvtpk_s(o0[4 * g] * linv, o0[4 * g + 1] * linv); w[0][g][1] = cvtpk_s(o0[4 * g + 2] * linv, o0[4 * g + 3] * linv);
        w[1][g][0] = cvtpk_s(o1[4 * g] * linv, o1[4 * g + 1] * linv); w[1][g][1] = cvtpk_s(o1[4 * g + 2] * linv, o1[4 * g + 3] * linv);
    }
#pragma unroll
    for (int t = 0; t < 2; ++t)
#pragma unroll
        for (int k = 0; k < 2; ++k) {
            const auto s0 = __builtin_amdgcn_permlane32_swap(w[t][2 * k][0], w[t][2 * k + 1][0], false, false);
            const auto s1 = __builtin_amdgcn_permlane32_swap(w[t][2 * k][1], w[t][2 * k + 1][1], false, false);
            if (p) *(u32x4*)(p + 32 * t + 16 * k + 8 * hi) = (u32x4){s0[0], s1[0], s0[1], s1[1]};
        }
}
constexpr int D_K = 0, D_V = 49152, D_LUT = 98304, D_OST = 0;
template <class Hook, class ReqFn> __device__ __forceinline__ void dilated_unit(const Hook& after_stage, const ReqFn& req, LAS unsigned char* lds, int tid, int pi, int bh, int u, const bf16_t* __restrict__ proj, const float* __restrict__ lutd, bf16_t* __restrict__ PO, float* __restrict__ PL) {
    const int lane = tid & 63, wave = __builtin_amdgcn_readfirstlane(tid >> 6), r32 = lane & 31, hi = lane >> 5;
    const int dil = (pi == 0) ? 1 : (pi == 1) ? 4 : 16, b = bh >> 2, h = bh & 3;
    const int r = u % dil, sb = u / dil;
    const int qsub = 256 * sb + 32 * wave + r32;
    const size_t qrow = (size_t)b * SEQ + (size_t)qsub * dil + r;
    bf16x8 qf[4];
#pragma unroll
    for (int s = 0; s < 4; ++s) qf[s] = *(const bf16x8*)(proj + qrow * NIN + COL_QD + h * 64 + 16 * s + 8 * hi);
    u32x4 lutv = {0u, 0u, 0u, 0u};
    if (tid < 64) lutv = ((const u32x4*)(lutd + (pi * 4 + h) * 256))[tid];
    __builtin_amdgcn_sched_barrier(0);
    __syncthreads();
    LAS float* lut = (LAS float*)(lds + D_LUT);
    const int ks0 = 256 * sb - 128;
    stage_rows<6>(lds, D_K, D_V, tid, COL_KD + h * 64, COL_VD + h * 64, [&](int row, bool& ok) -> const bf16_t* { const int ks = ks0 + row; ok = ks >= 0; return proj + ((size_t)b * SEQ + (size_t)max(ks, 0) * dil + r) * NIN; }, req);
    if (tid < 64) ((LAS u32x4*)lut)[tid] = lutv;
    after_stage();
    f32x16 o0, o1;
#pragma unroll
    for (int i = 0; i < 16; ++i) { o0[i] = 0.f; o1[i] = 0.f; }
    float m = NEGF, l = 0.f;
    const KCh kc4 = make_kch(lane);
    __syncthreads();
    const int j0 = wave >> 1;
    const int ja = max(j0, (-ks0) >> 6), jb = j0 + 3;
    {
        LAS const float* tb = lut + (32 * wave + r32 + 128 - 64 * ja - 4 * hi + 64 - 59);
        f32x16 pa0, pa1, pb0, pb1;
        qk64(lds, D_K + ja * 8192, qf, lane, kc4, pa0, pa1);
        if (ja + 1 < jb) qk64(lds, D_K + (ja + 1) * 8192, qf, lane, kc4, pb0, pb1);
        { TabFn fn{tb}; smpv64(lds, D_V + ja * 8192, pa0, pa1, o0, o1, m, l, lane, fn); }
        if (ja + 1 < jb) {
            __builtin_amdgcn_sched_barrier(0);
            if (ja + 2 < jb) qk64(lds, D_K + (ja + 2) * 8192, qf, lane, kc4, pa0, pa1);
            { TabFn fn{tb - 64}; smpv64(lds, D_V + (ja + 1) * 8192, pb0, pb1, o0, o1, m, l, lane, fn); }
            if (ja + 2 < jb) { __builtin_amdgcn_sched_barrier(0); TabFn fn{tb - 128}; smpv64(lds, D_V + (ja + 2) * 8192, pa0, pa1, o0, o1, m, l, lane, fn); }
        }
    }
    l += __shfl_xor(l, 32);
    store_direct(hi, o0, o1, __builtin_amdgcn_rcpf(l), PO + (size_t)pi * M * 256 + h * 64 + qrow * 256);
    if (hi == 0) PL[((size_t)pi * M + qrow) * 4 + h] = m * 0.6931471805599453f + __logf(l);
}
__device__ __forceinline__ void gate_item(LAS unsigned char* lds, int tid, int bh, int ownA, int ownB, const bf16_t* __restrict__ proj, const float* __restrict__ kp, unsigned short* __restrict__ LIST, int* __restrict__ CNT, bf16_t* __restrict__ PARTO) {
    const int lane = tid & 63, wave = __builtin_amdgcn_readfirstlane(tid >> 6), r32 = lane & 31, hi = lane >> 5;
    const int b = bh >> 2, h = bh & 3;
    LAS int* cnt = (LAS int*)lds;
    __syncthreads();
    if (tid < 64) cnt[tid] = 0;
    __syncthreads();
    const int sel = wave >> 2, own = sel ? ownB : ownA;
    const int qib0 = 64 * (wave & 3) + r32;
    const size_t qrow0 = (size_t)b * SEQ + 256 * own + qib0;
    bf16x8 qf[2][4];
#pragma unroll
    for (int tt = 0; tt < 2; ++tt)
#pragma unroll
        for (int s = 0; s < 4; ++s) qf[tt][s] = *(const bf16x8*)(proj + (qrow0 + 32 * tt) * NIN + COL_QA + h * 64 + 16 * s + 8 * hi);
    const float* k0 = kp + (size_t)((b * 32 + r32) * 2) * 256 + h * 64;
    pg8::f32x4 ka[4][2], kc[4][2];
#pragma unroll
    for (int s = 0; s < 4; ++s)
#pragma unroll
        for (int j = 0; j < 2; ++j) { ka[s][j] = *(const pg8::f32x4*)(k0 + 16 * s + 8 * hi + 4 * j); kc[s][j] = *(const pg8::f32x4*)(k0 + 256 + 16 * s + 8 * hi + 4 * j); }
    __builtin_amdgcn_sched_barrier(0);
    f32x16 g[2];
#pragma unroll
    for (int i = 0; i < 16; ++i) { g[0][i] = 0.f; g[1][i] = 0.f; }
#pragma unroll
    for (int s = 0; s < 4; ++s) {
        float kv[8];
#pragma unroll
        for (int j = 0; j < 2; ++j)
#pragma unroll
            for (int e = 0; e < 4; ++e) kv[4 * j + e] = (ka[s][j][e] + kc[s][j][e]) * (1.0f / 256.0f);
        u32x4 wh, wl;
#pragma unroll
        for (int j = 0; j < 4; ++j) {
            const bf16_t h0 = f2bf(kv[2 * j]), h1 = f2bf(kv[2 * j + 1]);
            const bf16_t l0 = f2bf(kv[2 * j] - bf2f(h0)), l1 = f2bf(kv[2 * j + 1] - bf2f(h1));
            wh[j] = (unsigned)h0 | ((unsigned)h1 << 16); wl[j] = (unsigned)l0 | ((unsigned)l1 << 16);
        }
#pragma unroll
        for (int tt = 0; tt < 2; ++tt) {
            g[tt] = __builtin_amdgcn_mfma_f32_32x32x16_bf16(__builtin_bit_cast(bf16x8, wh), qf[tt][s], g[tt], 0, 0, 0);
            g[tt] = __builtin_amdgcn_mfma_f32_32x32x16_bf16(__builtin_bit_cast(bf16x8, wl), qf[tt][s], g[tt], 0, 0, 0);
        }
    }
    int pk_c[2][3], pk_p[2][3];
#pragma unroll
    for (int tt = 0; tt < 2; ++tt) {
#pragma unroll
        for (int i = 0; i < 16; ++i) if (crow(i, hi) >= own) g[tt][i] = -INFINITY;
#pragma unroll
        for (int t = 0; t < 3; ++t) {
            pk_c[tt][t] = -1; pk_p[tt][t] = 0;
            float lm = -INFINITY;
#pragma unroll
            for (int i = 0; i < 16; ++i) lm = fmaxf(lm, g[tt][i]);
            const float gm = fmaxf(lm, __shfl_xor(lm, 32));
            int cand = 99;
#pragma unroll
            for (int i = 15; i >= 0; --i) if (g[tt][i] == gm) cand = crow(i, hi);
            cand = min(cand, __shfl_xor(cand, 32));
            if (gm > -INFINITY) {
#pragma unroll
                for (int i = 0; i < 16; ++i) if (crow(i, hi) == cand) g[tt][i] = -INFINITY;
                if (hi == 0) { pk_c[tt][t] = cand; pk_p[tt][t] = __hip_atomic_fetch_add(cnt + sel * 32 + cand, 1, __ATOMIC_RELAXED, __HIP_MEMORY_SCOPE_WORKGROUP); }
            }
        }
    }
    if (own < 3) { const int q = 64 * (wave & 3) + lane; const size_t qr = (size_t)b * SEQ + 256 * own + q;
        for (int sl = own; sl < 3; ++sl) { u32x4* z = (u32x4*)(PARTO + ((qr * 4 + h) * 3 + sl) * 64);
#pragma unroll
            for (int i = 0; i < 8; ++i) z[i] = (u32x4){0u, 0u, 0u, 0u}; } }
    __syncthreads();
    if (tid < 64) { const int c = cnt[tid]; int base = 0;
        if (c > 0) base = __hip_atomic_fetch_add(CNT + bh * 32 + (tid & 31), c, __ATOMIC_RELAXED, __HIP_MEMORY_SCOPE_AGENT);
        cnt[64 + tid] = base; }
    __syncthreads();
    if (hi == 0) {
#pragma unroll
        for (int tt = 0; tt < 2; ++tt)
#pragma unroll
            for (int t = 0; t < 3; ++t) { const int c = pk_c[tt][t];
                if (c >= 0) LIST[((size_t)bh * 32 + c) * LIST_CAP + cnt[64 + sel * 32 + c] + pk_p[tt][t]] = (unsigned short)((own << 10) | (t << 8) | (qib0 + 32 * tt)); }
    }
}
constexpr int M_K = 0, M_V = 32768, M_LUT = 65536, M_OST = 73728;
template <class Hook, class Hook2, class ReqFn> __device__ __forceinline__ void moba_item(const Hook& after_stage, const Hook2& next_hook, const ReqFn& req, int cj, LAS unsigned char* lds, int tid, int bh, int n, int part, int nparts, const bf16_t* __restrict__ proj, const float* __restrict__ rel_bias, const float* __restrict__ lutm, const unsigned short* __restrict__ LIST,
                                          bf16_t* __restrict__ PARTO, float* __restrict__ PARTML, bf16_t* __restrict__ Y) {
    const int lane = tid & 63, wave = __builtin_amdgcn_readfirstlane(tid >> 6), r32 = lane & 31, hi = lane >> 5;
    const int b = bh >> 2, h = bh & 3;
    const int ctot = __builtin_amdgcn_readfirstlane(cj);
    const int T = 8 + ((ctot + 31) >> 5);
    const unsigned short* lbase = LIST + ((size_t)bh * 32 + n) * LIST_CAP;
    const int stride = 8 * nparts, t0 = wave + 8 * part;
    struct EA { int lt; unsigned short raw; bool live; };
    auto stageA = [&](int t) -> EA { EA e; e.lt = min(t, T - 1); e.live = true; e.raw = 0;
        if (e.lt >= 8) { const int idx = 32 * (e.lt - 8) + r32; e.live = idx < ctot; e.raw = lbase[e.live ? idx : 0]; }
        return e; };
    struct EB { bool own; int sq; bool live; };
    auto stageB = [&](const EA& e, bf16x8 (&q)[4]) -> EB { EB m; m.own = e.lt < 8; m.live = e.live;
        if (m.own) m.sq = (n << 10) | (3 << 8) | (32 * e.lt + r32); else m.sq = e.raw;
        const size_t qrow = (size_t)b * SEQ + 256 * (m.sq >> 10) + (m.sq & 255);
#pragma unroll
        for (int s = 0; s < 4; ++s) q[s] = *(const bf16x8*)(proj + qrow * NIN + COL_QA + h * 64 + 16 * s + 8 * hi);
        return m; };
    EA ea0 = stageA(t0), ea1 = stageA(t0 + stride);
    bf16x8 q0[4];
    EB m0;
    if (part == 0) m0 = stageB(ea0, q0);
    u32x4 lutv = {0u, 0u, 0u, 0u};
    if (tid < 472) lutv = ((const u32x4*)(lutm + h * 1888))[tid];
    __builtin_amdgcn_sched_barrier(0);
    __syncthreads();
    LAS float* lut = (LAS float*)(lds + M_LUT);
    const bf16_t* kvb = proj + ((size_t)b * SEQ + 256 * n) * NIN;
    stage_rows<4>(lds, M_K, M_V, tid, COL_KA + h * 64, COL_VA + h * 64, [&](int row, bool& ok) -> const bf16_t* { ok = true; return kvb + (size_t)row * NIN; }, req);
    if (tid < 472) ((LAS u32x4*)lut)[tid] = lutv;
    after_stage();
    if (part != 0) m0 = stageB(ea0, q0);
    const KCh kc4 = make_kch(lane);
    __syncthreads();
    next_hook();
    if (t0 < T) {
#pragma unroll 1
        for (int t = t0; t < T; t += stride) {
            f32x16 o0, o1;
#pragma unroll
            for (int i = 0; i < 16; ++i) { o0[i] = 0.f; o1[i] = 0.f; }
            float m = NEGF, l = 0.f;
            const EB mc = m0;
            const int mqib = mc.sq & 255, mseg = mc.sq >> 10;
#define MOBA_NEXTQ() do { __builtin_amdgcn_sched_barrier(0); m0 = stageB(ea1, q0); ea1 = stageA(t + 2 * stride); __builtin_amdgcn_sched_barrier(0); } while (0)
            if (mc.own) {
                const int nks = (mqib - r32 + 31) / 64 + 1;
                for (int ks = 0; ks < nks; ++ks) { TabFn fn{lut + (mqib - 64 * ks - 4 * hi + 96 - 59)}; step64(lds, M_K + ks * 8192, M_V + ks * 8192, q0, o0, o1, m, l, lane, fn, kc4); }
                MOBA_NEXTQ();
            } else {
                const int d0 = 256 * (mseg - n) + mqib;
                LAS const float* tb = lut + ((d0 - 255 >= 1513) ? (1887 - 59) : (d0 - 4 * hi + 96 - 59));
                f32x16 pa0, pa1, pb0, pb1;
                qk64(lds, M_K, q0, lane, kc4, pa0, pa1);
                __builtin_amdgcn_sched_barrier(0);
                qk64(lds, M_K + 8192, q0, lane, kc4, pb0, pb1);      { TabFn fn{tb}; smpv64(lds, M_V, pa0, pa1, o0, o1, m, l, lane, fn); }
                __builtin_amdgcn_sched_barrier(0);
                qk64(lds, M_K + 2 * 8192, q0, lane, kc4, pa0, pa1);  { TabFn fn{tb - 64}; smpv64(lds, M_V + 8192, pb0, pb1, o0, o1, m, l, lane, fn); }
                __builtin_amdgcn_sched_barrier(0);
                qk64(lds, M_K + 3 * 8192, q0, lane, kc4, pb0, pb1);
                MOBA_NEXTQ();
                { TabFn fn{tb - 128}; smpv64(lds, M_V + 2 * 8192, pa0, pa1, o0, o1, m, l, lane, fn); }
                __builtin_amdgcn_sched_barrier(0);
                { TabFn fn{tb - 192}; smpv64(lds, M_V + 3 * 8192, pb0, pb1, o0, o1, m, l, lane, fn); }
            }
#undef MOBA_NEXTQ
            l += __shfl_xor(l, 32);
            const int mslot = (mc.sq >> 8) & 3; const size_t mqrow = (size_t)b * SEQ + 256 * mseg + mqib;
            bf16_t* dstp = nullptr;
            if (mc.live) dstp = (mslot == 3) ? Y + mqrow * DM + h * 64 : PARTO + ((mqrow * 4 + h) * 3 + mslot) * 64;
            store_direct(hi, o0, o1, __builtin_amdgcn_rcpf(l), dstp);
            if (mc.live && hi == 0) { float2 ml; ml.x = m; ml.y = l; *(float2*)(PARTML + ((mqrow * 4 + h) * 4 + mslot) * 2) = ml; }
        }
    }
}
}

namespace hg {
typedef short bf16x8 __attribute__((ext_vector_type(8)));
typedef float f32x4 __attribute__((ext_vector_type(4)));
typedef unsigned u32x2 __attribute__((ext_vector_type(2)));
constexpr int SEG_OFF = 0, BT_OFF = 2048, VT_OFF = 18432, KT_OFF = 26624;
constexpr int QS_OFF = 26624, QD_OFF = 34816, QO_OFF = 43008, KD_OFF = 51200, KO_OFF = 59392;
__device__ __forceinline__ void img_put(LAS unsigned char* lds, int off, int row, int d, float v) { *(LAS bf16_t*)(lds + off + row * 128 + ((((d >> 3) ^ (row & 7))) << 4) + (d & 7) * 2) = f2bf(v); }
__device__ __forceinline__ bf16x8 img_frag(LAS const unsigned char* lds, int off, int row, int chunk) { return *(const LAS bf16x8*)(lds + off + row * 128 + ((chunk ^ (row & 7)) << 4)); }
__device__ __forceinline__ unsigned cvtpk(float lo, float hi) { return cvtpk_s(lo, hi); }
struct Ch { float f[8], b[8], qv[8], iv[8], blast; };
template <bool NEEDQ> __device__ __forceinline__ void stage(LAS unsigned char* lds, int wave, int lane, const bf16_t* __restrict__ rowp  , float lb, Ch& c) {
    float cs = 0.f;
#pragma unroll
    for (int i = 0; i < 8; ++i) {
        const bf16_t* r = rowp + (size_t)(8 * wave + i) * NIN + lane;
        const float fp = bf2f(r[COL_FC]); c.iv[i] = bf2f(r[COL_IC]);
        if (NEEDQ) { const float q = bf2f(r[COL_QC]); c.qv[i] = q * __builtin_amdgcn_rcpf(1.0f + __expf(-q)) * 0.125f; }
        c.f[i] = lb + (1.0f - lb) * __builtin_amdgcn_rcpf(1.0f + __expf(-fp));
        cs += __logf(c.f[i]); c.b[i] = cs;
    }
    LAS float* seg = (LAS float*)(lds + SEG_OFF);
    seg[wave * 64 + lane] = cs;
    __syncthreads();
    float off = 0.f, tot = 0.f;
#pragma unroll
    for (int w = 0; w < 8; ++w) { const float s = seg[w * 64 + lane]; tot += s; if (w < wave) off += s; }
#pragma unroll
    for (int i = 0; i < 8; ++i) c.b[i] += off;
    c.blast = tot;
}
__device__ __forceinline__ void x1_item(LAS unsigned char* lds, int wave, int lane, int item, const bf16_t* __restrict__ proj, const float* __restrict__ lbp, float* __restrict__ DS, float* __restrict__ DEC) {
    const int bh = item >> 7, ch = item & 127, b = bh >> 2, h = bh & 3;
    __syncthreads();
    Ch c; stage<false>(lds, wave, lane, proj + ((size_t)b * SEQ + ch * 64) * NIN + h * 64, lbp[h * 64 + lane], c);
    u32x4 kw, vw;
#pragma unroll
    for (int j = 0; j < 4; ++j) {
        kw[j] = cvtpk((1.0f - c.f[2 * j]) * __expf(c.blast - c.b[2 * j]), (1.0f - c.f[2 * j + 1]) * __expf(c.blast - c.b[2 * j + 1]));
        vw[j] = cvtpk(c.iv[2 * j], c.iv[2 * j + 1]);
    }
    *(LAS u32x4*)(lds + KT_OFF + lane * 128 + ((wave ^ (lane & 7)) << 4)) = kw;
    *(LAS u32x4*)(lds + VT_OFF + lane * 128 + ((wave ^ (lane & 7)) << 4)) = vw;
    if (wave == 0) DEC[(size_t)item * 64 + lane] = __expf(c.blast);
    __syncthreads();
    const int fr = lane & 15, quad = lane >> 4, mt = wave >> 1;
#pragma unroll
    for (int n2 = 0; n2 < 2; ++n2) {
        const int nt = 2 * (wave & 1) + n2;
        f32x4 acc = {0.f, 0.f, 0.f, 0.f};
#pragma unroll
        for (int kk = 0; kk < 2; ++kk)
            acc = __builtin_amdgcn_mfma_f32_16x16x32_bf16(img_frag(lds, VT_OFF, 16 * mt + fr, quad + 4 * kk), img_frag(lds, KT_OFF, 16 * nt + fr, quad + 4 * kk), acc, 0, 0, 0);
        float* o = DS + (size_t)item * 4096 + (16 * mt + 4 * quad) * 64 + 16 * nt + fr;
#pragma unroll
        for (int r = 0; r < 4; ++r) o[r * 64] = acc[r];
    }
}
__device__ __forceinline__ void x2_scan(int gtid, int nthreads, const float* __restrict__ DS, const float* __restrict__ DEC, bf16_t* __restrict__ ST) {
    for (int e = gtid; e < 16 * 1024; e += nthreads) {
        const int bh = e >> 10, q = e & 1023;
        const int d4 = q & 15;
        f32x4 s = {0.f, 0.f, 0.f, 0.f};
#pragma unroll 1
        for (int c0 = 0; c0 < 128; c0 += 8) {
            f32x4 ds[8], de[8];
#pragma unroll
            for (int i = 0; i < 8; ++i) { const size_t it = (size_t)bh * 128 + c0 + i; ds[i] = *(const f32x4*)(DS + it * 4096 + q * 4); de[i] = *(const f32x4*)(DEC + it * 64 + d4 * 4); }
#pragma unroll
            for (int i = 0; i < 8; ++i) { const size_t it = (size_t)bh * 128 + c0 + i;
                uint2 w; w.x = cvtpk(s[0], s[1]); w.y = cvtpk(s[2], s[3]); *(uint2*)(ST + it * 4096 + q * 4) = w;
                s = s * de[i] + ds[i]; }
        }
    }
}
__device__ __forceinline__ void x3_item(LAS unsigned char* lds, int wave, int lane, int item, const bf16_t* __restrict__ proj, const float* __restrict__ lbp, const bf16_t* __restrict__ ST, bf16_t* __restrict__ Y) {
    const int bh = item >> 7, ch = item & 127, b = bh >> 2, h = bh & 3;
    __syncthreads();
    Ch c; stage<true>(lds, wave, lane, proj + ((size_t)b * SEQ + ch * 64) * NIN + h * 64, lbp[h * 64 + lane], c);
    LAS float* bt = (LAS float*)(lds + BT_OFF);
#pragma unroll
    for (int i = 0; i < 8; ++i) bt[(8 * wave + i) * 64 + lane] = c.b[i];
    { u32x4 vw;
#pragma unroll
      for (int j = 0; j < 4; ++j) vw[j] = cvtpk(c.iv[2 * j], c.iv[2 * j + 1]);
      *(LAS u32x4*)(lds + VT_OFF + lane * 128 + ((wave ^ (lane & 7)) << 4)) = vw; }
    __syncthreads();
    {
        const int I = wave >> 1;
        const float cI = bt[(16 * I + 7) * 64 + lane];
        const float rI = (I > 0) ? bt[(16 * I - 1) * 64 + lane] : 0.f;
        float rN[3];
#pragma unroll
        for (int ip = 1; ip < 4; ++ip) rN[ip - 1] = bt[(16 * ip - 1) * 64 + lane];
#pragma unroll
        for (int i = 0; i < 8; ++i) {
            const int t = 8 * wave + i; const float bb = c.b[i], q = c.qv[i], k = 1.0f - c.f[i];
            img_put(lds, QS_OFF, t, lane, q * __expf(bb));
            img_put(lds, QD_OFF, t, lane, q * __expf(bb - cI));
            img_put(lds, QO_OFF, t, lane, q * __expf(bb - rI));
            img_put(lds, KD_OFF, t, lane, k * __expf(cI - bb));
#pragma unroll
            for (int ip = 1; ip < 4; ++ip) if (ip > I) img_put(lds, KO_OFF + (ip - 1) * 8192, t, lane, k * __expf(rN[ip - 1] - bb));
        }
    }
    __syncthreads();
    const int fr = lane & 15, quad = lane >> 4, I = wave >> 1, vh = wave & 1;
    unsigned sc[4][2];
#pragma unroll
    for (int J = 0; J < 4; ++J) {
        sc[J][0] = 0u; sc[J][1] = 0u;
        if (J <= I) {
            f32x4 acc = {0.f, 0.f, 0.f, 0.f};
            const int ko = (J < I) ? KO_OFF + (I - 1) * 8192 : KD_OFF, qo = (J < I) ? QO_OFF : QD_OFF;
#pragma unroll
            for (int kk = 0; kk < 2; ++kk)
                acc = __builtin_amdgcn_mfma_f32_16x16x32_bf16(img_frag(lds, ko, 16 * J + fr, quad + 4 * kk), img_frag(lds, qo, 16 * I + fr, quad + 4 * kk), acc, 0, 0, 0);
            if (J == I) {
#pragma unroll
                for (int r = 0; r < 4; ++r) if (4 * quad + r > fr) acc[r] = 0.f;
            }
            sc[J][0] = cvtpk(acc[0], acc[1]); sc[J][1] = cvtpk(acc[2], acc[3]);
        }
    }
    const bf16_t* stp = ST + (size_t)item * 4096;
    const size_t orow = (size_t)b * SEQ + ch * 64 + 16 * I + fr;
#pragma unroll
    for (int m2 = 0; m2 < 2; ++m2) {
        const int mt = 2 * vh + m2, v = 16 * mt + fr;
        f32x4 acc = {0.f, 0.f, 0.f, 0.f};
#pragma unroll
        for (int ks = 0; ks < 2; ++ks) {
            if (2 * ks <= I) {
                u32x4 bw, aw;
                bw[0] = sc[2 * ks][0]; bw[1] = sc[2 * ks][1]; bw[2] = sc[2 * ks + 1][0]; bw[3] = sc[2 * ks + 1][1];
                const LAS unsigned char* vr = lds + VT_OFF + v * 128;
                const u32x2 a0 = *(const LAS u32x2*)(vr + (((4 * ks + (quad >> 1)) ^ (v & 7)) << 4) + (quad & 1) * 8);
                u32x2 a1 = {0u, 0u};
                if (2 * ks + 1 <= I) a1 = *(const LAS u32x2*)(vr + (((4 * ks + 2 + (quad >> 1)) ^ (v & 7)) << 4) + (quad & 1) * 8);
                aw[0] = a0.x; aw[1] = a0.y; aw[2] = a1.x; aw[3] = a1.y;
                acc = __builtin_amdgcn_mfma_f32_16x16x32_bf16(__builtin_bit_cast(bf16x8, aw), __builtin_bit_cast(bf16x8, bw), acc, 0, 0, 0);
            }
        }
#pragma unroll
        for (int kk = 0; kk < 2; ++kk) {
            const bf16x8 sa = *(const bf16x8*)(stp + v * 64 + 8 * quad + 32 * kk);
            acc = __builtin_amdgcn_mfma_f32_16x16x32_bf16(sa, img_frag(lds, QS_OFF, 16 * I + fr, quad + 4 * kk), acc, 0, 0, 0);
        }
        uint2 w; w.x = cvtpk(acc[0], acc[1]); w.y = cvtpk(acc[2], acc[3]);
        *(uint2*)(Y + orow * DM + 512 + h * 64 + 16 * mt + 4 * quad) = w;
    }
}
}

namespace hw {
typedef short bf16x8 __attribute__((ext_vector_type(8)));
typedef float f32x4 __attribute__((ext_vector_type(4)));
typedef unsigned u32x2 __attribute__((ext_vector_type(2)));
#define HW_LDSW() asm volatile("s_waitcnt lgkmcnt(0)" ::: "memory")
__device__ __forceinline__ bf16x8 frag128(LAS const unsigned char* base, int row, int chunk) { return *(const LAS bf16x8*)(base + row * 128 + ((chunk ^ (row & 7)) << 4)); }
template <class MidFn> __device__ __forceinline__ void x1_wave(const MidFn& mid, LAS unsigned char* wl, int lane, int item, const bf16_t* __restrict__ proj, const float* __restrict__ lbp, float* __restrict__ DS, float* __restrict__ DEC) {
    const int bh = item >> 7, ch = item & 127, b = bh >> 2, h = bh & 3;
    const bf16_t* rp = proj + ((size_t)b * SEQ + ch * 64) * NIN + h * 64 + lane;
    const float lb = lbp[h * 64 + lane];
    float f[64]; float cs = 0.f;
    const bf16_t* rpw = proj + ((size_t)b * SEQ + ch * 64 + (lane >> 3)) * NIN + h * 64 + (lane & 7) * 8;
    unsigned short rf[16], ri[16];
    u32x4 raw[4];
#define HWX1_ISSUE(G_) do { _Pragma("unroll") for (int k_ = 0; k_ < 2; ++k_) { const bf16_t* r_ = rpw + (size_t)(16 * (G_) + 8 * k_) * NIN; raw[k_] = *(const u32x4*)(r_ + COL_FC); raw[2 + k_] = *(const u32x4*)(r_ + COL_IC); } } while (0)
    HWX1_ISSUE(0);
    __builtin_amdgcn_sched_barrier(0);
    mid();
    HW_LDSW();
#pragma unroll
    for (int g2 = 0; g2 < 4; ++g2) {
#pragma unroll
        for (int a = 0; a < 2; ++a)
#pragma unroll
            for (int k = 0; k < 2; ++k) *(LAS u32x4*)(wl + a * 2048 + ((lane >> 3) + 8 * k) * 128 + (lane & 7) * 16) = raw[2 * a + k];
        __builtin_amdgcn_sched_barrier(0);
        if (g2 < 3) HWX1_ISSUE(g2 + 1);
        __builtin_amdgcn_sched_barrier(0);
#pragma unroll
        for (int i = 0; i < 16; ++i) { rf[i] = *(const LAS bf16_t*)(wl + i * 128 + lane * 2); ri[i] = *(const LAS bf16_t*)(wl + 2048 + i * 128 + lane * 2); }
        HW_LDSW();
#pragma unroll
        for (int i = 0; i < 16; i += 2) {
            const float da = 1.0f + __expf(-bf2f(rf[i])), db = 1.0f + __expf(-bf2f(rf[i + 1])), R = __builtin_amdgcn_rcpf(da * db);
            f[16 * g2 + i] = lb + (1.0f - lb) * (db * R); f[16 * g2 + i + 1] = lb + (1.0f - lb) * (da * R); }
#pragma unroll
        for (int q = 0; q < 2; ++q) { const int g = 2 * g2 + q;
            u32x4 vw; vw[0] = (unsigned)ri[8 * q] | ((unsigned)ri[8 * q + 1] << 16); vw[1] = (unsigned)ri[8 * q + 2] | ((unsigned)ri[8 * q + 3] << 16);
            vw[2] = (unsigned)ri[8 * q + 4] | ((unsigned)ri[8 * q + 5] << 16); vw[3] = (unsigned)ri[8 * q + 6] | ((unsigned)ri[8 * q + 7] << 16);
            *(LAS u32x4*)(wl + 8192 + lane * 128 + ((g ^ (lane & 7)) << 4)) = vw; }
    }
#undef HWX1_ISSUE
    cs = 1.0f;
#pragma unroll
    for (int g = 7; g >= 0; --g) {
        float kh[8];
#pragma unroll
        for (int i = 7; i >= 0; --i) { const float ff = f[8 * g + i]; kh[i] = (1.0f - ff) * cs; cs *= ff; }
        u32x4 kw; kw[0] = cvtpk_s(kh[0], kh[1]); kw[1] = cvtpk_s(kh[2], kh[3]); kw[2] = cvtpk_s(kh[4], kh[5]); kw[3] = cvtpk_s(kh[6], kh[7]);
        *(LAS u32x4*)(wl + lane * 128 + ((g ^ (lane & 7)) << 4)) = kw;
    }
    DEC[(size_t)item * 64 + lane] = cs;
    HW_LDSW();
    const int fr = lane & 15, quad = lane >> 4;
    float* dsp = DS + (size_t)item * 4096;
#pragma unroll
    for (int mt = 0; mt < 4; ++mt) {
        const bf16x8 a0 = frag128(wl + 8192, 16 * mt + fr, quad), a1 = frag128(wl + 8192, 16 * mt + fr, quad + 4);
#pragma unroll
        for (int nt = 0; nt < 4; ++nt) {
            f32x4 acc = {0.f, 0.f, 0.f, 0.f};
            acc = __builtin_amdgcn_mfma_f32_16x16x32_bf16(frag128(wl, 16 * nt + fr, quad), a0, acc, 0, 0, 0);
            acc = __builtin_amdgcn_mfma_f32_16x16x32_bf16(frag128(wl, 16 * nt + fr, quad + 4), a1, acc, 0, 0, 0);
            *(f32x4*)(dsp + (16 * mt + fr) * 64 + 16 * nt + 4 * quad) = acc;
        }
    }
    HW_LDSW();
}
template <class ReqFn> __device__ __forceinline__ void x3_wave(const ReqFn& req, LAS unsigned char* wl, int lane, int item, const bf16_t* __restrict__ proj, const float* __restrict__ lbp, const bf16_t* __restrict__ ST, bf16_t* __restrict__ Y) {
    const int bh = item >> 7, ch = item & 127, b = bh >> 2, h = bh & 3;
    const int fr = lane & 15, quad = lane >> 4;
    const bf16_t* rp = proj + ((size_t)b * SEQ + ch * 64) * NIN + h * 64 + lane;
    const float lb = lbp[h * 64 + lane];
    f32x4 S[4][4];
    { const bf16_t* sp = ST + (size_t)item * 4096;
#pragma unroll
      for (int tv = 0; tv < 4; ++tv)
#pragma unroll
          for (int td = 0; td < 4; ++td) { const uint2 w = *(const uint2*)(sp + (16 * tv + fr) * 64 + 16 * td + 4 * quad);
              S[td][tv] = (f32x4){__uint_as_float(w.x << 16), __uint_as_float(w.x & 0xffff0000u), __uint_as_float(w.y << 16), __uint_as_float(w.y & 0xffff0000u)}; } }
    LAS float* decl = (LAS float*)(wl + 10240);
    const bf16_t* rpw = proj + ((size_t)b * SEQ + ch * 64 + (lane >> 3)) * NIN + h * 64 + (lane & 7) * 8;
    u32x4 raw[6];
#define HWX_ISSUE(I_) do { _Pragma("unroll") for (int k_ = 0; k_ < 2; ++k_) { const bf16_t* r_ = rpw + (size_t)(16 * (I_) + 8 * k_) * NIN; \
        raw[k_] = *(const u32x4*)(r_ + COL_FC); raw[2 + k_] = *(const u32x4*)(r_ + COL_QC); raw[4 + k_] = *(const u32x4*)(r_ + COL_IC); } } while (0)
    HWX_ISSUE(0);
    __builtin_amdgcn_sched_barrier(0);
    req();
    __builtin_amdgcn_sched_barrier(0);
#pragma unroll 1
    for (int I = 0; I < 4; ++I) {
        float ff[16], qv[16], iv[16], bb[16];
        HW_LDSW();
#pragma unroll
        for (int a = 0; a < 3; ++a)
#pragma unroll
            for (int k = 0; k < 2; ++k) *(LAS u32x4*)(wl + a * 2048 + ((lane >> 3) + 8 * k) * 128 + (lane & 7) * 16) = raw[2 * a + k];
        __builtin_amdgcn_sched_barrier(0);
        { const int In = I < 3 ? I + 1 : 3;
          HWX_ISSUE(In); }
        __builtin_amdgcn_sched_barrier(0);
#pragma unroll
        for (int i = 0; i < 16; ++i) { ff[i] = bf2f(*(const LAS bf16_t*)(wl + i * 128 + lane * 2)); qv[i] = bf2f(*(const LAS bf16_t*)(wl + 2048 + i * 128 + lane * 2)); iv[i] = bf2f(*(const LAS bf16_t*)(wl + 4096 + i * 128 + lane * 2)); }
        HW_LDSW();
#pragma unroll
        for (int i = 0; i < 16; ++i) {
            const float df = 1.0f + __expf(-ff[i]), dq = 1.0f + __expf(-qv[i]), R = __builtin_amdgcn_rcpf(df * dq);
            ff[i] = lb + (1.0f - lb) * (dq * R); qv[i] = qv[i] * (df * R) * 0.125f; }
        float suf[16], mid[16];
        { float p = 1.0f;
#pragma unroll
          for (int i = 0; i < 16; ++i) { p *= ff[i]; bb[i] = p; }
          p = 1.0f;
#pragma unroll
          for (int i = 15; i >= 0; --i) { suf[i] = p; p *= ff[i]; }
          p = 1.0f;
#pragma unroll
          for (int i = 7; i >= 0; --i) { mid[i] = p; p *= ff[i]; }
          p = 1.0f;
#pragma unroll
          for (int i = 8; i < 16; ++i) { p *= ff[i]; mid[i] = p; } }
        HW_LDSW();
        { u32x4 v0, v1, k0, k1;
#pragma unroll
          for (int j = 0; j < 4; ++j) { v0[j] = cvtpk_s(iv[2 * j], iv[2 * j + 1]); v1[j] = cvtpk_s(iv[8 + 2 * j], iv[9 + 2 * j]);
              k0[j] = cvtpk_s((1.0f - ff[2 * j]) * suf[2 * j], (1.0f - ff[2 * j + 1]) * suf[2 * j + 1]);
              k1[j] = cvtpk_s((1.0f - ff[8 + 2 * j]) * suf[8 + 2 * j], (1.0f - ff[9 + 2 * j]) * suf[9 + 2 * j]); }
          *(LAS u32x4*)(wl + 8192 + lane * 32) = v0; *(LAS u32x4*)(wl + 8192 + lane * 32 + 16) = v1;
          *(LAS u32x4*)(wl + 6144 + lane * 32) = k0; *(LAS u32x4*)(wl + 6144 + lane * 32 + 16) = k1; }
        decl[lane] = bb[15];
#pragma unroll
        for (int i = 0; i < 16; ++i) {
            const int off = i * 128 + ((((lane >> 3) ^ (i & 7))) << 4) + (lane & 7) * 2;
            const float mr = __builtin_amdgcn_rcpf(mid[i]);
            *(LAS bf16_t*)(wl + off) = f2bf(qv[i] * bb[i]);
            *(LAS bf16_t*)(wl + 2048 + off) = f2bf(qv[i] * (i <= 7 ? mr : mid[i]));
            *(LAS bf16_t*)(wl + 4096 + off) = f2bf((1.0f - ff[i]) * (i <= 7 ? mid[i] : mr));
        }
        HW_LDSW();
        f32x4 sc = {0.f, 0.f, 0.f, 0.f};
        sc = __builtin_amdgcn_mfma_f32_16x16x32_bf16(frag128(wl + 4096, fr, quad), frag128(wl + 2048, fr, quad), sc, 0, 0, 0);
        sc = __builtin_amdgcn_mfma_f32_16x16x32_bf16(frag128(wl + 4096, fr, quad + 4), frag128(wl + 2048, fr, quad + 4), sc, 0, 0, 0);
#pragma unroll
        for (int r = 0; r < 4; ++r) if (4 * quad + r > fr) sc[r] = 0.f;
        u32x4 scb; scb[0] = cvtpk_s(sc[0], sc[1]); scb[1] = cvtpk_s(sc[2], sc[3]); scb[2] = 0u; scb[3] = 0u;
        u32x4 qi[2];
#pragma unroll
        for (int ks = 0; ks < 2; ++ks) {
            const u32x2 lo = *(const LAS u32x2*)(wl + fr * 128 + ((((4 * ks + (quad >> 1))) ^ (fr & 7)) << 4) + (quad & 1) * 8);
            const u32x2 hi2 = *(const LAS u32x2*)(wl + fr * 128 + ((((4 * ks + 2 + (quad >> 1))) ^ (fr & 7)) << 4) + (quad & 1) * 8);
            qi[ks] = (u32x4){lo[0], lo[1], hi2[0], hi2[1]};
        }
        const size_t orow = (size_t)b * SEQ + ch * 64 + 16 * I + fr;
#pragma unroll
        for (int tv = 0; tv < 4; ++tv) {
            const u32x2 vt = *(const LAS u32x2*)(wl + 8192 + (16 * tv + fr) * 32 + quad * 8);
            f32x4 acc = {0.f, 0.f, 0.f, 0.f};
            acc = __builtin_amdgcn_mfma_f32_16x16x32_bf16(__builtin_bit_cast(bf16x8, (u32x4){vt[0], vt[1], 0u, 0u}), __builtin_bit_cast(bf16x8, scb), acc, 0, 0, 0);
#pragma unroll
            for (int ks = 0; ks < 2; ++ks) {
                u32x4 sa; sa[0] = cvtpk_s(S[2 * ks][tv][0], S[2 * ks][tv][1]); sa[1] = cvtpk_s(S[2 * ks][tv][2], S[2 * ks][tv][3]);
                sa[2] = cvtpk_s(S[2 * ks + 1][tv][0], S[2 * ks + 1][tv][1]); sa[3] = cvtpk_s(S[2 * ks + 1][tv][2], S[2 * ks + 1][tv][3]);
                acc = __builtin_amdgcn_mfma_f32_16x16x32_bf16(__builtin_bit_cast(bf16x8, sa), __builtin_bit_cast(bf16x8, qi[ks]), acc, 0, 0, 0);
            }
            uint2 w; w.x = cvtpk_s(acc[0], acc[1]); w.y = cvtpk_s(acc[2], acc[3]);
            *(uint2*)(Y + orow * DM + 512 + h * 64 + 16 * tv + 4 * quad) = w;
        }
        if (I < 3) {
#pragma unroll
            for (int td = 0; td < 4; ++td) {
                const f32x4 dc = *(const LAS f32x4*)(wl + 10240 + (16 * td + 4 * quad) * 4);
                const u32x2 kt = *(const LAS u32x2*)(wl + 6144 + (16 * td + fr) * 32 + quad * 8);
                const bf16x8 ka = __builtin_bit_cast(bf16x8, (u32x4){kt[0], kt[1], 0u, 0u});
#pragma unroll
                for (int tv = 0; tv < 4; ++tv) {
                    const u32x2 vt = *(const LAS u32x2*)(wl + 8192 + (16 * tv + fr) * 32 + quad * 8);
                    S[td][tv] = __builtin_amdgcn_mfma_f32_16x16x32_bf16(ka, __builtin_bit_cast(bf16x8, (u32x4){vt[0], vt[1], 0u, 0u}), S[td][tv] * dc, 0, 0, 0);
                }
            }
        }
    }
    HW_LDSW();
#undef HWX_ISSUE
}
}

namespace s5 {
typedef short bf16x8 __attribute__((ext_vector_type(8)));
typedef float f32x4 __attribute__((ext_vector_type(4)));
__device__ __forceinline__ void cpow(double dt, double ar, double ai, int n, double& pr, double& pi) { const double mg = exp(n * dt * ar); double sn, cs; sincos_d(n * dt * ai, sn, cs); pr = mg * cs; pi = mg * sn; }
__device__ __forceinline__ void cpow_f(double dt, double ar, double ai, int n, double& pr, double& pi) {
    const float mg = __expf((float)(n * dt * ar)); const double th = n * dt * ai, k = rint(th * 0.15915494309189535); const float r = (float)fma(-k, 6.283185307179586, th);
    pr = (double)(mg * __cosf(r)); pi = (double)(mg * __sinf(r));
}
__device__ __forceinline__ void zfac(double dt, double ar, double ai, double& zr, double& zi) {
    double are, aim; cpow(dt, ar, ai, 1, are, aim);
    const double nr = are - 1.0, ni = aim, den = ar * ar + ai * ai; zr = (nr * ar + ni * ai) / den; zi = (ni * ar - nr * ai) / den;
}
__device__ __forceinline__ void tables_thread(int e, const float* a_re, const float* a_im, const float* log_dt, const float* b_re, const float* b_im, const float* c_re, const float* c_im,
                                              bf16_t* W1, bf16_t* W3, float* a64) {
    const int st = e & 63, p = (e >> 6) & 63, lg = e >> 12;
    const int id = lg * 64 + p;
    float brv[16], biv[16], crv[16], civ[16];
#pragma unroll
    for (int c4 = 0; c4 < 4; ++c4) { const float4 x = *(const float4*)(b_re + id * 16 + 4 * c4), y = *(const float4*)(b_im + id * 16 + 4 * c4);
        brv[4 * c4] = x.x; brv[4 * c4 + 1] = x.y; brv[4 * c4 + 2] = x.z; brv[4 * c4 + 3] = x.w; biv[4 * c4] = y.x; biv[4 * c4 + 1] = y.y; biv[4 * c4 + 2] = y.z; biv[4 * c4 + 3] = y.w; }
#pragma unroll
    for (int c = 0; c < 16; ++c) { crv[c] = c_re[(lg * 16 + c) * 64 + p]; civ[c] = c_im[(lg * 16 + c) * 64 + p]; }
    const double dt = exp((double)log_dt[lg]), ar = a_re[id], ai = a_im[id];
    __builtin_amdgcn_sched_barrier(0);
    double zr, zi; zfac(dt, ar, ai, zr, zi);
    { double pr, pi; cpow_f(dt, ar, ai, 63 - st, pr, pi);
      unsigned wr[8], wi[8];
#pragma unroll
      for (int c2 = 0; c2 < 8; ++c2) {
          float vr[2], vi[2];
#pragma unroll
          for (int q = 0; q < 2; ++q) { const int c = 2 * c2 + q; const double br = brv[c], bi = biv[c];
              const double bbr = zr * br - zi * bi, bbi = zr * bi + zi * br; vr[q] = (float)(pr * bbr - pi * bbi); vi[q] = (float)(pr * bbi + pi * bbr); }
          wr[c2] = pk2(vr[0], vr[1]); wi[c2] = pk2(vi[0], vi[1]);
      }
      u32x4* o0 = (u32x4*)(W1 + ((size_t)(lg * 128 + 2 * p) * 1024 + st * 16)); u32x4* o1 = (u32x4*)(W1 + ((size_t)(lg * 128 + 2 * p + 1) * 1024 + st * 16));
      o0[0] = (u32x4){wr[0], wr[1], wr[2], wr[3]}; o0[1] = (u32x4){wr[4], wr[5], wr[6], wr[7]};
      o1[0] = (u32x4){wi[0], wi[1], wi[2], wi[3]}; o1[1] = (u32x4){wi[4], wi[5], wi[6], wi[7]}; }
    { double pr, pi; cpow_f(dt, ar, ai, st + 1, pr, pi);
#pragma unroll
      for (int c = 0; c < 16; ++c) { const double cr = crv[c], ci = civ[c];
          *(unsigned*)(W3 + ((size_t)(lg * 1024 + st * 16 + c) * 128 + 2 * p)) = pk2((float)(cr * pr - ci * pi), -(float)(cr * pi + ci * pr)); }
      if (st == 63) { double qr, qi; cpow(dt, ar, ai, 64, qr, qi); a64[id * 2] = (float)qr; a64[id * 2 + 1] = (float)qi; } }
}
__device__ __forceinline__ void kmat_item(LAS float* scr, int tid, int item, const float* a_re, const float* a_im, const float* log_dt, const float* b_re, const float* b_im, const float* c_re, const float* c_im, const float* dskip, bf16_t* KM) {
    const int tau = item & 63, lg = item >> 6;
    __syncthreads();
    if (tid < 256) ((LAS f32x4*)(scr + 2048))[tid] = ((const f32x4*)(c_re + (size_t)lg * 1024))[tid];
    else ((LAS f32x4*)(scr + 3072))[tid - 256] = ((const f32x4*)(c_im + (size_t)lg * 1024))[tid - 256];
    { const int p = tid >> 3, c0 = (tid & 7) * 2, id = lg * 64 + p;
      const double dt = exp((double)log_dt[lg]), ar = a_re[id], ai = a_im[id];
      double zr, zi, pr, pi; zfac(dt, ar, ai, zr, zi); cpow_f(dt, ar, ai, tau, pr, pi);
#pragma unroll
      for (int q = 0; q < 2; ++q) { const int c = c0 + q; const double br = b_re[id * 16 + c], bi = b_im[id * 16 + c];
          const double bbr = zr * br - zi * bi, bbi = zr * bi + zi * br;
          scr[(p * 16 + c) * 2] = (float)(pr * bbr - pi * bbi); scr[(p * 16 + c) * 2 + 1] = (float)(pr * bbi + pi * bbr); } }
    __syncthreads();
    if (tid < 256) { const int c = tid >> 4, cp = tid & 15; float s = 0.f;
#pragma unroll 8
        for (int p = 0; p < 64; ++p) s += scr[2048 + c * 64 + p] * scr[(p * 16 + cp) * 2] - scr[3072 + c * 64 + p] * scr[(p * 16 + cp) * 2 + 1];
        if (tau == 0 && c == cp) s += dskip[lg * 16 + c];
        KM[((size_t)(lg * 64 + tau) * 16 + c) * 16 + cp] = f2bf(s); }
}
__device__ __forceinline__ void kmat_item8(LAS float* scr, int tid, int item, const float* a_re, const float* a_im, const float* log_dt, const float* b_re, const float* b_im, const float* c_re, const float* c_im, const float* dskip, bf16_t* KM) {
    const int t8 = item & 7, lg = item >> 3;
    __syncthreads();
    if (tid < 256) ((LAS f32x4*)(scr + 16384))[tid] = ((const f32x4*)(c_re + (size_t)lg * 1024))[tid];
    else ((LAS f32x4*)(scr + 17408))[tid - 256] = ((const f32x4*)(c_im + (size_t)lg * 1024))[tid - 256];
    { const int p = tid >> 3, c0 = (tid & 7) * 2, id = lg * 64 + p;
      const double dt = exp((double)log_dt[lg]), ar = a_re[id], ai = a_im[id];
      double zr, zi; zfac(dt, ar, ai, zr, zi);
      double bbr[2], bbi[2];
#pragma unroll
      for (int q = 0; q < 2; ++q) { const double br = b_re[id * 16 + c0 + q], bi = b_im[id * 16 + c0 + q]; bbr[q] = zr * br - zi * bi; bbi[q] = zr * bi + zi * br; }
#pragma unroll 1
      for (int j = 0; j < 8; ++j) { double pr, pi; cpow_f(dt, ar, ai, t8 * 8 + j, pr, pi);
#pragma unroll
          for (int q = 0; q < 2; ++q) { scr[j * 2048 + (p * 16 + c0 + q) * 2] = (float)(pr * bbr[q] - pi * bbi[q]); scr[j * 2048 + (p * 16 + c0 + q) * 2 + 1] = (float)(pr * bbi[q] + pi * bbr[q]); } } }
    __syncthreads();
    { const int c = (tid >> 4) & 15, cp = tid & 15, jh = tid >> 8;
      float s0 = 0.f, s1 = 0.f, s2 = 0.f, s3 = 0.f;
#pragma unroll 4
      for (int p = 0; p < 64; ++p) { const float cr = scr[16384 + c * 64 + p], ci = scr[17408 + c * 64 + p]; const LAS float* e = scr + jh * 4 * 2048 + (p * 16 + cp) * 2;
          s0 += cr * e[0] - ci * e[1]; s1 += cr * e[2048] - ci * e[2049]; s2 += cr * e[4096] - ci * e[4097]; s3 += cr * e[6144] - ci * e[6145]; }
      const int tau0 = t8 * 8 + jh * 4;
      if (tau0 == 0 && c == cp) s0 += dskip[lg * 16 + c];
      bf16_t* o = KM + ((size_t)(lg * 64 + tau0) * 16 + c) * 16 + cp;
      o[0] = f2bf(s0); o[256] = f2bf(s1); o[512] = f2bf(s2); o[768] = f2bf(s3); }
}
__device__ __forceinline__ size_t chunk_row(int cid) { return (size_t)(cid >> 7) * SEQ + (size_t)(cid & 127) * 64; }
__device__ __forceinline__ void x1_block(LAS unsigned char* lds, int wave, int lane, int g, int mtp, int lg, const bf16_t* __restrict__ proj, const bf16_t* __restrict__ W1, float* __restrict__ HEND) {
    const int fr = lane & 15, quad = lane >> 4, hsel = wave >> 2, nq = wave & 3, mt = 2 * mtp + hsel;
    const bf16_t* ap = proj + (chunk_row(mt * 16 + fr) + (quad >> 1)) * NIN + COL_U + g * 16 + 8 * (quad & 1);
    const bf16_t* bp = W1 + ((size_t)(lg * 128 + 32 * nq + fr) * 1024 + 8 * quad);
    u32x4 av[8];
#pragma unroll
    for (int i = 0; i < 8; ++i) av[i] = *(const u32x4*)(ap + (size_t)(2 * (nq + 4 * i)) * NIN);
    bf16x8 bq0[16], bq1[16];
#pragma unroll
    for (int i = 0; i < 16; ++i) { bq0[i] = *(const bf16x8*)(bp + 32 * i); bq1[i] = *(const bf16x8*)(bp + 16 * 1024 + 32 * i); }
    __builtin_amdgcn_sched_barrier(0);
    __syncthreads();
    LAS unsigned char* at = lds + hsel * 32768;
#pragma unroll
    for (int i = 0; i < 8; ++i) *(LAS u32x4*)(at + ((nq + 4 * i) * 64 + lane) * 16) = av[i];
    __syncthreads();
    f32x4 acc0 = {0.f, 0.f, 0.f, 0.f}, acc1 = {0.f, 0.f, 0.f, 0.f};
#pragma unroll
    for (int kk = 0; kk < 32; ++kk) {
        const bf16x8 a = *(const LAS bf16x8*)(at + (kk * 64 + lane) * 16);
        const bf16x8 bc0 = bq0[kk & 15], bc1 = bq1[kk & 15];
        if (kk + 16 < 32) { bq0[kk & 15] = *(const bf16x8*)(bp + 32 * (kk + 16)); bq1[kk & 15] = *(const bf16x8*)(bp + 16 * 1024 + 32 * (kk + 16)); }
        __builtin_amdgcn_sched_barrier(0);
        acc0 = __builtin_amdgcn_mfma_f32_16x16x32_bf16(bc0, a, acc0, 0, 0, 0);
        acc1 = __builtin_amdgcn_mfma_f32_16x16x32_bf16(bc1, a, acc1, 0, 0, 0);
    }
    { float* o = HEND + ((size_t)(mt * 16 + fr) * 16 + g) * 128 + 32 * nq + 4 * quad; *(f32x4*)o = acc0; *(f32x4*)(o + 16) = acc1; }
}
__device__ __forceinline__ void x2_scan(int e, const float* __restrict__ HEND, const float* __restrict__ a64, bf16_t* __restrict__ HST, int layer) {
    const int p = e & 63, g = (e >> 6) & 15, b = e >> 10;
    const float ar = a64[((layer * 16 + g) * 64 + p) * 2], ai = a64[((layer * 16 + g) * 64 + p) * 2 + 1];
    float hr = 0.f, hi = 0.f;
#pragma unroll 1
    for (int c0 = 0; c0 < 128; c0 += 16) {
        float2 he[16];
#pragma unroll
        for (int i = 0; i < 16; ++i) he[i] = *(const float2*)(HEND + ((size_t)(b * 128 + c0 + i) * 16 + g) * 128 + 2 * p);
#pragma unroll
        for (int i = 0; i < 16; ++i) {
            *(unsigned*)(HST + ((size_t)(b * 128 + c0 + i) * 16 + g) * 128 + 2 * p) = cvtpk_s(hr, hi);
            const float nr = ar * hr - ai * hi + he[i].x, ni = ar * hi + ai * hr + he[i].y; hr = nr; hi = ni;
        }
    }
}
template <class ReqFn> __device__ __forceinline__ void x3_item(const ReqFn& req, LAS unsigned char* lds, int wave, int lane, int item, int layer, const bf16_t* __restrict__ proj, const bf16_t* __restrict__ KM, const bf16_t* __restrict__ W3,
                                        const bf16_t* __restrict__ HST, bf16_t* __restrict__ ybpre) {
    const int g = item & 15, mt = item >> 4, lg = layer * 16 + g;
    const int tid = wave * 64 + lane;
    const int fr = lane & 15, quad = lane >> 4;
    const int tlo = 4 * wave, thi = 60 - 4 * wave;
    const u32x4* src = (const u32x4*)(KM + (size_t)lg * 64 * 256);
    const bf16_t* ap = proj + (chunk_row(mt * 16 + fr) + (quad >> 1)) * NIN + COL_U + g * 16 + 8 * (quad & 1);
    const bf16_t* hp = HST + ((size_t)(mt * 16 + fr) * 16 + g) * 128 + 8 * quad;
    const bf16_t* wlo = W3 + ((size_t)(lg * 1024 + tlo * 16 + fr) * 128 + 8 * quad);
    const bf16_t* whi = W3 + ((size_t)(lg * 1024 + thi * 16 + fr) * 128 + 8 * quad);
    u32x4 kv[4], av[4];
#pragma unroll
    for (int i = 0; i < 4; ++i) { kv[i] = src[tid + 512 * i]; av[i] = *(const u32x4*)(ap + (size_t)(2 * (wave + 8 * i)) * NIN); }
    bf16x8 ha[4], wb[16];
#pragma unroll
    for (int kk = 0; kk < 4; ++kk) ha[kk] = *(const bf16x8*)(hp + 32 * kk);
#define S5_W(ti_, kk_) (*(const bf16x8*)(((ti_) < 4 ? wlo + (size_t)(ti_) * 16 * 128 : whi + (size_t)((ti_) - 4) * 16 * 128) + 32 * (kk_)))
#pragma unroll
    for (int kk = 0; kk < 2; ++kk)
#pragma unroll
        for (int ti = 0; ti < 8; ++ti) wb[kk * 8 + ti] = S5_W(ti, kk);
    __builtin_amdgcn_sched_barrier(0);
    req();
    __builtin_amdgcn_sched_barrier(0);
    __syncthreads();
#pragma unroll
    for (int i = 0; i < 4; ++i) { ((LAS u32x4*)lds)[tid + 512 * i] = kv[i]; *(LAS u32x4*)(lds + 36864 + ((wave + 8 * i) * 64 + lane) * 16) = av[i]; }
    if (tid < 32) ((LAS u32x4*)(lds + 32768))[tid] = (u32x4){0u, 0u, 0u, 0u};
    __syncthreads();
    f32x4 acc[8];
#pragma unroll
    for (int i = 0; i < 8; ++i) acc[i] = (f32x4){0.f, 0.f, 0.f, 0.f};
    const int kkmax = (thi + 3) >> 1;
    const int lbase = (fr * 16 + 8 * (quad & 1)) * 2;
    const int kboth = 2 * wave + 1;
#define S5_B(t_, kk_) ({ const int tau_ = (t_) - 2 * (kk_) - (quad >> 1); *(const LAS bf16x8*)(lds + (tau_ < 0 ? 64 : tau_) * 512 + lbase); })
    bf16x8 lE0, lE1, lO0 = S5_B(tlo + 2, 0), lO1 = S5_B(tlo + 3, 0), hE0, hE1, hO0 = S5_B(thi + 2, 0), hO1 = S5_B(thi + 3, 0);
#define S5_MM(i_, a_, b_) acc[i_] = __builtin_amdgcn_mfma_f32_16x16x32_bf16(b_, a_, acc[i_], 0, 0, 0)
#pragma unroll 1
    for (int kk = 0; kk <= kkmax; kk += 2) {
        {
            const bf16x8 a = *(const LAS bf16x8*)(lds + 36864 + (kk * 64 + lane) * 16);
            hE0 = S5_B(thi, kk); hE1 = S5_B(thi + 1, kk);
            if (kk <= kboth) { lE0 = S5_B(tlo, kk); lE1 = S5_B(tlo + 1, kk); S5_MM(0, a, lE0); S5_MM(1, a, lE1); S5_MM(2, a, lO0); S5_MM(3, a, lO1); }
            S5_MM(4, a, hE0); S5_MM(5, a, hE1); S5_MM(6, a, hO0); S5_MM(7, a, hO1);
        }
        if (kk + 1 <= kkmax) {
            const bf16x8 a = *(const LAS bf16x8*)(lds + 36864 + ((kk + 1) * 64 + lane) * 16);
            hO0 = S5_B(thi, kk + 1); hO1 = S5_B(thi + 1, kk + 1);
            if (kk + 1 <= kboth) { lO0 = S5_B(tlo, kk + 1); lO1 = S5_B(tlo + 1, kk + 1); S5_MM(0, a, lO0); S5_MM(1, a, lO1); S5_MM(2, a, lE0); S5_MM(3, a, lE1); }
            S5_MM(4, a, hO0); S5_MM(5, a, hO1); S5_MM(6, a, hE0); S5_MM(7, a, hE1);
        }
    }
#undef S5_MM
#undef S5_B
#pragma unroll
    for (int kk = 0; kk < 2; ++kk)
#pragma unroll
        for (int ti = 0; ti < 8; ++ti) acc[ti] = __builtin_amdgcn_mfma_f32_16x16x32_bf16(wb[kk * 8 + ti], ha[kk], acc[ti], 0, 0, 0);
#pragma unroll
    for (int kk = 0; kk < 2; ++kk)
#pragma unroll
        for (int ti = 0; ti < 8; ++ti) wb[kk * 8 + ti] = S5_W(ti, kk + 2);
    __builtin_amdgcn_sched_barrier(0);
#pragma unroll
    for (int kk = 0; kk < 2; ++kk)
#pragma unroll
        for (int ti = 0; ti < 8; ++ti) acc[ti] = __builtin_amdgcn_mfma_f32_16x16x32_bf16(wb[kk * 8 + ti], ha[kk + 2], acc[ti], 0, 0, 0);
#undef S5_W
#pragma unroll
    for (int ti = 0; ti < 8; ++ti) {
        const int t = ti < 4 ? tlo + ti : thi + ti - 4;
        const size_t row = chunk_row(mt * 16 + fr) + t;
        float z[4];
#pragma unroll
        for (int r = 0; r < 4; r += 2) {
            const float y0 = acc[ti][r], y1 = acc[ti][r + 1];
            const float u0 = 1.5957691216057308f * (y0 + 0.044715f * y0 * y0 * y0), u1 = 1.5957691216057308f * (y1 + 0.044715f * y1 * y1 * y1);
            const float d0 = 1.0f + __expf(-u0), d1 = 1.0f + __expf(-u1), R = __builtin_amdgcn_rcpf(d0 * d1);
            z[r] = y0 * (d1 * R); z[r + 1] = y1 * (d0 * R);
        }
        uint2 w; w.x = cvtpk_s(z[0], z[1]); w.y = cvtpk_s(z[2], z[3]);
        *(uint2*)(ybpre + row * 256 + g * 16 + 4 * quad) = w;
    }
}
}

constexpr int NWAVES = 8;
constexpr int RING_BYTES = 131072, MISC_OFF = RING_BYTES + 320, LDS_BYTES = 147456;
typedef unsigned v4u __attribute__((ext_vector_type(4)));
#define LDS_WAIT() asm volatile("s_waitcnt lgkmcnt(0)" ::: "memory")

struct Args { const float* in[18]; float* out; unsigned char* ws; };

__device__ __forceinline__ void p0_transpose_item(const float* W, int K, int N, bf16_t* WT, LAS float* scr, int item, int lane) {
    const int nblk = N / 32, kb = item / nblk, nb = item % nblk, k0 = 64 * kb, n0 = 32 * nb;
    float wv[32];
#pragma unroll
    for (int i = 0; i < 32; ++i) { const int kk = 2 * i + (lane >> 5); wv[i] = W[(size_t)(k0 + kk) * N + n0 + (lane & 31)]; }
    __builtin_amdgcn_sched_barrier(0);
#pragma unroll
    for (int i = 0; i < 32; ++i) { const int kk = 2 * i + (lane >> 5); scr[kk * 33 + (lane & 31)] = wv[i]; }
    LDS_WAIT();
    const int c = lane & 7;
#pragma unroll
    for (int j = 0; j < 4; ++j) { const int n = (lane >> 3) + 8 * j; const LAS float* s = scr + (8 * c) * 33 + n;
        v4u o; o.x = pk2(s[0 * 33], s[1 * 33]); o.y = pk2(s[2 * 33], s[3 * 33]); o.z = pk2(s[4 * 33], s[5 * 33]); o.w = pk2(s[6 * 33], s[7 * 33]);
        *(v4u*)(WT + (size_t)(n0 + n) * K + k0 + 8 * c) = o; }
    LDS_WAIT();
}
__device__ __forceinline__ void prep_small(int id, const float* a_re, const float* a_im, const float* log_dt, const float* b_re, const float* b_im, const float* hl, float* sm) {
    if (id < DEPTH * 16 * 64) {
        const int lg = id >> 6;
        const double dt = exp((double)log_dt[lg]), ar = a_re[id], ai = a_im[id];
        const double mag = exp(dt * ar); double sn, cs; sincos_d(dt * ai, sn, cs);
        const double are = mag * cs, aim = mag * sn, nr = are - 1.0, ni = aim, den = ar * ar + ai * ai;
        const double zr = (nr * ar + ni * ai) / den, zi = (ni * ar - nr * ai) / den;
        sm[SM_ABAR + id * 2] = (float)are; sm[SM_ABAR + id * 2 + 1] = (float)aim;
        for (int c = 0; c < 16; ++c) {
            const double br = b_re[id * 16 + c], bi = b_im[id * 16 + c];
            sm[SM_BBAR + (id * 16 + c) * 2] = (float)(zr * br - zi * bi);
            sm[SM_BBAR + (id * 16 + c) * 2 + 1] = (float)(zr * bi + zi * br);
        }
    }
    if (id < 256) {
        const float h0 = hl[id], h1 = hl[256 + id], mx = fmaxf(h0, h1), e0 = expf(h0 - mx), e1 = expf(h1 - mx);
        sm[SM_LB + id] = 0.0f; sm[SM_LB + 256 + id] = e1 / (e0 + e1);
    }
}

__device__ __forceinline__ void prep_bbar_one(int e, const float* a_re, const float* a_im, const float* log_dt, const float* b_re, const float* b_im, float* sm) {
    const int id = e >> 4, lg = id >> 6;
    const float ldt = log_dt[lg], arf = a_re[id], aif = a_im[id], brf = b_re[e], bif = b_im[e];
    const double dt = exp((double)ldt), ar = arf, ai = aif;
    const double mag = exp(dt * ar); double sn, cs; sincos_d(dt * ai, sn, cs);
    const double nr = mag * cs - 1.0, ni = mag * sn, den = ar * ar + ai * ai;
    const double zr = (nr * ar + ni * ai) / den, zi = (ni * ar - nr * ai) / den;
    const double br = brf, bi = bif;
    sm[SM_BBAR + e * 2] = (float)(zr * br - zi * bi); sm[SM_BBAR + e * 2 + 1] = (float)(zr * bi + zi * br);
}
__device__ __forceinline__ void prep_abar_one(int id, const float* a_re, const float* a_im, const float* log_dt, const float* hl, float* sm) {
    if (id < DEPTH * 16 * 64) {
        const int lg = id >> 6;
        const double dt = exp((double)log_dt[lg]), ar = a_re[id], ai = a_im[id];
        const double mag = exp(dt * ar); double sn, cs; sincos_d(dt * ai, sn, cs);
        sm[SM_ABAR + id * 2] = (float)(mag * cs); sm[SM_ABAR + id * 2 + 1] = (float)(mag * sn);
    }
    if (id < 256) {
        const float h0 = hl[id], h1 = hl[256 + id], mx = fmaxf(h0, h1), e0 = expf(h0 - mx), e1 = expf(h1 - mx);
        sm[SM_LB + id] = 0.0f; sm[SM_LB + 256 + id] = e1 / (e0 + e1);
    }
}
__device__ __forceinline__ float dot64(const float* qs, const bf16_t* krow) {
    float s = 0.f;
#pragma unroll
    for (int i = 0; i < 8; ++i) {
        const u32x4 v = *(const u32x4*)(krow + i * 8);
#pragma unroll
        for (int j = 0; j < 4; ++j) { s = fmaf(qs[i * 8 + 2 * j], __uint_as_float(v[j] << 16), s); s = fmaf(qs[i * 8 + 2 * j + 1], __uint_as_float(v[j] & 0xffff0000u), s); }
    }
    return s;
}
__device__ __forceinline__ void moba_simple(int gid, int lane, float* scr, const bf16_t* __restrict__ proj, const float* __restrict__ kmean, const float* __restrict__ rel_bias, bf16_t* __restrict__ Y) {
    const int s = gid % SEQ, h = (gid / SEQ) & 3, b = gid / (SEQ * 4);
    float* qs = scr; float* ps = scr + 64;
    const size_t row = (size_t)b * SEQ + s;
    WSYNC();
    qs[lane] = bf2f(proj[row * NIN + COL_QA + h * 64 + lane]);
    WSYNC();
    const int own = s >> 8;
    float g = -INFINITY;
    if (lane < own) { const float* km = kmean + ((b * 4 + h) * 32 + lane) * 64; float a = 0.f; for (int d = 0; d < 64; ++d) a = fmaf(qs[d], km[d], a); g = a; }
    int blk[4]; bool val[4];
#pragma unroll
    for (int t = 0; t < 3; ++t) {
        const float mx = wave_max(g);
        val[t] = mx > -INFINITY;
        const unsigned long long mk = __ballot(g == mx);
        const int idx = val[t] ? (__ffsll((long long)mk) - 1) : own;
        blk[t] = idx;
        if (val[t] && lane == idx) g = -INFINITY;
    }
    blk[3] = own; val[3] = true;
    float lmax = NEGF;
#pragma unroll
    for (int t = 0; t < 4; ++t) {
        for (int i = 0; i < 4; ++i) {
            const int kk = lane + 64 * i, kpos = blk[t] * 256 + kk;
            const bool ok = (t < 3) ? val[t] : (kpos <= s);
            float lg = NEGF;
            if (ok) lg = dot64(qs, proj + ((size_t)b * SEQ + kpos) * NIN + COL_KA + h * 64) * 0.125f + rel_bias[t5_bucket(s - kpos) * 8 + h];
            ps[t * 256 + kk] = lg; lmax = fmaxf(lmax, lg);
        }
    }
    const float mx = wave_max(lmax);
    float lsum = 0.f;
    for (int i = 0; i < 16; ++i) { const float p = expf(ps[lane + 64 * i] - mx); ps[lane + 64 * i] = p; lsum += p; }
    const float tot = wave_sum(lsum);
    WSYNC();
    float acc = 0.f;
#pragma unroll
    for (int t = 0; t < 4; ++t) {
        if (!val[t]) continue;
        const bf16_t* vp = proj + ((size_t)b * SEQ + blk[t] * 256) * NIN + COL_VA + h * 64 + lane;
        const int nk = (t < 3) ? 256 : (s - own * 256 + 1);
        for (int kk = 0; kk < nk; ++kk) acc = fmaf(ps[t * 256 + kk], bf2f(vp[(size_t)kk * NIN]), acc);
    }
    Y[row * DM + h * 64 + lane] = f2bf(acc / tot);
}
__device__ __forceinline__ void dilated_simple(int gid, int lane, float* scr, const bf16_t* __restrict__ proj, const float* __restrict__ rel_bias, bf16_t* __restrict__ Y) {
    const int s = gid % SEQ, h = (gid / SEQ) & 3, b = gid / (SEQ * 4);
    float* qs = scr; float* ps = scr + 64;
    const size_t row = (size_t)b * SEQ + s;
    WSYNC();
    qs[lane] = bf2f(proj[row * NIN + COL_QD + h * 64 + lane]);
    WSYNC();
    float lse[3], ssum[3];
#pragma unroll
    for (int pi = 0; pi < 3; ++pi) {
        const int dil = (pi == 0) ? 1 : (pi == 1) ? 4 : 16;
        float lmax = NEGF;
        for (int i = 0; i < 3; ++i) {
            const int j = lane + 64 * i, kpos = s - j * dil;
            float lg = NEGF;
            if (j <= 128 && kpos >= 0) lg = dot64(qs, proj + ((size_t)b * SEQ + kpos) * NIN + COL_KD + h * 64) * 0.125f + rel_bias[t5_bucket(j * dil) * 8 + 4 + h];
            ps[pi * 192 + j] = lg; lmax = fmaxf(lmax, lg);
        }
        const float mx = wave_max(lmax);
        float lsum = 0.f;
        for (int i = 0; i < 3; ++i) { const int j = lane + 64 * i; const float p = expf(ps[pi * 192 + j] - mx); ps[pi * 192 + j] = p; lsum += p; }
        ssum[pi] = wave_sum(lsum);
        lse[pi] = mx + logf(ssum[pi]);
    }
    WSYNC();
    const float lm = fmaxf(lse[0], fmaxf(lse[1], lse[2]));
    const float w0 = expf(lse[0] - lm), w1 = expf(lse[1] - lm), w2 = expf(lse[2] - lm), wt = w0 + w1 + w2;
    const float wgt[3] = {w0 / wt, w1 / wt, w2 / wt};
    float out = 0.f;
#pragma unroll
    for (int pi = 0; pi < 3; ++pi) {
        const int dil = (pi == 0) ? 1 : (pi == 1) ? 4 : 16;
        float acc = 0.f;
        for (int j = 0; j <= 128; ++j) {
            const int kpos = s - j * dil; if (kpos < 0) break;
            acc = fmaf(ps[pi * 192 + j], bf2f(proj[((size_t)b * SEQ + kpos) * NIN + COL_VD + h * 64 + lane]), acc);
        }
        out += wgt[pi] * acc / ssum[pi];
    }
    Y[row * DM + 768 + h * 64 + lane] = f2bf(out);
}
__device__ __forceinline__ void s5_simple(int b, int g, int lane, float* scr, const bf16_t* __restrict__ proj, const float* __restrict__ sm, const float* __restrict__ c_re, const float* __restrict__ c_im,
                                          const float* __restrict__ dskip, bf16_t* __restrict__ ybpre, int layer) {
    float* hs = scr; float* us = scr + 8192; float* cs = scr + 8192 + 1024;
    const int pid = (layer * 16 + g) * 64 + lane;
    const float are = sm[SM_ABAR + pid * 2], aim = sm[SM_ABAR + pid * 2 + 1];
    float bbr[16], bbi[16];
#pragma unroll
    for (int c = 0; c < 16; ++c) { bbr[c] = sm[SM_BBAR + (pid * 16 + c) * 2]; bbi[c] = sm[SM_BBAR + (pid * 16 + c) * 2 + 1]; }
    for (int c = 0; c < 16; ++c) { cs[(c * 65 + lane) * 2] = c_re[((layer * 16 + g) * 16 + c) * 64 + lane]; cs[(c * 65 + lane) * 2 + 1] = c_im[((layer * 16 + g) * 16 + c) * 64 + lane]; }
    const int oc = lane & 15, otq = lane >> 4;
    const float dsk = dskip[layer * 256 + g * 16 + oc];
    float hr = 0.f, hi = 0.f;
#pragma unroll 1
    for (int t0 = 0; t0 < SEQ; t0 += 64) {
        WSYNC();
#pragma unroll 1
        for (int e = lane; e < 1024; e += 64) { const int t = e >> 4, c = e & 15; us[t * 16 + c] = bf2f(proj[((size_t)b * SEQ + t0 + t) * NIN + COL_U + g * 16 + c]); }
        WSYNC();
#pragma unroll 1
        for (int t = 0; t < 64; ++t) {
            float xr = 0.f, xi = 0.f;
#pragma unroll
            for (int c = 0; c < 16; ++c) { const float u = us[t * 16 + c]; xr = fmaf(bbr[c], u, xr); xi = fmaf(bbi[c], u, xi); }
            const float nr = are * hr - aim * hi + xr, ni = are * hi + aim * hr + xi;
            hr = nr; hi = ni;
            hs[(t * 64 + lane) * 2] = hr; hs[(t * 64 + lane) * 2 + 1] = hi;
        }
        WSYNC();
#pragma unroll 1
        for (int i = 0; i < 16; ++i) {
            const int t = otq + 4 * i;
            float y = 0.f;
#pragma unroll 4
            for (int p = 0; p < 64; ++p) y += hs[(t * 64 + p) * 2] * cs[(oc * 65 + p) * 2] - hs[(t * 64 + p) * 2 + 1] * cs[(oc * 65 + p) * 2 + 1];
            y += dsk * us[t * 16 + oc];
            ybpre[((size_t)b * SEQ + t0 + t) * 256 + g * 16 + oc] = f2bf(gelu_tanh(y));
        }
    }
}
__device__ __forceinline__ void hgrn_simple(int b, int h, int lane, float* scr, const bf16_t* __restrict__ proj, const float* __restrict__ sm, bf16_t* __restrict__ Y, int layer) {
    float* fs = scr; float* qs = scr + 4096; float* is = scr + 8192;
    const float lb = sm[SM_LB + layer * 256 + h * 64 + lane];
    float S[64];
#pragma unroll
    for (int d = 0; d < 64; ++d) S[d] = 0.f;
    for (int t0 = 0; t0 < SEQ; t0 += 64) {
        WSYNC();
        for (int t = 0; t < 64; ++t) {
            const bf16_t* r = proj + ((size_t)b * SEQ + t0 + t) * NIN + h * 64 + lane;
            const float qv = bf2f(r[COL_QC]), fv = bf2f(r[COL_FC]), iv = bf2f(r[COL_IC]);
            fs[t * 64 + lane] = lb + (1.0f - lb) * sigmoidf_(fv); qs[t * 64 + lane] = siluf_(qv) * 0.125f; is[t * 64 + lane] = iv;
        }
        WSYNC();
        for (int t = 0; t < 64; ++t) {
            const float iv = is[t * 64 + lane];
            float o = 0.f;
#pragma unroll
            for (int d = 0; d < 64; ++d) { const float f = fs[t * 64 + d]; S[d] = fmaf(f, S[d] - iv, iv); o = fmaf(qs[t * 64 + d], S[d], o); }
            Y[((size_t)b * SEQ + t0 + t) * DM + 512 + h * 64 + lane] = f2bf(o);
        }
    }
}
__device__ __forceinline__ void unpack16(const bf16_t* p, float* v) {
    const u32x4 y0 = *(const u32x4*)p, y1 = *(const u32x4*)(p + 8);
#pragma unroll
    for (int j = 0; j < 4; ++j) { v[2 * j] = __uint_as_float(y0[j] << 16); v[2 * j + 1] = __uint_as_float(y0[j] & 0xffff0000u); v[8 + 2 * j] = __uint_as_float(y1[j] << 16); v[8 + 2 * j + 1] = __uint_as_float(y1[j] & 0xffff0000u); }
}
using pg8::f32x4;
struct CombLd { u32x4 g0, g1, a0, a1, b0, b1, c0, c1, d0, d1; f32x4 w01, w23; float p1, p2; };
__device__ __forceinline__ void combine_load(CombLd& L, size_t row, int lane, const bf16_t* __restrict__ Y, const bf16_t* __restrict__ proj, const bf16_t* __restrict__ PO, const float* __restrict__ PL, const bf16_t* __restrict__ PARTO, const float* __restrict__ PARTML) {
    const int le = (lane >= 16 && lane < 32) ? lane - 16 : lane;
    const bf16_t* yp = Y + row * DM + le * 16; const bf16_t* gp = proj + row * NIN + COL_G + le * 16;
    const bool is_m = lane < 32, is_d = lane >= 48;
    const int hm = (le >> 2) & 3;
    const bf16_t* s0 = yp; const bf16_t* s1 = yp; const bf16_t* s2 = yp; const bf16_t* s3 = yp;
    if (is_m) { const bf16_t* pb = PARTO + ((row * 4 + hm) * 3) * 64 + (le & 3) * 16; s1 = pb; s2 = pb + 64; s3 = pb + 128; }
    if (is_d) { const bf16_t* pb = PO + row * 256 + (lane - 48) * 16; s0 = pb; s1 = pb + (size_t)M * 256; s2 = pb + 2 * (size_t)M * 256; s3 = pb; }
    const float* wp = is_m ? PARTML + ((row * 4 + hm) * 4) * 2 : PL + row * 4 + hm;
    L.g0 = *(const u32x4*)gp; L.g1 = *(const u32x4*)(gp + 8);
    L.a0 = *(const u32x4*)s0; L.a1 = *(const u32x4*)(s0 + 8); L.b0 = *(const u32x4*)s1; L.b1 = *(const u32x4*)(s1 + 8);
    L.c0 = *(const u32x4*)s2; L.c1 = *(const u32x4*)(s2 + 8); L.d0 = *(const u32x4*)s3; L.d1 = *(const u32x4*)(s3 + 8);
    L.w01 = (f32x4){0.f, 0.f, 0.f, 0.f}; L.w23 = (f32x4){0.f, 0.f, 0.f, 0.f}; L.p1 = 0.f; L.p2 = 0.f;
    if (is_m) { L.w01 = *(const f32x4*)wp; L.w23 = *(const f32x4*)(wp + 4); }
    if (is_d) { L.w01[0] = wp[0]; L.p1 = wp[(size_t)M * 4]; L.p2 = wp[2 * (size_t)M * 4]; }
}
__device__ __forceinline__ void combine_finish(const CombLd& L, size_t row, int lane, bf16_t* __restrict__ Y, const f32x4 (&gn)[4]) {
    bf16_t* yp = Y + row * DM + lane * 16;
    const bool is_m = lane < 16, is_d = lane >= 48, is_s = (lane >= 16) && (lane < 32);
    const f32x4 w01 = L.w01, w23 = L.w23; const float p1 = L.p1, p2 = L.p2;
    float wa = 1.f, wb = 0.f, wc = 0.f, wd = 0.f;
    if (is_m) {
        const int own = (int)((row % SEQ) >> 8);
        const float m3 = w23[2], l3 = w23[3];
        const float m0 = own > 0 ? w01[0] : NEGF, m1 = own > 1 ? w01[2] : NEGF, m2 = own > 2 ? w23[0] : NEGF;
        const float mx = fmaxf(fmaxf(m3, m0), fmaxf(m1, m2));
        wa = l3 * __builtin_amdgcn_exp2f(m3 - mx); wb = own > 0 ? w01[1] * __builtin_amdgcn_exp2f(m0 - mx) : 0.f; wc = own > 1 ? w01[3] * __builtin_amdgcn_exp2f(m1 - mx) : 0.f; wd = own > 2 ? w23[1] * __builtin_amdgcn_exp2f(m2 - mx) : 0.f;
        const float wi = __builtin_amdgcn_rcpf(wa + wb + wc + wd); wa *= wi; wb *= wi; wc *= wi; wd *= wi;
    }
    if (is_d) { const float mx = fmaxf(w01[0], fmaxf(p1, p2)); wa = __expf(w01[0] - mx); wb = __expf(p1 - mx); wc = __expf(p2 - mx); const float wi = __builtin_amdgcn_rcpf(wa + wb + wc); wa *= wi; wb *= wi; wc *= wi; wd = 0.f; }
    float v[16], gt[16];
#define CB_LO(x) __uint_as_float((x) << 16)
#define CB_HI(x) __uint_as_float((x) & 0xffff0000u)
#pragma unroll
    for (int j = 0; j < 4; ++j) {
        v[2 * j] = wa * CB_LO(L.a0[j]) + wb * CB_LO(L.b0[j]) + wc * CB_LO(L.c0[j]) + wd * CB_LO(L.d0[j]);         v[2 * j + 1] = wa * CB_HI(L.a0[j]) + wb * CB_HI(L.b0[j]) + wc * CB_HI(L.c0[j]) + wd * CB_HI(L.d0[j]);
        v[8 + 2 * j] = wa * CB_LO(L.a1[j]) + wb * CB_LO(L.b1[j]) + wc * CB_LO(L.c1[j]) + wd * CB_LO(L.d1[j]);     v[9 + 2 * j] = wa * CB_HI(L.a1[j]) + wb * CB_HI(L.b1[j]) + wc * CB_HI(L.c1[j]) + wd * CB_HI(L.d1[j]);
        gt[2 * j] = CB_LO(L.g0[j]); gt[2 * j + 1] = CB_HI(L.g0[j]); gt[8 + 2 * j] = CB_LO(L.g1[j]); gt[9 + 2 * j] = CB_HI(L.g1[j]);
    }
#undef CB_LO
#undef CB_HI
    float ss = 0.f;
#pragma unroll
    for (int i = 0; i < 16; ++i) ss = fmaf(v[i], v[i], ss);
    ss += __shfl_xor(ss, 1); ss += __shfl_xor(ss, 2);
    const float r = rsqrtf(ss * (1.0f / 64.0f) + RMS_EPS);
    float o[16];
#pragma unroll
    for (int i = 0; i < 16; i += 2) {
        const float da = 1.0f + __expf(-gt[i]), db = 1.0f + __expf(-gt[i + 1]), R = __builtin_amdgcn_rcpf(da * db);
        o[i] = v[i] * r * gn[i >> 2][i & 3] * (gt[i] * (db * R)); o[i + 1] = v[i + 1] * r * gn[(i + 1) >> 2][(i + 1) & 3] * (gt[i + 1] * (da * R)); }
    u32x4 q0, q1;
    q0.x = cvtpk_s(o[0], o[1]); q0.y = cvtpk_s(o[2], o[3]); q0.z = cvtpk_s(o[4], o[5]); q0.w = cvtpk_s(o[6], o[7]);
    q1.x = cvtpk_s(o[8], o[9]); q1.y = cvtpk_s(o[10], o[11]); q1.z = cvtpk_s(o[12], o[13]); q1.w = cvtpk_s(o[14], o[15]);
    if (!is_s) { *(u32x4*)yp = q0; *(u32x4*)(yp + 8) = q1; }
}
__device__ __forceinline__ void layernorm_row(size_t row, int lane, float* __restrict__ z, bf16_t* __restrict__ xb, const float* __restrict__ lg, const float* __restrict__ lbias) {
    float4* zp = (float4*)(z + row * DM) + lane;
    float4 v[4]; float s = 0.f;
#pragma unroll
    for (int j = 0; j < 4; ++j) { v[j] = zp[64 * j]; s += (v[j].x + v[j].y) + (v[j].z + v[j].w); }
    const float mean = wave_sum(s) * (1.0f / DM); float q = 0.f;
#pragma unroll
    for (int j = 0; j < 4; ++j) { v[j].x -= mean; v[j].y -= mean; v[j].z -= mean; v[j].w -= mean; q += (v[j].x * v[j].x + v[j].y * v[j].y) + (v[j].z * v[j].z + v[j].w * v[j].w); }
    const float rstd = rsqrtf(wave_sum(q) * (1.0f / DM) + LN_EPS);
#pragma unroll
    for (int j = 0; j < 4; ++j) {
        const float4 gg = ((const float4*)lg)[lane + 64 * j], bb = ((const float4*)lbias)[lane + 64 * j];
        float4 o; o.x = v[j].x * rstd * gg.x + bb.x; o.y = v[j].y * rstd * gg.y + bb.y; o.z = v[j].z * rstd * gg.z + bb.z; o.w = v[j].w * rstd * gg.w + bb.w;
        zp[64 * j] = o;
        uint2 ob; ob.x = pk2(o.x, o.y); ob.y = pk2(o.z, o.w);
        ((uint2*)(xb + row * DM))[lane + 64 * j] = ob;
    }
}

struct PrepPtrs { const float *w_in, *w_out, *glu_w, *a_re, *a_im, *log_dt, *b_re, *b_im, *c_re, *c_im, *dskip; unsigned char* ws; };
__device__ __forceinline__ void prep_layer(LAS unsigned char* ldsl, PrepPtrs p, int l, int bxr, int nbr) {
    const int lane = lane_id_opaque(), wave = __builtin_amdgcn_readfirstlane((int)threadIdx.x >> 6), tid = wave * 64 + lane;
    LAS float* scr = (LAS float*)(ldsl + wave * 16384);
    constexpr int I_IN = (DM / 64) * (NIN / 32), I_OUT = (DM / 64) * (DM / 32), I_GLU = (BW / 64) * (BW / 32), I_L = I_IN + I_OUT + I_GLU;
    if (l == 0)
    for (int it0 = bxr * NWAVES + wave; it0 < 2 * I_L; it0 += nbr * NWAVES) { const int lt = it0 >= I_L ? 1 : 0; int r = it0 - lt * I_L;
        if (r < I_IN) { p0_transpose_item(p.w_in + (size_t)lt * DM * NIN, DM, NIN, (bf16_t*)(p.ws + WS_WTIN) + (size_t)lt * NIN * DM, scr, r, lane); continue; } r -= I_IN;
        if (r < I_OUT) { p0_transpose_item(p.w_out + (size_t)lt * DM * DM, DM, DM, (bf16_t*)(p.ws + WS_WTOUT) + (size_t)lt * DM * DM, scr, r, lane); continue; } r -= I_OUT;
        p0_transpose_item(p.glu_w + (size_t)lt * BW * BW, BW, BW, (bf16_t*)(p.ws + WS_GLUWT) + (size_t)lt * BW * BW, scr, r, lane); }
    for (int e = l * 65536 + ((bxr + 128 * (1 - l)) % nbr) * 512 + tid; e < (l + 1) * 65536; e += nbr * 512)
        s5::tables_thread(e, p.a_re, p.a_im, p.log_dt, p.b_re, p.b_im, p.c_re, p.c_im, (bf16_t*)(p.ws + WS_W1), (bf16_t*)(p.ws + WS_W3), (float*)(p.ws + WS_SMALL) + SM_A64);
    for (int j = (bxr + 128 * l) % nbr; j < 128; j += nbr)
        s5::kmat_item8((LAS float*)ldsl, tid, l * 128 + j, p.a_re, p.a_im, p.log_dt, p.b_re, p.b_im, p.c_re, p.c_im, p.dskip, (bf16_t*)(p.ws + WS_KM));
}

#define OPQS(x) asm volatile("" : "+s"(x))
#define OPQ(x) asm volatile("" : "+v"(x))
__global__ void __launch_bounds__(NWAVES * 64, 2) mega_fwd(Args args) {
    extern __shared__ __attribute__((aligned(16))) unsigned char lds[];
#define LANE_ID() ({ unsigned z_ = 0u; asm volatile("" : "+v"(z_)); (int)__builtin_amdgcn_mbcnt_hi(~0u, __builtin_amdgcn_mbcnt_lo(~0u, z_)); })
#define TID_() (wave * 64 + LANE_ID())
#define tid_ TID_()
#define lane_ LANE_ID()
    const int wave = __builtin_amdgcn_readfirstlane((int)threadIdx.x >> 6);
    const int G = gridDim.x, bx = blockIdx.x, bx_ = bx;
    LAS unsigned char* ldsl = (LAS unsigned char*)lds;
    volatile LAS unsigned* MISC = (volatile LAS unsigned*)(ldsl + MISC_OFF);
    for (int u = tid_; u < (LDS_BYTES - RING_BYTES) / 4; u += NWAVES * 64) ((LAS unsigned*)(ldsl + RING_BYTES))[u] = 0u;
    __syncthreads();
    const XcdBarrier bar = xcd_barrier_post((unsigned*)(args.ws + WS_CTL) + CW_BAR, MISC + 8);
    const int gw = bx * NWAVES + wave, NGW = G * NWAVES;
#ifdef PROBE_A
#ifndef PROBE_BLK
#define PROBE_BLK 0
#endif
#ifndef PROBE_OFF
#define PROBE_OFF 0
#endif
#define STAMP(k) do { if (bx_ == PROBE_BLK && threadIdx.x == 0) MISC[16 + (k)] = (unsigned)__builtin_amdgcn_s_memrealtime(); } while (0)
#else
#define STAMP(k) do { } while (0)
#endif
#define SUBSTAMP(k) STAMP(32 + (k))
    int stamp_i = 0;
#define GRID_BAR() do { GRID_BAR0(); ++stamp_i; STAMP(stamp_i); } while (0)
    constexpr int DIL_QA = 768, DIL_QB = 1024;
#define DIL_UNIT(park_, req_, tidq_, ug_, ws_) do { const int ug__ = (ug_); fa2::dilated_unit(park_, req_, ldsl, tidq_, 2 - ug__ / 512, (ug__ >> 5) & 15, ug__ & 31, (const bf16_t*)((ws_) + WS_PROJ), (const float*)((ws_) + WS_SMALL) + SM_LUTD, (bf16_t*)((ws_) + WS_PO), (float*)((ws_) + WS_PL)); } while (0)
#define DIL_FILL(wqp_, lo_, hi_, ws_) do { unsigned* wq__ = (wqp_); const int tid__ = wave * 64 + LANE_ID(); __syncthreads(); \
        if (tid__ == 0) MISC[4] = __hip_atomic_fetch_add(wq__, 1u, __ATOMIC_RELAXED, __HIP_MEMORY_SCOPE_AGENT); \
        for (;;) { __syncthreads(); const int it__ = (int)MISC[4]; if (it__ >= (hi_) - (lo_)) break; unsigned nxt__ = 0u; int tidq__ = tid__; OPQ(tidq__); \
            auto req__ = [&]() { if (tidq__ == 0) nxt__ = __hip_atomic_fetch_add(wq__, 1u, __ATOMIC_RELAXED, __HIP_MEMORY_SCOPE_AGENT); }; \
            auto park__ = [&]() { if (tidq__ == 0) MISC[4] = nxt__; }; DIL_UNIT(park__, req__, tidq__, (lo_) + it__, ws_); } } while (0)
#define GRID_BAR0() do { XcdBarrier b_ = bar; unsigned x_ = b_.x; unsigned* p_ = b_.bar; asm volatile("" : "+s"(x_), "+s"(p_)); b_.x = x_; b_.bar = p_; xcd_barrier(b_); } while (0)

    STAMP(0);
    {
        const Args* A = &args; unsigned char* ws = launder_g(args.ws);
        int lane = lane_, tid = tid_; OPQ(lane); OPQ(tid);
        const float* x = A->in[0]; const float* w_in = A->in[1]; const float* glu_w = A->in[11]; const float* w_out = A->in[15];
        bf16_t* wtin = (bf16_t*)(ws + WS_WTIN); bf16_t* wtout = (bf16_t*)(ws + WS_WTOUT); bf16_t* gluwt = (bf16_t*)(ws + WS_GLUWT); bf16_t* xb = (bf16_t*)(ws + WS_XB);
        for (size_t i = (size_t)bx * 512 + tid; i < (size_t)M * DM / 4; i += (size_t)G * 512 * 8) {
            float4 v[8];
#pragma unroll
            for (int j = 0; j < 8; ++j) v[j] = ((const float4*)x)[i + (size_t)j * G * 512];
            __builtin_amdgcn_sched_barrier(0);
#pragma unroll
            for (int j = 0; j < 8; ++j) { uint2 o; o.x = cvtpk_s(v[j].x, v[j].y); o.y = cvtpk_s(v[j].z, v[j].w); ((uint2*)xb)[i + (size_t)j * G * 512] = o; }
        }
        { PrepPtrs pp{A->in[1], A->in[15], A->in[11], A->in[3], A->in[4], A->in[5], A->in[6], A->in[7], A->in[8], A->in[9], A->in[10], ws}; prep_layer(ldsl, pp, 0, bx, G); prep_layer(ldsl, pp, 1, bx, G); }
        SUBSTAMP(8);
        SUBSTAMP(9);
        if (bx >= 30 && bx < 94) prep_bbar_one((bx - 30) * 512 + tid, A->in[3], A->in[4], A->in[5], A->in[6], A->in[7], (float*)(ws + WS_SMALL));
        if (bx >= 94 && bx < 98) prep_abar_one((bx - 94) * 512 + tid, A->in[3], A->in[4], A->in[5], A->in[13], (float*)(ws + WS_SMALL));
        if (bx >= 98 && bx < 102) { float* smc = (float*)(ws + WS_SMALL); const int i = (bx - 98) * 512 + tid;
            if (i < 256) smc[SM_RELB + i] = A->in[2][i];
            if (i < 512) smc[SM_GLUB + i] = A->in[12][i];
            smc[SM_GAIN + i] = A->in[14][i]; smc[SM_LNG + i] = A->in[16][i]; smc[SM_LNB + i] = A->in[17][i]; }
        if (bx >= 9 && bx < 9 + 21) {
            float* smc = (float*)(ws + WS_SMALL); const float* rb = A->in[2];
            const int i = (bx - 9) * 512 + tid;
            if (i < 4 * 1888) { const int h = i / 1888, dd = i % 1888 - 96; smc[SM_LUTM + i] = dd >= 0 ? rb[t5_bucket(dd) * 8 + h] * 1.4426950408889634f : NEGF; }
            else if (i < 4 * 1888 + 3 * 4 * 256) { const int i2 = i - 4 * 1888, pi = i2 >> 10, h = (i2 >> 8) & 3, dd = (i2 & 255) - 64, dil = (pi == 0) ? 1 : (pi == 1) ? 4 : 16;
                smc[SM_LUTD + i2] = (dd >= 0 && dd <= 128) ? rb[t5_bucket(dd * dil) * 8 + 4 + h] * 1.4426950408889634f : NEGF; } }
    }
    GRID_BAR();

    auto layer_body = [&](auto LC) __attribute__((always_inline)) { constexpr int l = decltype(LC)::value;
        {
            const Args* A = &args; unsigned char* ws = launder_g(args.ws);
            pg8::Gemm g{(const bf16_t*)(ws + WS_XB), (const bf16_t*)(ws + WS_WTIN) + (size_t)l * NIN * DM, M, NIN, DM}; int tidg = tid_, bxg = bx; OPQ(tidg); OPQS(bxg); pg8::StaticOrder S; S.init(M, NIN, G, bxg);
            pg8::EpiStoreBf16 E{(bf16_t*)(ws + WS_PROJ), NIN, (float*)(ws + WS_KP)};
            pg8::gemm_phase<pg8::EpiStoreBf16, pg8::StaticOrder, true, true>(ldsl, g, S, E, tidg);
        }
        GRID_BAR();
        {
            const Args* A = &args; unsigned char* ws = launder_g(args.ws);
            const bf16_t* proj = (const bf16_t*)(ws + WS_PROJ);
            int lane = lane_; OPQ(lane); const int tid = wave * 64 + lane;
            unsigned char* sx = (unsigned char*)launder_g(args.out);
            const float* lbp = (const float*)(ws + WS_SMALL) + SM_LB + l * 256;
            unsigned* wq = (unsigned*)(ws + WS_CTL) + CW_WQ + 64 * l;
            bool s5_todo = true;
            auto s5_items = [&]() { if (s5_todo) { s5_todo = false;
                for (int it = bx_; it < 256; it += G)
                    s5::x1_block(ldsl, wave, lane, it & 15, it >> 4, l * 16 + (it & 15), proj, (const bf16_t*)(ws + WS_W1), (float*)(ws + WS_HEND));
                __syncthreads(); } };
            for (int it = gw; it < 2048; it += NGW) hw::x1_wave(s5_items, ldsl + wave * 16384, lane, it, proj, lbp, (float*)(ws + WS_DS), (float*)(ws + WS_DEC));
            s5_items();
            SUBSTAMP(0);
            SUBSTAMP(1);
            constexpr int N_GATE2 = 256;
            for (int it = bx_; it < N_GATE2; it += G) {
                int tidq = tid; OPQ(tidq);
                fa2::gate_item(ldsl, tidq, it & 15, 31 - (it >> 4), 15 - (it >> 4), proj, (const float*)(ws + WS_KP), (unsigned short*)(sx + (WS_LIST - WS_XB)), (int*)(ws + WS_CTL) + CW_CNT + l * 512, (bf16_t*)(sx + (WS_PARTO - WS_XB)));
            }
            SUBSTAMP(2);
            DIL_FILL((unsigned*)(ws + WS_CTL) + CW_WQ + 64 * (4 + l), 0, DIL_QA, ws);
            SUBSTAMP(7);
        }
        GRID_BAR();
        {
            const Args* A = &args; unsigned char* ws = launder_g(args.ws);
            const bf16_t* proj = (const bf16_t*)(ws + WS_PROJ); const float* sm = (const float*)(ws + WS_SMALL);
            unsigned char* sx = (unsigned char*)launder_g(args.out);
            int lane = lane_; OPQ(lane);
            int bx = bx_; OPQS(bx);
            const int tid = wave * 64 + lane;
            if (bx < 32) hg::x2_scan(bx * 512 + tid, 32 * 512, (const float*)(ws + WS_DS), (const float*)(ws + WS_DEC), (bf16_t*)(ws + WS_ST));
            else if (bx < 40) s5::x2_scan((bx - 32) * 512 + tid, (const float*)(ws + WS_HEND), sm + SM_A64, (bf16_t*)(ws + WS_HST), l);
            unsigned* wq = (unsigned*)(ws + WS_CTL) + CW_WQ + 64 * (2 + l);
            unsigned* sflag = (unsigned*)(ws + WS_CTL) + CW_WQ + 64 * (10 + l);
            const float* lutm = sm + SM_LUTM; const float* lutd = sm + SM_LUTD;
            const float* lbp = sm + SM_LB + l * 256;
            if (bx < 40) {
                asm volatile("s_waitcnt vmcnt(0)" ::: "memory"); __syncthreads();
                if (tid == 0) { __builtin_amdgcn_fence(__ATOMIC_RELEASE, "agent"); asm volatile("s_waitcnt vmcnt(0)" ::: "memory"); __hip_atomic_fetch_add(sflag, 1u, __ATOMIC_RELAXED, __HIP_MEMORY_SCOPE_AGENT); }
            }
            bool scans_seen = false;
            int pre_it = -1, pre_cj = 0;
#define MOBA_DEC(it_, n_, part_, np_) do { n_ = (it_) >> 4; part_ = 0; np_ = 1; } while (0)
            constexpr int N_MOBA = 32 * 16, N_S5X = 512, N_HGX = 256, N_DIL = 1536 - DIL_QA;
            __syncthreads();
            if (wave == 0 && LANE_ID() == 0) MISC[4] = __hip_atomic_fetch_add(wq, 1u, __ATOMIC_RELAXED, __HIP_MEMORY_SCOPE_AGENT);
#define XQ_HEAD(limit_) __syncthreads(); const int it = (int)MISC[4]; if (it >= (limit_)) break; int tidq = wave * 64 + LANE_ID(); OPQ(tidq); unsigned nxt = 0u; \
                auto req = [&]() { if (tidq == 0) nxt = __hip_atomic_fetch_add(wq, 1u, __ATOMIC_RELAXED, __HIP_MEMORY_SCOPE_AGENT); }; auto park = [&]() { if (tidq == 0) MISC[4] = nxt; };
            for (;;) {
                XQ_HEAD(N_MOBA);
                SUBSTAMP(10);
                int n, part, np;
                MOBA_DEC(it, n, part, np);
                const int bhq = it & 15;
                const int* cntp = (const int*)(ws + WS_CTL) + CW_CNT + l * 512;
                int cj = pre_cj;
                if (pre_it != it) cj = cntp[bhq * 32 + n];
                auto nexth = [&]() { const int nit = (int)MISC[4]; pre_it = nit; pre_cj = 0;
                    if (nit < N_MOBA) { int n2, p2, np2; MOBA_DEC(nit, n2, p2, np2); (void)p2; (void)np2; pre_cj = cntp[(nit & 15) * 32 + n2]; } };
                fa2::moba_item(park, nexth, req, cj, ldsl, tidq, bhq, n, part, np, proj, sm + SM_RELB, lutm, (const unsigned short*)(sx + (WS_LIST - WS_XB)), (bf16_t*)(sx + (WS_PARTO - WS_XB)), (float*)(sx + (WS_PARTML - WS_XB)), (bf16_t*)(ws + WS_Y));
            }
            for (;;) {
                XQ_HEAD(N_MOBA + N_S5X + N_HGX);
                if (it < N_MOBA + N_S5X) SUBSTAMP(11); else SUBSTAMP(12);
                if (!scans_seen) {
                    if (tidq == 0) { unsigned sp = 0; while (__hip_atomic_load(sflag, __ATOMIC_RELAXED, __HIP_MEMORY_SCOPE_AGENT) < 40u) { __builtin_amdgcn_s_sleep(4); if (++sp > (1u << 24)) break; }
                        __builtin_amdgcn_fence(__ATOMIC_ACQUIRE, "agent"); asm volatile("s_waitcnt vmcnt(0)" ::: "memory"); }
                    scans_seen = true;
                }
                __syncthreads();
                if (it < N_MOBA + N_S5X) s5::x3_item(req, ldsl, wave, tidq & 63, it - N_MOBA, l, proj, (const bf16_t*)(ws + WS_KM), (const bf16_t*)(ws + WS_W3), (const bf16_t*)(ws + WS_HST), (bf16_t*)(ws + WS_YBPRE));
                else hw::x3_wave(req, ldsl + wave * 16384, tidq & 63, (it - N_MOBA - N_S5X) * 8 + wave, proj, lbp, (const bf16_t*)(ws + WS_ST), (bf16_t*)(ws + WS_Y));
                park();
            }
            for (;;) {
                XQ_HEAD(N_MOBA + N_S5X + N_HGX + N_DIL);
                SUBSTAMP(13);
                DIL_UNIT(park, req, tidq, DIL_QA + it - (N_MOBA + N_S5X + N_HGX), ws);
            }
#undef XQ_HEAD
            SUBSTAMP(5);
        }
        GRID_BAR();
        {
            const Args* A = &args; unsigned char* ws = launder_g(args.ws);
            unsigned char* sx = (unsigned char*)launder_g(args.out);
            {
                const bf16_t* ybpre = (const bf16_t*)(ws + WS_YBPRE);
                pg8::Gemm g{ybpre, (const bf16_t*)(ws + WS_GLUWT) + (size_t)l * BW * BW, M, BW, BW}; int tidg = tid_, bxg = bx; OPQ(tidg); OPQS(bxg); pg8::StaticOrder S; S.init(M, BW, G, bxg);
                const float* smp = (const float*)(ws + WS_SMALL);
                pg8::EpiGluNorm E{(bf16_t*)(ws + WS_Y), ybpre, (const bf16_t*)(ws + WS_PROJ), smp + SM_GLUB + l * BW, smp + SM_GAIN + l * DM, ldsl + RING_BYTES + 1024};
                pg8::gemm_phase<pg8::EpiGluNorm, pg8::StaticOrder, true, false>(ldsl, g, S, E, tidg);
            }
            {
                int lane = lane_; OPQ(lane);
                unsigned* wq = (unsigned*)(ws + WS_CTL) + CW_WQ + 64 * (8 + l);
                __syncthreads();
                if (wave == 0 && lane == 0) MISC[4] = __hip_atomic_fetch_add(wq, 1u, __ATOMIC_RELAXED, __HIP_MEMORY_SCOPE_AGENT);
                for (;;) {
                    __syncthreads();
                    const int ch = (int)MISC[4];
                    if (ch >= M / 32) break;
                    __syncthreads();
                    unsigned nxt = 0u; int l0q = lane; OPQ(l0q);
                    {
                        const float* gnp = (const float*)(ws + WS_SMALL) + SM_GAIN + l * DM + lane * 16;
                        const f32x4 gn[4] = {*(const f32x4*)gnp, *(const f32x4*)(gnp + 4), *(const f32x4*)(gnp + 8), *(const f32x4*)(gnp + 12)};
#define CMB_LD(L_, row_) combine_load(L_, (row_), lane, (const bf16_t*)(ws + WS_Y), (const bf16_t*)(ws + WS_PROJ), (const bf16_t*)(ws + WS_PO), (const float*)(ws + WS_PL), (const bf16_t*)(sx + (WS_PARTO - WS_XB)), (const float*)(sx + (WS_PARTML - WS_XB)))
                        const size_t row0 = (size_t)ch * 32 + wave * 4;
                        CombLd L0, L1, L2;
                        CMB_LD(L0, row0); CMB_LD(L1, row0 + 1); CMB_LD(L2, row0 + 2);
#define CMB_FIN(L_, r_) do { __builtin_amdgcn_sched_barrier(0); combine_finish(L_, row0 + (r_), lane, (bf16_t*)(ws + WS_Y), gn); if ((r_) + 3 < 4) CMB_LD(L_, row0 + (r_) + 3); } while (0)
                        CMB_FIN(L0, 0);
                        __builtin_amdgcn_sched_barrier(0);
                        if (wave == 0 && l0q == 0) nxt = __hip_atomic_fetch_add(wq, 1u, __ATOMIC_RELAXED, __HIP_MEMORY_SCOPE_AGENT);
                        CMB_FIN(L1, 1); CMB_FIN(L2, 2); CMB_FIN(L0, 3);
#undef CMB_FIN
#undef CMB_LD
                    }
                    if (wave == 0 && l0q == 0) MISC[4] = nxt;
                }
            }
        }
        GRID_BAR();
        {
            const Args* A = &args; unsigned char* ws = launder_g(args.ws);
            pg8::Gemm g{(const bf16_t*)(ws + WS_Y), (const bf16_t*)(ws + WS_WTOUT) + (size_t)l * DM * DM, M, DM, DM}; int tidg = tid_, bxg = bx; OPQ(tidg); OPQS(bxg); pg8::StaticOrder S; S.init(M, DM, G, bxg);
            const float* smp = (const float*)(ws + WS_SMALL);
            float* outp = launder_g(args.out); const float* resp = launder_g(args.in[0]);
            pg8::EpiResLn<l> E{resp, outp, (bf16_t*)(ws + WS_XB), smp + SM_LNG + l * DM, smp + SM_LNB + l * DM, (unsigned long long*)(ws + WS_YBPRE), (unsigned*)(ws + WS_CTL) + CW_SEAM + l * 128 * 64, ldsl + RING_BYTES + 1024};
            pg8::gemm_phase<pg8::EpiResLn<l>, pg8::StaticOrder, true, true>(ldsl, g, S, E, tidg);
        }
        if (l + 1 < DEPTH) GRID_BAR();
    };
    layer_body(std::integral_constant<int, 0>{});
    layer_body(std::integral_constant<int, 1>{});
#ifdef PROBE_A
    ++stamp_i; STAMP(stamp_i);
    if (bx_ == PROBE_BLK && threadIdx.x == 0) { asm volatile("s_waitcnt vmcnt(0) lgkmcnt(0)" ::: "memory"); args.out[0] += ((float)(MISC[16 + PROBE_B] - MISC[16 + PROBE_A]) - (float)PROBE_OFF) * 1e-3f; }
#endif
}

extern "C" void kernel_launch(void* const* d_in, const int* in_sizes, int n_in, void* d_out, int out_size, void* d_ws, size_t ws_size, hipStream_t stream) {
    static int grid = 0;
    if (grid == 0) {
        if (n_in != 18 || in_sizes[0] != M * DM || out_size != M * DM || ws_size < WS_END) { fprintf(stderr, "kernel_launch: unexpected shapes (n_in %d, in0 %d, out %d, ws %zu)\n", n_in, n_in > 0 ? in_sizes[0] : -1, out_size, ws_size); grid = -1; return; }
        int dev = 0, cus = 0, per_cu = 0;
        if (hipGetDevice(&dev) != hipSuccess || hipDeviceGetAttribute(&cus, hipDeviceAttributeMultiprocessorCount, dev) != hipSuccess) { grid = -1; return; }
        if (hipFuncSetAttribute((const void*)mega_fwd, hipFuncAttributeMaxDynamicSharedMemorySize, LDS_BYTES) != hipSuccess) { fprintf(stderr, "kernel_launch: hipFuncSetAttribute failed\n"); grid = -1; return; }
        if (hipOccupancyMaxActiveBlocksPerMultiprocessor(&per_cu, (const void*)mega_fwd, NWAVES * 64, LDS_BYTES) != hipSuccess || per_cu < 1) { fprintf(stderr, "kernel_launch: occupancy query says %d\n", per_cu); }
        (void)hipGetLastError();
        grid = cus;
    }
    if (grid < 0) return;
    if (hipMemsetAsync((char*)d_ws + WS_CTL, 0, CTL_ZERO_BYTES, stream) != hipSuccess) return;
    Args a{};
    for (int i = 0; i < 18; ++i) a.in[i] = (const float*)d_in[i];
    a.out = (float*)d_out; a.ws = (unsigned char*)d_ws;
    hipLaunchKernelGGL(mega_fwd, dim3(grid), dim3(NWAVES * 64), LDS_BYTES, stream, a);
}
```
